# Optimizing an MI355X kernel written in HIP

```python
import math
import jax
import jax.numpy as jnp
from jax import lax
import numpy as np

D_MODEL = 2048
BATCH = 1
SEQ = 16384
DEPTH = 2

N_EVEN = (DEPTH + 1) // 2
N_ODD = DEPTH // 2
RMS_EPS = 1e-6
LN_EPS = 1e-5
NEG_INF = -1e30

CONV_DIM = D_MODEL // 2
CONV_WIDTH = 31
DIL_HEAD_DIM = 64
DIL_HEADS = (D_MODEL // 2) // DIL_HEAD_DIM
DIL_DIM = DIL_HEADS * DIL_HEAD_DIM
DIL_CONFIGS = ((128, 1), (512, 4), (2048, 16))
DIL_HALF = DIL_CONFIGS[0][0] // (2 * DIL_CONFIGS[0][1])
N_BUCKETS = 32
T5_MAX_DIST = DIL_CONFIGS[-1][0] // 2
MLA_HEADS = 12
Q_LORA = 512
KV_LORA = 128
NOPE_DIM = 128
ROPE_DIM = 64
V_DIM = 128
ROPE_BASE = 10000.0
Q_BLOCK = 128
S5_DIM = D_MODEL // 4
S5_GROUP = 16
S5_GROUPS = S5_DIM // S5_GROUP
S5_STATE = 64
EVEN_IN = 2 * CONV_DIM + 3 * DIL_DIM
EVEN_MIX = CONV_DIM + DIL_DIM
ODD_IN = Q_LORA + KV_LORA + ROPE_DIM + S5_DIM
ODD_MIX = MLA_HEADS * V_DIM + S5_DIM
F_DENSE = 5632
N_EXPERTS = 8
TOP_K = 2
F_EXPERT = 7168

kernel_name = 'hybrid_conv_dilattn_mla_s5_moe_encoder'


def rms_norm(x, g):
    xf = x.astype(jnp.float32)
    y = xf * lax.rsqrt(jnp.mean(xf * xf, axis=-1, keepdims=True) + RMS_EPS)
    return (y * g.astype(jnp.float32)).astype(x.dtype)


def layer_norm(x, g, b):
    xf = x.astype(jnp.float32)
    mu = jnp.mean(xf, axis=-1, keepdims=True)
    var = jnp.mean(jnp.square(xf - mu), axis=-1, keepdims=True)
    y = (xf - mu) * lax.rsqrt(var + LN_EPS)
    return (y * g.astype(jnp.float32) + b.astype(jnp.float32)).astype(x.dtype)


def modulate(h, shift, scale):
    return h * (1 + scale) + shift


def swiglu(h, w1, w3, w2):
    return (jax.nn.silu(h @ w1) * (h @ w3)) @ w2


def t5_bucket(rel):
    half = N_BUCKETS // 2
    exact = half // 2
    n = jnp.abs(rel)
    large = exact + (jnp.log(jnp.maximum(n, 1).astype(jnp.float32) / exact)
                     / math.log(T5_MAX_DIST / exact) * (half - exact)).astype(jnp.int32)
    large = jnp.minimum(large, half - 1)
    return jnp.where(rel > 0, half, 0) + jnp.where(n < exact, n, large)


def band_attention(q, k, v, bias):
    n, length, nh, hd = q.shape
    blk = DIL_HALF
    nb = -(-length // blk)
    pad = nb * blk - length
    q = jnp.pad(q, ((0, 0), (0, pad), (0, 0), (0, 0)))
    k = jnp.pad(k, ((0, 0), (blk, pad + blk), (0, 0), (0, 0)))
    v = jnp.pad(v, ((0, 0), (blk, pad + blk), (0, 0), (0, 0)))
    qb = q.reshape(n, nb, blk, nh, hd)
    kb = k.reshape(n, nb + 2, blk, nh, hd)
    vb = v.reshape(n, nb + 2, blk, nh, hd)
    kw = jnp.concatenate([kb[:, :-2], kb[:, 1:-1], kb[:, 2:]], axis=2)
    vw = jnp.concatenate([vb[:, :-2], vb[:, 1:-1], vb[:, 2:]], axis=2)
    s = jnp.einsum('nbqhd,nbkhd->nbhqk', qb, kw) * (hd ** -0.5) + bias
    qpos = (jnp.arange(nb) * blk)[:, None] + jnp.arange(blk)
    kpos = (jnp.arange(nb) * blk - blk)[:, None] + jnp.arange(3 * blk)
    dist = kpos[:, None, :] - qpos[:, :, None]
    valid = (jnp.abs(dist) <= blk) & (kpos[:, None, :] >= 0) & (kpos[:, None, :] < length)
    s = jnp.where(valid[None, :, None], s, NEG_INF)
    m = jnp.max(s, axis=-1, keepdims=True)
    p = jnp.exp(s - m)
    l = jnp.sum(p, axis=-1)
    l = jnp.swapaxes(l, -1, -2)
    o = jnp.einsum('nbhqk,nbkhd->nbqhd', p, vw) / l[..., None]
    m = jnp.swapaxes(m[..., 0], -1, -2)
    return (o.reshape(n, nb * blk, nh, hd)[:, :length],
            m.reshape(n, nb * blk, nh)[:, :length],
            l.reshape(n, nb * blk, nh)[:, :length])


def dilated_attention(q, k, v, t5_table):
    bsz, seq, nh, hd = q.shape
    q, k, v = (t.astype(jnp.float32) for t in (q, k, v))
    slot = jnp.arange(3 * DIL_HALF)[None, :] - DIL_HALF - jnp.arange(DIL_HALF)[:, None]
    outs, maxes, dens = [], [], []
    for _, dil in DIL_CONFIGS:
        sub = seq // dil

        def to_sub(t):
            return t.reshape(bsz, sub, dil, *t.shape[2:]).swapaxes(1, 2).reshape(bsz * dil, sub, *t.shape[2:])

        def from_sub(t):
            return t.reshape(bsz, dil, sub, *t.shape[2:]).swapaxes(1, 2).reshape(bsz, seq, *t.shape[2:])

        bias = jnp.transpose(t5_table[t5_bucket(slot * dil)], (2, 0, 1)).astype(jnp.float32)
        o, m, l = band_attention(to_sub(q), to_sub(k), to_sub(v), bias)
        outs.append(from_sub(o))
        maxes.append(from_sub(m))
        dens.append(from_sub(l))
    o, m, l = jnp.stack(outs), jnp.stack(maxes), jnp.stack(dens)
    w = l * jnp.exp(m - jnp.max(m, axis=0, keepdims=True))
    return jnp.sum(w[..., None] * o, axis=0) / jnp.sum(w, axis=0)[..., None]


def even_mixer(h, t5_table, w_in, conv_w, conv_b, cln_g, cln_b, w_out):
    bsz, seq, _ = h.shape
    z = h @ w_in
    a_val, a_gate, q, k, v = jnp.split(
        z, [CONV_DIM, 2 * CONV_DIM, 2 * CONV_DIM + DIL_DIM, 2 * CONV_DIM + 2 * DIL_DIM], axis=-1)
    a = a_val * jax.nn.sigmoid(a_gate)
    a = lax.conv_general_dilated(
        a, conv_w[:, None, :].astype(a.dtype), window_strides=(1,),
        padding=((CONV_WIDTH // 2, CONV_WIDTH // 2),),
        dimension_numbers=('NWC', 'WIO', 'NWC'), feature_group_count=CONV_DIM) + conv_b
    a = jax.nn.silu(layer_norm(a, cln_g, cln_b))
    o = dilated_attention(q.reshape(bsz, seq, DIL_HEADS, DIL_HEAD_DIM),
                          k.reshape(bsz, seq, DIL_HEADS, DIL_HEAD_DIM),
                          v.reshape(bsz, seq, DIL_HEADS, DIL_HEAD_DIM), t5_table)
    o = o.reshape(bsz, seq, DIL_DIM).astype(h.dtype)
    return jnp.concatenate([a.astype(h.dtype), o], axis=-1) @ w_out


def rope_tables(seq):
    pos = jnp.arange(seq, dtype=jnp.float32)
    inv_freq = ROPE_BASE ** (-jnp.arange(0, ROPE_DIM, 2, dtype=jnp.float32) / ROPE_DIM)
    ang = pos[:, None] * inv_freq[None, :]
    return jnp.cos(ang), jnp.sin(ang)


def apply_rope(x, cos, sin):
    xf = x.astype(jnp.float32)
    x1, x2 = xf[..., :ROPE_DIM // 2], xf[..., ROPE_DIM // 2:]
    return jnp.concatenate([x1 * cos - x2 * sin, x2 * cos + x1 * sin], axis=-1).astype(x.dtype)


def mla_attention(q_nope, q_pe, k_nope, k_pe, v):
    bsz, seq, nh, _ = q_nope.shape
    nq = seq // Q_BLOCK
    scale = (NOPE_DIM + ROPE_DIM) ** -0.5
    k_nope, k_pe, v = (t.astype(jnp.float32) for t in (k_nope, k_pe, v))

    def blocks(t):
        return t.astype(jnp.float32).reshape(bsz, nq, Q_BLOCK, *t.shape[2:]).swapaxes(0, 1)

    def attend(qs):
        qn, qp = qs
        s = (jnp.einsum('bqhd,bkhd->bhqk', qn, k_nope)
             + jnp.einsum('bqhr,bkr->bhqk', qp, k_pe)) * scale
        p = jax.nn.softmax(s, axis=-1)
        return jnp.einsum('bhqk,bkhd->bqhd', p, v)

    o = lax.map(attend, (blocks(q_nope), blocks(q_pe)))
    return o.swapaxes(0, 1).reshape(bsz, seq, nh, V_DIM)


def s5_scan(u, a_re, a_im, log_dt, b_re, b_im, c_re, c_im, reverse):
    A = lax.complex(a_re.astype(jnp.float32), a_im.astype(jnp.float32))
    dt = jnp.exp(log_dt.astype(jnp.float32))[:, None]
    a_bar = jnp.exp(A * dt)
    b_c = lax.complex(b_re.astype(jnp.float32), b_im.astype(jnp.float32))
    b_bar = ((a_bar - 1.0) / A)[..., None] * b_c
    bu = jnp.einsum('bsgc,gpc->bsgp', u.astype(jnp.complex64), b_bar)

    def combine(e1, e2):
        a1, b1 = e1
        a2, b2 = e2
        return a1 * a2, a2 * b1 + b2

    _, xs = lax.associative_scan(combine, (jnp.broadcast_to(a_bar, bu.shape), bu),
                                 reverse=reverse, axis=1)
    c_c = lax.complex(c_re.astype(jnp.float32), c_im.astype(jnp.float32))
    return jnp.real(jnp.einsum('bsgp,gcp->bsgc', xs, c_c))


def odd_mixer(h, w_in, q_norm_g, w_uq, kv_norm_g, w_ukv, a_re, a_im, log_dt,
              b_re, b_im, c_re, c_im, d_skip, w_glu, w_out):
    bsz, seq, _ = h.shape
    z = h @ w_in
    c_q, c_kv, k_pe, u = jnp.split(z, [Q_LORA, Q_LORA + KV_LORA, Q_LORA + KV_LORA + ROPE_DIM], axis=-1)
    q = (rms_norm(c_q, q_norm_g) @ w_uq).reshape(bsz, seq, MLA_HEADS, NOPE_DIM + ROPE_DIM)
    kv = (rms_norm(c_kv, kv_norm_g) @ w_ukv).reshape(bsz, seq, MLA_HEADS, NOPE_DIM + V_DIM)
    cos, sin = rope_tables(seq)
    q_pe = apply_rope(q[..., NOPE_DIM:], cos[:, None, :], sin[:, None, :])
    k_pe = apply_rope(k_pe, cos, sin)
    o_mla = mla_attention(q[..., :NOPE_DIM], q_pe, kv[..., :NOPE_DIM], k_pe, kv[..., NOPE_DIM:])
    o_mla = o_mla.reshape(bsz, seq, MLA_HEADS * V_DIM).astype(h.dtype)
    uf = u.astype(jnp.float32)
    ug = uf.reshape(bsz, seq, S5_GROUPS, S5_GROUP)
    y = (s5_scan(ug, a_re[0], a_im[0], log_dt[0], b_re[0], b_im[0], c_re[0], c_im[0], False)
         + s5_scan(ug, a_re[1], a_im[1], log_dt[1], b_re[1], b_im[1], c_re[1], c_im[1], True))
    y = y.reshape(bsz, seq, S5_DIM) + d_skip.astype(jnp.float32) * uf
    y = jax.nn.gelu(y)
    y = y * jax.nn.sigmoid(y @ w_glu.astype(jnp.float32))
    return jnp.concatenate([o_mla, y.astype(h.dtype)], axis=-1) @ w_out


def moe_swiglu(h, router_w, w1, w3, w2):
    logits = (h @ router_w).astype(jnp.float32)
    top_v, top_i = lax.top_k(logits, TOP_K)
    gates = jax.nn.softmax(top_v, axis=-1)
    combine = jnp.sum(jax.nn.one_hot(top_i, N_EXPERTS, dtype=jnp.float32) * gates[..., None], axis=-2)
    combine = combine.astype(h.dtype)
    out = jnp.zeros_like(h)
    for e in range(N_EXPERTS):
        out = out + combine[..., e:e + 1] * swiglu(h, w1[e], w3[e], w2[e])
    return out


def setup_inputs(seed: int = 0) -> dict:
    key = jax.random.key(seed)
    ks = iter(jax.random.split(key, 48))

    def nrm(shape, std):
        return std * jax.random.normal(next(ks), shape, jnp.float32)

    def gain(shape):
        return 1.0 + nrm(shape, 0.05)

    D = D_MODEL
    G, P, Gc = S5_GROUPS, S5_STATE, S5_GROUP
    a_im0 = jnp.pi * jnp.arange(P, dtype=jnp.float32)
    return {
        'x': nrm((BATCH, SEQ, D), 1.0),
        'c': nrm((BATCH, D), 1.0),
        't5_table': nrm((N_BUCKETS, DIL_HEADS), 0.5),
        'norm_g': gain((DEPTH, 4, D)),
        'ada_w': nrm((DEPTH, D, 6 * D), 0.5 * D ** -0.5),
        'ada_b': nrm((DEPTH, 6 * D), 0.02),
        'e_w_in': nrm((N_EVEN, D, EVEN_IN), D ** -0.5),
        'e_conv_w': nrm((N_EVEN, CONV_WIDTH, CONV_DIM), CONV_WIDTH ** -0.5),
        'e_conv_b': nrm((N_EVEN, CONV_DIM), 0.02),
        'e_cln_g': gain((N_EVEN, CONV_DIM)),
        'e_cln_b': nrm((N_EVEN, CONV_DIM), 0.02),
        'e_w_out': nrm((N_EVEN, EVEN_MIX, D), EVEN_MIX ** -0.5),
        'e_ffn_w1': nrm((N_EVEN, D, F_DENSE), D ** -0.5),
        'e_ffn_w3': nrm((N_EVEN, D, F_DENSE), D ** -0.5),
        'e_ffn_w2': nrm((N_EVEN, F_DENSE, D), F_DENSE ** -0.5),
        'o_w_in': nrm((N_ODD, D, ODD_IN), D ** -0.5),
        'o_q_norm_g': gain((N_ODD, Q_LORA)),
        'o_w_uq': nrm((N_ODD, Q_LORA, MLA_HEADS * (NOPE_DIM + ROPE_DIM)), Q_LORA ** -0.5),
        'o_kv_norm_g': gain((N_ODD, KV_LORA)),
        'o_w_ukv': nrm((N_ODD, KV_LORA, MLA_HEADS * (NOPE_DIM + V_DIM)), KV_LORA ** -0.5),
        's5_a_re': -0.5 + nrm((N_ODD, 2, G, P), 0.01),
        's5_a_im': a_im0 + nrm((N_ODD, 2, G, P), 0.01),
        's5_log_dt': jax.random.uniform(next(ks), (N_ODD, 2, G), jnp.float32,
                                        math.log(1e-3), math.log(1e-1)),
        's5_b_re': nrm((N_ODD, 2, G, P, Gc), (2 * Gc) ** -0.5),
        's5_b_im': nrm((N_ODD, 2, G, P, Gc), (2 * Gc) ** -0.5),
        's5_c_re': nrm((N_ODD, 2, G, Gc, P), (2 * P) ** -0.5),
        's5_c_im': nrm((N_ODD, 2, G, Gc, P), (2 * P) ** -0.5),
        's5_d': nrm((N_ODD, S5_DIM), 1.0),
        's5_w_glu': nrm((N_ODD, S5_DIM, S5_DIM), S5_DIM ** -0.5),
        'o_w_out': nrm((N_ODD, ODD_MIX, D), ODD_MIX ** -0.5),
        'router_w': nrm((N_ODD, D, N_EXPERTS), D ** -0.5),
        'moe_w1': nrm((N_ODD, N_EXPERTS, D, F_EXPERT), D ** -0.5),
        'moe_w3': nrm((N_ODD, N_EXPERTS, D, F_EXPERT), D ** -0.5),
        'moe_w2': nrm((N_ODD, N_EXPERTS, F_EXPERT, D), F_EXPERT ** -0.5),
    }


def reference(x, c, t5_table, norm_g, ada_w, ada_b, e_w_in, e_conv_w, e_conv_b, e_cln_g,
              e_cln_b, e_w_out, e_ffn_w1, e_ffn_w3, e_ffn_w2, o_w_in, o_q_norm_g, o_w_uq,
              o_kv_norm_g, o_w_ukv, s5_a_re, s5_a_im, s5_log_dt, s5_b_re, s5_b_im, s5_c_re,
              s5_c_im, s5_d, s5_w_glu, o_w_out, router_w, moe_w1, moe_w3, moe_w2):
    cond = jax.nn.silu(c)
    for layer in range(DEPTH):
        i = layer // 2
        mod = cond @ ada_w[layer] + ada_b[layer]
        sh_m, sc_m, gt_m, sh_f, sc_f, gt_f = jnp.split(mod[:, None, :], 6, axis=-1)
        g = norm_g[layer]
        h = modulate(rms_norm(x, g[0]), sh_m, sc_m)
        if layer % 2 == 0:
            y = even_mixer(h, t5_table, e_w_in[i], e_conv_w[i], e_conv_b[i], e_cln_g[i],
                           e_cln_b[i], e_w_out[i])
        else:
            y = odd_mixer(h, o_w_in[i], o_q_norm_g[i], o_w_uq[i], o_kv_norm_g[i], o_w_ukv[i],
                          s5_a_re[i], s5_a_im[i], s5_log_dt[i], s5_b_re[i], s5_b_im[i],
                          s5_c_re[i], s5_c_im[i], s5_d[i], s5_w_glu[i], o_w_out[i])
        x = x + gt_m * rms_norm(y, g[1])
        h = modulate(rms_norm(x, g[2]), sh_f, sc_f)
        if layer % 2 == 0:
            y = swiglu(h, e_ffn_w1[i], e_ffn_w3[i], e_ffn_w2[i])
        else:
            y = moe_swiglu(h, router_w[i], moe_w1[i], moe_w3[i], moe_w2[i])
        x = x + gt_f * rms_norm(y, g[3])
    return x
```

```cpp
#include <hip/hip_runtime.h>
#include <cstdio>
#include <cstdint>

namespace pg8 {
#define PG8_LAS __attribute__((address_space(3)))
typedef unsigned short bf16_t;
typedef short bf16x8 __attribute__((ext_vector_type(8)));
typedef float f32x4 __attribute__((ext_vector_type(4)));
typedef unsigned u32x4 __attribute__((ext_vector_type(4)));
typedef unsigned u32x2 __attribute__((ext_vector_type(2)));
constexpr int BM = 256, BK = 64, HALF = 128, HTB = HALF * BK * 2  , STAGE_BYTES = 8 * HTB, NXCD = 8, WGM = 8;

__host__ __device__ __forceinline__ int lds_byte(int r, int c) { const int st = (r >> 4) * 2 + (c >> 5), rr = r & 15, cc = c & 31, ob = rr * 64 + cc * 2; return st * 1024 + (ob ^ (((ob >> 9) & 1) << 5)); }
__host__ __device__ __forceinline__ void stage_rc(int b, int& R, int& C) { const int st = b / 1024, sb = b % 1024, swz = sb ^ (((sb >> 9) & 1) << 5); R = (st >> 1) * 16 + swz / 64; C = (st & 1) * 32 + (swz % 64) / 2; }
__host__ __device__ __forceinline__ int perm32(int rho) { const int n = rho >> 4, i = rho & 15; return 8 * (i >> 2) + 4 * n + (i & 3); }

struct Unit { int pm, pn; };
struct Gemm { const void* A; const void* Bt; int K; };

struct StaticOrder {
    int nM, nN, nwg, G, c;
    const int* texp; size_t estride;
    const int* rowidx;
    __device__ void init(int nM_, int nN_, int G_, int c_) { nM = nM_; nN = nN_; nwg = nM * nN; G = G_; c = c_; texp = nullptr; estride = 0; rowidx = nullptr; }
    __device__ bool next(int i, Unit& u) const {
        const long L = (long)i * G + c; if (L >= nwg) return false;
        int wgid = (int)L; { const int q = nwg / NXCD, r = nwg % NXCD, xcd = wgid % NXCD, off = wgid / NXCD; wgid = (xcd < r ? xcd * (q + 1) : r * (q + 1) + (xcd - r) * q) + off; }
        const int nig = WGM * nN, gid = wgid / nig, fm = gid * WGM, gsz = (nM - fm) < WGM ? (nM - fm) : WGM;
        u.pm = fm + ((wgid % nig) % gsz); u.pn = (wgid % nig) / gsz; return true;
    }
    __device__ __forceinline__ size_t b_off(const Unit& u) const { return texp ? (size_t)__builtin_amdgcn_readfirstlane(texp[u.pm]) * estride : (size_t)0; }
};

__device__ __forceinline__ unsigned cvt_pk_bf16(float lo, float hi) { unsigned r; asm volatile("v_cvt_pk_bf16_f32 %0, %1, %2" : "=v"(r) : "v"(lo), "v"(hi)); return r; }

struct EpiF32 {
    static constexpr bool PERM = false;
    float* C; int ldc;
    __device__ __forceinline__ void operator()(const f32x4 (&acc)[2][2][4][2], const Unit& u, int wr, int wc, int fr, int fq) const {
        const int row0 = u.pm * BM + wr * 64 + fr, col0 = u.pn * BM + wc * 32 + 4 * fq;
#pragma unroll
        for (int ai = 0; ai < 2; ++ai)
#pragma unroll
            for (int m = 0; m < 4; ++m) { float* rowp = C + (size_t)(row0 + ai * HALF + m * 16) * ldc + col0;
#pragma unroll
                for (int bj = 0; bj < 2; ++bj)
#pragma unroll
                    for (int n = 0; n < 2; ++n) *(f32x4*)(rowp + bj * HALF + n * 16) = acc[ai][bj][m][n]; }
    }
};
struct EpiBf16 {
    static constexpr bool PERM = true;
    bf16_t* O; int ldc; float sc = 1.0f;
    __device__ __forceinline__ void operator()(const f32x4 (&acc)[2][2][4][2], const Unit& u, int wr, int wc, int fr, int fq) const {
        const int row0 = u.pm * BM + wr * 64 + fr, col0 = u.pn * BM + wc * 32 + 8 * fq;
#pragma unroll
        for (int ai = 0; ai < 2; ++ai)
#pragma unroll
            for (int m = 0; m < 4; ++m) { bf16_t* rowp = O + (size_t)(row0 + ai * HALF + m * 16) * ldc + col0;
#pragma unroll
                for (int bj = 0; bj < 2; ++bj) { const f32x4 v0 = acc[ai][bj][m][0] * sc, v1 = acc[ai][bj][m][1] * sc;
                    u32x4 w; w.x = cvt_pk_bf16(v0[0], v0[1]); w.y = cvt_pk_bf16(v0[2], v0[3]); w.z = cvt_pk_bf16(v1[0], v1[1]); w.w = cvt_pk_bf16(v1[2], v1[3]);
                    *(u32x4*)(rowp + bj * HALF) = w; } }
    }
};
__device__ __forceinline__ float silu_f(float v) { return v * __builtin_amdgcn_rcpf(1.0f + __builtin_amdgcn_exp2f(-1.4426950408889634f * v)); }
__device__ __forceinline__ float sigmoid_f(float v) { return __builtin_amdgcn_rcpf(1.0f + __builtin_amdgcn_exp2f(-1.4426950408889634f * v)); }
struct EpiSwiGLU {
    static constexpr bool PERM = false;
    bf16_t* O; int ldc;
    __device__ __forceinline__ void operator()(const f32x4 (&acc)[2][2][4][2], const Unit& u, int wr, int wc, int fr, int fq) const {
        const int row0 = u.pm * BM + wr * 64 + fr, col0 = u.pn * (BM / 2) + wc * 16 + 4 * fq;
#pragma unroll
        for (int ai = 0; ai < 2; ++ai)
#pragma unroll
            for (int m = 0; m < 4; ++m) { bf16_t* rowp = O + (size_t)(row0 + ai * HALF + m * 16) * ldc + col0;
#pragma unroll
                for (int bj = 0; bj < 2; ++bj) { const f32x4 a = acc[ai][bj][m][0], b = acc[ai][bj][m][1];
                    u32x2 w; w.x = cvt_pk_bf16(silu_f(a[0]) * b[0], silu_f(a[1]) * b[1]); w.y = cvt_pk_bf16(silu_f(a[2]) * b[2], silu_f(a[3]) * b[3]);
                    *(u32x2*)(rowp + bj * (HALF / 2)) = w; } }
    }
};
struct EpiSwiGLU8 {
    static constexpr bool PERM = false;
    unsigned char* O; int ldc; float isc, osc;
    __device__ __forceinline__ void operator()(const f32x4 (&acc)[2][2][4][2], const Unit& u, int wr, int wc, int fr, int fq) const {
        const int row0 = u.pm * BM + wr * 64 + fr, col0 = u.pn * (BM / 2) + wc * 16 + 4 * fq;
#pragma unroll
        for (int ai = 0; ai < 2; ++ai)
#pragma unroll
            for (int m = 0; m < 4; ++m) { unsigned char* rowp = O + (size_t)(row0 + ai * HALF + m * 16) * ldc + col0;
#pragma unroll
                for (int bj = 0; bj < 2; ++bj) { const f32x4 a = acc[ai][bj][m][0] * isc, b = acc[ai][bj][m][1] * (isc * osc);
                    float v[4];
#pragma unroll
                    for (int e = 0; e < 4; ++e) v[e] = __builtin_fminf(__builtin_fmaxf(silu_f(a[e]) * b[e], -448.f), 448.f);
                    int w = 0; w = __builtin_amdgcn_cvt_pk_fp8_f32(v[0], v[1], w, false); w = __builtin_amdgcn_cvt_pk_fp8_f32(v[2], v[3], w, true);
                    *(int*)(rowp + bj * (HALF / 2)) = w; } }
    }
};
struct EpiGate {
    static constexpr bool PERM = false;
    const bf16_t* Y; int ldy; bf16_t* O; int ldc; int ocol0;
    __device__ __forceinline__ void operator()(const f32x4 (&acc)[2][2][4][2], const Unit& u, int wr, int wc, int fr, int fq) const {
        const int row0 = u.pm * BM + wr * 64 + fr, col0 = u.pn * BM + wc * 32 + 4 * fq;
#pragma unroll
        for (int ai = 0; ai < 2; ++ai)
#pragma unroll
            for (int m = 0; m < 4; ++m) { const size_t r = (size_t)(row0 + ai * HALF + m * 16);
#pragma unroll
                for (int bj = 0; bj < 2; ++bj)
#pragma unroll
                    for (int n = 0; n < 2; ++n) { const int c = col0 + bj * HALF + n * 16; const f32x4 a = acc[ai][bj][m][n];
                        const u32x2 y = *(const u32x2*)(Y + r * ldy + c);
                        const float y0 = __uint_as_float(y.x << 16), y1 = __uint_as_float(y.x & 0xffff0000u), y2 = __uint_as_float(y.y << 16), y3 = __uint_as_float(y.y & 0xffff0000u);
                        u32x2 w; w.x = cvt_pk_bf16(y0 * sigmoid_f(a[0]), y1 * sigmoid_f(a[1])); w.y = cvt_pk_bf16(y2 * sigmoid_f(a[2]), y3 * sigmoid_f(a[3]));
                        *(u32x2*)(O + r * ldc + ocol0 + c) = w; } }
    }
};

typedef int v8i32 __attribute__((ext_vector_type(8)));
__device__ __forceinline__ void glds16s(const void* sbase, unsigned voff, unsigned lds_dst) { unsigned keep;
    asm volatile("s_mov_b32 %0, m0\n\ts_mov_b32 m0, %3\n\ts_nop 0\n\tglobal_load_lds_dwordx4 %1, %2\n\ts_mov_b32 m0, %0" : "=&s"(keep) : "v"(voff), "s"(sbase), "s"(lds_dst) : "memory"); }
template <bool FP8 = false, bool GATHER = false, class Epi, class Sched>
__device__ __forceinline__ void gemm_phase(PG8_LAS unsigned char* lds, const Gemm g, const Sched& S, const Epi& E) {
    const int tid = threadIdx.x, wid = __builtin_amdgcn_readfirstlane(tid >> 6), lane = tid & 63, wr = wid >> 2, wc = wid & 3, fr = lane & 15, fq = lane >> 4;
    const int K = FP8 ? (g.K >> 1) : g.K, nt = K / BK;
    unsigned voffA[2], voffB[2];
#pragma unroll
    for (int i = 0; i < 2; ++i) { int R, C; stage_rc(tid * 16 + i * 8192, R, C); const int Rb = Epi::PERM ? ((R & ~31) + perm32(R & 31)) : R;
        voffA[i] = (unsigned)(R * K + C) * 2u; voffB[i] = (unsigned)(Rb * K + C) * 2u; }
    const size_t kstep = (size_t)(BK * 2);
    const size_t qstep = (size_t)64 * K * 2;
    const size_t hstep = (size_t)HALF * K * 2;
    const size_t tstep = 2 * hstep;
    const unsigned ldsw = (unsigned)wid * 1024u, ldsbase = (unsigned)(uintptr_t)lds;
    const int aoff = lds_byte(wr * 64 + fr, fq * 8), boff = lds_byte(wc * 32 + fr, fq * 8);
#define PG8_SA(b, h) (((b) * 2 + (h)) * HTB)
#define PG8_SB(b, h) ((4 + (b) * 2 + (h)) * HTB)
#define PG8_STAGE(bufoff, gbase, voff) do { _Pragma("unroll") for (int _i = 0; _i < 2; ++_i) glds16s((const void*)(gbase), (voff)[_i], ldsbase + (unsigned)(bufoff) + ldsw + (unsigned)_i * 8192u); } while (0)
#define PG8_STAGE1(bufoff, gbase, voff0) do { _Pragma("unroll") for (int _i = 0; _i < 2; ++_i) glds16s((const void*)((const char*)(gbase) + (size_t)_i * qstep), voff0, ldsbase + (unsigned)(bufoff) + ldsw + (unsigned)_i * 8192u); } while (0)
#define PG8_STAGE_A(bufoff, h, ap, og) do { if constexpr (GATHER) PG8_STAGE(bufoff, ap, (og)[h]); else PG8_STAGE1(bufoff, (ap) + (h) * hstep, voffA[0]); } while (0)
#define PG8_LDA(dst, b, h) do { _Pragma("unroll") for (int m = 0; m < 4; ++m) _Pragma("unroll") for (int k = 0; k < 2; ++k) dst[m][k] = *(const PG8_LAS bf16x8*)(lds + PG8_SA(b, h) + aoff + m * 2048 + k * 1024); } while (0)
#define PG8_LDB(dst, b, h) do { _Pragma("unroll") for (int n = 0; n < 2; ++n) _Pragma("unroll") for (int k = 0; k < 2; ++k) dst[n][k] = *(const PG8_LAS bf16x8*)(lds + PG8_SB(b, h) + boff + n * 2048 + k * 1024); } while (0)
#define PG8_MMA(ai, bj, At, Bt) do { __builtin_amdgcn_s_setprio(1); _Pragma("unroll") for (int m = 0; m < 4; ++m) _Pragma("unroll") for (int n = 0; n < 2; ++n) { \
        if constexpr (FP8) { const v8i32 bq = __builtin_bit_cast(v8i32, __builtin_shufflevector(Bt[n][0], Bt[n][1], 0, 1, 2, 3, 4, 5, 6, 7, 8, 9, 10, 11, 12, 13, 14, 15)); \
            const v8i32 aq = __builtin_bit_cast(v8i32, __builtin_shufflevector(At[m][0], At[m][1], 0, 1, 2, 3, 4, 5, 6, 7, 8, 9, 10, 11, 12, 13, 14, 15)); \
            acc[ai][bj][m][n] = __builtin_amdgcn_mfma_scale_f32_16x16x128_f8f6f4(bq, aq, acc[ai][bj][m][n], 0, 0, 0, 0, 0, 0);     } \
        else { _Pragma("unroll") for (int k = 0; k < 2; ++k) acc[ai][bj][m][n] = __builtin_amdgcn_mfma_f32_16x16x32_bf16(Bt[n][k], At[m][k], acc[ai][bj][m][n], 0, 0, 0); } } \
        __builtin_amdgcn_s_setprio(0); } while (0)
#define PG8_WAIT_V(n) asm volatile("s_waitcnt vmcnt(" #n ")" ::: "memory")
#define PG8_WAIT_L(n) asm volatile("s_waitcnt lgkmcnt(" #n ")" ::: "memory")
#define PG8_BAR __builtin_amdgcn_s_barrier()
#define PG8_SCHED __builtin_amdgcn_sched_barrier(0)
#define PG8_AOFF(dst, u) do { if constexpr (GATHER) { int t2_ = (int)threadIdx.x; asm volatile("" : "+v"(t2_)); _Pragma("unroll") for (int _i = 0; _i < 2; ++_i) { int R_, C_; stage_rc(t2_ * 16 + _i * 8192, R_, C_); \
        _Pragma("unroll") for (int _h = 0; _h < 2; ++_h) { const int _row = S.rowidx[(u).pm * BM + _h * HALF + R_]; dst[_h][_i] = (unsigned)((size_t)_row * K + C_) * 2u; } } } } while (0)
    Unit cur, nxt; int ui = 0;
    if (!S.next(0, cur)) return;
    f32x4 acc[2][2][4][2];
#pragma unroll
    for (int a = 0; a < 2; ++a)
#pragma unroll
        for (int b = 0; b < 2; ++b)
#pragma unroll
            for (int m = 0; m < 4; ++m)
#pragma unroll
                for (int n = 0; n < 2; ++n) acc[a][b][m][n] = (f32x4){0.f, 0.f, 0.f, 0.f};
    bf16x8 At[4][2], B0[2][2], B1[2][2];
    unsigned oC[2][2];
#define PG8_OSLOT ((PG8_LAS u32x4*)(lds + STAGE_BYTES) + (int)threadIdx.x)
    PG8_AOFF(oC, cur);
    const char* const gA = (const char*)g.A;
    const char* cA = GATHER ? gA : gA + (size_t)cur.pm * tstep;
    const char* cB = (const char*)g.Bt + S.b_off(cur) + (size_t)cur.pn * tstep;
    PG8_STAGE1(PG8_SB(0, 0), cB, voffB[0]); PG8_STAGE1(PG8_SB(0, 1), cB + hstep, voffB[0]); PG8_STAGE_A(PG8_SA(0, 0), 0, cA, oC); PG8_STAGE_A(PG8_SA(0, 1), 1, cA, oC);
    if (wr == 1) PG8_BAR;
    PG8_WAIT_V(2); PG8_BAR;
    PG8_STAGE1(PG8_SB(1, 0), cB + kstep, voffB[0]); PG8_STAGE_A(PG8_SA(1, 0), 0, cA + kstep, oC); PG8_STAGE1(PG8_SB(1, 1), cB + hstep + kstep, voffB[0]);
    PG8_WAIT_V(6); PG8_BAR;
    for (;;) {
        const bool has_next = S.next(ui + 1, nxt);
        const char* nB = cB; const char* nA = cA;
        if (has_next) { nB = (const char*)g.Bt + S.b_off(nxt) + (size_t)nxt.pn * tstep; nA = GATHER ? gA : gA + (size_t)nxt.pm * tstep;
            if constexpr (GATHER) { unsigned oN[2][2]; PG8_AOFF(oN, nxt); *PG8_OSLOT = (u32x4){oN[0][0], oN[0][1], oN[1][0], oN[1][1]}; } }
        for (int t = 0; t < nt; t += 2) {
            const bool last = (t == nt - 2);
            const char* a1 = cA + (size_t)(t + 1) * kstep;
            const char* a2 = last ? nA : cA + (size_t)(t + 2) * kstep; const char* b2 = last ? nB : cB + (size_t)(t + 2) * kstep;
            const char* a3 = a2 + kstep; const char* b3 = b2 + kstep;
            unsigned o2[2][2];
            if constexpr (GATHER) {
                if (last && has_next) { const u32x4 q = *PG8_OSLOT; o2[0][0] = q.x; o2[0][1] = q.y; o2[1][0] = q.z; o2[1][1] = q.w; }
                else { o2[0][0] = oC[0][0]; o2[0][1] = oC[0][1]; o2[1][0] = oC[1][0]; o2[1][1] = oC[1][1]; }
            }
            PG8_LDB(B0, 0, 0); PG8_LDB(B1, 0, 1); PG8_SCHED; PG8_LDA(At, 0, 0); PG8_STAGE_A(PG8_SA(1, 1), 1, a1, oC);
            PG8_WAIT_V(8); PG8_WAIT_L(0); PG8_BAR; PG8_MMA(0, 0, At, B0); PG8_MMA(0, 1, At, B1); PG8_BAR; PG8_SCHED;
            PG8_LDA(At, 0, 1); PG8_STAGE1(PG8_SB(0, 0), b2, voffB[0]); PG8_STAGE1(PG8_SB(0, 1), b2 + hstep, voffB[0]); PG8_STAGE_A(PG8_SA(0, 0), 0, a2, o2);
            PG8_WAIT_V(8); PG8_WAIT_L(0); PG8_BAR; PG8_MMA(1, 0, At, B0); PG8_MMA(1, 1, At, B1); PG8_BAR; PG8_SCHED;
            PG8_LDB(B0, 1, 0); PG8_LDB(B1, 1, 1); PG8_SCHED; PG8_LDA(At, 1, 0); PG8_STAGE_A(PG8_SA(0, 1), 1, a2, o2);
            PG8_WAIT_V(8); PG8_WAIT_L(0); PG8_BAR; PG8_MMA(0, 0, At, B0); PG8_MMA(0, 1, At, B1); PG8_BAR; PG8_SCHED;
            PG8_LDA(At, 1, 1); PG8_STAGE1(PG8_SB(1, 0), b3, voffB[0]); PG8_STAGE1(PG8_SB(1, 1), b3 + hstep, voffB[0]); PG8_STAGE_A(PG8_SA(1, 0), 0, a3, o2);
            PG8_WAIT_V(8); PG8_WAIT_L(0); PG8_BAR; PG8_MMA(1, 0, At, B0); PG8_MMA(1, 1, At, B1); PG8_BAR; PG8_SCHED;
        }
        if (wr == 0) PG8_BAR;
        { int t3 = (int)threadIdx.x; asm volatile("" : "+v"(t3)); E(acc, cur, wr, wc, t3 & 15, (t3 >> 4) & 3); }
        if (!has_next) break;
#pragma unroll
        for (int a = 0; a < 2; ++a)
#pragma unroll
            for (int b = 0; b < 2; ++b)
#pragma unroll
                for (int m = 0; m < 4; ++m)
#pragma unroll
                    for (int n = 0; n < 2; ++n) acc[a][b][m][n] = (f32x4){0.f, 0.f, 0.f, 0.f};
        cur = nxt; cB = nB; cA = nA; ++ui;
        if constexpr (GATHER) { const u32x4 q = *PG8_OSLOT; oC[0][0] = q.x; oC[0][1] = q.y; oC[1][0] = q.z; oC[1][1] = q.w; }
        if (wr == 1) PG8_BAR;
    }
    PG8_WAIT_V(0);
    PG8_BAR;
#undef PG8_SA
#undef PG8_SB
#undef PG8_STAGE
#undef PG8_STAGE_A
#undef PG8_STAGE1
#undef PG8_LDA
#undef PG8_LDB
#undef PG8_MMA
#undef PG8_WAIT_V
#undef PG8_WAIT_L
#undef PG8_BAR
#undef PG8_SCHED
#undef PG8_AOFF
#undef PG8_OSLOT
}
}
namespace mla2 {
using bf16x8 = __attribute__((ext_vector_type(8))) short;
using s16x4  = __attribute__((ext_vector_type(4))) short;
using f32x16 = __attribute__((ext_vector_type(16))) float;
using f32x4v = __attribute__((ext_vector_type(4))) float;
using u32x4  = __attribute__((ext_vector_type(4))) unsigned;
constexpr int NW = 8, QBLK = 32, KVBLK = 64;
constexpr float SCALE = 0.072168783648703220f;
constexpr float THR = 8.f;
constexpr int NQREG = 4, NQL = 12 - NQREG;
constexpr int LDQ = 2304, LDKV = 3072, LDKP = 64, LDO = 2048;
constexpr int SHM_V = KVBLK * 128 * 2, SHM_KN = KVBLK * 128 * 2, SHM_KP = KVBLK * 64 * 2;
constexpr int SHM_K = SHM_KN + SHM_KP;
constexpr int OFF_V = 0, OFF_KN = 2 * SHM_V, OFF_WS = OFF_KN + 2 * SHM_K, OFF_QS = OFF_WS + NW * 64 * 4, QS_WAVE = NQL * 1024, SHM_ATTN = OFF_QS + NW * QS_WAVE;
#define MLA2_QB(row, c16) ((((c16) >> 1) * 32 + (row)) * 32 + ((((c16) & 1) ^ (((row) >> 3) & 1)) << 4))
#define MLA2_SBAR() __builtin_amdgcn_sched_barrier(0)
#ifndef MLA2_WAIT0
#define MLA2_WAIT0 0
#endif
#if MLA2_WAIT0
#define MLA2_LWAIT(n) do { asm volatile("s_waitcnt lgkmcnt(0)" ::: "memory"); __builtin_amdgcn_sched_barrier(0); } while (0)
#else
#ifndef MLA2_SBMASK
#define MLA2_SBMASK 0x416
#endif
#define MLA2_LWAIT(n) do { asm volatile("s_waitcnt lgkmcnt(" #n ")" ::: "memory"); __builtin_amdgcn_sched_barrier(MLA2_SBMASK); } while (0)
#ifndef MLA2_FENCES
#define MLA2_FENCES 1
#endif
#if MLA2_FENCES
#define MLA2_FENCE() __builtin_amdgcn_sched_barrier(0)
#else
#define MLA2_FENCE() do {} while (0)
#endif
#define MLA2_W2(n, A, B) asm volatile("s_waitcnt lgkmcnt(" #n ")" : "+v"(A), "+v"(B) :: "memory")
#define MLA2_W3(n, A, B, C) asm volatile("s_waitcnt lgkmcnt(" #n ")" : "+v"(A), "+v"(B), "+v"(C) :: "memory")
#endif
__device__ __forceinline__ int crow(int r, int hi) { return (r & 3) + 8 * (r >> 2) + 4 * hi; }
__device__ __forceinline__ unsigned cvtpk(float lo, float hi) { unsigned r; asm volatile("v_cvt_pk_bf16_f32 %0, %1, %2" : "=v"(r) : "v"(lo), "v"(hi)); return r; }
#ifndef MLA2_PLAIN_RD
#define MLA2_PLAIN_RD 0
#endif
template <int OFF> __device__ __forceinline__ bf16x8 lds_rd(int addr) {
#if MLA2_PLAIN_RD
  return *(const __attribute__((address_space(3))) bf16x8*)(unsigned)(addr + OFF);
#else
  bf16x8 r; asm volatile("ds_read_b128 %0, %1 offset:%2" : "=v"(r) : "v"(addr), "i"(OFF) : "memory"); return r;
#endif
}
using f32x2v = __attribute__((ext_vector_type(2))) float;
__device__ __forceinline__ float max3f(float a, float b, float c) { float r; asm volatile("v_max3_f32 %0, %1, %2, %3" : "=v"(r) : "v"(a), "v"(b), "v"(c)); return r; }
template <int OFF> __device__ __forceinline__ s16x4 tr_read(int vb) { s16x4 r; asm volatile("ds_read_b64_tr_b16 %0, %1 offset:%2" : "=&v"(r) : "v"(vb), "i"(OFF) : "memory"); return r; }

__device__ __forceinline__ void partialSM(f32x16& p0, f32x16& p1, float& m_reg, float& mn, float& alpha) {
  constexpr float C = SCALE * 1.4426950408889634f;
  float pmax = p0[0];
#pragma unroll
  for (int r = 1; r < 16; ++r) pmax = fmaxf(pmax, p0[r]);
#pragma unroll
  for (int r = 0; r < 16; ++r) pmax = fmaxf(pmax, p1[r]);
  { auto rr = __builtin_amdgcn_permlane32_swap(__float_as_uint(pmax), __float_as_uint(pmax), false, false);
    pmax = fmaxf(__uint_as_float(rr[0]), __uint_as_float(rr[1])); }
  if (__builtin_expect(__all(pmax - m_reg <= THR / SCALE), 1)) { mn = m_reg; alpha = 1.f; }
  else { mn = fmaxf(m_reg, pmax); alpha = __builtin_amdgcn_exp2f((m_reg - mn) * C); m_reg = mn; }
  float mnC = -mn * C;
#pragma unroll
  for (int r = 0; r < 16; ++r) p0[r] = fmaf(p0[r], C, mnC);
#pragma unroll
  for (int r = 0; r < 16; ++r) p1[r] = fmaf(p1[r], C, mnC);
#pragma unroll
  for (int r = 0; r < 16; ++r) p0[r] = __builtin_amdgcn_exp2f(p0[r]);
}
__device__ __forceinline__ void finishSM(f32x16& p0, f32x16& p1, float alpha, float& l_reg, bf16x8& pa0, bf16x8& pa1, bf16x8& pa2, bf16x8& pa3) {
#pragma unroll
  for (int r = 0; r < 16; ++r) p1[r] = __builtin_amdgcn_exp2f(p1[r]);
  float ps = 0;
#pragma unroll
  for (int r = 0; r < 16; ++r) ps += p0[r];
#pragma unroll
  for (int r = 0; r < 16; ++r) ps += p1[r];
  { auto rr = __builtin_amdgcn_permlane32_swap(__float_as_uint(ps), __float_as_uint(ps), false, false);
    ps = __uint_as_float(rr[0]) + __uint_as_float(rr[1]); }
  l_reg = l_reg * alpha + ps;
#define MLA2_PK4(P, BASE, OUT) do { unsigned a0 = cvtpk(P[BASE + 0], P[BASE + 1]), a1 = cvtpk(P[BASE + 2], P[BASE + 3]);   \
    unsigned b0 = cvtpk(P[BASE + 4], P[BASE + 5]), b1 = cvtpk(P[BASE + 6], P[BASE + 7]);                              \
    auto r0 = __builtin_amdgcn_permlane32_swap(a0, b0, false, false); auto r1 = __builtin_amdgcn_permlane32_swap(a1, b1, false, false); \
    u32x4 w = {r0[0], r1[0], r0[1], r1[1]}; OUT = *reinterpret_cast<bf16x8*>(&w); } while (0)
  MLA2_PK4(p0, 0, pa0); MLA2_PK4(p0, 8, pa1); MLA2_PK4(p1, 0, pa2); MLA2_PK4(p1, 8, pa3);
#undef MLA2_PK4
}
constexpr int ko(int B, int s) { return B * SHM_K + (s >> 2) * 8192; }
constexpr int qo(int s) { return (s - NQREG) * 1024; }
template <int B> __device__ __forceinline__ void qkt(f32x16& p0, f32x16& p1, const int (&kb)[4], int qbase, const bf16x8 (&qr)[NQREG]) {
  p0 = f32x16{}; p1 = f32x16{};
  bf16x8 a0, a1, aq, c0, c1, cq;
#define MLA2_RD(s, X0, X1, XQ) do { X0 = lds_rd<ko(B, s)>(kb[(s) & 3]); X1 = lds_rd<ko(B, s) + 4096>(kb[(s) & 3]); if constexpr ((s) >= NQREG) XQ = lds_rd<qo((s) >= NQREG ? (s) : NQREG)>(qbase); } while (0)
#define MLA2_MM(s, X0, X1, XQ) do { const bf16x8 q_ = ((s) < NQREG) ? qr[(s) < NQREG ? (s) : 0] : XQ; \
    p0 = __builtin_amdgcn_mfma_f32_32x32x16_bf16(X0, q_, p0, 0, 0, 0); p1 = __builtin_amdgcn_mfma_f32_32x32x16_bf16(X1, q_, p1, 0, 0, 0); } while (0)
  MLA2_RD(0, a0, a1, aq); MLA2_RD(1, c0, c1, cq);
  MLA2_W2(2, a0, a1); MLA2_MM(0, a0, a1, aq); MLA2_RD(2, a0, a1, aq);
  MLA2_W2(2, c0, c1); MLA2_MM(1, c0, c1, cq); MLA2_RD(3, c0, c1, cq);
  MLA2_W2(2, a0, a1); MLA2_MM(2, a0, a1, aq); MLA2_RD(4, a0, a1, aq);
  MLA2_W2(3, c0, c1); MLA2_MM(3, c0, c1, cq); MLA2_RD(5, c0, c1, cq); MLA2_FENCE();
  MLA2_W3(3, a0, a1, aq); MLA2_MM(4, a0, a1, aq); MLA2_RD(6, a0, a1, aq);
  MLA2_W3(3, c0, c1, cq); MLA2_MM(5, c0, c1, cq); MLA2_RD(7, c0, c1, cq);
  MLA2_W3(3, a0, a1, aq); MLA2_MM(6, a0, a1, aq); MLA2_RD(8, a0, a1, aq);
  MLA2_W3(3, c0, c1, cq); MLA2_MM(7, c0, c1, cq); MLA2_RD(9, c0, c1, cq); MLA2_FENCE();
  MLA2_W3(3, a0, a1, aq); MLA2_MM(8, a0, a1, aq); MLA2_RD(10, a0, a1, aq);
  MLA2_W3(3, c0, c1, cq); MLA2_MM(9, c0, c1, cq); MLA2_RD(11, c0, c1, cq);
  MLA2_W3(3, a0, a1, aq); MLA2_MM(10, a0, a1, aq);
  MLA2_W3(0, c0, c1, cq); MLA2_MM(11, c0, c1, cq);
#undef MLA2_RD
#undef MLA2_MM
}
__device__ __forceinline__ int v_st(int k, int c) { const int kk = (k & ~0xC) | ((k & 4) << 1) | ((k & 8) >> 1); return ((kk >> 3) * 4 + (c >> 5)) * 512 + ((kk & 7) * 32 + (c & 31)) * 2; }
__device__ __forceinline__ int v_rd_base(int lane) { return ((lane & 3) << 3) | (((lane >> 2) & 3) << 6) | (((lane >> 4) & 1) << 5) | (((lane >> 5) & 1) << 8); }
constexpr int v_rd_off(int d0, int ks, int half) { return d0 * 512 + ks * 4096 + half * 2048; }
template <int B> __device__ __forceinline__ void pv(f32x16 (&o)[4], int vb, bf16x8 pa0, bf16x8 pa1, bf16x8 pa2, bf16x8 pa3) {
  s16x4 l0, h0, l1, h1, l2, h2;
#define MLA2_PK(L, H) (bf16x8){L[0], L[1], L[2], L[3], H[0], H[1], H[2], H[3]}
#define MLA2_PR(k, L, H) do { L = tr_read<B * SHM_V + v_rd_off((k) & 3, (k) >> 2, 0)>(vb); H = tr_read<B * SHM_V + v_rd_off((k) & 3, (k) >> 2, 1)>(vb); } while (0)
#define MLA2_PM(k, L, H) do { const bf16x8 pa_ = ((k) >> 2) == 0 ? pa0 : ((k) >> 2) == 1 ? pa1 : ((k) >> 2) == 2 ? pa2 : pa3; \
    o[(k) & 3] = __builtin_amdgcn_mfma_f32_32x32x16_bf16(pa_, MLA2_PK(L, H), o[(k) & 3], 0, 0, 0); } while (0)
  MLA2_PR(0, l0, h0); MLA2_PR(1, l1, h1); MLA2_PR(2, l2, h2);
  MLA2_W2(4, l0, h0); MLA2_PM(0, l0, h0); MLA2_PR(3, l0, h0);
  MLA2_W2(4, l1, h1); MLA2_PM(1, l1, h1); MLA2_PR(4, l1, h1);
  MLA2_W2(4, l2, h2); MLA2_PM(2, l2, h2); MLA2_PR(5, l2, h2);
  MLA2_W2(4, l0, h0); MLA2_PM(3, l0, h0); MLA2_PR(6, l0, h0); MLA2_FENCE();
  MLA2_W2(4, l1, h1); MLA2_PM(4, l1, h1); MLA2_PR(7, l1, h1);
  MLA2_W2(4, l2, h2); MLA2_PM(5, l2, h2); MLA2_PR(8, l2, h2);
  MLA2_W2(4, l0, h0); MLA2_PM(6, l0, h0); MLA2_PR(9, l0, h0);
  MLA2_W2(4, l1, h1); MLA2_PM(7, l1, h1); MLA2_PR(10, l1, h1); MLA2_FENCE();
  MLA2_W2(4, l2, h2); MLA2_PM(8, l2, h2); MLA2_PR(11, l2, h2);
  MLA2_W2(4, l0, h0); MLA2_PM(9, l0, h0); MLA2_PR(12, l0, h0);
  MLA2_W2(4, l1, h1); MLA2_PM(10, l1, h1); MLA2_PR(13, l1, h1);
  MLA2_W2(4, l2, h2); MLA2_PM(11, l2, h2); MLA2_PR(14, l2, h2); MLA2_FENCE();
  MLA2_W2(4, l0, h0); MLA2_PM(12, l0, h0); MLA2_PR(15, l0, h0);
  MLA2_W2(4, l1, h1); MLA2_PM(13, l1, h1);
  MLA2_W2(2, l2, h2); MLA2_PM(14, l2, h2);
  MLA2_W2(0, l0, h0); MLA2_PM(15, l0, h0);
#undef MLA2_PK
#undef MLA2_PR
#undef MLA2_PM
}
#define MLA2_PK4B(P, BASE, OUT) do { unsigned a0_ = cvtpk(P[BASE + 0], P[BASE + 1]), a1_ = cvtpk(P[BASE + 2], P[BASE + 3]);   \
    unsigned b0_ = cvtpk(P[BASE + 4], P[BASE + 5]), b1_ = cvtpk(P[BASE + 6], P[BASE + 7]);                              \
    auto r0_ = __builtin_amdgcn_permlane32_swap(a0_, b0_, false, false); auto r1_ = __builtin_amdgcn_permlane32_swap(a1_, b1_, false, false); \
    u32x4 w_ = {r0_[0], r1_[0], r0_[1], r1_[1]}; OUT = *reinterpret_cast<bf16x8*>(&w_); } while (0)
template <int B> __device__ __forceinline__ void r1(f32x16& n0, f32x16& n1, const int (&kb)[4], int qbase, const bf16x8 (&qr)[NQREG],
                                                    f32x16& p0, f32x16& p1, float alpha, float& l_reg, bf16x8& pa0, bf16x8& pa1, bf16x8& pa2, bf16x8& pa3) {
  bf16x8 a0, a1, aq, c0, c1, cq; f32x2v ps2 = {0.f, 0.f};
#define MLA2_RD(s, X0, X1, XQ) do { X0 = lds_rd<ko(B, s)>(kb[(s) & 3]); X1 = lds_rd<ko(B, s) + 4096>(kb[(s) & 3]); if constexpr ((s) >= NQREG) XQ = lds_rd<qo((s) >= NQREG ? (s) : NQREG)>(qbase); } while (0)
#define MLA2_MM(s, X0, X1, XQ) do { const bf16x8 q_ = ((s) < NQREG) ? qr[(s) < NQREG ? (s) : 0] : XQ; \
    if constexpr ((s) == 0) { n0 = __builtin_amdgcn_mfma_f32_32x32x16_bf16(X0, q_, f32x16{}, 0, 0, 0); n1 = __builtin_amdgcn_mfma_f32_32x32x16_bf16(X1, q_, f32x16{}, 0, 0, 0); }     \
    else { n0 = __builtin_amdgcn_mfma_f32_32x32x16_bf16(X0, q_, n0, 0, 0, 0); n1 = __builtin_amdgcn_mfma_f32_32x32x16_bf16(X1, q_, n1, 0, 0, 0); } } while (0)
#define MLA2_CE(k) do { p1[2 * (k)] = __builtin_amdgcn_exp2f(p1[2 * (k)]); p1[2 * (k) + 1] = __builtin_amdgcn_exp2f(p1[2 * (k) + 1]); ps2 += (f32x2v){p0[2 * (k)], p0[2 * (k) + 1]}; ps2 += (f32x2v){p1[2 * (k)], p1[2 * (k) + 1]}; \
    asm volatile("" : "+v"(p1), "+v"(ps2)); } while (0)
  MLA2_RD(0, a0, a1, aq); MLA2_RD(1, c0, c1, cq);
  MLA2_W2(2, a0, a1); MLA2_MM(0, a0, a1, aq); MLA2_RD(2, a0, a1, aq); MLA2_CE(0); MLA2_SBAR();
  MLA2_W2(2, c0, c1); MLA2_MM(1, c0, c1, cq); MLA2_RD(3, c0, c1, cq); MLA2_CE(1); MLA2_SBAR();
  MLA2_W2(2, a0, a1); MLA2_MM(2, a0, a1, aq); MLA2_RD(4, a0, a1, aq); MLA2_CE(2); MLA2_SBAR();
  MLA2_W2(3, c0, c1); MLA2_MM(3, c0, c1, cq); MLA2_RD(5, c0, c1, cq); MLA2_CE(3); MLA2_SBAR();
  MLA2_W3(3, a0, a1, aq); MLA2_MM(4, a0, a1, aq); MLA2_RD(6, a0, a1, aq); MLA2_CE(4); MLA2_SBAR();
  MLA2_W3(3, c0, c1, cq); MLA2_MM(5, c0, c1, cq); MLA2_RD(7, c0, c1, cq); MLA2_CE(5); MLA2_SBAR();
  MLA2_W3(3, a0, a1, aq); MLA2_MM(6, a0, a1, aq); MLA2_RD(8, a0, a1, aq); MLA2_CE(6); MLA2_SBAR();
  MLA2_W3(3, c0, c1, cq); MLA2_MM(7, c0, c1, cq); MLA2_RD(9, c0, c1, cq); MLA2_CE(7); MLA2_SBAR();
  MLA2_W3(3, a0, a1, aq); MLA2_MM(8, a0, a1, aq); MLA2_RD(10, a0, a1, aq);
  float ps = ps2[0] + ps2[1];
  { auto rr = __builtin_amdgcn_permlane32_swap(__float_as_uint(ps), __float_as_uint(ps), false, false); ps = __uint_as_float(rr[0]) + __uint_as_float(rr[1]); }
  l_reg = l_reg * alpha + ps; MLA2_PK4B(p0, 0, pa0); asm volatile("" : "+v"(l_reg), "+v"(pa0)); MLA2_SBAR();
  MLA2_W3(3, c0, c1, cq); MLA2_MM(9, c0, c1, cq); MLA2_RD(11, c0, c1, cq); MLA2_PK4B(p0, 8, pa1); asm volatile("" : "+v"(pa1)); MLA2_SBAR();
  MLA2_W3(3, a0, a1, aq); MLA2_MM(10, a0, a1, aq); MLA2_PK4B(p1, 0, pa2); asm volatile("" : "+v"(pa2)); MLA2_SBAR();
  MLA2_W3(0, c0, c1, cq); MLA2_MM(11, c0, c1, cq); MLA2_PK4B(p1, 8, pa3); asm volatile("" : "+v"(pa3)); MLA2_SBAR();
#undef MLA2_RD
#undef MLA2_MM
#undef MLA2_CE
}
template <int B> __device__ __forceinline__ void r2(f32x16 (&o)[4], int vb, bf16x8 pa0, bf16x8 pa1, bf16x8 pa2, bf16x8 pa3,
                                                    f32x16& q0, f32x16& q1, float& m_reg, float& alpha) {
  constexpr float C = SCALE * 1.4426950408889634f;
  s16x4 l0, h0, l1, h1, l2, h2; float mx, mnC;
#define MLA2_PK(L, H) (bf16x8){L[0], L[1], L[2], L[3], H[0], H[1], H[2], H[3]}
#define MLA2_PR(k, L, H) do { L = tr_read<B * SHM_V + v_rd_off((k) & 3, (k) >> 2, 0)>(vb); H = tr_read<B * SHM_V + v_rd_off((k) & 3, (k) >> 2, 1)>(vb); } while (0)
#define MLA2_PM(k, L, H) do { const bf16x8 pa_ = ((k) >> 2) == 0 ? pa0 : ((k) >> 2) == 1 ? pa1 : ((k) >> 2) == 2 ? pa2 : pa3; \
    o[(k) & 3] = __builtin_amdgcn_mfma_f32_32x32x16_bf16(pa_, MLA2_PK(L, H), o[(k) & 3], 0, 0, 0); } while (0)
#define MLA2_MX(Q, b) do { mx = max3f(mx, Q[b], Q[b + 1]); mx = max3f(mx, Q[b + 2], Q[b + 3]); mx = max3f(mx, Q[b + 4], Q[b + 5]); mx = max3f(mx, Q[b + 6], Q[b + 7]); } while (0)
#define MLA2_FM(Q, b) do { _Pragma("unroll") for (int e_ = 0; e_ < 4; e_ += 2) { f32x2v t_ = {Q[(b) + e_], Q[(b) + e_ + 1]}; t_ = t_ * C2 + M2; Q[(b) + e_] = t_[0]; Q[(b) + e_ + 1] = t_[1]; } asm volatile("" : "+v"(Q)); } while (0)
#define MLA2_EX(Q, b) do { _Pragma("unroll") for (int e_ = 0; e_ < 4; ++e_) Q[(b) + e_] = __builtin_amdgcn_exp2f(Q[(b) + e_]); asm volatile("" : "+v"(Q)); } while (0)
  MLA2_PR(0, l0, h0); MLA2_PR(1, l1, h1); MLA2_PR(2, l2, h2);
  mx = q0[0];
  MLA2_W2(4, l0, h0); MLA2_PM(0, l0, h0); MLA2_PR(3, l0, h0); MLA2_MX(q0, 0); MLA2_SBAR();
  MLA2_W2(4, l1, h1); MLA2_PM(1, l1, h1); MLA2_PR(4, l1, h1); MLA2_MX(q0, 8); MLA2_SBAR();
  MLA2_W2(4, l2, h2); MLA2_PM(2, l2, h2); MLA2_PR(5, l2, h2); MLA2_MX(q1, 0); MLA2_SBAR();
  MLA2_W2(4, l0, h0); MLA2_PM(3, l0, h0); MLA2_PR(6, l0, h0); MLA2_MX(q1, 8); MLA2_SBAR();
  MLA2_W2(4, l1, h1); MLA2_PM(4, l1, h1); MLA2_PR(7, l1, h1);
  { auto rr = __builtin_amdgcn_permlane32_swap(__float_as_uint(mx), __float_as_uint(mx), false, false); mx = fmaxf(__uint_as_float(rr[0]), __uint_as_float(rr[1])); }
  { const bool keep = __all(mx - m_reg <= THR / SCALE); const float mn = keep ? m_reg : fmaxf(m_reg, mx); const float al = __builtin_amdgcn_exp2f((m_reg - mn) * C);
    alpha = keep ? 1.f : al; m_reg = mn; mnC = -mn * C; asm volatile("" : "+v"(alpha), "+v"(m_reg), "+v"(mnC)); }
  const f32x2v C2 = {C, C}, M2 = {mnC, mnC};
  MLA2_SBAR();
  MLA2_W2(4, l2, h2); MLA2_PM(5, l2, h2); MLA2_PR(8, l2, h2); MLA2_FM(q0, 0); MLA2_FM(q0, 4); MLA2_SBAR();
  MLA2_W2(4, l0, h0); MLA2_PM(6, l0, h0); MLA2_PR(9, l0, h0); MLA2_FM(q0, 8); MLA2_FM(q0, 12); MLA2_SBAR();
  MLA2_W2(4, l1, h1); MLA2_PM(7, l1, h1); MLA2_PR(10, l1, h1); MLA2_FM(q1, 0); MLA2_FM(q1, 4); MLA2_SBAR();
  MLA2_W2(4, l2, h2); MLA2_PM(8, l2, h2); MLA2_PR(11, l2, h2); MLA2_FM(q1, 8); MLA2_FM(q1, 12); MLA2_SBAR();
  MLA2_W2(4, l0, h0); MLA2_PM(9, l0, h0); MLA2_PR(12, l0, h0); MLA2_EX(q0, 0); MLA2_SBAR();
  MLA2_W2(4, l1, h1); MLA2_PM(10, l1, h1); MLA2_PR(13, l1, h1); MLA2_EX(q0, 4); MLA2_SBAR();
  MLA2_W2(4, l2, h2); MLA2_PM(11, l2, h2); MLA2_PR(14, l2, h2); MLA2_EX(q0, 8); MLA2_SBAR();
  MLA2_W2(4, l0, h0); MLA2_PM(12, l0, h0); MLA2_PR(15, l0, h0); MLA2_EX(q0, 12); MLA2_SBAR();
  MLA2_W2(4, l1, h1); MLA2_PM(13, l1, h1); MLA2_SBAR();
  MLA2_W2(2, l2, h2); MLA2_PM(14, l2, h2); MLA2_SBAR();
  MLA2_W2(0, l0, h0); MLA2_PM(15, l0, h0); MLA2_SBAR();
#undef MLA2_PK
#undef MLA2_PR
#undef MLA2_PM
#undef MLA2_MX
#undef MLA2_FM
#undef MLA2_EX
}
__device__ __forceinline__ float bflo(unsigned u) { return __uint_as_float(u << 16); }
__device__ __forceinline__ float bfhi(unsigned u) { return __uint_as_float(u & 0xffff0000u); }

struct CvJob { const float* w1; const float* w3; const float* w2; unsigned char* d13; unsigned char* d2; float scale; int next, stride; };
constexpr int CV_G13 = 8 * (2048 / 16) * (7168 / 64), CV_G2 = 8 * (7168 / 16) * (2048 / 64), CV_NG = 2 * CV_G13 + CV_G2;
__device__ __forceinline__ void cv_issue(const CvJob& J, int lane, float (&r)[16], unsigned char*& dst) {
  const int g = J.next;
  if (g < 2 * CV_G13) { const int mm = g / CV_G13, rem = g - mm * CV_G13, e = rem / 14336, r2 = rem - e * 14336, nb = r2 >> 7, kb = r2 & 127;
    const float* src = (mm ? J.w3 : J.w1) + (size_t)e * 2048 * 7168 + (size_t)(kb * 16) * 7168 + nb * 64 + lane;
#pragma unroll
    for (int i = 0; i < 16; ++i) r[i] = src[(size_t)i * 7168];
    const int n = nb * 64 + lane; dst = J.d13 + (size_t)e * 14336 * 2048 + (size_t)((n >> 4) * 32 + mm * 16 + (n & 15)) * 2048 + kb * 16;
  } else { const int g2 = g - 2 * CV_G13, e = g2 / 14336, r2 = g2 - e * 14336, nb = r2 / 448, kb = r2 - nb * 448;
    const float* src = J.w2 + (size_t)e * 7168 * 2048 + (size_t)(kb * 16) * 2048 + nb * 64 + lane;
#pragma unroll
    for (int i = 0; i < 16; ++i) r[i] = src[(size_t)i * 2048];
    dst = J.d2 + (size_t)e * 2048 * 7168 + (size_t)(nb * 64 + lane) * 7168 + kb * 16; }
}
__device__ __forceinline__ unsigned cv_pk4(float a, float b, float c, float d, float s) {
  a = __builtin_fminf(__builtin_fmaxf(a * s, -448.f), 448.f); b = __builtin_fminf(__builtin_fmaxf(b * s, -448.f), 448.f); c = __builtin_fminf(__builtin_fmaxf(c * s, -448.f), 448.f); d = __builtin_fminf(__builtin_fmaxf(d * s, -448.f), 448.f);
  int w = 0; w = __builtin_amdgcn_cvt_pk_fp8_f32(a, b, w, false); w = __builtin_amdgcn_cvt_pk_fp8_f32(c, d, w, true); return (unsigned)w; }
__device__ __forceinline__ void cv_finish(const CvJob& J, const float (&r)[16], unsigned char* dst) {
  u32x4 o; o[0] = cv_pk4(r[0], r[1], r[2], r[3], J.scale); o[1] = cv_pk4(r[4], r[5], r[6], r[7], J.scale); o[2] = cv_pk4(r[8], r[9], r[10], r[11], J.scale); o[3] = cv_pk4(r[12], r[13], r[14], r[15], J.scale);
  *reinterpret_cast<u32x4*>(dst) = o;
}
__device__ __forceinline__ void attn_unit(const unsigned short* __restrict__ Qg, const unsigned short* __restrict__ KVg, const unsigned short* __restrict__ KPg,
                                          const float* __restrict__ cosT, const float* __restrict__ sinT, unsigned short* __restrict__ Og, int h, int q0, int seq, char* lds, CvJob& J) {
  const int tid = threadIdx.x, wid = tid >> 6, lane = tid & 63, r32 = lane & 31, hi = lane >> 5;
  char* V_lds = lds + OFF_V; char* KN_lds = lds + OFF_KN;
  float* ws = (float*)(lds + OFF_WS) + wid * 64; float* li_l = ws; float* al_l = ws + 32;
  float m_reg = -1e30f, l_reg = 0; f32x16 o[4] = {}; bf16x8 qr[NQREG];
  char* Qs = lds + OFF_QS + wid * QS_WAVE;
  {
    const int qrow = q0 + wid * QBLK + r32;
    const unsigned short* Qw = Qg + (size_t)qrow * LDQ + h * 192 + hi * 8;
#pragma unroll
    for (int d0 = 0; d0 < 8; ++d0) { const bf16x8 v = *reinterpret_cast<const bf16x8*>(Qw + d0 * 16);
      if (d0 < NQREG) qr[d0 < NQREG ? d0 : 0] = v; else *reinterpret_cast<bf16x8*>(Qs + MLA2_QB(r32, (d0 - NQREG) * 2 + hi)) = v; }
#pragma unroll
    for (int ab = 0; ab < 2; ++ab) {
      const u32x4 x1 = *reinterpret_cast<const u32x4*>(Qw + 128 + ab * 16), x2 = *reinterpret_cast<const u32x4*>(Qw + 128 + 32 + ab * 16);
      const float* cp = cosT + (size_t)qrow * 32 + ab * 16 + hi * 8; const float* sp = sinT + (size_t)qrow * 32 + ab * 16 + hi * 8;
      const f32x4v c0 = *reinterpret_cast<const f32x4v*>(cp), c1 = *reinterpret_cast<const f32x4v*>(cp + 4), s0 = *reinterpret_cast<const f32x4v*>(sp), s1 = *reinterpret_cast<const f32x4v*>(sp + 4);
      u32x4 o1, o2;
#define MLA2_ROT(W, CL, CH, SL, SH) do { const float a0 = bflo(x1[W]), a1 = bfhi(x1[W]), b0 = bflo(x2[W]), b1 = bfhi(x2[W]); \
        o1[W] = cvtpk(a0 * (CL) - b0 * (SL), a1 * (CH) - b1 * (SH)); o2[W] = cvtpk(b0 * (CL) + a0 * (SL), b1 * (CH) + a1 * (SH)); } while (0)
      MLA2_ROT(0, c0[0], c0[1], s0[0], s0[1]); MLA2_ROT(1, c0[2], c0[3], s0[2], s0[3]); MLA2_ROT(2, c1[0], c1[1], s1[0], s1[1]); MLA2_ROT(3, c1[2], c1[3], s1[2], s1[3]);
#undef MLA2_ROT
      *reinterpret_cast<u32x4*>(Qs + MLA2_QB(r32, (8 + ab - NQREG) * 2 + hi)) = o1;
      *reinterpret_cast<u32x4*>(Qs + MLA2_QB(r32, (10 + ab - NQREG) * 2 + hi)) = o2;
    }
  }
  const int lo = r32 * 32 + ((hi ^ ((r32 >> 3) & 1)) << 4);
  const int qbase = (int)(uintptr_t)Qs + lo;
  int kb[4];
#pragma unroll
  for (int j = 0; j < 4; ++j) kb[j] = (int)(uintptr_t)KN_lds + r32 * 128 + (((j * 2 + hi) ^ ((r32 >> 1) & 7)) << 4);
  const int vb0 = (int)(uintptr_t)V_lds + v_rd_base(lane);
  const unsigned short* Kh = KVg + h * 256; const unsigned short* Vh = KVg + h * 256 + 128;
  const int wu = __builtin_amdgcn_readfirstlane(wid);
  unsigned kd_off[3], kd_lds[3]; const unsigned short* kd_base[3]; int kd_stride[3];
#pragma unroll
  for (int i = 0; i < 3; ++i) { const int pi = 3 * wu + i, img = pi >> 3, grp = pi & 7, row = 8 * grp + (lane >> 3), c8 = (lane & 7) ^ ((row >> 1) & 7);
    kd_lds[i] = (unsigned)(uintptr_t)KN_lds + (unsigned)pi * 1024u;
    if (img < 2) { kd_base[i] = Kh + img * 64; kd_stride[i] = LDKV; kd_off[i] = (unsigned)(row * LDKV + c8 * 8) * 2u; }
    else { kd_base[i] = KPg; kd_stride[i] = LDKP; kd_off[i] = (unsigned)(row * LDKP + c8 * 8) * 2u; } }
  const int vkk = wu * 8 + ((lane & 31) >> 2), vk = (vkk & ~0xC) | ((vkk & 4) << 1) | ((vkk & 8) >> 1);
  const unsigned v_off = (unsigned)(vk * LDKV + (lane >> 5) * 32 + (lane & 3) * 8) * 2u;
  const unsigned ldsV = (unsigned)(uintptr_t)V_lds + (unsigned)wu * 2048u;
#define MLA2_DMA_K(b, k0) do { _Pragma("unroll") for (int i_ = 0; i_ < 3; ++i_) pg8::glds16s(kd_base[i_] + (size_t)(k0) * kd_stride[i_], kd_off[i_], kd_lds[i_] + (b) * SHM_K); } while (0)
#define MLA2_DMA_V(b, k0) do { const unsigned short* vb_ = Vh + (size_t)(k0) * LDKV; \
    pg8::glds16s(vb_, v_off, ldsV + (b) * SHM_V); pg8::glds16s(vb_ + 64, v_off, ldsV + (b) * SHM_V + 1024u); } while (0)
#define MLA2_LANDED() do { asm volatile("s_waitcnt vmcnt(0)" ::: "memory"); __syncthreads(); } while (0)
#define MLA2_RESC(a) do { if (__any((a) < 1.f)) { if (hi == 0) al_l[r32] = (a); asm volatile("s_waitcnt lgkmcnt(0)" ::: "memory"); \
    _Pragma("unroll") for (int d = 0; d < 4; ++d) _Pragma("unroll") for (int r = 0; r < 16; ++r) o[d][r] *= al_l[crow(r, hi)]; } } while (0)
  f32x16 pA0, pA1, pB0, pB1; float mnA, alA, alB; bf16x8 pa0, pa1, pa2, pa3; const int NT = seq / KVBLK;
  MLA2_DMA_K(0, 0); MLA2_DMA_V(0, 0); MLA2_DMA_K(1, KVBLK);
  MLA2_LANDED();
  qkt<0>(pA0, pA1, kb, qbase, qr); partialSM(pA0, pA1, m_reg, mnA, alA);
  __syncthreads();
  if (2 < NT) MLA2_DMA_K(0, 2 * KVBLK); MLA2_DMA_V(1, KVBLK);
  for (int j = 1; j + 1 < NT; j += 2) {
    float cvr[16]; unsigned char* cvd = nullptr; const bool cv_on = J.next < CV_NG;
    if (cv_on) cv_issue(J, lane, cvr, cvd);
    MLA2_SBAR(); r1<1>(pB0, pB1, kb, qbase, qr, pA0, pA1, alA, l_reg, pa0, pa1, pa2, pa3);
    r2<0>(o, vb0, pa0, pa1, pa2, pa3, pB0, pB1, m_reg, alB);
    MLA2_RESC(alB); MLA2_LANDED();
    if (j + 2 < NT) MLA2_DMA_K(1, (j + 2) * KVBLK); MLA2_DMA_V(0, (j + 1) * KVBLK);
    MLA2_SBAR(); r1<0>(pA0, pA1, kb, qbase, qr, pB0, pB1, alB, l_reg, pa0, pa1, pa2, pa3);
    r2<1>(o, vb0, pa0, pa1, pa2, pa3, pA0, pA1, m_reg, alA);
    if (cv_on) { cv_finish(J, cvr, cvd); J.next += J.stride; }
    MLA2_RESC(alA); MLA2_LANDED();
    if (j + 3 < NT) MLA2_DMA_K(0, (j + 3) * KVBLK); MLA2_DMA_V(1, (j + 2) * KVBLK);
  }
  MLA2_SBAR(); r1<1>(pB0, pB1, kb, qbase, qr, pA0, pA1, alA, l_reg, pa0, pa1, pa2, pa3);
  r2<0>(o, vb0, pa0, pa1, pa2, pa3, pB0, pB1, m_reg, alB);
  MLA2_RESC(alB); MLA2_LANDED();
  finishSM(pB0, pB1, alB, l_reg, pa0, pa1, pa2, pa3); MLA2_SBAR();
  pv<1>(o, vb0, pa0, pa1, pa2, pa3);
  if (hi == 0) li_l[r32] = l_reg; asm volatile("s_waitcnt lgkmcnt(0)" ::: "memory");
  float rli[16];
#pragma unroll
  for (int r = 0; r < 16; ++r) rli[r] = __builtin_amdgcn_rcpf(li_l[crow(r, hi)]);
  unsigned short* Ow = Og + (size_t)(q0 + wid * QBLK) * LDO + h * 128;
#pragma unroll
  for (int r = 0; r < 16; ++r) { const int orow = crow(r, hi);
#pragma unroll
    for (int d0 = 0; d0 < 4; ++d0) { const float v = o[d0][r] * rli[r]; unsigned u = __float_as_uint(v); u = (u + 0x7fffu + ((u >> 16) & 1u)) >> 16; Ow[(size_t)orow * LDO + d0 * 32 + r32] = (unsigned short)u; } }
  __syncthreads();
#undef MLA2_DMA_K
#undef MLA2_DMA_V
#undef MLA2_LANDED
#undef MLA2_RESC
}
}
constexpr int S = 16384, D = 2048;
constexpr int E_IN = 5120, CONVD = 1024, CONVW = 31, DIL_H = 16;
constexpr int FD = 5632;
constexpr int O_INP = 1280;
constexpr int QL = 512, KVL = 128, KVLP = 256, S5D = 512;
constexpr int NQ = 2304, NKV = 3072;
constexpr int NE = 8, FE = 7168;
constexpr int MAXROWS = 34816, MAXTILES = 136;
constexpr int S5_CL = 128, S5_NCH = S / S5_CL;
constexpr int ADA_KS = 16;
constexpr float MOE_WSCALE = 1024.f, MOE_HSCALE = 16.f, MOE_ASCALE = 8.f;

constexpr size_t MiB = 1u << 20;
constexpr size_t WS_CTL = 0, CTL_ZERO_BYTES = 1 * MiB;
constexpr size_t WS_MODP = 1 * MiB;
constexpr size_t WS_COS = 3 * MiB, WS_SIN = 5 * MiB;
constexpr size_t WS_S5P = 7 * MiB;
constexpr size_t WS_S5E = 384 * MiB;
constexpr size_t WS_ROUTE = 10 * MiB;
constexpr size_t RT_TOKE = 0, RT_TOKG = 128 * 1024, RT_POS = 256 * 1024, RT_ROWIDX = 384 * 1024, RT_TEXP = 528 * 1024, RT_NTILE = 529 * 1024;
constexpr size_t WS_YF = 11 * MiB;
constexpr size_t WS_WB = 44 * MiB;
constexpr size_t WB_EIN = WS_WB, WB_EOUT = WS_WB + 20 * MiB, WB_EF13 = WS_WB + 28 * MiB, WB_EF2 = WS_WB + 72 * MiB, WB_OIN = WS_WB + 94 * MiB,
                 WB_UQ = WS_WB + 99 * MiB, WB_UKV = WS_WB + 102 * MiB, WB_GLU = WS_WB + 104 * MiB, WB_OOUT = WS_WB + 105 * MiB, WB_M13 = WS_WB + 113 * MiB, WB_M2 = WS_WB + 561 * MiB;
constexpr size_t WS_HB = 830 * MiB;
constexpr size_t WS_Y = 894 * MiB;
constexpr size_t WS_R = 1022 * MiB;
constexpr size_t R_Z = WS_R, R_MIX = WS_R + 160 * MiB, R_ACT = WS_R + 224 * MiB, R_PO = WS_R + 400 * MiB, R_PML = WS_R + 496 * MiB;
constexpr size_t R_Z1 = WS_R, R_CQN = WS_R + 40 * MiB, R_CKVN = WS_R + 56 * MiB, R_KPE = WS_R + 64 * MiB, R_Q = WS_R + 66 * MiB, R_KV = WS_R + 138 * MiB,
                 R_MIX2 = WS_R + 234 * MiB, R_YG = WS_R + 298 * MiB;
constexpr size_t R_ACTS = WS_R, R_HS8 = WS_R + 240 * MiB, R_YS = WS_R + 476 * MiB;
constexpr size_t WS_END = WS_R + 612 * MiB;
constexpr int CW_BAR = 4096;
constexpr int CW_TBCNT = 16384;

constexpr int LDS_BYTES = 163840;
constexpr int COND_OFF = 133120;
constexpr int MISC_OFF = LDS_BYTES - 512;
constexpr int NWAVES = 8;

#define GAS __attribute__((address_space(1)))
#define LAS __attribute__((address_space(3)))
typedef unsigned short bf16;
typedef unsigned v4u __attribute__((ext_vector_type(4)));
typedef unsigned v2u __attribute__((ext_vector_type(2)));
typedef float f32x4 __attribute__((ext_vector_type(4)));
typedef float f32x2 __attribute__((ext_vector_type(2)));
typedef short bf16x8 __attribute__((ext_vector_type(8)));
#define LDS_WAIT() asm volatile("s_waitcnt lgkmcnt(0)" ::: "memory")
#define VM_WAIT() asm volatile("s_waitcnt vmcnt(0)" ::: "memory")
__device__ __forceinline__ unsigned f2bf(float f) { unsigned u = __builtin_bit_cast(unsigned, f); return (u + 0x7fffu + ((u >> 16) & 1u)) >> 16; }
__device__ __forceinline__ unsigned pk2(float lo, float hi) { return f2bf(lo) | (f2bf(hi) << 16); }
__device__ __forceinline__ float bflo(unsigned u) { return __uint_as_float(u << 16); }
__device__ __forceinline__ float bfhi(unsigned u) { return __uint_as_float(u & 0xffff0000u); }
__device__ __forceinline__ float bf1(unsigned short b) { return __uint_as_float(((unsigned)b) << 16); }
__device__ __forceinline__ float fexp(float x) { return __builtin_amdgcn_exp2f(1.4426950408889634f * x); }
__device__ __forceinline__ float fsilu(float v) { return v * __builtin_amdgcn_rcpf(1.0f + fexp(-v)); }
__device__ __forceinline__ float fsigmoid(float v) { return __builtin_amdgcn_rcpf(1.0f + fexp(-v)); }
__device__ __forceinline__ float wave_sum(float v) {
#pragma unroll
    for (int o = 1; o < 64; o <<= 1) v += __shfl_xor(v, o);
    return v;
}
__device__ __forceinline__ void sincos_rev(double rev, double& s, double& c) {
    rev -= __builtin_floor(rev);
    const double q4 = __builtin_floor(rev * 4.0 + 0.5);
    const double r = rev - q4 * 0.25;
    const double th = r * 6.283185307179586476925;
    const double t2 = th * th;
    double sp = 1.0 / 1307674368000.0; sp = sp * (-t2) + 1.0 / 6227020800.0; sp = sp * (-t2) + 1.0 / 39916800.0; sp = sp * (-t2) + 1.0 / 362880.0; sp = sp * (-t2) + 1.0 / 5040.0; sp = sp * (-t2) + 1.0 / 120.0; sp = sp * (-t2) + 1.0 / 6.0; sp = sp * (-t2) + 1.0;
    const double sn = sp * th;
    double cp = 1.0 / 87178291200.0; cp = cp * (-t2) + 1.0 / 479001600.0; cp = cp * (-t2) + 1.0 / 3628800.0; cp = cp * (-t2) + 1.0 / 40320.0; cp = cp * (-t2) + 1.0 / 720.0; cp = cp * (-t2) + 1.0 / 24.0; cp = cp * (-t2) + 0.5; cp = cp * (-t2) + 1.0;
    const int q = ((int)q4) & 3;
    s = (q == 0) ? sn : (q == 1) ? cp : (q == 2) ? -sn : -cp;
    c = (q == 0) ? cp : (q == 1) ? -sn : (q == 2) ? -cp : sn;
}
__device__ __forceinline__ double exp_small(double x) {
    double p = 1.0 / 3628800.0; p = p * x + 1.0 / 362880.0; p = p * x + 1.0 / 40320.0; p = p * x + 1.0 / 5040.0; p = p * x + 1.0 / 720.0; p = p * x + 1.0 / 120.0; p = p * x + 1.0 / 24.0; p = p * x + 1.0 / 6.0; p = p * x + 0.5; p = p * x + 1.0; p = p * x + 1.0;
    return p;
}

#define XB_TMO      128
#define XB_XCNT(j)  (256  + 64 * (j))
#define XB_XSUB(j)  (1280 + 64 * (j))
#define XB_XGEN(j)  (2304 + 64 * (j))
#define XB_TOP      3328
#define XB_TOPGEN   3392
#define XCD_BAR_WORDS 3456
#define XB_SPIN_CAP (1u << 20)
__device__ __forceinline__ unsigned xb_ld(unsigned* p)              { return __hip_atomic_load(p, __ATOMIC_RELAXED, __HIP_MEMORY_SCOPE_AGENT); }
__device__ __forceinline__ unsigned xb_add(unsigned* p, unsigned v) { return __hip_atomic_fetch_add(p, v, __ATOMIC_RELAXED, __HIP_MEMORY_SCOPE_AGENT); }
__device__ __forceinline__ unsigned xb_xcc_id() { return (unsigned)__builtin_amdgcn_s_getreg((3 << 11) | 20) & 0xFu; }
#define XB_SPIN(cond, bar) do { unsigned _sp = 0; while (cond) { __builtin_amdgcn_s_sleep(1); \
    if ((++_sp & 255u) == 0u) { if (xb_ld(&(bar)[XB_TMO])) break; if (_sp > XB_SPIN_CAP) { atomicAdd(&(bar)[XB_TMO], 1u); break; } } } } while (0)
struct XcdBarrier { unsigned* bar; unsigned x; volatile LAS unsigned* st; };
__device__ __forceinline__ XcdBarrier xcd_barrier_post(unsigned* bar, volatile LAS unsigned* st) {
    XcdBarrier b; b.bar = bar; b.x = xb_xcc_id(); b.st = st;
    if (threadIdx.x == 0) (void)xb_add(&bar[XB_XCNT(b.x)], 1u);
    return b;
}
__device__ __forceinline__ void xcd_barrier_complete(unsigned* bar, unsigned x, unsigned& nloc, unsigned& nx) {
    const unsigned G = gridDim.x * gridDim.y * gridDim.z;
    unsigned sum, cnt, mine, sp = 0u;
    for (;;) {
        sum = 0u; cnt = 0u; mine = 0u;
#pragma unroll
        for (unsigned j = 0; j < 16; ++j) { const unsigned c = xb_ld(&bar[XB_XCNT(j)]); sum += c; cnt += (c > 0u) ? 1u : 0u; mine = (j == x) ? c : mine; }
        if (sum == G) break;
        __builtin_amdgcn_s_sleep(1);
        if ((++sp & 255u) == 0u) { if (xb_ld(&bar[XB_TMO])) break; if (sp > XB_SPIN_CAP) { atomicAdd(&bar[XB_TMO], 1u); break; } }
    }
    nloc = mine > 0u ? mine : 1u; nx = cnt > 0u ? cnt : 1u;
}
__device__ __forceinline__ void xcd_barrier(const XcdBarrier& b) {
    asm volatile("s_waitcnt vmcnt(0)" ::: "memory");
    __syncthreads();
    if (threadIdx.x == 0) {
        unsigned* bar = b.bar;
        __builtin_amdgcn_s_waitcnt(0);
        unsigned nloc = b.st[0], nx = b.st[1];
        if (nloc == 0u) { xcd_barrier_complete(bar, b.x, nloc, nx); b.st[0] = nloc; b.st[1] = nx; }
        const unsigned old = xb_add(&bar[XB_XSUB(b.x)], 1u);
        const unsigned gen = old / nloc;
        if (old + 1u == (gen + 1u) * nloc) {
            __builtin_amdgcn_fence(__ATOMIC_RELEASE, "agent");
            asm volatile("s_waitcnt vmcnt(0)" ::: "memory");
            const unsigned og = xb_add(&bar[XB_TOP], 1u);
            const unsigned tg = og / nx;
            if (og + 1u == (tg + 1u) * nx) xb_add(&bar[XB_TOPGEN], 1u);
            else XB_SPIN(xb_ld(&bar[XB_TOPGEN]) == tg, bar);
            __builtin_amdgcn_fence(__ATOMIC_ACQUIRE, "agent");
            xb_add(&bar[XB_XGEN(b.x)], 1u);
            asm volatile("s_waitcnt vmcnt(0)" ::: "memory");
        } else {
            XB_SPIN(xb_ld(&bar[XB_XGEN(b.x)]) == gen, bar);
            __builtin_amdgcn_fence(__ATOMIC_ACQUIRE, "agent");
            asm volatile("s_waitcnt vmcnt(0)" ::: "memory");
        }
    }
    __syncthreads();
}

struct Args { const float* in[34]; float* out; unsigned char* ws; int ph_lo, ph_hi; };
enum { I_X = 0, I_C, I_T5, I_NG, I_ADAW, I_ADAB, I_EWIN, I_ECW, I_ECB, I_ECG, I_ECLB, I_EWOUT, I_EF1, I_EF3, I_EF2, I_OWIN, I_QNG, I_UQ, I_KVNG, I_UKV,
       I_SARE, I_SAIM, I_SLDT, I_SBRE, I_SBIM, I_SCRE, I_SCIM, I_SD, I_SGLU, I_OWOUT, I_RW, I_M1, I_M3, I_M2 };
struct Frame {
    LAS unsigned char* lds;
    const Args* a;
    unsigned char* ws;
    int tid, lane, wave, vcu, G, gw, NGW;
};

__device__ __forceinline__ void cvt_tile(const float* __restrict__ W, int K, int N, bf16* __restrict__ Wt, int ldk, int grp, int mul, int off, int item, LAS float* scr, int lane) {
    const int nblk = N >> 6, kb = item / nblk, nb = item - kb * nblk, k0 = kb << 6, n0 = nb << 6;
    const int lc = (lane & 15) * 4, lr = lane >> 4;
    f32x4 v[16];
#pragma unroll
    for (int i = 0; i < 16; ++i) v[i] = *(const f32x4*)(W + (size_t)(k0 + lr + 4 * i) * N + n0 + lc);
#pragma unroll
    for (int i = 0; i < 16; ++i) { LAS float* d = scr + (lr + 4 * i) * 65 + lc; d[0] = v[i][0]; d[1] = v[i][1]; d[2] = v[i][2]; d[3] = v[i][3]; }
    LDS_WAIT();
    const int c = lane & 7;
#pragma unroll
    for (int j = 0; j < 8; ++j) { const int n = (lane >> 3) + 8 * j; const LAS float* s = scr + (8 * c) * 65 + n;
        v4u o; o.x = pk2(s[0 * 65], s[1 * 65]); o.y = pk2(s[2 * 65], s[3 * 65]); o.z = pk2(s[4 * 65], s[5 * 65]); o.w = pk2(s[6 * 65], s[7 * 65]);
        const int nn = n0 + n, drow = (nn / grp) * (grp * mul) + off + (nn % grp);
        *(v4u*)(Wt + (size_t)drow * ldk + k0 + 8 * c) = o; }
    LDS_WAIT();
}

__device__ __forceinline__ unsigned pk4_fp8(float a, float b, float c, float d) {
    a = __builtin_fminf(__builtin_fmaxf(a, -448.f), 448.f); b = __builtin_fminf(__builtin_fmaxf(b, -448.f), 448.f); c = __builtin_fminf(__builtin_fmaxf(c, -448.f), 448.f); d = __builtin_fminf(__builtin_fmaxf(d, -448.f), 448.f);
    int w = 0; w = __builtin_amdgcn_cvt_pk_fp8_f32(a, b, w, false); w = __builtin_amdgcn_cvt_pk_fp8_f32(c, d, w, true); return (unsigned)w; }
__device__ __forceinline__ void cvt_tile8(const float* __restrict__ W, int K, int N, unsigned char* __restrict__ Wt, int ldk, int grp, int mul, int off, float scale, int item, LAS float* scr, int lane) {
    const int nblk = N >> 6, kb = item / nblk, nb = item - kb * nblk, k0 = kb << 6, n0 = nb << 6;
    const int lc = (lane & 15) * 4, lr = lane >> 4;
    f32x4 v[16];
#pragma unroll
    for (int i = 0; i < 16; ++i) v[i] = *(const f32x4*)(W + (size_t)(k0 + lr + 4 * i) * N + n0 + lc);
#pragma unroll
    for (int i = 0; i < 16; ++i) { LAS float* d = scr + (lr + 4 * i) * 65 + lc; d[0] = v[i][0] * scale; d[1] = v[i][1] * scale; d[2] = v[i][2] * scale; d[3] = v[i][3] * scale; }
    LDS_WAIT();
    const int c = lane & 3;
#pragma unroll
    for (int j = 0; j < 4; ++j) { const int n = (lane >> 2) + 16 * j; const LAS float* s = scr + (16 * c) * 65 + n;
        v4u o; o.x = pk4_fp8(s[0 * 65], s[1 * 65], s[2 * 65], s[3 * 65]); o.y = pk4_fp8(s[4 * 65], s[5 * 65], s[6 * 65], s[7 * 65]);
        o.z = pk4_fp8(s[8 * 65], s[9 * 65], s[10 * 65], s[11 * 65]); o.w = pk4_fp8(s[12 * 65], s[13 * 65], s[14 * 65], s[15 * 65]);
        const int nn = n0 + n, drow = (nn / grp) * (grp * mul) + off + (nn % grp);
        *(v4u*)(Wt + (size_t)drow * ldk + k0 + 16 * c) = o; }
    LDS_WAIT();
}

__device__ __forceinline__ void p0_prologue(Frame& F) {
    const Args& A = *F.a;
    LAS float* condL = (LAS float*)(F.lds + COND_OFF);
    for (int i = F.tid; i < D; i += NWAVES * 64) condL[i] = fsilu(A.in[I_C][i]);
    __syncthreads();
    LAS float* scr = (LAS float*)(F.lds + F.wave * 16640);
    const int lane = F.lane;
    constexpr int N_ADA = 96 * ADA_KS, N_ROPE = S * 32 / 64, N_S5 = 64, N_Z1 = 256, N_Z2 = 768;
#define CVT_M(SRC, KK, NN, DSTOFF, LDK, GRP, MUL, OFF, NEXP) { constexpr int per = ((KK) / 64) * ((NN) / 64); constexpr int tot = per * (NEXP); \
        if (r < tot) { const int e = r / per, t = r - e * per; cvt_tile(A.in[SRC] + (size_t)e * (KK) * (NN), KK, NN, (bf16*)(F.ws + (DSTOFF)) + (size_t)e * ((NN) * (MUL)) * (LDK), LDK, GRP, MUL, OFF, t, scr, lane); continue; } r -= tot; }
#define CVT_M8(SRC, KK, NN, DSTOFF, LDK, GRP, MUL, OFF, NEXP) { constexpr int per = ((KK) / 64) * ((NN) / 64); constexpr int tot = per * (NEXP); \
        if (r < tot) { const int e = r / per, t = r - e * per; cvt_tile8(A.in[SRC] + (size_t)e * (KK) * (NN), KK, NN, (unsigned char*)(F.ws + (DSTOFF)) + (size_t)e * ((NN) * (MUL)) * (LDK), LDK, GRP, MUL, OFF, MOE_WSCALE, t, scr, lane); continue; } r -= tot; }
    constexpr int N_CVT = (32 * 80) + (32 * 32) + 2 * (32 * 88) + (88 * 32) + (32 * 19) + (8 * 36) + (2 * 48) + (8 * 8) + (32 * 32);
    constexpr int N_ITEMS = N_CVT + N_ADA + N_ROPE + N_S5 + N_Z1 + N_Z2;
    for (int it = F.gw; it < N_ITEMS; it += F.NGW) {
        int r = it;
        CVT_M(I_EWIN, 2048, 5120, WB_EIN, 2048, 64, 1, 0, 1)
        CVT_M(I_EWOUT, 2048, 2048, WB_EOUT, 2048, 64, 1, 0, 1)
        CVT_M(I_EF1, 2048, 5632, WB_EF13, 2048, 16, 2, 0, 1)
        CVT_M(I_EF3, 2048, 5632, WB_EF13, 2048, 16, 2, 16, 1)
        CVT_M(I_EF2, 5632, 2048, WB_EF2, 5632, 64, 1, 0, 1)
        CVT_M(I_OWIN, 2048, 1216, WB_OIN, 2048, 64, 1, 0, 1)
        CVT_M(I_UQ, 512, 2304, WB_UQ, 512, 64, 1, 0, 1)
        CVT_M(I_UKV, 128, 3072, WB_UKV, 256, 64, 1, 0, 1)
        CVT_M(I_SGLU, 512, 512, WB_GLU, 512, 64, 1, 0, 1)
        CVT_M(I_OWOUT, 2048, 2048, WB_OOUT, 2048, 64, 1, 0, 1)
        if (r < N_ADA) {
            const int chunk = r % 96, ks = r / 96, l = chunk / 48, n0 = (chunk % 48) * 256;
            const float* w = A.in[I_ADAW] + (size_t)l * D * 12288 + (size_t)(ks * 128) * 12288 + n0 + 4 * lane;
            f32x4 acc = {0.f, 0.f, 0.f, 0.f};
#pragma unroll 8
            for (int k = 0; k < 128; ++k) { const f32x4 v = *(const f32x4*)(w + (size_t)k * 12288); const float cv = condL[ks * 128 + k]; acc += v * cv; }
            *(f32x4*)((float*)(F.ws + WS_MODP) + (size_t)ks * 24576 + l * 12288 + n0 + 4 * lane) = acc;
            continue; }
        r -= N_ADA;
        if (r < N_ROPE) {
            const int idx = r * 64 + lane, pos = idx >> 5, j = idx & 31;
            double f = 1.0; for (int q = 0; q < j; ++q) f *= 0.74989420933245582730;
            const float ang = (float)pos * (float)f;
            double sn, cs; sincos_rev((double)ang * 0.15915494309189533577, sn, cs);
            ((float*)(F.ws + WS_COS))[idx] = (float)cs; ((float*)(F.ws + WS_SIN))[idx] = (float)sn;
            continue; }
        r -= N_ROPE;
        if (r < N_S5) {
            const int p = lane;
            const double are = (double)A.in[I_SARE][r * 64 + p], aim = (double)A.in[I_SAIM][r * 64 + p];
            const double dt = (double)fexp(A.in[I_SLDT][r]);
            const double er = exp_small(are * dt); double sn, cs; sincos_rev(aim * dt * 0.15915494309189533577, sn, cs);
            const double abr = er * cs, abi = er * sn;
            double eL = er; for (int q = 1; q < S5_CL; q <<= 1) eL *= eL;
            double snL, csL; sincos_rev(aim * dt * (double)S5_CL * 0.15915494309189533577, snL, csL);
            const double nr = abr - 1.0, ni = abi, den = are * are + aim * aim;
            const double qr = (nr * are + ni * aim) / den, qi = (ni * are - nr * aim) / den;
            float* o = (float*)(F.ws + WS_S5P) + (size_t)r * 36 * 64;
            o[0 * 64 + p] = (float)abr; o[1 * 64 + p] = (float)abi; o[2 * 64 + p] = (float)(eL * csL); o[3 * 64 + p] = (float)(eL * snL);
#pragma unroll
            for (int c = 0; c < 16; ++c) { const double br = (double)A.in[I_SBRE][(size_t)(r * 64 + p) * 16 + c], bi = (double)A.in[I_SBIM][(size_t)(r * 64 + p) * 16 + c];
                o[(4 + c) * 64 + p] = (float)(qr * br - qi * bi); o[(20 + c) * 64 + p] = (float)(qr * bi + qi * br); }
            continue; }
        r -= N_S5;
        if (r < N_Z1) { ((v4u*)(F.ws + WB_OIN + (size_t)1216 * 2048 * 2))[r * 64 + lane] = (v4u){0u, 0u, 0u, 0u}; continue; }
        r -= N_Z1;
        { const int ch = r * 64 + lane, row = ch >> 4, cc = ch & 15; *(v4u*)(F.ws + WB_UKV + (size_t)row * 512 + 256 + cc * 16) = (v4u){0u, 0u, 0u, 0u}; }
    }
#undef CVT_M
#undef CVT_M8
}

__device__ __forceinline__ float mod_val(Frame& F, int L, int chunk, int col) {
    const Args& A = *F.a; const int o = L * 12288 + chunk * 2048 + col;
    float s = A.in[I_ADAB][o]; const float* mp = (const float*)(F.ws + WS_MODP) + o;
#pragma unroll
    for (int ks = 0; ks < ADA_KS; ++ks) s += mp[(size_t)ks * 24576];
    return s;
}
template <bool RES, bool HOUT, bool ROUTE, bool GATHER>
__device__ __forceinline__ void resnorm_phase(Frame& F, const float* xin, float* xout, const bf16* y, int Lr, int gchunk, int gi1, int Lh, int shchunk, int gi2) {
    const Args& A = *F.a;
    LAS float* A1 = (LAS float*)F.lds; LAS float* A2 = A1 + D; LAS float* B2 = A2 + D; LAS float* RT = B2 + D;
    for (int col = F.tid; col < D; col += NWAVES * 64) {
        if (RES) A1[col] = mod_val(F, Lr, gchunk, col) * A.in[I_NG][(Lr * 4 + gi1) * D + col];
        if (HOUT) { A2[col] = A.in[I_NG][(Lh * 4 + gi2) * D + col] * (1.0f + mod_val(F, Lh, shchunk + 1, col)); B2[col] = mod_val(F, Lh, shchunk, col); }
    }
    if (ROUTE) for (int i = F.tid; i < D * NE; i += NWAVES * 64) RT[(i & 7) * D + (i >> 3)] = A.in[I_RW][i];
    __syncthreads();
    const int lane = F.lane;
    bf16* hb = (bf16*)(F.ws + WS_HB);
    for (int row = F.gw; row < S; row += F.NGW) {
        f32x4 xv[8];
#pragma unroll
        for (int j = 0; j < 8; ++j) xv[j] = *(const f32x4*)(xin + (size_t)row * D + 4 * lane + 256 * j);
        if (RES) {
            f32x4 yv[8];
            if (GATHER) {
                const int* pos = (const int*)(F.ws + WS_ROUTE + RT_POS); const float* tg = (const float*)(F.ws + WS_ROUTE + RT_TOKG);
                const int p0 = pos[2 * row], p1 = pos[2 * row + 1]; const float g0 = tg[2 * row], g1 = tg[2 * row + 1];
                const bf16* ys = (const bf16*)(F.ws + R_YS);
#pragma unroll
                for (int j = 0; j < 8; ++j) { const v2u a = *(const v2u*)(ys + (size_t)p0 * D + 4 * lane + 256 * j), b = *(const v2u*)(ys + (size_t)p1 * D + 4 * lane + 256 * j);
                    yv[j] = (f32x4){g0 * bflo(a.x) + g1 * bflo(b.x), g0 * bfhi(a.x) + g1 * bfhi(b.x), g0 * bflo(a.y) + g1 * bflo(b.y), g0 * bfhi(a.y) + g1 * bfhi(b.y)}; }
            } else {
#pragma unroll
                for (int j = 0; j < 8; ++j) { const v2u a = *(const v2u*)(y + (size_t)row * D + 4 * lane + 256 * j); yv[j] = (f32x4){bflo(a.x), bfhi(a.x), bflo(a.y), bfhi(a.y)}; }
            }
            float ss = 0.f;
#pragma unroll
            for (int j = 0; j < 8; ++j) ss += (yv[j][0] * yv[j][0] + yv[j][1] * yv[j][1]) + (yv[j][2] * yv[j][2] + yv[j][3] * yv[j][3]);
            const float rstd = 1.0f / sqrtf(wave_sum(ss) * (1.0f / D) + 1e-6f);
#pragma unroll
            for (int j = 0; j < 8; ++j) { const f32x4 a1 = *(const LAS f32x4*)(A1 + 4 * lane + 256 * j); xv[j] += a1 * (yv[j] * rstd);
                *(f32x4*)(xout + (size_t)row * D + 4 * lane + 256 * j) = xv[j]; }
        }
        if (HOUT) {
            float ss = 0.f;
#pragma unroll
            for (int j = 0; j < 8; ++j) ss += (xv[j][0] * xv[j][0] + xv[j][1] * xv[j][1]) + (xv[j][2] * xv[j][2] + xv[j][3] * xv[j][3]);
            const float rstd = 1.0f / sqrtf(wave_sum(ss) * (1.0f / D) + 1e-6f);
#pragma unroll
            for (int j = 0; j < 8; ++j) { const f32x4 a2 = *(const LAS f32x4*)(A2 + 4 * lane + 256 * j), b2 = *(const LAS f32x4*)(B2 + 4 * lane + 256 * j);
                xv[j] = (xv[j] * rstd) * a2 + b2;
                if (ROUTE) { *(unsigned*)((unsigned char*)hb + (size_t)row * D + 4 * lane + 256 * j) = pk4_fp8(xv[j][0] * MOE_HSCALE, xv[j][1] * MOE_HSCALE, xv[j][2] * MOE_HSCALE, xv[j][3] * MOE_HSCALE); }
                else { v2u w; w.x = pk2(xv[j][0], xv[j][1]); w.y = pk2(xv[j][2], xv[j][3]);
                *(v2u*)(hb + (size_t)row * D + 4 * lane + 256 * j) = w; } }
            if (ROUTE) {
                int i0 = -1, i1 = -1; float v0 = -3.0e38f, v1 = -3.0e38f;
#pragma nounroll
                for (int e = 0; e < NE; ++e) { float s = 0.f;
#pragma unroll
                    for (int j = 0; j < 8; ++j) { const f32x4 w = *(const LAS f32x4*)(RT + e * D + 4 * lane + 256 * j); s += (xv[j][0] * w[0] + xv[j][1] * w[1]) + (xv[j][2] * w[2] + xv[j][3] * w[3]); }
                    s = wave_sum(s);
                    if (s > v0) { v1 = v0; i1 = i0; v0 = s; i0 = e; } else if (s > v1) { v1 = s; i1 = e; } }
                const float g0 = 1.0f / (1.0f + fexp(v1 - v0)), g1 = 1.0f - g0;
                if (lane == 0) {
                    int* te = (int*)(F.ws + WS_ROUTE + RT_TOKE); float* tg = (float*)(F.ws + WS_ROUTE + RT_TOKG);
                    te[2 * row] = i0; te[2 * row + 1] = i1; tg[2 * row] = g0; tg[2 * row + 1] = g1;
                    unsigned* cnt = (unsigned*)(F.ws + WS_CTL) + CW_TBCNT + (row >> 6) * NE;
                    atomicAdd(cnt + i0, 1u); atomicAdd(cnt + i1, 1u);
                }
            }
        }
    }
}

__device__ __forceinline__ void moe_slots_phase(Frame& F) {
    LAS int* cntL = (LAS int*)F.lds;
    LAS int* tot = cntL + 2048;
    LAS int* base = tot + 8; LAS int* tbase = base + 8; LAS int* texpL = tbase + 16;
    const unsigned* cnt = (const unsigned*)(F.ws + WS_CTL) + CW_TBCNT;
    for (int i = F.tid; i < 2048; i += NWAVES * 64) cntL[i] = (int)cnt[i];
    __syncthreads();
    if (F.tid < NE) { int s = 0; for (int b = 0; b < 256; ++b) s += cntL[b * 8 + F.tid]; tot[F.tid] = s; }
    __syncthreads();
    if (F.tid == 0) { int b = 0, tb = 0; for (int e = 0; e < NE; ++e) { base[e] = b; tbase[e] = tb; const int nt = (tot[e] + 255) >> 8; for (int q = 0; q < nt; ++q) texpL[tb + q] = e; tb += nt; b += nt * 256; } tbase[NE] = tb; }
    __syncthreads();
    const int NT = tbase[NE];
    int* rowidx = (int*)(F.ws + WS_ROUTE + RT_ROWIDX); int* pos = (int*)(F.ws + WS_ROUTE + RT_POS);
    const int* te = (const int*)(F.ws + WS_ROUTE + RT_TOKE);
    if (blockIdx.x == 0) { int* texp = (int*)(F.ws + WS_ROUTE + RT_TEXP); for (int i = F.tid; i < NT; i += NWAVES * 64) texp[i] = texpL[i]; if (F.tid == 0) *(int*)(F.ws + WS_ROUTE + RT_NTILE) = NT; }
    LAS int* slotL = texpL + 160;
    const unsigned char* hb8 = (const unsigned char*)(F.ws + WS_HB); unsigned char* hs8 = (unsigned char*)(F.ws + R_HS8);
    for (int tb = blockIdx.x; tb < 256; tb += F.G) {
        if (F.wave == 0) {
            const int tok = tb * 64 + F.lane;
            const int e0 = te[2 * tok], e1 = te[2 * tok + 1];
            const unsigned long long lt = (F.lane == 0) ? 0ull : (~0ull >> (64 - F.lane));
#pragma unroll
            for (int e = 0; e < NE; ++e) {
                int pre = 0; for (int b = 0; b < tb; ++b) pre += cntL[b * 8 + e];
                const unsigned long long m0 = __ballot(e0 == e), m1 = __ballot(e1 == e);
                const int st = base[e] + pre;
                if (e0 == e) { const int s = st + __popcll(m0 & lt); rowidx[s] = tok; pos[2 * tok] = s; slotL[2 * F.lane] = s; }
                if (e1 == e) { const int s = st + __popcll(m0) + __popcll(m1 & lt); rowidx[s] = tok; pos[2 * tok + 1] = s; slotL[2 * F.lane + 1] = s; }
            }
        }
        __syncthreads();
        for (int idx = F.tid; idx < 128 * 128; idx += NWAVES * 64) { const int si = idx >> 7, ch = idx & 127;
            const v4u v = *(const v4u*)(hb8 + (size_t)(tb * 64 + (si >> 1)) * D + ch * 16);
            *(v4u*)(hs8 + (size_t)slotL[si] * D + ch * 16) = v; }
        __syncthreads();
    }
}
__device__ __forceinline__ void conv_phase(Frame& F) {
    const Args& A = *F.a;
    const bf16* z = (const bf16*)(F.ws + R_Z); bf16* mix = (bf16*)(F.ws + R_MIX);
    LAS unsigned char* gl = F.lds;
    LAS float* part = (LAS float*)(F.lds + 126976);
    LAS float* stat = part + 512;
    const int tid = F.tid, ch = 2 * tid;
    float w0[CONVW], w1[CONVW];
#pragma unroll
    for (int w = 0; w < CONVW; ++w) { const f32x2 v = *(const f32x2*)(A.in[I_ECW] + w * CONVD + ch); w0[w] = v[0]; w1[w] = v[1]; }
    const f32x2 cb = *(const f32x2*)(A.in[I_ECB] + ch), lg = *(const f32x2*)(A.in[I_ECG] + ch), lb = *(const f32x2*)(A.in[I_ECLB] + ch);
    for (int tile = blockIdx.x; tile < S / 32; tile += F.G) {
        const int t0 = tile * 32;
        for (int idx = tid; idx < 62 * 128; idx += NWAVES * 64) {
            const int row = idx >> 7, c8 = (idx & 127) * 8, t = t0 - 15 + row;
            v4u o = {0u, 0u, 0u, 0u};
            if (t >= 0 && t < S) {
                const v4u a = *(const v4u*)(z + (size_t)t * E_IN + c8), g = *(const v4u*)(z + (size_t)t * E_IN + CONVD + c8);
#pragma unroll
                for (int q = 0; q < 4; ++q) o[q] = pk2(bflo(a[q]) * fsigmoid(bflo(g[q])), bfhi(a[q]) * fsigmoid(bfhi(g[q])));
            }
            *(LAS v4u*)(gl + row * 2048 + c8 * 2) = o;
        }
        __syncthreads();
#pragma nounroll
        for (int half = 0; half < 2; ++half) {
            float a0[16], a1[16];
#pragma unroll
            for (int i = 0; i < 16; ++i) { a0[i] = cb[0]; a1[i] = cb[1]; }
            const LAS unsigned char* gh = gl + half * 16 * 2048 + tid * 4;
#pragma unroll
            for (int r = 0; r < 46; ++r) {
                const unsigned v = *(const LAS unsigned*)(gh + r * 2048);
                const float v0 = bflo(v), v1 = bfhi(v);
#pragma unroll
                for (int i = 0; i < 16; ++i) { if (r - i >= 0 && r - i < CONVW) { a0[i] += v0 * w0[r - i]; a1[i] += v1 * w1[r - i]; } }
            }
#pragma unroll
            for (int i = 0; i < 16; ++i) {
                float s1 = a0[i] + a1[i], s2 = a0[i] * a0[i] + a1[i] * a1[i];
                s1 = wave_sum(s1); s2 = wave_sum(s2);
                if (F.lane == 0) { part[(F.wave * 16 + i) * 2] = s1; part[(F.wave * 16 + i) * 2 + 1] = s2; }
            }
            __syncthreads();
            if (tid < 16) { float s1 = 0.f, s2 = 0.f;
#pragma unroll
                for (int w = 0; w < NWAVES; ++w) { s1 += part[(w * 16 + tid) * 2]; s2 += part[(w * 16 + tid) * 2 + 1]; }
                const float mean = s1 * (1.0f / CONVD), var = fmaxf(s2 * (1.0f / CONVD) - mean * mean, 0.f);
                stat[tid * 2] = mean; stat[tid * 2 + 1] = 1.0f / sqrtf(var + 1e-5f); }
            __syncthreads();
#pragma unroll
            for (int i = 0; i < 16; ++i) {
                const float mean = stat[i * 2], rstd = stat[i * 2 + 1];
                const float y0 = (a0[i] - mean) * rstd * lg[0] + lb[0], y1 = (a1[i] - mean) * rstd * lg[1] + lb[1];
                *(unsigned*)(mix + (size_t)(t0 + half * 16 + i) * D + ch) = pk2(fsilu(y0), fsilu(y1));
            }
            __syncthreads();
        }
    }
}

__device__ __forceinline__ int t5_bucket_dev(int rel) {
    const int n = rel < 0 ? -rel : rel;
    int large = 8 + (int)(__logf((float)(n < 1 ? 1 : n) * 0.125f) / 4.852030263919617f * 8.0f);
    large = large < 15 ? large : 15;
    return (rel > 0 ? 16 : 0) + (n < 8 ? n : large);
}
__device__ __forceinline__ void latent_phase(Frame& F) {
    const Args& A = *F.a; const int lane = F.lane;
    const bf16* z1 = (const bf16*)(F.ws + R_Z1); bf16* cqn = (bf16*)(F.ws + R_CQN); bf16* ckvn = (bf16*)(F.ws + R_CKVN); bf16* kpe = (bf16*)(F.ws + R_KPE);
    const float* cosT = (const float*)(F.ws + WS_COS); const float* sinT = (const float*)(F.ws + WS_SIN);
    float qg[8]; { const f32x4 a = *(const f32x4*)(A.in[I_QNG] + 8 * lane), b = *(const f32x4*)(A.in[I_QNG] + 8 * lane + 4); qg[0] = a[0]; qg[1] = a[1]; qg[2] = a[2]; qg[3] = a[3]; qg[4] = b[0]; qg[5] = b[1]; qg[6] = b[2]; qg[7] = b[3]; }
    const f32x2 kg = *(const f32x2*)(A.in[I_KVNG] + 2 * lane);
    for (int row = F.gw; row < S; row += F.NGW) {
        const bf16* zr = z1 + (size_t)row * O_INP;
        const v4u q = *(const v4u*)(zr + 8 * lane);
        float v[8]; float ss = 0.f;
#pragma unroll
        for (int e = 0; e < 4; ++e) { v[2 * e] = bflo(q[e]); v[2 * e + 1] = bfhi(q[e]); ss += v[2 * e] * v[2 * e] + v[2 * e + 1] * v[2 * e + 1]; }
        const float r1 = 1.0f / sqrtf(wave_sum(ss) * (1.0f / QL) + 1e-6f);
        v4u o;
#pragma unroll
        for (int e = 0; e < 4; ++e) o[e] = pk2(v[2 * e] * r1 * qg[2 * e], v[2 * e + 1] * r1 * qg[2 * e + 1]);
        *(v4u*)(cqn + (size_t)row * QL + 8 * lane) = o;
        const unsigned kv = *(const unsigned*)(zr + 512 + 2 * lane);
        const float k0 = bflo(kv), k1 = bfhi(kv);
        const float r2 = 1.0f / sqrtf(wave_sum(k0 * k0 + k1 * k1) * (1.0f / KVL) + 1e-6f);
        *(unsigned*)(ckvn + (size_t)row * KVLP + 2 * lane) = pk2(k0 * r2 * kg[0], k1 * r2 * kg[1]);
        *(unsigned*)(ckvn + (size_t)row * KVLP + 128 + 2 * lane) = 0u;
        if (lane < 32) {
            const float x1 = bf1(zr[640 + lane]), x2 = bf1(zr[672 + lane]), cs = cosT[row * 32 + lane], sn = sinT[row * 32 + lane];
            kpe[(size_t)row * 64 + lane] = (bf16)f2bf(x1 * cs - x2 * sn); kpe[(size_t)row * 64 + 32 + lane] = (bf16)f2bf(x2 * cs + x1 * sn);
        }
    }
}

namespace s5 {
using bf16x8 = __attribute__((ext_vector_type(8))) short;
using f32x16 = __attribute__((ext_vector_type(16))) float;
constexpr int XS_ROW = 272;
constexpr int WAVE_LDS = 32 * XS_ROW + 2 * S5_CL * 16 * 2;
struct Par { float ar0, ai0, ar1, ai1, Lr0, Li0, Lr1, Li1; bf16x8 bt[4]; };
__device__ __forceinline__ void load_par(Frame& F, int dg, int n, int hb, Par& P) {
    const float* sp = (const float*)(F.ws + WS_S5P) + (size_t)dg * 36 * 64;
    P.ar0 = sp[n]; P.ai0 = sp[64 + n]; P.Lr0 = sp[128 + n]; P.Li0 = sp[192 + n];
    P.ar1 = sp[32 + n]; P.ai1 = sp[64 + 32 + n]; P.Lr1 = sp[128 + 32 + n]; P.Li1 = sp[192 + 32 + n];
#pragma unroll
    for (int t = 0; t < 4; ++t) { const float* b = sp + (size_t)((t < 2 ? 4 : 20) + 8 * hb) * 64 + 32 * (t & 1) + n;
        v4u w; w.x = pk2(b[0], b[64]); w.y = pk2(b[128], b[192]); w.z = pk2(b[256], b[320]); w.w = pk2(b[384], b[448]); P.bt[t] = __builtin_bit_cast(bf16x8, w); }
}
__device__ __forceinline__ int tok_of(int c0, int sp, int dir) { return dir ? (c0 + S5_CL - 1 - sp) : (c0 + sp); }
__device__ __forceinline__ void bu_block(Frame& F, const Par& P, int g, int ck, int blk, int dir, int lane, f32x16 (&D)[4]) {
    const bf16* z1 = (const bf16*)(F.ws + R_Z1);
    const int m = lane & 31, ha = lane >> 5, seg = (m >> 2) & 1, idx = 4 * (m >> 3) + (m & 3);
    const int t = tok_of((ck + 64 * seg) * S5_CL, 16 * blk + idx, dir);
    const bf16x8 ua = *(const bf16x8*)(z1 + (size_t)t * O_INP + 704 + g * 16 + 8 * ha);
#pragma unroll
    for (int q = 0; q < 4; ++q) D[q] = __builtin_amdgcn_mfma_f32_32x32x16_bf16(ua, P.bt[q], f32x16{}, 0, 0, 0);
}
__device__ __forceinline__ void scan16(const Par& P, f32x16 (&D)[4], float& x0r, float& x0i, float& x1r, float& x1i) {
#pragma unroll
    for (int r = 0; r < 16; ++r) {
        const float n0r = fmaf(P.ar0, x0r, fmaf(-P.ai0, x0i, D[0][r])), n0i = fmaf(P.ar0, x0i, fmaf(P.ai0, x0r, D[2][r]));
        const float n1r = fmaf(P.ar1, x1r, fmaf(-P.ai1, x1i, D[1][r])), n1i = fmaf(P.ar1, x1i, fmaf(P.ai1, x1r, D[3][r]));
        x0r = n0r; x0i = n0i; x1r = n1r; x1i = n1i; D[0][r] = n0r; D[2][r] = n0i; D[1][r] = n1r; D[3][r] = n1i; }
}
}

__device__ __forceinline__ void s5_pass1(Frame& F) {
    using namespace s5;
    float* E = (float*)(F.ws + WS_S5E);
    const int lane = F.lane, n = lane & 31, hd = lane >> 5;
    for (int task = F.gw; task < 32 * 64; task += F.NGW) {
        const int g = task >> 6, ck = task & 63;
        for (int dir = 0; dir < 2; ++dir) {
            Par P; load_par(F, dir * 32 + g, n, hd, P);
            float x0r = 0.f, x0i = 0.f, x1r = 0.f, x1i = 0.f;
            for (int blk = 0; blk < S5_CL / 16; ++blk) { f32x16 D[4]; bu_block(F, P, g, ck, blk, dir, lane, D); scan16(P, D, x0r, x0i, x1r, x1i); }
            float* e = E + ((size_t)((dir * 32 + g) * S5_NCH + ck + 64 * hd) * 2) * 64 + n;
            e[0] = x0r; e[64] = x0i; e[32] = x1r; e[96] = x1i;
        }
    }
}
__device__ __forceinline__ float gelu_tanh(float x) { const float u = 0.7978845608028654f * (x + 0.044715f * x * x * x); const float t = 1.0f - 2.0f * __builtin_amdgcn_rcpf(1.0f + fexp(2.0f * u)); return 0.5f * x * (1.0f + t); }
__device__ __forceinline__ void s5_pass3(Frame& F) {
    using namespace s5;
    const Args& A = *F.a;
    LAS unsigned char* xs = F.lds + F.wave * WAVE_LDS; LAS bf16* yfl = (LAS bf16*)(xs + 32 * XS_ROW);
    const float* E = (const float*)(F.ws + WS_S5E); bf16* YG = (bf16*)(F.ws + R_YG); const bf16* z1 = (const bf16*)(F.ws + R_Z1);
    const int lane = F.lane, n = lane & 31, hd = lane >> 5, cn = lane & 15, kq = lane >> 4;
    for (int task = F.gw; task < 32 * 64; task += F.NGW) {
        const int g = task >> 6, ck = task & 63, ckl = ck + 64 * hd;
        const float dsk = A.in[I_SD][g * 16 + cn];
        for (int dir = 0; dir < 2; ++dir) {
            const int dg = dir * 32 + g;
            Par P; load_par(F, dg, n, hd, P);
            float x0r = 0.f, x0i = 0.f, x1r = 0.f, x1i = 0.f;
            { const float* e = E + ((size_t)dg * S5_NCH * 2) * 64 + n; const int nprev = dir ? (S5_NCH - 1 - ckl) : ckl;
              const int nmax = dir ? (S5_NCH - 1 - ck) : (ck + 64);
              for (int j0 = 0; j0 < nmax; j0 += 8) {
                  float er0[8], ei0[8], er1[8], ei1[8];
#pragma unroll
                  for (int q = 0; q < 8; ++q) { const int jj = (j0 + q < nprev) ? (j0 + q) : 0; const int j = dir ? (S5_NCH - 1 - jj) : jj; const float* ej = e + (size_t)j * 128;
                      er0[q] = ej[0]; ei0[q] = ej[64]; er1[q] = ej[32]; ei1[q] = ej[96]; }
#pragma unroll
                  for (int q = 0; q < 8; ++q) { if (j0 + q < nprev) {
                      const float a = P.Lr0 * x0r - P.Li0 * x0i + er0[q], b = P.Lr0 * x0i + P.Li0 * x0r + ei0[q]; x0r = a; x0i = b;
                      const float c = P.Lr1 * x1r - P.Li1 * x1i + er1[q], d = P.Lr1 * x1i + P.Li1 * x1r + ei1[q]; x1r = c; x1i = d; } }
              } }
            bf16x8 Bc[4];
#pragma unroll
            for (int ks = 0; ks < 4; ++ks) { const int p0 = ks * 16 + kq * 4;
                const f32x4 cr = *(const f32x4*)(A.in[I_SCRE] + ((size_t)dg * 16 + cn) * 64 + p0), ci = *(const f32x4*)(A.in[I_SCIM] + ((size_t)dg * 16 + cn) * 64 + p0);
                v4u w; w.x = pk2(cr[0], -ci[0]); w.y = pk2(cr[1], -ci[1]); w.z = pk2(cr[2], -ci[2]); w.w = pk2(cr[3], -ci[3]); Bc[ks] = __builtin_bit_cast(bf16x8, w); }
            for (int blk = 0; blk < S5_CL / 16; ++blk) {
                f32x16 D[4]; bu_block(F, P, g, ck, blk, dir, lane, D); scan16(P, D, x0r, x0i, x1r, x1i);
#pragma unroll
                for (int r = 0; r < 16; ++r) { LAS unsigned char* row = xs + (16 * hd + r) * XS_ROW + 4 * n;
                    *(LAS unsigned*)row = pg8::cvt_pk_bf16(D[0][r], D[2][r]); *(LAS unsigned*)(row + 128) = pg8::cvt_pk_bf16(D[1][r], D[3][r]); }
#pragma unroll
                for (int sg = 0; sg < 2; ++sg) {
                    pg8::f32x4 acc = {0.f, 0.f, 0.f, 0.f};
#pragma unroll
                    for (int ks = 0; ks < 4; ++ks) { const bf16x8 af = *(const LAS bf16x8*)(xs + (16 * sg + cn) * XS_ROW + (ks * 32 + kq * 8) * 2);
                        acc = __builtin_amdgcn_mfma_f32_16x16x32_bf16(af, Bc[ks], acc, 0, 0, 0); }
#pragma unroll
                    for (int i = 0; i < 4; ++i) { const int sp = 16 * blk + 4 * kq + i; const int c0 = (ck + 64 * sg) * S5_CL; const int t = tok_of(c0, sp, dir), tl = t - c0;
                        if (dir == 0) yfl[(sg * S5_CL + tl) * 16 + cn] = (bf16)f2bf(acc[i]);
                        else { const float uu = bf1(z1[(size_t)t * O_INP + 704 + g * 16 + cn]); const float yv = acc[i] + bf1(yfl[(sg * S5_CL + tl) * 16 + cn]) + dsk * uu;
                            YG[(size_t)t * S5D + g * 16 + cn] = (bf16)f2bf(gelu_tanh(yv)); } }
                }
            }
        }
        LDS_WAIT();
    }
}
namespace dil {
using bf16x8 = __attribute__((ext_vector_type(8))) short;
using s16x4  = __attribute__((ext_vector_type(4))) short;
using f32x16 = __attribute__((ext_vector_type(16))) float;
using u32x4  = __attribute__((ext_vector_type(4))) unsigned;
constexpr int K_OFF = 0, V_OFF = 49152, BT_OFF = 98304, LI_OFF = 99328;
constexpr int NUNITS = 3 * 1024;
__device__ __forceinline__ int crow(int r, int hi) { return (r & 3) + 8 * (r >> 2) + 4 * hi; }
__device__ __forceinline__ unsigned cvtpk(float lo, float hi) { unsigned r; asm volatile("v_cvt_pk_bf16_f32 %0, %1, %2" : "=v"(r) : "v"(lo), "v"(hi)); return r; }
template <int OFF> __device__ __forceinline__ s16x4 tr_read(int vb) {
  s16x4 r; asm volatile("ds_read_b64_tr_b16 %0, %1 offset:%2" : "=&v"(r) : "v"(vb), "i"(OFF) : "memory"); return r;
}
struct UnitId { int c, d, r, qb, h, sub; };
__device__ __forceinline__ UnitId decode(int u) {
    UnitId U; U.c = u >> 10; const int rem = u & 1023; U.h = rem & 15; const int blk = rem >> 4;
    U.d = (U.c == 0) ? 1 : (U.c == 1) ? 4 : 16; U.sub = S / U.d; const int bpr = U.sub >> 8;
    U.r = blk / bpr; U.qb = blk - U.r * bpr; return U;
}
}

__device__ __forceinline__ void dilattn2_phase(Frame& F) {
    using namespace dil;
    const Args& A = *F.a;
    unsigned char* wsl = F.ws; int lane_l = F.lane, tid_l = F.tid; asm volatile("" : "+s"(wsl), "+v"(lane_l), "+v"(tid_l));
    const bf16* z = (const bf16*)(wsl + R_Z);
    bf16* PO = (bf16*)(wsl + R_PO); float* PML = (float*)(wsl + R_PML);
    LAS unsigned char* lds = F.lds;
    const int tid = tid_l, lane = lane_l, w = F.wave, r32 = lane & 31, hi = lane >> 5;
    v4u kk[6], vv[6];
#define DIL_LOAD(UU) do { _Pragma("unroll") for (int i = 0; i < 6; ++i) { const int idx = tid + 512 * i, key = idx >> 3, ch = idx & 7, sp = (UU).qb * 256 - 64 + key; \
        kk[i] = (v4u){0u, 0u, 0u, 0u}; vv[i] = (v4u){0u, 0u, 0u, 0u}; \
        if (sp >= 0 && sp < (UU).sub) { const bf16* rp = z + ((size_t)sp * (UU).d + (UU).r) * E_IN + (UU).h * 64 + ch * 8; kk[i] = *(const v4u*)(rp + 3072); vv[i] = *(const v4u*)(rp + 4096); } } } while (0)
    if (F.vcu < NUNITS) { const UnitId U0 = decode(F.vcu); DIL_LOAD(U0); }
    for (int u = F.vcu; u < NUNITS; u += F.G) {
        const UnitId U = decode(u);
        const int d = U.d, h = U.h, sub = U.sub;
        {
#pragma unroll
            for (int i = 0; i < 6; ++i) { const int idx = tid + 512 * i, key = idx >> 3, ch = idx & 7;
                *(LAS v4u*)(lds + K_OFF + key * 128 + ((ch * 16) ^ (((key >> 1) & 7) << 4))) = kk[i];
                *(LAS v4u*)(lds + V_OFF + key * 128 + ((ch * 16) ^ (((key >> 1) & 1) << 6))) = vv[i]; }
            if (tid < 129) ((LAS float*)(lds + BT_OFF))[32 + tid] = A.in[I_T5][t5_bucket_dev(d * (tid - 64)) * DIL_H + h] * 1.4426950408889634f;
        }
        __syncthreads();
        f32x16 p[5];
        {
            const size_t qtok = (size_t)(U.qb * 256 + 32 * w + r32) * d + U.r;
            const bf16* qp = z + qtok * E_IN + 2048 + h * 64 + hi * 8;
            bf16x8 qf[4];
#pragma unroll
            for (int ks = 0; ks < 4; ++ks) qf[ks] = *(const bf16x8*)(qp + ks * 16);
            int ka[4];
#pragma unroll
            for (int ks = 0; ks < 4; ++ks) ka[ks] = K_OFF + (32 * w + r32) * 128 + ((ks * 32 + hi * 16) ^ (((r32 >> 1) & 7) << 4));
#pragma unroll
            for (int kt = 0; kt < 5; ++kt) { p[kt] = f32x16{};
#pragma unroll
                for (int ks = 0; ks < 4; ++ks) { const bf16x8 kf = *(const LAS bf16x8*)(lds + ka[ks] + kt * 4096); p[kt] = __builtin_amdgcn_mfma_f32_32x32x16_bf16(kf, qf[ks], p[kt], 0, 0, 0); } }
        }
        const int bidx = 4 * hi - r32;
        const int sp0 = U.qb * 256 + 32 * w - 64 + 4 * hi;
        const LAS float* btl = (const LAS float*)(lds + BT_OFF) + 32 + bidx;
        const bool edge = (U.qb * 256 + 32 * w - 64 < 0) || (U.qb * 256 + 32 * w + 96 > sub);
        constexpr float SC = 0.125f * 1.4426950408889634f;
#pragma unroll
        for (int kt = 0; kt < 5; ++kt)
#pragma unroll
            for (int rg = 0; rg < 16; ++rg) { const int cr = 32 * kt + (rg & 3) + 8 * (rg >> 2);
                float s = fmaf(p[kt][rg], SC, btl[cr]);
                if (kt == 0) s = (bidx + cr >= 0) ? s : -1e30f;
                if (kt >= 3) s = (bidx + cr <= 128) ? s : -1e30f;
                p[kt][rg] = s; }
        if (edge) {
#pragma unroll
            for (int kt = 0; kt < 5; ++kt)
#pragma unroll
                for (int rg = 0; rg < 16; ++rg) { const int cr = 32 * kt + (rg & 3) + 8 * (rg >> 2); const int sp = sp0 + cr; p[kt][rg] = (sp >= 0 && sp < sub) ? p[kt][rg] : -1e30f; }
        }
        float m2 = p[0][0];
#pragma unroll
        for (int kt = 0; kt < 5; ++kt)
#pragma unroll
            for (int rg = 0; rg < 16; ++rg) m2 = fmaxf(m2, p[kt][rg]);
        { auto rr = __builtin_amdgcn_permlane32_swap(__float_as_uint(m2), __float_as_uint(m2), false, false); m2 = fmaxf(__uint_as_float(rr[0]), __uint_as_float(rr[1])); }
        float l = 0.f;
#pragma unroll
        for (int kt = 0; kt < 5; ++kt)
#pragma unroll
            for (int rg = 0; rg < 16; ++rg) { const float e = __builtin_amdgcn_exp2f(p[kt][rg] - m2); p[kt][rg] = e; l += e; }
        { auto rr = __builtin_amdgcn_permlane32_swap(__float_as_uint(l), __float_as_uint(l), false, false); l = __uint_as_float(rr[0]) + __uint_as_float(rr[1]); }
        if (u + F.G < NUNITS) { const UnitId UN = decode(u + F.G); DIL_LOAD(UN); }
        f32x16 o0 = {}, o1 = {};
        {
            const int q = (lane >> 2) & 3, pp = lane & 3, nh = (lane >> 4) & 1, qb1 = (q >> 1) & 1;
            const int vrow = V_OFF + (32 * w + 8 * hi + q) * 128;
            const int vb0 = (int)(uintptr_t)lds + vrow + ((32 * nh + 8 * pp) ^ (qb1 << 6));
            const int vb1 = (int)(uintptr_t)lds + vrow + ((64 + 32 * nh + 8 * pp) ^ (qb1 << 6));
#define DIL_PK4(P, BASE, OUT) do { unsigned a0 = cvtpk(P[BASE + 0], P[BASE + 1]), a1 = cvtpk(P[BASE + 2], P[BASE + 3]); unsigned b0 = cvtpk(P[BASE + 4], P[BASE + 5]), b1 = cvtpk(P[BASE + 6], P[BASE + 7]); \
    auto r0 = __builtin_amdgcn_permlane32_swap(a0, b0, false, false); auto r1 = __builtin_amdgcn_permlane32_swap(a1, b1, false, false); \
    u32x4 wv = {r0[0], r1[0], r0[1], r1[1]}; OUT = *reinterpret_cast<bf16x8*>(&wv); } while (0)
#define DIL_PK(L, H) (bf16x8){L[0], L[1], L[2], L[3], H[0], H[1], H[2], H[3]}
#define DIL_PV(KT) do { bf16x8 pa0, pa1; DIL_PK4(p[KT], 0, pa0); DIL_PK4(p[KT], 8, pa1); \
    const s16x4 l00 = tr_read<(KT) * 4096>(vb0), h00 = tr_read<(KT) * 4096 + 512>(vb0), l01 = tr_read<(KT) * 4096>(vb1), h01 = tr_read<(KT) * 4096 + 512>(vb1); \
    const s16x4 l10 = tr_read<(KT) * 4096 + 2048>(vb0), h10 = tr_read<(KT) * 4096 + 2048 + 512>(vb0), l11 = tr_read<(KT) * 4096 + 2048>(vb1), h11 = tr_read<(KT) * 4096 + 2048 + 512>(vb1); \
    asm volatile("s_waitcnt lgkmcnt(0)" ::: "memory"); __builtin_amdgcn_sched_barrier(0); \
    o0 = __builtin_amdgcn_mfma_f32_32x32x16_bf16(pa0, DIL_PK(l00, h00), o0, 0, 0, 0); o1 = __builtin_amdgcn_mfma_f32_32x32x16_bf16(pa0, DIL_PK(l01, h01), o1, 0, 0, 0); \
    o0 = __builtin_amdgcn_mfma_f32_32x32x16_bf16(pa1, DIL_PK(l10, h10), o0, 0, 0, 0); o1 = __builtin_amdgcn_mfma_f32_32x32x16_bf16(pa1, DIL_PK(l11, h11), o1, 0, 0, 0); } while (0)
            DIL_PV(0); DIL_PV(1); DIL_PV(2); DIL_PV(3); DIL_PV(4);
#undef DIL_PV
#undef DIL_PK
#undef DIL_PK4
        }
        LAS float* li = (LAS float*)(lds + LI_OFF) + w * 32;
        if (hi == 0) { li[r32] = l;
            const size_t tok = (size_t)(U.qb * 256 + 32 * w + r32) * d + U.r;
            *(f32x2*)(PML + (((size_t)U.c * S + tok) * DIL_H + h) * 2) = (f32x2){m2 * 0.6931471805599453f, l}; }
        LDS_WAIT();
#pragma unroll
        for (int rg = 0; rg < 16; ++rg) { const int qi = crow(rg, hi); const float rl = __builtin_amdgcn_rcpf(li[qi]);
            const size_t tok = (size_t)(U.qb * 256 + 32 * w + qi) * d + U.r;
            bf16* op = PO + ((size_t)U.c * S + tok) * 1024 + h * 64 + r32;
            op[0] = (bf16)f2bf(o0[rg] * rl); op[32] = (bf16)f2bf(o1[rg] * rl); }
        __syncthreads();
    }
#undef DIL_LOAD
}
__device__ __forceinline__ void dil_combine_phase(Frame& F) {
    const bf16* PO = (const bf16*)(F.ws + R_PO); const float* PML = (const float*)(F.ws + R_PML); bf16* mix = (bf16*)(F.ws + R_MIX);
    for (int idx = F.gw * 64 + F.lane; idx < S * 128; idx += F.NGW * 64) {
        const int tok = idx >> 7, ch = idx & 127, h = ch >> 3;
        f32x2 ml[3]; v4u ov[3];
#pragma unroll
        for (int c = 0; c < 3; ++c) { ml[c] = *(const f32x2*)(PML + (((size_t)c * S + tok) * DIL_H + h) * 2); ov[c] = *(const v4u*)(PO + ((size_t)c * S + tok) * 1024 + ch * 8); }
        const float M = fmaxf(ml[0][0], fmaxf(ml[1][0], ml[2][0]));
        float wc[3], ws = 0.f;
#pragma unroll
        for (int c = 0; c < 3; ++c) { wc[c] = ml[c][1] * fexp(ml[c][0] - M); ws += wc[c]; }
        const float rw = 1.0f / ws;
        v4u o;
#pragma unroll
        for (int e = 0; e < 4; ++e) { float a = 0.f, b = 0.f;
#pragma unroll
            for (int c = 0; c < 3; ++c) { a += wc[c] * bflo(ov[c][e]); b += wc[c] * bfhi(ov[c][e]); }
            o[e] = pk2(a * rw, b * rw); }
        *(v4u*)(mix + (size_t)tok * D + 1024 + ch * 8) = o;
    }
}
#ifndef MK_N_LAUNCHES
#define MK_N_LAUNCHES 1
#endif
constexpr int NPH = 20;
__global__ void __launch_bounds__(NWAVES * 64, 2) mk_fwd(Args args) {
    extern __shared__ __attribute__((aligned(16))) unsigned char lds_raw[];
    Frame F;
    F.lds = (LAS unsigned char*)lds_raw; F.a = &args; F.ws = args.ws;
    F.tid = threadIdx.x; F.lane = F.tid & 63; F.wave = __builtin_amdgcn_readfirstlane(F.tid >> 6);
    F.G = gridDim.x; { const int bx = blockIdx.x; F.vcu = (F.G % 8 == 0) ? (bx % 8) * (F.G / 8) + bx / 8 : bx; }
    F.gw = F.vcu * NWAVES + F.wave; F.NGW = F.G * NWAVES;
    volatile LAS unsigned* MISC = (volatile LAS unsigned*)(F.lds + MISC_OFF);
    for (int u = F.tid; u < 128; u += NWAVES * 64) MISC[u] = 0u;
    __syncthreads();
    XcdBarrier bar; bar.bar = (unsigned*)(F.ws + WS_CTL) + CW_BAR; bar.x = 0; bar.st = nullptr;
    if (MK_N_LAUNCHES == 1) bar = xcd_barrier_post((unsigned*)(F.ws + WS_CTL) + CW_BAR, MISC + 8);
    const int lo = args.ph_lo, hi = args.ph_hi;
#ifndef PH_MASK
#define PH_MASK 0xFFFFFFFFu
#endif
#define IN(k) (((PH_MASK >> (k)) & 1u) && lo <= (k) && (k) < hi)
#ifndef PH_TWICE
#define PH_TWICE 0u
#endif
#define TW(k) (((PH_TWICE >> (k)) & 1u) != 0u)
#define REP(k)
#define RB(k)
#define REFRESH() do { int t_ = (int)threadIdx.x; asm volatile("" : "+v"(t_)); F.tid = t_; F.lane = t_ & 63; } while (0)
#ifdef DOUBLE_BARRIERS
#define SEAM(k) do { if (IN(k) && IN((k) + 1)) { xcd_barrier(bar); xcd_barrier(bar); } else __syncthreads(); } while (0)
#else
#define SEAM(k) do { if (IN(k) && IN((k) + 1)) xcd_barrier(bar); else __syncthreads(); } while (0)
#endif
    typedef pg8::bf16_t b16;
    const float* x_in = args.in[I_X]; float* xo = args.out;
    b16* Y = (b16*)(F.ws + WS_Y); b16* HB = (b16*)(F.ws + WS_HB);
    const int bid = (int)blockIdx.x;

    if (IN(0)) REP(0) { REFRESH(); p0_prologue(F); RB(0); } SEAM(0);
    if (IN(1)) { REFRESH(); resnorm_phase<false, true, false, false>(F, x_in, nullptr, nullptr, 0, 0, 0, 0, 0, 0); } SEAM(1);
    if (IN(2)) REP(2) { REFRESH(); pg8::Gemm g{HB, (const b16*)(F.ws + WB_EIN), D}; pg8::StaticOrder so; so.init(S / 256, E_IN / 256, F.G, bid);
        pg8::EpiBf16 E{(b16*)(F.ws + R_Z), E_IN}; pg8::gemm_phase(F.lds, g, so, E); RB(2); } SEAM(2);
    if (IN(3)) REP(3) { REFRESH(); conv_phase(F); __syncthreads(); dilattn2_phase(F); RB(3); } SEAM(3);
    if (IN(4)) REP(4) { REFRESH(); dil_combine_phase(F); RB(4); } SEAM(4);
    if (IN(5)) REP(5) { REFRESH(); pg8::Gemm g{(const b16*)(F.ws + R_MIX), (const b16*)(F.ws + WB_EOUT), D}; pg8::StaticOrder so; so.init(S / 256, D / 256, F.G, bid);
        pg8::EpiBf16 E{Y, D}; pg8::gemm_phase(F.lds, g, so, E); RB(5); } SEAM(5);
    if (IN(6)) { REFRESH(); resnorm_phase<true, true, false, false>(F, x_in, xo, Y, 0, 2, 1, 0, 3, 2); } SEAM(6);
    if (IN(7)) REP(7) { REFRESH(); pg8::Gemm g{HB, (const b16*)(F.ws + WB_EF13), D}; pg8::StaticOrder so; so.init(S / 256, 2 * FD / 256, F.G, bid);
        pg8::EpiSwiGLU E{(b16*)(F.ws + R_ACT), FD}; pg8::gemm_phase(F.lds, g, so, E); RB(7); } SEAM(7);
    if (IN(8)) REP(8) { REFRESH(); pg8::Gemm g{(const b16*)(F.ws + R_ACT), (const b16*)(F.ws + WB_EF2), FD}; pg8::StaticOrder so; so.init(S / 256, D / 256, F.G, bid);
        pg8::EpiBf16 E{Y, D}; pg8::gemm_phase(F.lds, g, so, E); RB(8); } SEAM(8);
    if (IN(9)) { REFRESH(); resnorm_phase<true, true, false, false>(F, xo, xo, Y, 0, 5, 3, 1, 0, 0); } SEAM(9);
    if (IN(10)) REP(10) { REFRESH(); pg8::Gemm g{HB, (const b16*)(F.ws + WB_OIN), D}; pg8::StaticOrder so; so.init(S / 256, O_INP / 256, F.G, bid);
        pg8::EpiBf16 E{(b16*)(F.ws + R_Z1), O_INP}; pg8::gemm_phase(F.lds, g, so, E); RB(10); } SEAM(10);
    if (IN(11)) REP(11) { REFRESH(); latent_phase(F); s5_pass1(F); RB(11); } SEAM(11);
    if (IN(12)) REP(12) { REFRESH();
        { pg8::Gemm g{(const b16*)(F.ws + R_CQN), (const b16*)(F.ws + WB_UQ), QL}; pg8::StaticOrder so; so.init(S / 256, NQ / 256, F.G, bid);
          pg8::EpiBf16 E{(b16*)(F.ws + R_Q), NQ}; pg8::gemm_phase(F.lds, g, so, E); }
        { pg8::Gemm g{(const b16*)(F.ws + R_CKVN), (const b16*)(F.ws + WB_UKV), KVLP}; pg8::StaticOrder so; so.init(S / 256, NKV / 256, F.G, bid);
          pg8::EpiBf16 E{(b16*)(F.ws + R_KV), NKV}; pg8::gemm_phase(F.lds, g, so, E); }
        __syncthreads();
        s5_pass3(F);
    RB(12); } SEAM(12);
    if (IN(13)) REP(13) { REFRESH();
        { pg8::Gemm g{(const b16*)(F.ws + R_YG), (const b16*)(F.ws + WB_GLU), S5D}; pg8::StaticOrder so; so.init(S / 256, S5D / 256, F.G, bid);
          pg8::EpiGate E{(const b16*)(F.ws + R_YG), S5D, (b16*)(F.ws + R_MIX2), D, 1536}; pg8::gemm_phase(F.lds, g, so, E); }
        __syncthreads();
        mla2::CvJob J{args.in[I_M1], args.in[I_M3], args.in[I_M2], (unsigned char*)(F.ws + WB_M13), (unsigned char*)(F.ws + WB_M2), MOE_WSCALE, F.gw, F.NGW};
        for (int u = F.vcu; u < 12 * (S / 256); u += F.G) { const int h = u >> 6, qb = u & 63;
            mla2::attn_unit((const unsigned short*)(F.ws + R_Q), (const unsigned short*)(F.ws + R_KV), (const unsigned short*)(F.ws + R_KPE),
                           (const float*)(F.ws + WS_COS), (const float*)(F.ws + WS_SIN), (unsigned short*)(F.ws + R_MIX2), h, qb * 256, S, (char*)lds_raw, J); }
        while (J.next < mla2::CV_NG) { float cvr[16]; unsigned char* cvd; mla2::cv_issue(J, F.lane, cvr, cvd); mla2::cv_finish(J, cvr, cvd); J.next += J.stride; }
    RB(13); } SEAM(13);
    if (IN(14)) REP(14) { REFRESH(); pg8::Gemm g{(const b16*)(F.ws + R_MIX2), (const b16*)(F.ws + WB_OOUT), D}; pg8::StaticOrder so; so.init(S / 256, D / 256, F.G, bid);
        pg8::EpiBf16 E{Y, D}; pg8::gemm_phase(F.lds, g, so, E); RB(14); } SEAM(14);
    if (IN(15)) { REFRESH(); resnorm_phase<true, true, true, false>(F, xo, xo, Y, 1, 2, 1, 1, 3, 2); } SEAM(15);
    if (IN(16)) REP(16) { REFRESH(); moe_slots_phase(F); RB(16); } SEAM(16);
    if (IN(17)) REP(17) { REFRESH(); const int nt = __builtin_amdgcn_readfirstlane(*(const int*)(F.ws + WS_ROUTE + RT_NTILE));
        pg8::Gemm g{(const void*)(F.ws + R_HS8), (const void*)(F.ws + WB_M13), D}; pg8::StaticOrder so; so.init(nt, 2 * FE / 256, F.G, bid);
        so.texp = (const int*)(F.ws + WS_ROUTE + RT_TEXP); so.estride = (size_t)2 * FE * D;
        pg8::EpiSwiGLU8 E{(unsigned char*)(F.ws + R_ACTS), FE, 1.0f / (MOE_WSCALE * MOE_HSCALE), MOE_ASCALE}; pg8::gemm_phase<true, false>(F.lds, g, so, E); RB(17); } SEAM(17);
    if (IN(18)) REP(18) { REFRESH(); const int nt = __builtin_amdgcn_readfirstlane(*(const int*)(F.ws + WS_ROUTE + RT_NTILE));
        pg8::Gemm g{(const void*)(F.ws + R_ACTS), (const void*)(F.ws + WB_M2), FE}; pg8::StaticOrder so; so.init(nt, D / 256, F.G, bid);
        so.texp = (const int*)(F.ws + WS_ROUTE + RT_TEXP); so.estride = (size_t)D * FE;
        pg8::EpiBf16 E{(b16*)(F.ws + R_YS), D, 1.0f / (MOE_WSCALE * MOE_ASCALE)}; pg8::gemm_phase<true, false>(F.lds, g, so, E); RB(18); } SEAM(18);
    if (IN(19)) { REFRESH(); resnorm_phase<true, false, false, true>(F, xo, xo, nullptr, 1, 5, 3, 0, 0, 0); }
#undef IN
#undef SEAM
}

extern "C" void kernel_launch(void* const* d_in, const int* in_sizes, int n_in, void* d_out, int out_size, void* d_ws, size_t ws_size, hipStream_t stream) {
    static int grid = 0;
    if (grid == 0) {
        if (n_in != 34 || out_size != S * D || ws_size < WS_END) { fprintf(stderr, "kernel_launch: unexpected shapes: n_in %d out %d ws %zu (need %zu)\n", n_in, out_size, ws_size, (size_t)WS_END); grid = -1; return; }
        int dev = 0, cus = 0, per_cu = 0;
        if (hipGetDevice(&dev) != hipSuccess || hipDeviceGetAttribute(&cus, hipDeviceAttributeMultiprocessorCount, dev) != hipSuccess) { grid = -1; return; }
        if (hipFuncSetAttribute((const void*)mk_fwd, hipFuncAttributeMaxDynamicSharedMemorySize, LDS_BYTES) != hipSuccess) { fprintf(stderr, "kernel_launch: hipFuncSetAttribute failed\n"); grid = -1; return; }
        if (hipOccupancyMaxActiveBlocksPerMultiprocessor(&per_cu, (const void*)mk_fwd, NWAVES * 64, LDS_BYTES) != hipSuccess || per_cu < 1) { fprintf(stderr, "kernel_launch: note: occupancy query says %d\n", per_cu); (void)hipGetLastError(); }
        grid = cus;
    }
    if (grid < 0) return;
    if (hipMemsetAsync((char*)d_ws + WS_CTL, 0, CTL_ZERO_BYTES, stream) != hipSuccess) return;
    Args a{};
    for (int i = 0; i < 34; ++i) a.in[i] = (const float*)d_in[i];
    a.out = (float*)d_out; a.ws = (unsigned char*)d_ws;
#if MK_N_LAUNCHES == 1
    a.ph_lo = 0; a.ph_hi = NPH;
    hipLaunchKernelGGL(mk_fwd, dim3(grid), dim3(NWAVES * 64), LDS_BYTES, stream, a);
#else
    for (int p = 0; p < NPH; ++p) { a.ph_lo = p; a.ph_hi = p + 1; hipLaunchKernelGGL(mk_fwd, dim3(grid), dim3(NWAVES * 64), LDS_BYTES, stream, a);
        if (TW(p)) hipLaunchKernelGGL(mk_fwd, dim3(grid), dim3(NWAVES * 64), LDS_BYTES, stream, a); }
#endif
}
```

```cpp
#include <hip/hip_runtime.h>
#include <cstdio>
#include <cstdint>

namespace pg8 {
#define PG8_LAS __attribute__((address_space(3)))
typedef unsigned short bf16_t;
typedef short bf16x8 __attribute__((ext_vector_type(8)));
typedef float f32x4 __attribute__((ext_vector_type(4)));
typedef unsigned u32x4 __attribute__((ext_vector_type(4)));
typedef unsigned u32x2 __attribute__((ext_vector_type(2)));
constexpr int BM = 256, BK = 64, HALF = 128, HTB = HALF * BK * 2  , STAGE_BYTES = 8 * HTB, NXCD = 8, WGM = 8;

__host__ __device__ __forceinline__ int lds_byte(int r, int c) { const int st = (r >> 4) * 2 + (c >> 5), rr = r & 15, cc = c & 31, ob = rr * 64 + cc * 2; return st * 1024 + (ob ^ (((ob >> 9) & 1) << 5)); }
__host__ __device__ __forceinline__ void stage_rc(int b, int& R, int& C) { const int st = b / 1024, sb = b % 1024, swz = sb ^ (((sb >> 9) & 1) << 5); R = (st >> 1) * 16 + swz / 64; C = (st & 1) * 32 + (swz % 64) / 2; }
__host__ __device__ __forceinline__ int perm32(int rho) { const int n = rho >> 4, i = rho & 15; return 8 * (i >> 2) + 4 * n + (i & 3); }

struct Unit { int pm, pn, ks; };
struct Gemm { const void* A; const void* Bt; int K; int kl = 0; };

struct StaticOrder {
    int nM, nN, nwg, G, c;
    const int* texp; size_t estride;
    const int* rowidx;
    __device__ void init(int nM_, int nN_, int G_, int c_) { nM = nM_; nN = nN_; nwg = nM * nN; G = G_; c = c_; texp = nullptr; estride = 0; rowidx = nullptr; }
    __device__ bool next(int i, Unit& u) const {
        const long L = (long)i * G + c; if (L >= nwg) return false;
        int wgid = (int)L; { const int q = nwg / NXCD, r = nwg % NXCD, xcd = wgid % NXCD, off = wgid / NXCD; wgid = (xcd < r ? xcd * (q + 1) : r * (q + 1) + (xcd - r) * q) + off; }
        const int nig = WGM * nN, gid = wgid / nig, fm = gid * WGM, gsz = (nM - fm) < WGM ? (nM - fm) : WGM;
        u.pm = fm + ((wgid % nig) % gsz); u.pn = (wgid % nig) / gsz; return true;
    }
    __device__ __forceinline__ size_t b_off(const Unit& u) const { return texp ? (size_t)__builtin_amdgcn_readfirstlane(texp[u.pm]) * estride : (size_t)0; }
    __device__ __forceinline__ size_t k_off(const Unit&) const { return 0; }
};
struct SplitOrder {
    int pm0, ntail, s, nN, G, c; size_t kbytes;
    const int* texp; size_t estride; const int* rowidx;
    __device__ void init(int pm0_, int ntail_, int s_, int nN_, int G_, int c_, size_t kbytes_) { pm0 = pm0_; ntail = ntail_; s = s_; nN = nN_; G = G_; c = c_; kbytes = kbytes_; texp = nullptr; estride = 0; rowidx = nullptr; }
    __device__ bool next(int i, Unit& u) const {
        const long L = (long)i * G + c; if (L >= (long)ntail * s * nN) return false;
        const int g = (int)L / nN; u.pn = (int)L - g * nN; const int t = g / s; u.pm = pm0 + t; u.ks = g - t * s; return true;
    }
    __device__ __forceinline__ size_t b_off(const Unit& u) const { return texp ? (size_t)__builtin_amdgcn_readfirstlane(texp[u.pm]) * estride : (size_t)0; }
    __device__ __forceinline__ size_t k_off(const Unit& u) const { return (size_t)u.ks * kbytes; }
};

__device__ __forceinline__ unsigned cvt_pk_bf16(float lo, float hi) { unsigned r; asm volatile("v_cvt_pk_bf16_f32 %0, %1, %2" : "=v"(r) : "v"(lo), "v"(hi)); return r; }

struct EpiF32 {
    static constexpr bool PERM = false;
    float* C; int ldc;
    __device__ __forceinline__ void operator()(const f32x4 (&acc)[2][2][4][2], const Unit& u, int wr, int wc, int fr, int fq) const {
        const int row0 = u.pm * BM + wr * 64 + fr, col0 = u.pn * BM + wc * 32 + 4 * fq;
#pragma unroll
        for (int ai = 0; ai < 2; ++ai)
#pragma unroll
            for (int m = 0; m < 4; ++m) { float* rowp = C + (size_t)(row0 + ai * HALF + m * 16) * ldc + col0;
#pragma unroll
                for (int bj = 0; bj < 2; ++bj)
#pragma unroll
                    for (int n = 0; n < 2; ++n) *(f32x4*)(rowp + bj * HALF + n * 16) = acc[ai][bj][m][n]; }
    }
};
struct EpiF32S {
    static constexpr bool PERM = false;
    float* C; int ldc; int pm0; size_t sstride; float sc;
    __device__ __forceinline__ void operator()(const f32x4 (&acc)[2][2][4][2], const Unit& u, int wr, int wc, int fr, int fq) const {
        const int row0 = (u.pm - pm0) * BM + wr * 64 + fr, col0 = u.pn * BM + wc * 32 + 4 * fq;
        float* Cs = C + (size_t)u.ks * sstride;
#pragma unroll
        for (int ai = 0; ai < 2; ++ai)
#pragma unroll
            for (int m = 0; m < 4; ++m) { float* rowp = Cs + (size_t)(row0 + ai * HALF + m * 16) * ldc + col0;
#pragma unroll
                for (int bj = 0; bj < 2; ++bj)
#pragma unroll
                    for (int n = 0; n < 2; ++n) *(f32x4*)(rowp + bj * HALF + n * 16) = acc[ai][bj][m][n] * sc; }
    }
};
struct EpiBf16 {
    static constexpr bool PERM = true;
    bf16_t* O; int ldc; float sc = 1.0f;
    __device__ __forceinline__ void operator()(const f32x4 (&acc)[2][2][4][2], const Unit& u, int wr, int wc, int fr, int fq) const {
        const int row0 = u.pm * BM + wr * 64 + fr, col0 = u.pn * BM + wc * 32 + 8 * fq;
#pragma unroll
        for (int ai = 0; ai < 2; ++ai)
#pragma unroll
            for (int m = 0; m < 4; ++m) { bf16_t* rowp = O + (size_t)(row0 + ai * HALF + m * 16) * ldc + col0;
#pragma unroll
                for (int bj = 0; bj < 2; ++bj) { const f32x4 v0 = acc[ai][bj][m][0] * sc, v1 = acc[ai][bj][m][1] * sc;
                    u32x4 w; w.x = cvt_pk_bf16(v0[0], v0[1]); w.y = cvt_pk_bf16(v0[2], v0[3]); w.z = cvt_pk_bf16(v1[0], v1[1]); w.w = cvt_pk_bf16(v1[2], v1[3]);
                    *(u32x4*)(rowp + bj * HALF) = w; } }
    }
};
__device__ __forceinline__ float silu_f(float v) { return v * __builtin_amdgcn_rcpf(1.0f + __builtin_amdgcn_exp2f(-1.4426950408889634f * v)); }
__device__ __forceinline__ float sigmoid_f(float v) { return __builtin_amdgcn_rcpf(1.0f + __builtin_amdgcn_exp2f(-1.4426950408889634f * v)); }
struct EpiSwiGLU {
    static constexpr bool PERM = false;
    bf16_t* O; int ldc;
    __device__ __forceinline__ void operator()(const f32x4 (&acc)[2][2][4][2], const Unit& u, int wr, int wc, int fr, int fq) const {
        const int row0 = u.pm * BM + wr * 64 + fr, col0 = u.pn * (BM / 2) + wc * 16 + 4 * fq;
#pragma unroll
        for (int ai = 0; ai < 2; ++ai)
#pragma unroll
            for (int m = 0; m < 4; ++m) { bf16_t* rowp = O + (size_t)(row0 + ai * HALF + m * 16) * ldc + col0;
#pragma unroll
                for (int bj = 0; bj < 2; ++bj) { const f32x4 a = acc[ai][bj][m][0], b = acc[ai][bj][m][1];
                    u32x2 w; w.x = cvt_pk_bf16(silu_f(a[0]) * b[0], silu_f(a[1]) * b[1]); w.y = cvt_pk_bf16(silu_f(a[2]) * b[2], silu_f(a[3]) * b[3]);
                    *(u32x2*)(rowp + bj * (HALF / 2)) = w; } }
    }
};
struct EpiSwiGLU8 {
    static constexpr bool PERM = false;
    unsigned char* O; int ldc; float isc, osc;
    __device__ __forceinline__ void operator()(const f32x4 (&acc)[2][2][4][2], const Unit& u, int wr, int wc, int fr, int fq) const {
        const int row0 = u.pm * BM + wr * 64 + fr, col0 = u.pn * (BM / 2) + wc * 16 + 4 * fq;
#pragma unroll
        for (int ai = 0; ai < 2; ++ai)
#pragma unroll
            for (int m = 0; m < 4; ++m) { unsigned char* rowp = O + (size_t)(row0 + ai * HALF + m * 16) * ldc + col0;
#pragma unroll
                for (int bj = 0; bj < 2; ++bj) { const f32x4 a = acc[ai][bj][m][0] * isc, b = acc[ai][bj][m][1] * (isc * osc);
                    float v[4];
#pragma unroll
                    for (int e = 0; e < 4; ++e) v[e] = __builtin_fminf(__builtin_fmaxf(silu_f(a[e]) * b[e], -448.f), 448.f);
                    int w = 0; w = __builtin_amdgcn_cvt_pk_fp8_f32(v[0], v[1], w, false); w = __builtin_amdgcn_cvt_pk_fp8_f32(v[2], v[3], w, true);
                    *(int*)(rowp + bj * (HALF / 2)) = w; } }
    }
};
struct EpiGate {
    static constexpr bool PERM = false;
    const bf16_t* Y; int ldy; bf16_t* O; int ldc; int ocol0;
    __device__ __forceinline__ void operator()(const f32x4 (&acc)[2][2][4][2], const Unit& u, int wr, int wc, int fr, int fq) const {
        const int row0 = u.pm * BM + wr * 64 + fr, col0 = u.pn * BM + wc * 32 + 4 * fq;
#pragma unroll
        for (int ai = 0; ai < 2; ++ai)
#pragma unroll
            for (int m = 0; m < 4; ++m) { const size_t r = (size_t)(row0 + ai * HALF + m * 16);
#pragma unroll
                for (int bj = 0; bj < 2; ++bj)
#pragma unroll
                    for (int n = 0; n < 2; ++n) { const int c = col0 + bj * HALF + n * 16; const f32x4 a = acc[ai][bj][m][n];
                        const u32x2 y = *(const u32x2*)(Y + r * ldy + c);
                        const float y0 = __uint_as_float(y.x << 16), y1 = __uint_as_float(y.x & 0xffff0000u), y2 = __uint_as_float(y.y << 16), y3 = __uint_as_float(y.y & 0xffff0000u);
                        u32x2 w; w.x = cvt_pk_bf16(y0 * sigmoid_f(a[0]), y1 * sigmoid_f(a[1])); w.y = cvt_pk_bf16(y2 * sigmoid_f(a[2]), y3 * sigmoid_f(a[3]));
                        *(u32x2*)(O + r * ldc + ocol0 + c) = w; } }
    }
};

typedef int v8i32 __attribute__((ext_vector_type(8)));
__device__ __forceinline__ void glds16s(const void* sbase, unsigned voff, unsigned lds_dst) { unsigned keep;
    asm volatile("s_mov_b32 %0, m0\n\ts_mov_b32 m0, %3\n\ts_nop 0\n\tglobal_load_lds_dwordx4 %1, %2\n\ts_mov_b32 m0, %0" : "=&s"(keep) : "v"(voff), "s"(sbase), "s"(lds_dst) : "memory"); }
template <bool FP8 = false, bool GATHER = false, class Epi, class Sched>
__device__ __forceinline__ void gemm_phase(PG8_LAS unsigned char* lds, const Gemm g, const Sched& S, const Epi& E) {
    const int tid = threadIdx.x, wid = __builtin_amdgcn_readfirstlane(tid >> 6), lane = tid & 63, wr = wid >> 2, wc = wid & 3, fr = lane & 15, fq = lane >> 4;
    const int K = FP8 ? (g.K >> 1) : g.K, nt = (g.kl ? (FP8 ? (g.kl >> 1) : g.kl) : K) / BK;
    unsigned voffA[2], voffB[2];
#pragma unroll
    for (int i = 0; i < 2; ++i) { int R, C; stage_rc(tid * 16 + i * 8192, R, C); const int Rb = Epi::PERM ? ((R & ~31) + perm32(R & 31)) : R;
        voffA[i] = (unsigned)(R * K + C) * 2u; voffB[i] = (unsigned)(Rb * K + C) * 2u; }
    const size_t kstep = (size_t)(BK * 2);
    const size_t qstep = (size_t)64 * K * 2;
    const size_t hstep = (size_t)HALF * K * 2;
    const size_t tstep = 2 * hstep;
    const unsigned ldsw = (unsigned)wid * 1024u, ldsbase = (unsigned)(uintptr_t)lds;
    const int aoff = lds_byte(wr * 64 + fr, fq * 8), boff = lds_byte(wc * 32 + fr, fq * 8);
#define PG8_SA(b, h) (((b) * 2 + (h)) * HTB)
#define PG8_SB(b, h) ((4 + (b) * 2 + (h)) * HTB)
#define PG8_STAGE(bufoff, gbase, voff) do { _Pragma("unroll") for (int _i = 0; _i < 2; ++_i) glds16s((const void*)(gbase), (voff)[_i], ldsbase + (unsigned)(bufoff) + ldsw + (unsigned)_i * 8192u); } while (0)
#define PG8_STAGE1(bufoff, gbase, voff0) do { _Pragma("unroll") for (int _i = 0; _i < 2; ++_i) glds16s((const void*)((const char*)(gbase) + (size_t)_i * qstep), voff0, ldsbase + (unsigned)(bufoff) + ldsw + (unsigned)_i * 8192u); } while (0)
#define PG8_STAGE_A(bufoff, h, ap, og) do { if constexpr (GATHER) PG8_STAGE(bufoff, ap, (og)[h]); else PG8_STAGE1(bufoff, (ap) + (h) * hstep, voffA[0]); } while (0)
#define PG8_LDA(dst, b, h) do { _Pragma("unroll") for (int m = 0; m < 4; ++m) _Pragma("unroll") for (int k = 0; k < 2; ++k) dst[m][k] = *(const PG8_LAS bf16x8*)(lds + PG8_SA(b, h) + aoff + m * 2048 + k * 1024); } while (0)
#define PG8_LDB(dst, b, h) do { _Pragma("unroll") for (int n = 0; n < 2; ++n) _Pragma("unroll") for (int k = 0; k < 2; ++k) dst[n][k] = *(const PG8_LAS bf16x8*)(lds + PG8_SB(b, h) + boff + n * 2048 + k * 1024); } while (0)
#define PG8_MMA(ai, bj, At, Bt) do { __builtin_amdgcn_s_setprio(1); _Pragma("unroll") for (int m = 0; m < 4; ++m) _Pragma("unroll") for (int n = 0; n < 2; ++n) { \
        if constexpr (FP8) { const v8i32 bq = __builtin_bit_cast(v8i32, __builtin_shufflevector(Bt[n][0], Bt[n][1], 0, 1, 2, 3, 4, 5, 6, 7, 8, 9, 10, 11, 12, 13, 14, 15)); \
            const v8i32 aq = __builtin_bit_cast(v8i32, __builtin_shufflevector(At[m][0], At[m][1], 0, 1, 2, 3, 4, 5, 6, 7, 8, 9, 10, 11, 12, 13, 14, 15)); \
            acc[ai][bj][m][n] = __builtin_amdgcn_mfma_scale_f32_16x16x128_f8f6f4(bq, aq, acc[ai][bj][m][n], 0, 0, 0, 0, 0, 0);     } \
        else { _Pragma("unroll") for (int k = 0; k < 2; ++k) acc[ai][bj][m][n] = __builtin_amdgcn_mfma_f32_16x16x32_bf16(Bt[n][k], At[m][k], acc[ai][bj][m][n], 0, 0, 0); } } \
        __builtin_amdgcn_s_setprio(0); } while (0)
#define PG8_WAIT_V(n) asm volatile("s_waitcnt vmcnt(" #n ")" ::: "memory")
#define PG8_WAIT_L(n) asm volatile("s_waitcnt lgkmcnt(" #n ")" ::: "memory")
#define PG8_BAR __builtin_amdgcn_s_barrier()
#define PG8_SCHED __builtin_amdgcn_sched_barrier(0)
#define PG8_AOFF(dst, u) do { if constexpr (GATHER) { int t2_ = (int)threadIdx.x; asm volatile("" : "+v"(t2_)); _Pragma("unroll") for (int _i = 0; _i < 2; ++_i) { int R_, C_; stage_rc(t2_ * 16 + _i * 8192, R_, C_); \
        _Pragma("unroll") for (int _h = 0; _h < 2; ++_h) { const int _row = S.rowidx[(u).pm * BM + _h * HALF + R_]; dst[_h][_i] = (unsigned)((size_t)_row * K + C_) * 2u; } } } } while (0)
    Unit cur, nxt; int ui = 0;
    if (!S.next(0, cur)) return;
    f32x4 acc[2][2][4][2];
#pragma unroll
    for (int a = 0; a < 2; ++a)
#pragma unroll
        for (int b = 0; b < 2; ++b)
#pragma unroll
            for (int m = 0; m < 4; ++m)
#pragma unroll
                for (int n = 0; n < 2; ++n) acc[a][b][m][n] = (f32x4){0.f, 0.f, 0.f, 0.f};
    bf16x8 At[4][2], B0[2][2], B1[2][2];
    unsigned oC[2][2];
#define PG8_OSLOT ((PG8_LAS u32x4*)(lds + STAGE_BYTES) + (int)threadIdx.x)
    PG8_AOFF(oC, cur);
    const char* const gA = (const char*)g.A;
    const char* cA = (GATHER ? gA : gA + (size_t)cur.pm * tstep) + S.k_off(cur);
    const char* cB = (const char*)g.Bt + S.b_off(cur) + (size_t)cur.pn * tstep + S.k_off(cur);
    PG8_STAGE1(PG8_SB(0, 0), cB, voffB[0]); PG8_STAGE1(PG8_SB(0, 1), cB + hstep, voffB[0]); PG8_STAGE_A(PG8_SA(0, 0), 0, cA, oC); PG8_STAGE_A(PG8_SA(0, 1), 1, cA, oC);
    if (wr == 1) PG8_BAR;
    PG8_WAIT_V(2); PG8_BAR;
    PG8_STAGE1(PG8_SB(1, 0), cB + kstep, voffB[0]); PG8_STAGE_A(PG8_SA(1, 0), 0, cA + kstep, oC); PG8_STAGE1(PG8_SB(1, 1), cB + hstep + kstep, voffB[0]);
    PG8_WAIT_V(6); PG8_BAR;
    for (;;) {
        const bool has_next = S.next(ui + 1, nxt);
        const char* nB = cB; const char* nA = cA;
        if (has_next) { nB = (const char*)g.Bt + S.b_off(nxt) + (size_t)nxt.pn * tstep + S.k_off(nxt); nA = (GATHER ? gA : gA + (size_t)nxt.pm * tstep) + S.k_off(nxt);
            if constexpr (GATHER) { unsigned oN[2][2]; PG8_AOFF(oN, nxt); *PG8_OSLOT = (u32x4){oN[0][0], oN[0][1], oN[1][0], oN[1][1]}; } }
        for (int t = 0; t < nt; t += 2) {
            const bool last = (t == nt - 2);
            const char* a1 = cA + (size_t)(t + 1) * kstep;
            const char* a2 = last ? nA : cA + (size_t)(t + 2) * kstep; const char* b2 = last ? nB : cB + (size_t)(t + 2) * kstep;
            const char* a3 = a2 + kstep; const char* b3 = b2 + kstep;
            unsigned o2[2][2];
            if constexpr (GATHER) {
                if (last && has_next) { const u32x4 q = *PG8_OSLOT; o2[0][0] = q.x; o2[0][1] = q.y; o2[1][0] = q.z; o2[1][1] = q.w; }
                else { o2[0][0] = oC[0][0]; o2[0][1] = oC[0][1]; o2[1][0] = oC[1][0]; o2[1][1] = oC[1][1]; }
            }
            PG8_LDB(B0, 0, 0); PG8_LDB(B1, 0, 1); PG8_SCHED; PG8_LDA(At, 0, 0); PG8_STAGE_A(PG8_SA(1, 1), 1, a1, oC);
            PG8_WAIT_V(8); PG8_WAIT_L(0); PG8_BAR; PG8_MMA(0, 0, At, B0); PG8_MMA(0, 1, At, B1); PG8_BAR; PG8_SCHED;
            PG8_LDA(At, 0, 1); PG8_STAGE1(PG8_SB(0, 0), b2, voffB[0]); PG8_STAGE1(PG8_SB(0, 1), b2 + hstep, voffB[0]); PG8_STAGE_A(PG8_SA(0, 0), 0, a2, o2);
            PG8_WAIT_V(8); PG8_WAIT_L(0); PG8_BAR; PG8_MMA(1, 0, At, B0); PG8_MMA(1, 1, At, B1); PG8_BAR; PG8_SCHED;
            PG8_LDB(B0, 1, 0); PG8_LDB(B1, 1, 1); PG8_SCHED; PG8_LDA(At, 1, 0); PG8_STAGE_A(PG8_SA(0, 1), 1, a2, o2);
            PG8_WAIT_V(8); PG8_WAIT_L(0); PG8_BAR; PG8_MMA(0, 0, At, B0); PG8_MMA(0, 1, At, B1); PG8_BAR; PG8_SCHED;
            PG8_LDA(At, 1, 1); PG8_STAGE1(PG8_SB(1, 0), b3, voffB[0]); PG8_STAGE1(PG8_SB(1, 1), b3 + hstep, voffB[0]); PG8_STAGE_A(PG8_SA(1, 0), 0, a3, o2);
            PG8_WAIT_V(8); PG8_WAIT_L(0); PG8_BAR; PG8_MMA(1, 0, At, B0); PG8_MMA(1, 1, At, B1); PG8_BAR; PG8_SCHED;
        }
        if (wr == 0) PG8_BAR;
        { int t3 = (int)threadIdx.x; asm volatile("" : "+v"(t3)); E(acc, cur, wr, wc, t3 & 15, (t3 >> 4) & 3); }
        if (!has_next) break;
#pragma unroll
        for (int a = 0; a < 2; ++a)
#pragma unroll
            for (int b = 0; b < 2; ++b)
#pragma unroll
                for (int m = 0; m < 4; ++m)
#pragma unroll
                    for (int n = 0; n < 2; ++n) acc[a][b][m][n] = (f32x4){0.f, 0.f, 0.f, 0.f};
        cur = nxt; cB = nB; cA = nA; ++ui;
        if constexpr (GATHER) { const u32x4 q = *PG8_OSLOT; oC[0][0] = q.x; oC[0][1] = q.y; oC[1][0] = q.z; oC[1][1] = q.w; }
        if (wr == 1) PG8_BAR;
    }
    PG8_WAIT_V(0);
    PG8_BAR;
#undef PG8_SA
#undef PG8_SB
#undef PG8_STAGE
#undef PG8_STAGE_A
#undef PG8_STAGE1
#undef PG8_LDA
#undef PG8_LDB
#undef PG8_MMA
#undef PG8_WAIT_V
#undef PG8_WAIT_L
#undef PG8_BAR
#undef PG8_SCHED
#undef PG8_AOFF
#undef PG8_OSLOT
}
}
namespace mla2 {
using bf16x8 = __attribute__((ext_vector_type(8))) short;
using s16x4  = __attribute__((ext_vector_type(4))) short;
using f32x16 = __attribute__((ext_vector_type(16))) float;
using f32x4v = __attribute__((ext_vector_type(4))) float;
using u32x4  = __attribute__((ext_vector_type(4))) unsigned;
constexpr int NW = 8, QBLK = 32, KVBLK = 64;
constexpr float SCALE = 0.072168783648703220f;
constexpr float THR = 8.f;
constexpr int NQREG = 4, NQL = 12 - NQREG;
constexpr int LDQ = 2304, LDKV = 3072, LDKP = 64, LDO = 2048;
constexpr int SHM_V = KVBLK * 128 * 2, SHM_KN = KVBLK * 128 * 2, SHM_KP = KVBLK * 64 * 2;
constexpr int SHM_K = SHM_KN + SHM_KP;
constexpr int OFF_V = 0, OFF_KN = 2 * SHM_V, OFF_WS = OFF_KN + 2 * SHM_K, OFF_QS = OFF_WS + NW * 64 * 4, QS_WAVE = NQL * 1024, SHM_ATTN = OFF_QS + NW * QS_WAVE;
#define MLA2_QB(row, c16) ((((c16) >> 1) * 32 + (row)) * 32 + ((((c16) & 1) ^ (((row) >> 3) & 1)) << 4))
#define MLA2_SBAR() __builtin_amdgcn_sched_barrier(0)
#ifndef MLA2_WAIT0
#define MLA2_WAIT0 0
#endif
#if MLA2_WAIT0
#define MLA2_LWAIT(n) do { asm volatile("s_waitcnt lgkmcnt(0)" ::: "memory"); __builtin_amdgcn_sched_barrier(0); } while (0)
#else
#ifndef MLA2_SBMASK
#define MLA2_SBMASK 0x416
#endif
#define MLA2_LWAIT(n) do { asm volatile("s_waitcnt lgkmcnt(" #n ")" ::: "memory"); __builtin_amdgcn_sched_barrier(MLA2_SBMASK); } while (0)
#ifndef MLA2_FENCES
#define MLA2_FENCES 1
#endif
#if MLA2_FENCES
#define MLA2_FENCE() __builtin_amdgcn_sched_barrier(0)
#else
#define MLA2_FENCE() do {} while (0)
#endif
#define MLA2_W2(n, A, B) asm volatile("s_waitcnt lgkmcnt(" #n ")" : "+v"(A), "+v"(B) :: "memory")
#define MLA2_W3(n, A, B, C) asm volatile("s_waitcnt lgkmcnt(" #n ")" : "+v"(A), "+v"(B), "+v"(C) :: "memory")
#endif
__device__ __forceinline__ int crow(int r, int hi) { return (r & 3) + 8 * (r >> 2) + 4 * hi; }
__device__ __forceinline__ unsigned cvtpk(float lo, float hi) { unsigned r; asm volatile("v_cvt_pk_bf16_f32 %0, %1, %2" : "=v"(r) : "v"(lo), "v"(hi)); return r; }
#ifndef MLA2_PLAIN_RD
#define MLA2_PLAIN_RD 0
#endif
template <int OFF> __device__ __forceinline__ bf16x8 lds_rd(int addr) {
#if MLA2_PLAIN_RD
  return *(const __attribute__((address_space(3))) bf16x8*)(unsigned)(addr + OFF);
#else
  bf16x8 r; asm volatile("ds_read_b128 %0, %1 offset:%2" : "=v"(r) : "v"(addr), "i"(OFF) : "memory"); return r;
#endif
}
using f32x2v = __attribute__((ext_vector_type(2))) float;
__device__ __forceinline__ float max3f(float a, float b, float c) { float r; asm volatile("v_max3_f32 %0, %1, %2, %3" : "=v"(r) : "v"(a), "v"(b), "v"(c)); return r; }
template <int OFF> __device__ __forceinline__ s16x4 tr_read(int vb) { s16x4 r; asm volatile("ds_read_b64_tr_b16 %0, %1 offset:%2" : "=&v"(r) : "v"(vb), "i"(OFF) : "memory"); return r; }

__device__ __forceinline__ void partialSM(f32x16& p0, f32x16& p1, float& m_reg, float& mn, float& alpha) {
  constexpr float C = SCALE * 1.4426950408889634f;
  float pmax = p0[0];
#pragma unroll
  for (int r = 1; r < 16; ++r) pmax = fmaxf(pmax, p0[r]);
#pragma unroll
  for (int r = 0; r < 16; ++r) pmax = fmaxf(pmax, p1[r]);
  { auto rr = __builtin_amdgcn_permlane32_swap(__float_as_uint(pmax), __float_as_uint(pmax), false, false);
    pmax = fmaxf(__uint_as_float(rr[0]), __uint_as_float(rr[1])); }
  if (__builtin_expect(__all(pmax - m_reg <= THR / SCALE), 1)) { mn = m_reg; alpha = 1.f; }
  else { mn = fmaxf(m_reg, pmax); alpha = __builtin_amdgcn_exp2f((m_reg - mn) * C); m_reg = mn; }
  float mnC = -mn * C;
#pragma unroll
  for (int r = 0; r < 16; ++r) p0[r] = fmaf(p0[r], C, mnC);
#pragma unroll
  for (int r = 0; r < 16; ++r) p1[r] = fmaf(p1[r], C, mnC);
#pragma unroll
  for (int r = 0; r < 16; ++r) p0[r] = __builtin_amdgcn_exp2f(p0[r]);
}
__device__ __forceinline__ void finishSM(f32x16& p0, f32x16& p1, float alpha, float& l_reg, bf16x8& pa0, bf16x8& pa1, bf16x8& pa2, bf16x8& pa3) {
#pragma unroll
  for (int r = 0; r < 16; ++r) p1[r] = __builtin_amdgcn_exp2f(p1[r]);
  float ps = 0;
#pragma unroll
  for (int r = 0; r < 16; ++r) ps += p0[r];
#pragma unroll
  for (int r = 0; r < 16; ++r) ps += p1[r];
  { auto rr = __builtin_amdgcn_permlane32_swap(__float_as_uint(ps), __float_as_uint(ps), false, false);
    ps = __uint_as_float(rr[0]) + __uint_as_float(rr[1]); }
  l_reg = l_reg * alpha + ps;
#define MLA2_PK4(P, BASE, OUT) do { unsigned a0 = cvtpk(P[BASE + 0], P[BASE + 1]), a1 = cvtpk(P[BASE + 2], P[BASE + 3]);   \
    unsigned b0 = cvtpk(P[BASE + 4], P[BASE + 5]), b1 = cvtpk(P[BASE + 6], P[BASE + 7]);                              \
    auto r0 = __builtin_amdgcn_permlane32_swap(a0, b0, false, false); auto r1 = __builtin_amdgcn_permlane32_swap(a1, b1, false, false); \
    u32x4 w = {r0[0], r1[0], r0[1], r1[1]}; OUT = *reinterpret_cast<bf16x8*>(&w); } while (0)
  MLA2_PK4(p0, 0, pa0); MLA2_PK4(p0, 8, pa1); MLA2_PK4(p1, 0, pa2); MLA2_PK4(p1, 8, pa3);
#undef MLA2_PK4
}
constexpr int ko(int B, int s) { return B * SHM_K + (s >> 2) * 8192; }
constexpr int qo(int s) { return (s - NQREG) * 1024; }
template <int B> __device__ __forceinline__ void qkt(f32x16& p0, f32x16& p1, const int (&kb)[4], int qbase, const bf16x8 (&qr)[NQREG]) {
  p0 = f32x16{}; p1 = f32x16{};
  bf16x8 a0, a1, aq, c0, c1, cq;
#define MLA2_RD(s, X0, X1, XQ) do { X0 = lds_rd<ko(B, s)>(kb[(s) & 3]); X1 = lds_rd<ko(B, s) + 4096>(kb[(s) & 3]); if constexpr ((s) >= NQREG) XQ = lds_rd<qo((s) >= NQREG ? (s) : NQREG)>(qbase); } while (0)
#define MLA2_MM(s, X0, X1, XQ) do { const bf16x8 q_ = ((s) < NQREG) ? qr[(s) < NQREG ? (s) : 0] : XQ; \
    p0 = __builtin_amdgcn_mfma_f32_32x32x16_bf16(X0, q_, p0, 0, 0, 0); p1 = __builtin_amdgcn_mfma_f32_32x32x16_bf16(X1, q_, p1, 0, 0, 0); } while (0)
  MLA2_RD(0, a0, a1, aq); MLA2_RD(1, c0, c1, cq);
  MLA2_W2(2, a0, a1); MLA2_MM(0, a0, a1, aq); MLA2_RD(2, a0, a1, aq);
  MLA2_W2(2, c0, c1); MLA2_MM(1, c0, c1, cq); MLA2_RD(3, c0, c1, cq);
  MLA2_W2(2, a0, a1); MLA2_MM(2, a0, a1, aq); MLA2_RD(4, a0, a1, aq);
  MLA2_W2(3, c0, c1); MLA2_MM(3, c0, c1, cq); MLA2_RD(5, c0, c1, cq); MLA2_FENCE();
  MLA2_W3(3, a0, a1, aq); MLA2_MM(4, a0, a1, aq); MLA2_RD(6, a0, a1, aq);
  MLA2_W3(3, c0, c1, cq); MLA2_MM(5, c0, c1, cq); MLA2_RD(7, c0, c1, cq);
  MLA2_W3(3, a0, a1, aq); MLA2_MM(6, a0, a1, aq); MLA2_RD(8, a0, a1, aq);
  MLA2_W3(3, c0, c1, cq); MLA2_MM(7, c0, c1, cq); MLA2_RD(9, c0, c1, cq); MLA2_FENCE();
  MLA2_W3(3, a0, a1, aq); MLA2_MM(8, a0, a1, aq); MLA2_RD(10, a0, a1, aq);
  MLA2_W3(3, c0, c1, cq); MLA2_MM(9, c0, c1, cq); MLA2_RD(11, c0, c1, cq);
  MLA2_W3(3, a0, a1, aq); MLA2_MM(10, a0, a1, aq);
  MLA2_W3(0, c0, c1, cq); MLA2_MM(11, c0, c1, cq);
#undef MLA2_RD
#undef MLA2_MM
}
__device__ __forceinline__ int v_st(int k, int c) { const int kk = (k & ~0xC) | ((k & 4) << 1) | ((k & 8) >> 1); return ((kk >> 3) * 4 + (c >> 5)) * 512 + ((kk & 7) * 32 + (c & 31)) * 2; }
__device__ __forceinline__ int v_rd_base(int lane) { return ((lane & 3) << 3) | (((lane >> 2) & 3) << 6) | (((lane >> 4) & 1) << 5) | (((lane >> 5) & 1) << 8); }
constexpr int v_rd_off(int d0, int ks, int half) { return d0 * 512 + ks * 4096 + half * 2048; }
template <int B> __device__ __forceinline__ void pv(f32x16 (&o)[4], int vb, bf16x8 pa0, bf16x8 pa1, bf16x8 pa2, bf16x8 pa3) {
  s16x4 l0, h0, l1, h1, l2, h2;
#define MLA2_PK(L, H) (bf16x8){L[0], L[1], L[2], L[3], H[0], H[1], H[2], H[3]}
#define MLA2_PR(k, L, H) do { L = tr_read<B * SHM_V + v_rd_off((k) & 3, (k) >> 2, 0)>(vb); H = tr_read<B * SHM_V + v_rd_off((k) & 3, (k) >> 2, 1)>(vb); } while (0)
#define MLA2_PM(k, L, H) do { const bf16x8 pa_ = ((k) >> 2) == 0 ? pa0 : ((k) >> 2) == 1 ? pa1 : ((k) >> 2) == 2 ? pa2 : pa3; \
    o[(k) & 3] = __builtin_amdgcn_mfma_f32_32x32x16_bf16(pa_, MLA2_PK(L, H), o[(k) & 3], 0, 0, 0); } while (0)
  MLA2_PR(0, l0, h0); MLA2_PR(1, l1, h1); MLA2_PR(2, l2, h2);
  MLA2_W2(4, l0, h0); MLA2_PM(0, l0, h0); MLA2_PR(3, l0, h0);
  MLA2_W2(4, l1, h1); MLA2_PM(1, l1, h1); MLA2_PR(4, l1, h1);
  MLA2_W2(4, l2, h2); MLA2_PM(2, l2, h2); MLA2_PR(5, l2, h2);
  MLA2_W2(4, l0, h0); MLA2_PM(3, l0, h0); MLA2_PR(6, l0, h0); MLA2_FENCE();
  MLA2_W2(4, l1, h1); MLA2_PM(4, l1, h1); MLA2_PR(7, l1, h1);
  MLA2_W2(4, l2, h2); MLA2_PM(5, l2, h2); MLA2_PR(8, l2, h2);
  MLA2_W2(4, l0, h0); MLA2_PM(6, l0, h0); MLA2_PR(9, l0, h0);
  MLA2_W2(4, l1, h1); MLA2_PM(7, l1, h1); MLA2_PR(10, l1, h1); MLA2_FENCE();
  MLA2_W2(4, l2, h2); MLA2_PM(8, l2, h2); MLA2_PR(11, l2, h2);
  MLA2_W2(4, l0, h0); MLA2_PM(9, l0, h0); MLA2_PR(12, l0, h0);
  MLA2_W2(4, l1, h1); MLA2_PM(10, l1, h1); MLA2_PR(13, l1, h1);
  MLA2_W2(4, l2, h2); MLA2_PM(11, l2, h2); MLA2_PR(14, l2, h2); MLA2_FENCE();
  MLA2_W2(4, l0, h0); MLA2_PM(12, l0, h0); MLA2_PR(15, l0, h0);
  MLA2_W2(4, l1, h1); MLA2_PM(13, l1, h1);
  MLA2_W2(2, l2, h2); MLA2_PM(14, l2, h2);
  MLA2_W2(0, l0, h0); MLA2_PM(15, l0, h0);
#undef MLA2_PK
#undef MLA2_PR
#undef MLA2_PM
}
#define MLA2_PK4B(P, BASE, OUT) do { unsigned a0_ = cvtpk(P[BASE + 0], P[BASE + 1]), a1_ = cvtpk(P[BASE + 2], P[BASE + 3]);   \
    unsigned b0_ = cvtpk(P[BASE + 4], P[BASE + 5]), b1_ = cvtpk(P[BASE + 6], P[BASE + 7]);                              \
    auto r0_ = __builtin_amdgcn_permlane32_swap(a0_, b0_, false, false); auto r1_ = __builtin_amdgcn_permlane32_swap(a1_, b1_, false, false); \
    u32x4 w_ = {r0_[0], r1_[0], r0_[1], r1_[1]}; OUT = *reinterpret_cast<bf16x8*>(&w_); } while (0)
template <int B> __device__ __forceinline__ void r1(f32x16& n0, f32x16& n1, const int (&kb)[4], int qbase, const bf16x8 (&qr)[NQREG],
                                                    f32x16& p0, f32x16& p1, float alpha, float& l_reg, bf16x8& pa0, bf16x8& pa1, bf16x8& pa2, bf16x8& pa3) {
  bf16x8 a0, a1, aq, c0, c1, cq; f32x2v ps2 = {0.f, 0.f};
#define MLA2_RD(s, X0, X1, XQ) do { X0 = lds_rd<ko(B, s)>(kb[(s) & 3]); X1 = lds_rd<ko(B, s) + 4096>(kb[(s) & 3]); if constexpr ((s) >= NQREG) XQ = lds_rd<qo((s) >= NQREG ? (s) : NQREG)>(qbase); } while (0)
#define MLA2_MM(s, X0, X1, XQ) do { const bf16x8 q_ = ((s) < NQREG) ? qr[(s) < NQREG ? (s) : 0] : XQ; \
    if constexpr ((s) == 0) { n0 = __builtin_amdgcn_mfma_f32_32x32x16_bf16(X0, q_, f32x16{}, 0, 0, 0); n1 = __builtin_amdgcn_mfma_f32_32x32x16_bf16(X1, q_, f32x16{}, 0, 0, 0); }     \
    else { n0 = __builtin_amdgcn_mfma_f32_32x32x16_bf16(X0, q_, n0, 0, 0, 0); n1 = __builtin_amdgcn_mfma_f32_32x32x16_bf16(X1, q_, n1, 0, 0, 0); } } while (0)
#define MLA2_CE(k) do { p1[2 * (k)] = __builtin_amdgcn_exp2f(p1[2 * (k)]); p1[2 * (k) + 1] = __builtin_amdgcn_exp2f(p1[2 * (k) + 1]); ps2 += (f32x2v){p0[2 * (k)], p0[2 * (k) + 1]}; ps2 += (f32x2v){p1[2 * (k)], p1[2 * (k) + 1]}; \
    asm volatile("" : "+v"(p1), "+v"(ps2)); } while (0)
  MLA2_RD(0, a0, a1, aq); MLA2_RD(1, c0, c1, cq);
  MLA2_W2(2, a0, a1); MLA2_MM(0, a0, a1, aq); MLA2_RD(2, a0, a1, aq); MLA2_CE(0); MLA2_SBAR();
  MLA2_W2(2, c0, c1); MLA2_MM(1, c0, c1, cq); MLA2_RD(3, c0, c1, cq); MLA2_CE(1); MLA2_SBAR();
  MLA2_W2(2, a0, a1); MLA2_MM(2, a0, a1, aq); MLA2_RD(4, a0, a1, aq); MLA2_CE(2); MLA2_SBAR();
  MLA2_W2(3, c0, c1); MLA2_MM(3, c0, c1, cq); MLA2_RD(5, c0, c1, cq); MLA2_CE(3); MLA2_SBAR();
  MLA2_W3(3, a0, a1, aq); MLA2_MM(4, a0, a1, aq); MLA2_RD(6, a0, a1, aq); MLA2_CE(4); MLA2_SBAR();
  MLA2_W3(3, c0, c1, cq); MLA2_MM(5, c0, c1, cq); MLA2_RD(7, c0, c1, cq); MLA2_CE(5); MLA2_SBAR();
  MLA2_W3(3, a0, a1, aq); MLA2_MM(6, a0, a1, aq); MLA2_RD(8, a0, a1, aq); MLA2_CE(6); MLA2_SBAR();
  MLA2_W3(3, c0, c1, cq); MLA2_MM(7, c0, c1, cq); MLA2_RD(9, c0, c1, cq); MLA2_CE(7); MLA2_SBAR();
  MLA2_W3(3, a0, a1, aq); MLA2_MM(8, a0, a1, aq); MLA2_RD(10, a0, a1, aq);
  float ps = ps2[0] + ps2[1];
  { auto rr = __builtin_amdgcn_permlane32_swap(__float_as_uint(ps), __float_as_uint(ps), false, false); ps = __uint_as_float(rr[0]) + __uint_as_float(rr[1]); }
  l_reg = l_reg * alpha + ps; MLA2_PK4B(p0, 0, pa0); asm volatile("" : "+v"(l_reg), "+v"(pa0)); MLA2_SBAR();
  MLA2_W3(3, c0, c1, cq); MLA2_MM(9, c0, c1, cq); MLA2_RD(11, c0, c1, cq); MLA2_PK4B(p0, 8, pa1); asm volatile("" : "+v"(pa1)); MLA2_SBAR();
  MLA2_W3(3, a0, a1, aq); MLA2_MM(10, a0, a1, aq); MLA2_PK4B(p1, 0, pa2); asm volatile("" : "+v"(pa2)); MLA2_SBAR();
  MLA2_W3(0, c0, c1, cq); MLA2_MM(11, c0, c1, cq); MLA2_PK4B(p1, 8, pa3); asm volatile("" : "+v"(pa3)); MLA2_SBAR();
#undef MLA2_RD
#undef MLA2_MM
#undef MLA2_CE
}
template <int B> __device__ __forceinline__ void r2(f32x16 (&o)[4], int vb, bf16x8 pa0, bf16x8 pa1, bf16x8 pa2, bf16x8 pa3,
                                                    f32x16& q0, f32x16& q1, float& m_reg, float& alpha) {
  constexpr float C = SCALE * 1.4426950408889634f;
  s16x4 l0, h0, l1, h1, l2, h2; float mx, mnC;
#define MLA2_PK(L, H) (bf16x8){L[0], L[1], L[2], L[3], H[0], H[1], H[2], H[3]}
#define MLA2_PR(k, L, H) do { L = tr_read<B * SHM_V + v_rd_off((k) & 3, (k) >> 2, 0)>(vb); H = tr_read<B * SHM_V + v_rd_off((k) & 3, (k) >> 2, 1)>(vb); } while (0)
#define MLA2_PM(k, L, H) do { const bf16x8 pa_ = ((k) >> 2) == 0 ? pa0 : ((k) >> 2) == 1 ? pa1 : ((k) >> 2) == 2 ? pa2 : pa3; \
    o[(k) & 3] = __builtin_amdgcn_mfma_f32_32x32x16_bf16(pa_, MLA2_PK(L, H), o[(k) & 3], 0, 0, 0); } while (0)
#define MLA2_MX(Q, b) do { mx = max3f(mx, Q[b], Q[b + 1]); mx = max3f(mx, Q[b + 2], Q[b + 3]); mx = max3f(mx, Q[b + 4], Q[b + 5]); mx = max3f(mx, Q[b + 6], Q[b + 7]); } while (0)
#define MLA2_FM(Q, b) do { _Pragma("unroll") for (int e_ = 0; e_ < 4; e_ += 2) { f32x2v t_ = {Q[(b) + e_], Q[(b) + e_ + 1]}; t_ = t_ * C2 + M2; Q[(b) + e_] = t_[0]; Q[(b) + e_ + 1] = t_[1]; } asm volatile("" : "+v"(Q)); } while (0)
#define MLA2_EX(Q, b) do { _Pragma("unroll") for (int e_ = 0; e_ < 4; ++e_) Q[(b) + e_] = __builtin_amdgcn_exp2f(Q[(b) + e_]); asm volatile("" : "+v"(Q)); } while (0)
  MLA2_PR(0, l0, h0); MLA2_PR(1, l1, h1); MLA2_PR(2, l2, h2);
  mx = q0[0];
  MLA2_W2(4, l0, h0); MLA2_PM(0, l0, h0); MLA2_PR(3, l0, h0); MLA2_MX(q0, 0); MLA2_SBAR();
  MLA2_W2(4, l1, h1); MLA2_PM(1, l1, h1); MLA2_PR(4, l1, h1); MLA2_MX(q0, 8); MLA2_SBAR();
  MLA2_W2(4, l2, h2); MLA2_PM(2, l2, h2); MLA2_PR(5, l2, h2); MLA2_MX(q1, 0); MLA2_SBAR();
  MLA2_W2(4, l0, h0); MLA2_PM(3, l0, h0); MLA2_PR(6, l0, h0); MLA2_MX(q1, 8); MLA2_SBAR();
  MLA2_W2(4, l1, h1); MLA2_PM(4, l1, h1); MLA2_PR(7, l1, h1);
  { auto rr = __builtin_amdgcn_permlane32_swap(__float_as_uint(mx), __float_as_uint(mx), false, false); mx = fmaxf(__uint_as_float(rr[0]), __uint_as_float(rr[1])); }
  { const bool keep = __all(mx - m_reg <= THR / SCALE); const float mn = keep ? m_reg : fmaxf(m_reg, mx); const float al = __builtin_amdgcn_exp2f((m_reg - mn) * C);
    alpha = keep ? 1.f : al; m_reg = mn; mnC = -mn * C; asm volatile("" : "+v"(alpha), "+v"(m_reg), "+v"(mnC)); }
  const f32x2v C2 = {C, C}, M2 = {mnC, mnC};
  MLA2_SBAR();
  MLA2_W2(4, l2, h2); MLA2_PM(5, l2, h2); MLA2_PR(8, l2, h2); MLA2_FM(q0, 0); MLA2_FM(q0, 4); MLA2_SBAR();
  MLA2_W2(4, l0, h0); MLA2_PM(6, l0, h0); MLA2_PR(9, l0, h0); MLA2_FM(q0, 8); MLA2_FM(q0, 12); MLA2_SBAR();
  MLA2_W2(4, l1, h1); MLA2_PM(7, l1, h1); MLA2_PR(10, l1, h1); MLA2_FM(q1, 0); MLA2_FM(q1, 4); MLA2_SBAR();
  MLA2_W2(4, l2, h2); MLA2_PM(8, l2, h2); MLA2_PR(11, l2, h2); MLA2_FM(q1, 8); MLA2_FM(q1, 12); MLA2_SBAR();
  MLA2_W2(4, l0, h0); MLA2_PM(9, l0, h0); MLA2_PR(12, l0, h0); MLA2_EX(q0, 0); MLA2_SBAR();
  MLA2_W2(4, l1, h1); MLA2_PM(10, l1, h1); MLA2_PR(13, l1, h1); MLA2_EX(q0, 4); MLA2_SBAR();
  MLA2_W2(4, l2, h2); MLA2_PM(11, l2, h2); MLA2_PR(14, l2, h2); MLA2_EX(q0, 8); MLA2_SBAR();
  MLA2_W2(4, l0, h0); MLA2_PM(12, l0, h0); MLA2_PR(15, l0, h0); MLA2_EX(q0, 12); MLA2_SBAR();
  MLA2_W2(4, l1, h1); MLA2_PM(13, l1, h1); MLA2_SBAR();
  MLA2_W2(2, l2, h2); MLA2_PM(14, l2, h2); MLA2_SBAR();
  MLA2_W2(0, l0, h0); MLA2_PM(15, l0, h0); MLA2_SBAR();
#undef MLA2_PK
#undef MLA2_PR
#undef MLA2_PM
#undef MLA2_MX
#undef MLA2_FM
#undef MLA2_EX
}
__device__ __forceinline__ float bflo(unsigned u) { return __uint_as_float(u << 16); }
__device__ __forceinline__ float bfhi(unsigned u) { return __uint_as_float(u & 0xffff0000u); }

struct CvJob { const float* w1; const float* w3; const float* w2; unsigned char* d13; unsigned char* d2; float scale; int next, stride; };
constexpr int CV_G13 = 8 * (2048 / 16) * (7168 / 64), CV_G2 = 8 * (7168 / 16) * (2048 / 64), CV_NG = 2 * CV_G13 + CV_G2;
__device__ __forceinline__ void cv_issue(const CvJob& J, int lane, float (&r)[16], unsigned char*& dst) {
  const int g = J.next;
  if (g < 2 * CV_G13) { const int mm = g / CV_G13, rem = g - mm * CV_G13, e = rem / 14336, r2 = rem - e * 14336, nb = r2 >> 7, kb = r2 & 127;
    const float* src = (mm ? J.w3 : J.w1) + (size_t)e * 2048 * 7168 + (size_t)(kb * 16) * 7168 + nb * 64 + lane;
#pragma unroll
    for (int i = 0; i < 16; ++i) r[i] = src[(size_t)i * 7168];
    const int n = nb * 64 + lane; dst = J.d13 + (size_t)e * 14336 * 2048 + (size_t)((n >> 4) * 32 + mm * 16 + (n & 15)) * 2048 + kb * 16;
  } else { const int g2 = g - 2 * CV_G13, e = g2 / 14336, r2 = g2 - e * 14336, nb = r2 / 448, kb = r2 - nb * 448;
    const float* src = J.w2 + (size_t)e * 7168 * 2048 + (size_t)(kb * 16) * 2048 + nb * 64 + lane;
#pragma unroll
    for (int i = 0; i < 16; ++i) r[i] = src[(size_t)i * 2048];
    dst = J.d2 + (size_t)e * 2048 * 7168 + (size_t)(nb * 64 + lane) * 7168 + kb * 16; }
}
__device__ __forceinline__ unsigned cv_pk4(float a, float b, float c, float d, float s) {
  a = __builtin_fminf(__builtin_fmaxf(a * s, -448.f), 448.f); b = __builtin_fminf(__builtin_fmaxf(b * s, -448.f), 448.f); c = __builtin_fminf(__builtin_fmaxf(c * s, -448.f), 448.f); d = __builtin_fminf(__builtin_fmaxf(d * s, -448.f), 448.f);
  int w = 0; w = __builtin_amdgcn_cvt_pk_fp8_f32(a, b, w, false); w = __builtin_amdgcn_cvt_pk_fp8_f32(c, d, w, true); return (unsigned)w; }
__device__ __forceinline__ void cv_finish(const CvJob& J, const float (&r)[16], unsigned char* dst) {
  u32x4 o; o[0] = cv_pk4(r[0], r[1], r[2], r[3], J.scale); o[1] = cv_pk4(r[4], r[5], r[6], r[7], J.scale); o[2] = cv_pk4(r[8], r[9], r[10], r[11], J.scale); o[3] = cv_pk4(r[12], r[13], r[14], r[15], J.scale);
  *reinterpret_cast<u32x4*>(dst) = o;
}
__device__ __forceinline__ void attn_unit(const unsigned short* __restrict__ Qg, const unsigned short* __restrict__ KVg, const unsigned short* __restrict__ KPg,
                                          const float* __restrict__ cosT, const float* __restrict__ sinT, unsigned short* __restrict__ Og, int h, int q0, int seq, char* lds, CvJob& J) {
  const int tid = threadIdx.x, wid = tid >> 6, lane = tid & 63, r32 = lane & 31, hi = lane >> 5;
  char* V_lds = lds + OFF_V; char* KN_lds = lds + OFF_KN;
  float* ws = (float*)(lds + OFF_WS) + wid * 64; float* li_l = ws; float* al_l = ws + 32;
  float m_reg = -1e30f, l_reg = 0; f32x16 o[4] = {}; bf16x8 qr[NQREG];
  char* Qs = lds + OFF_QS + wid * QS_WAVE;
  {
    const int qrow = q0 + wid * QBLK + r32;
    const unsigned short* Qw = Qg + (size_t)qrow * LDQ + h * 192 + hi * 8;
#pragma unroll
    for (int d0 = 0; d0 < 8; ++d0) { const bf16x8 v = *reinterpret_cast<const bf16x8*>(Qw + d0 * 16);
      if (d0 < NQREG) qr[d0 < NQREG ? d0 : 0] = v; else *reinterpret_cast<bf16x8*>(Qs + MLA2_QB(r32, (d0 - NQREG) * 2 + hi)) = v; }
#pragma unroll
    for (int ab = 0; ab < 2; ++ab) {
      const u32x4 x1 = *reinterpret_cast<const u32x4*>(Qw + 128 + ab * 16), x2 = *reinterpret_cast<const u32x4*>(Qw + 128 + 32 + ab * 16);
      const float* cp = cosT + (size_t)qrow * 32 + ab * 16 + hi * 8; const float* sp = sinT + (size_t)qrow * 32 + ab * 16 + hi * 8;
      const f32x4v c0 = *reinterpret_cast<const f32x4v*>(cp), c1 = *reinterpret_cast<const f32x4v*>(cp + 4), s0 = *reinterpret_cast<const f32x4v*>(sp), s1 = *reinterpret_cast<const f32x4v*>(sp + 4);
      u32x4 o1, o2;
#define MLA2_ROT(W, CL, CH, SL, SH) do { const float a0 = bflo(x1[W]), a1 = bfhi(x1[W]), b0 = bflo(x2[W]), b1 = bfhi(x2[W]); \
        o1[W] = cvtpk(a0 * (CL) - b0 * (SL), a1 * (CH) - b1 * (SH)); o2[W] = cvtpk(b0 * (CL) + a0 * (SL), b1 * (CH) + a1 * (SH)); } while (0)
      MLA2_ROT(0, c0[0], c0[1], s0[0], s0[1]); MLA2_ROT(1, c0[2], c0[3], s0[2], s0[3]); MLA2_ROT(2, c1[0], c1[1], s1[0], s1[1]); MLA2_ROT(3, c1[2], c1[3], s1[2], s1[3]);
#undef MLA2_ROT
      *reinterpret_cast<u32x4*>(Qs + MLA2_QB(r32, (8 + ab - NQREG) * 2 + hi)) = o1;
      *reinterpret_cast<u32x4*>(Qs + MLA2_QB(r32, (10 + ab - NQREG) * 2 + hi)) = o2;
    }
  }
  const int lo = r32 * 32 + ((hi ^ ((r32 >> 3) & 1)) << 4);
  const int qbase = (int)(uintptr_t)Qs + lo;
  int kb[4];
#pragma unroll
  for (int j = 0; j < 4; ++j) kb[j] = (int)(uintptr_t)KN_lds + r32 * 128 + (((j * 2 + hi) ^ ((r32 >> 1) & 7)) << 4);
  const int vb0 = (int)(uintptr_t)V_lds + v_rd_base(lane);
  const unsigned short* Kh = KVg + h * 256; const unsigned short* Vh = KVg + h * 256 + 128;
  const int wu = __builtin_amdgcn_readfirstlane(wid);
  unsigned kd_off[3], kd_lds[3]; const unsigned short* kd_base[3]; int kd_stride[3];
#pragma unroll
  for (int i = 0; i < 3; ++i) { const int pi = 3 * wu + i, img = pi >> 3, grp = pi & 7, row = 8 * grp + (lane >> 3), c8 = (lane & 7) ^ ((row >> 1) & 7);
    kd_lds[i] = (unsigned)(uintptr_t)KN_lds + (unsigned)pi * 1024u;
    if (img < 2) { kd_base[i] = Kh + img * 64; kd_stride[i] = LDKV; kd_off[i] = (unsigned)(row * LDKV + c8 * 8) * 2u; }
    else { kd_base[i] = KPg; kd_stride[i] = LDKP; kd_off[i] = (unsigned)(row * LDKP + c8 * 8) * 2u; } }
  const int vkk = wu * 8 + ((lane & 31) >> 2), vk = (vkk & ~0xC) | ((vkk & 4) << 1) | ((vkk & 8) >> 1);
  const unsigned v_off = (unsigned)(vk * LDKV + (lane >> 5) * 32 + (lane & 3) * 8) * 2u;
  const unsigned ldsV = (unsigned)(uintptr_t)V_lds + (unsigned)wu * 2048u;
#define MLA2_DMA_K(b, k0) do { _Pragma("unroll") for (int i_ = 0; i_ < 3; ++i_) pg8::glds16s(kd_base[i_] + (size_t)(k0) * kd_stride[i_], kd_off[i_], kd_lds[i_] + (b) * SHM_K); } while (0)
#define MLA2_DMA_V(b, k0) do { const unsigned short* vb_ = Vh + (size_t)(k0) * LDKV; \
    pg8::glds16s(vb_, v_off, ldsV + (b) * SHM_V); pg8::glds16s(vb_ + 64, v_off, ldsV + (b) * SHM_V + 1024u); } while (0)
#define MLA2_LANDED() do { asm volatile("s_waitcnt vmcnt(0)" ::: "memory"); __syncthreads(); } while (0)
#define MLA2_RESC(a) do { if (__any((a) < 1.f)) { if (hi == 0) al_l[r32] = (a); asm volatile("s_waitcnt lgkmcnt(0)" ::: "memory"); \
    _Pragma("unroll") for (int d = 0; d < 4; ++d) _Pragma("unroll") for (int r = 0; r < 16; ++r) o[d][r] *= al_l[crow(r, hi)]; } } while (0)
  f32x16 pA0, pA1, pB0, pB1; float mnA, alA, alB; bf16x8 pa0, pa1, pa2, pa3; const int NT = seq / KVBLK;
  MLA2_DMA_K(0, 0); MLA2_DMA_V(0, 0); MLA2_DMA_K(1, KVBLK);
  MLA2_LANDED();
  qkt<0>(pA0, pA1, kb, qbase, qr); partialSM(pA0, pA1, m_reg, mnA, alA);
  __syncthreads();
  if (2 < NT) MLA2_DMA_K(0, 2 * KVBLK); MLA2_DMA_V(1, KVBLK);
  for (int j = 1; j + 1 < NT; j += 2) {
    float cvr[16]; unsigned char* cvd = nullptr; const bool cv_on = J.next < CV_NG;
    if (cv_on) cv_issue(J, lane, cvr, cvd);
    MLA2_SBAR(); r1<1>(pB0, pB1, kb, qbase, qr, pA0, pA1, alA, l_reg, pa0, pa1, pa2, pa3);
    r2<0>(o, vb0, pa0, pa1, pa2, pa3, pB0, pB1, m_reg, alB);
    MLA2_RESC(alB); MLA2_LANDED();
    if (j + 2 < NT) MLA2_DMA_K(1, (j + 2) * KVBLK); MLA2_DMA_V(0, (j + 1) * KVBLK);
    MLA2_SBAR(); r1<0>(pA0, pA1, kb, qbase, qr, pB0, pB1, alB, l_reg, pa0, pa1, pa2, pa3);
    r2<1>(o, vb0, pa0, pa1, pa2, pa3, pA0, pA1, m_reg, alA);
    if (cv_on) { cv_finish(J, cvr, cvd); J.next += J.stride; }
    MLA2_RESC(alA); MLA2_LANDED();
    if (j + 3 < NT) MLA2_DMA_K(0, (j + 3) * KVBLK); MLA2_DMA_V(1, (j + 2) * KVBLK);
  }
  MLA2_SBAR(); r1<1>(pB0, pB1, kb, qbase, qr, pA0, pA1, alA, l_reg, pa0, pa1, pa2, pa3);
  r2<0>(o, vb0, pa0, pa1, pa2, pa3, pB0, pB1, m_reg, alB);
  MLA2_RESC(alB); MLA2_LANDED();
  finishSM(pB0, pB1, alB, l_reg, pa0, pa1, pa2, pa3); MLA2_SBAR();
  pv<1>(o, vb0, pa0, pa1, pa2, pa3);
  if (hi == 0) li_l[r32] = l_reg; asm volatile("s_waitcnt lgkmcnt(0)" ::: "memory");
  float rli[16];
#pragma unroll
  for (int r = 0; r < 16; ++r) rli[r] = __builtin_amdgcn_rcpf(li_l[crow(r, hi)]);
  unsigned short* Ow = Og + (size_t)(q0 + wid * QBLK) * LDO + h * 128;
#pragma unroll
  for (int r = 0; r < 16; ++r) { const int orow = crow(r, hi);
#pragma unroll
    for (int d0 = 0; d0 < 4; ++d0) { const float v = o[d0][r] * rli[r]; unsigned u = __float_as_uint(v); u = (u + 0x7fffu + ((u >> 16) & 1u)) >> 16; Ow[(size_t)orow * LDO + d0 * 32 + r32] = (unsigned short)u; } }
  __syncthreads();
#undef MLA2_DMA_K
#undef MLA2_DMA_V
#undef MLA2_LANDED
#undef MLA2_RESC
}
}
constexpr int S = 16384, D = 2048;
constexpr int E_IN = 5120, CONVD = 1024, CONVW = 31, DIL_H = 16;
constexpr int FD = 5632;
constexpr int O_INP = 1280;
constexpr int QL = 512, KVL = 128, KVLP = 256, S5D = 512;
constexpr int NQ = 2304, NKV = 3072;
constexpr int NE = 8, FE = 7168;
constexpr int MAXROWS = 34816, MAXTILES = 136;
constexpr int S5_CL = 128, S5_NCH = S / S5_CL;
constexpr int ADA_KS = 16;
constexpr float MOE_WSCALE = 1024.f, MOE_HSCALE = 16.f, MOE_ASCALE = 8.f;

constexpr size_t MiB = 1u << 20;
constexpr size_t WS_CTL = 0, CTL_ZERO_BYTES = 1 * MiB;
constexpr size_t WS_MODP = 1 * MiB;
constexpr size_t WS_COS = 3 * MiB, WS_SIN = 5 * MiB;
constexpr size_t WS_S5P = 7 * MiB;
constexpr size_t WS_S5E = 384 * MiB;
constexpr size_t WS_ROUTE = 10 * MiB;
constexpr size_t RT_TOKE = 0, RT_TOKG = 128 * 1024, RT_POS = 256 * 1024, RT_ROWIDX = 384 * 1024, RT_TEXP = 528 * 1024, RT_NTILE = 529 * 1024;
constexpr size_t WS_YF = 11 * MiB;
constexpr size_t WS_WB = 44 * MiB;
constexpr size_t WB_EIN = WS_WB, WB_EOUT = WS_WB + 20 * MiB, WB_EF13 = WS_WB + 28 * MiB, WB_EF2 = WS_WB + 72 * MiB, WB_OIN = WS_WB + 94 * MiB,
                 WB_UQ = WS_WB + 99 * MiB, WB_UKV = WS_WB + 102 * MiB, WB_GLU = WS_WB + 104 * MiB, WB_OOUT = WS_WB + 105 * MiB, WB_M13 = WS_WB + 113 * MiB, WB_M2 = WS_WB + 561 * MiB;
constexpr size_t WS_HB = 830 * MiB;
constexpr size_t WS_Y = 894 * MiB;
constexpr size_t WS_R = 1022 * MiB;
constexpr size_t R_Z = WS_R, R_MIX = WS_R + 160 * MiB, R_ACT = WS_R + 224 * MiB, R_PO = WS_R + 400 * MiB, R_PML = WS_R + 496 * MiB;
constexpr size_t R_Z1 = WS_R, R_CQN = WS_R + 40 * MiB, R_CKVN = WS_R + 56 * MiB, R_KPE = WS_R + 64 * MiB, R_Q = WS_R + 66 * MiB, R_KV = WS_R + 138 * MiB,
                 R_MIX2 = WS_R + 234 * MiB, R_YG = WS_R + 298 * MiB;
constexpr size_t R_YT = WS_R + 240 * MiB;
constexpr size_t R_ACTS = WS_R, R_HS8 = WS_R + 240 * MiB, R_YS = WS_R + 476 * MiB;
constexpr size_t WS_END = WS_R + 612 * MiB;
constexpr int CW_BAR = 4096;
constexpr int CW_TBCNT = 16384;

constexpr int LDS_BYTES = 163840;
constexpr int COND_OFF = 133120;
constexpr int MISC_OFF = LDS_BYTES - 512;
constexpr int NWAVES = 8;

#define GAS __attribute__((address_space(1)))
#define LAS __attribute__((address_space(3)))
typedef unsigned short bf16;
typedef unsigned v4u __attribute__((ext_vector_type(4)));
typedef unsigned v2u __attribute__((ext_vector_type(2)));
typedef float f32x4 __attribute__((ext_vector_type(4)));
typedef float f32x2 __attribute__((ext_vector_type(2)));
typedef short bf16x8 __attribute__((ext_vector_type(8)));
#define LDS_WAIT() asm volatile("s_waitcnt lgkmcnt(0)" ::: "memory")
#define VM_WAIT() asm volatile("s_waitcnt vmcnt(0)" ::: "memory")
__device__ __forceinline__ unsigned f2bf(float f) { unsigned u = __builtin_bit_cast(unsigned, f); return (u + 0x7fffu + ((u >> 16) & 1u)) >> 16; }
__device__ __forceinline__ unsigned pk2(float lo, float hi) { return f2bf(lo) | (f2bf(hi) << 16); }
__device__ __forceinline__ float bflo(unsigned u) { return __uint_as_float(u << 16); }
__device__ __forceinline__ float bfhi(unsigned u) { return __uint_as_float(u & 0xffff0000u); }
__device__ __forceinline__ float bf1(unsigned short b) { return __uint_as_float(((unsigned)b) << 16); }
__device__ __forceinline__ float fexp(float x) { return __builtin_amdgcn_exp2f(1.4426950408889634f * x); }
__device__ __forceinline__ float fsilu(float v) { return v * __builtin_amdgcn_rcpf(1.0f + fexp(-v)); }
__device__ __forceinline__ float fsigmoid(float v) { return __builtin_amdgcn_rcpf(1.0f + fexp(-v)); }
__device__ __forceinline__ float wave_sum(float v) {
#pragma unroll
    for (int o = 1; o < 64; o <<= 1) v += __shfl_xor(v, o);
    return v;
}
__device__ __forceinline__ void sincos_rev(double rev, double& s, double& c) {
    rev -= __builtin_floor(rev);
    const double q4 = __builtin_floor(rev * 4.0 + 0.5);
    const double r = rev - q4 * 0.25;
    const double th = r * 6.283185307179586476925;
    const double t2 = th * th;
    double sp = 1.0 / 1307674368000.0; sp = sp * (-t2) + 1.0 / 6227020800.0; sp = sp * (-t2) + 1.0 / 39916800.0; sp = sp * (-t2) + 1.0 / 362880.0; sp = sp * (-t2) + 1.0 / 5040.0; sp = sp * (-t2) + 1.0 / 120.0; sp = sp * (-t2) + 1.0 / 6.0; sp = sp * (-t2) + 1.0;
    const double sn = sp * th;
    double cp = 1.0 / 87178291200.0; cp = cp * (-t2) + 1.0 / 479001600.0; cp = cp * (-t2) + 1.0 / 3628800.0; cp = cp * (-t2) + 1.0 / 40320.0; cp = cp * (-t2) + 1.0 / 720.0; cp = cp * (-t2) + 1.0 / 24.0; cp = cp * (-t2) + 0.5; cp = cp * (-t2) + 1.0;
    const int q = ((int)q4) & 3;
    s = (q == 0) ? sn : (q == 1) ? cp : (q == 2) ? -sn : -cp;
    c = (q == 0) ? cp : (q == 1) ? -sn : (q == 2) ? -cp : sn;
}
__device__ __forceinline__ double exp_small(double x) {
    double p = 1.0 / 3628800.0; p = p * x + 1.0 / 362880.0; p = p * x + 1.0 / 40320.0; p = p * x + 1.0 / 5040.0; p = p * x + 1.0 / 720.0; p = p * x + 1.0 / 120.0; p = p * x + 1.0 / 24.0; p = p * x + 1.0 / 6.0; p = p * x + 0.5; p = p * x + 1.0; p = p * x + 1.0;
    return p;
}

#define XB_TMO      128
#define XB_XCNT(j)  (256  + 64 * (j))
#define XB_XSUB(j)  (1280 + 64 * (j))
#define XB_XGEN(j)  (2304 + 64 * (j))
#define XB_TOP      3328
#define XB_TOPGEN   3392
#define XCD_BAR_WORDS 3456
#define XB_SPIN_CAP (1u << 20)
__device__ __forceinline__ unsigned xb_ld(unsigned* p)              { return __hip_atomic_load(p, __ATOMIC_RELAXED, __HIP_MEMORY_SCOPE_AGENT); }
__device__ __forceinline__ unsigned xb_add(unsigned* p, unsigned v) { return __hip_atomic_fetch_add(p, v, __ATOMIC_RELAXED, __HIP_MEMORY_SCOPE_AGENT); }
__device__ __forceinline__ unsigned xb_xcc_id() { return (unsigned)__builtin_amdgcn_s_getreg((3 << 11) | 20) & 0xFu; }
#define XB_SPIN(cond, bar) do { unsigned _sp = 0; while (cond) { __builtin_amdgcn_s_sleep(1); \
    if ((++_sp & 255u) == 0u) { if (xb_ld(&(bar)[XB_TMO])) break; if (_sp > XB_SPIN_CAP) { atomicAdd(&(bar)[XB_TMO], 1u); break; } } } } while (0)
struct XcdBarrier { unsigned* bar; unsigned x; volatile LAS unsigned* st; };
__device__ __forceinline__ XcdBarrier xcd_barrier_post(unsigned* bar, volatile LAS unsigned* st) {
    XcdBarrier b; b.bar = bar; b.x = xb_xcc_id(); b.st = st;
    if (threadIdx.x == 0) (void)xb_add(&bar[XB_XCNT(b.x)], 1u);
    return b;
}
__device__ __forceinline__ void xcd_barrier_complete(unsigned* bar, unsigned x, unsigned& nloc, unsigned& nx) {
    const unsigned G = gridDim.x * gridDim.y * gridDim.z;
    unsigned sum, cnt, mine, sp = 0u;
    for (;;) {
        sum = 0u; cnt = 0u; mine = 0u;
#pragma unroll
        for (unsigned j = 0; j < 16; ++j) { const unsigned c = xb_ld(&bar[XB_XCNT(j)]); sum += c; cnt += (c > 0u) ? 1u : 0u; mine = (j == x) ? c : mine; }
        if (sum == G) break;
        __builtin_amdgcn_s_sleep(1);
        if ((++sp & 255u) == 0u) { if (xb_ld(&bar[XB_TMO])) break; if (sp > XB_SPIN_CAP) { atomicAdd(&bar[XB_TMO], 1u); break; } }
    }
    nloc = mine > 0u ? mine : 1u; nx = cnt > 0u ? cnt : 1u;
}
__device__ __forceinline__ void xcd_barrier(const XcdBarrier& b) {
    asm volatile("s_waitcnt vmcnt(0)" ::: "memory");
    __syncthreads();
    if (threadIdx.x == 0) {
        unsigned* bar = b.bar;
        __builtin_amdgcn_s_waitcnt(0);
        unsigned nloc = b.st[0], nx = b.st[1];
        if (nloc == 0u) { xcd_barrier_complete(bar, b.x, nloc, nx); b.st[0] = nloc; b.st[1] = nx; }
        const unsigned old = xb_add(&bar[XB_XSUB(b.x)], 1u);
        const unsigned gen = old / nloc;
        if (old + 1u == (gen + 1u) * nloc) {
            __builtin_amdgcn_fence(__ATOMIC_RELEASE, "agent");
            asm volatile("s_waitcnt vmcnt(0)" ::: "memory");
            const unsigned og = xb_add(&bar[XB_TOP], 1u);
            const unsigned tg = og / nx;
            if (og + 1u == (tg + 1u) * nx) xb_add(&bar[XB_TOPGEN], 1u);
            else XB_SPIN(xb_ld(&bar[XB_TOPGEN]) == tg, bar);
            __builtin_amdgcn_fence(__ATOMIC_ACQUIRE, "agent");
            xb_add(&bar[XB_XGEN(b.x)], 1u);
            asm volatile("s_waitcnt vmcnt(0)" ::: "memory");
        } else {
            XB_SPIN(xb_ld(&bar[XB_XGEN(b.x)]) == gen, bar);
            __builtin_amdgcn_fence(__ATOMIC_ACQUIRE, "agent");
            asm volatile("s_waitcnt vmcnt(0)" ::: "memory");
        }
    }
    __syncthreads();
}

struct Args { const float* in[34]; float* out; unsigned char* ws; int ph_lo, ph_hi; };
enum { I_X = 0, I_C, I_T5, I_NG, I_ADAW, I_ADAB, I_EWIN, I_ECW, I_ECB, I_ECG, I_ECLB, I_EWOUT, I_EF1, I_EF3, I_EF2, I_OWIN, I_QNG, I_UQ, I_KVNG, I_UKV,
       I_SARE, I_SAIM, I_SLDT, I_SBRE, I_SBIM, I_SCRE, I_SCIM, I_SD, I_SGLU, I_OWOUT, I_RW, I_M1, I_M3, I_M2 };
struct Frame {
    LAS unsigned char* lds;
    const Args* a;
    unsigned char* ws;
    int tid, lane, wave, vcu, G, gw, NGW;
};

__device__ __forceinline__ void cvt_tile(const float* __restrict__ W, int K, int N, bf16* __restrict__ Wt, int ldk, int grp, int mul, int off, int item, LAS float* scr, int lane) {
    const int nblk = N >> 6, kb = item / nblk, nb = item - kb * nblk, k0 = kb << 6, n0 = nb << 6;
    const int lc = (lane & 15) * 4, lr = lane >> 4;
    f32x4 v[16];
#pragma unroll
    for (int i = 0; i < 16; ++i) v[i] = *(const f32x4*)(W + (size_t)(k0 + lr + 4 * i) * N + n0 + lc);
#pragma unroll
    for (int i = 0; i < 16; ++i) { LAS float* d = scr + (lr + 4 * i) * 65 + lc; d[0] = v[i][0]; d[1] = v[i][1]; d[2] = v[i][2]; d[3] = v[i][3]; }
    LDS_WAIT();
    const int c = lane & 7;
#pragma unroll
    for (int j = 0; j < 8; ++j) { const int n = (lane >> 3) + 8 * j; const LAS float* s = scr + (8 * c) * 65 + n;
        v4u o; o.x = pk2(s[0 * 65], s[1 * 65]); o.y = pk2(s[2 * 65], s[3 * 65]); o.z = pk2(s[4 * 65], s[5 * 65]); o.w = pk2(s[6 * 65], s[7 * 65]);
        const int nn = n0 + n, drow = (nn / grp) * (grp * mul) + off + (nn % grp);
        *(v4u*)(Wt + (size_t)drow * ldk + k0 + 8 * c) = o; }
    LDS_WAIT();
}

__device__ __forceinline__ unsigned pk4_fp8(float a, float b, float c, float d) {
    a = __builtin_fminf(__builtin_fmaxf(a, -448.f), 448.f); b = __builtin_fminf(__builtin_fmaxf(b, -448.f), 448.f); c = __builtin_fminf(__builtin_fmaxf(c, -448.f), 448.f); d = __builtin_fminf(__builtin_fmaxf(d, -448.f), 448.f);
    int w = 0; w = __builtin_amdgcn_cvt_pk_fp8_f32(a, b, w, false); w = __builtin_amdgcn_cvt_pk_fp8_f32(c, d, w, true); return (unsigned)w; }
__device__ __forceinline__ void cvt_tile8(const float* __restrict__ W, int K, int N, unsigned char* __restrict__ Wt, int ldk, int grp, int mul, int off, float scale, int item, LAS float* scr, int lane) {
    const int nblk = N >> 6, kb = item / nblk, nb = item - kb * nblk, k0 = kb << 6, n0 = nb << 6;
    const int lc = (lane & 15) * 4, lr = lane >> 4;
    f32x4 v[16];
#pragma unroll
    for (int i = 0; i < 16; ++i) v[i] = *(const f32x4*)(W + (size_t)(k0 + lr + 4 * i) * N + n0 + lc);
#pragma unroll
    for (int i = 0; i < 16; ++i) { LAS float* d = scr + (lr + 4 * i) * 65 + lc; d[0] = v[i][0] * scale; d[1] = v[i][1] * scale; d[2] = v[i][2] * scale; d[3] = v[i][3] * scale; }
    LDS_WAIT();
    const int c = lane & 3;
#pragma unroll
    for (int j = 0; j < 4; ++j) { const int n = (lane >> 2) + 16 * j; const LAS float* s = scr + (16 * c) * 65 + n;
        v4u o; o.x = pk4_fp8(s[0 * 65], s[1 * 65], s[2 * 65], s[3 * 65]); o.y = pk4_fp8(s[4 * 65], s[5 * 65], s[6 * 65], s[7 * 65]);
        o.z = pk4_fp8(s[8 * 65], s[9 * 65], s[10 * 65], s[11 * 65]); o.w = pk4_fp8(s[12 * 65], s[13 * 65], s[14 * 65], s[15 * 65]);
        const int nn = n0 + n, drow = (nn / grp) * (grp * mul) + off + (nn % grp);
        *(v4u*)(Wt + (size_t)drow * ldk + k0 + 16 * c) = o; }
    LDS_WAIT();
}

__device__ __forceinline__ void p0_prologue(Frame& F) {
    const Args& A = *F.a;
    LAS float* condL = (LAS float*)(F.lds + COND_OFF);
    for (int i = F.tid; i < D; i += NWAVES * 64) condL[i] = fsilu(A.in[I_C][i]);
    __syncthreads();
    LAS float* scr = (LAS float*)(F.lds + F.wave * 16640);
    const int lane = F.lane;
    constexpr int N_ADA = 96 * ADA_KS, N_ROPE = S * 32 / 64, N_S5 = 64, N_Z1 = 256, N_Z2 = 768;
#define CVT_M(SRC, KK, NN, DSTOFF, LDK, GRP, MUL, OFF, NEXP) { constexpr int per = ((KK) / 64) * ((NN) / 64); constexpr int tot = per * (NEXP); \
        if (r < tot) { const int e = r / per, t = r - e * per; cvt_tile(A.in[SRC] + (size_t)e * (KK) * (NN), KK, NN, (bf16*)(F.ws + (DSTOFF)) + (size_t)e * ((NN) * (MUL)) * (LDK), LDK, GRP, MUL, OFF, t, scr, lane); continue; } r -= tot; }
#define CVT_M8(SRC, KK, NN, DSTOFF, LDK, GRP, MUL, OFF, NEXP) { constexpr int per = ((KK) / 64) * ((NN) / 64); constexpr int tot = per * (NEXP); \
        if (r < tot) { const int e = r / per, t = r - e * per; cvt_tile8(A.in[SRC] + (size_t)e * (KK) * (NN), KK, NN, (unsigned char*)(F.ws + (DSTOFF)) + (size_t)e * ((NN) * (MUL)) * (LDK), LDK, GRP, MUL, OFF, MOE_WSCALE, t, scr, lane); continue; } r -= tot; }
    constexpr int N_CVT = (32 * 80) + (32 * 32) + 2 * (32 * 88) + (88 * 32) + (32 * 19) + (8 * 36) + (2 * 48) + (8 * 8) + (32 * 32);
    constexpr int N_ITEMS = N_CVT + N_ADA + N_ROPE + N_S5 + N_Z1 + N_Z2;
    for (int it = F.gw; it < N_ITEMS; it += F.NGW) {
        int r = it;
        CVT_M(I_EWIN, 2048, 5120, WB_EIN, 2048, 64, 1, 0, 1)
        CVT_M(I_EWOUT, 2048, 2048, WB_EOUT, 2048, 64, 1, 0, 1)
        CVT_M(I_EF1, 2048, 5632, WB_EF13, 2048, 16, 2, 0, 1)
        CVT_M(I_EF3, 2048, 5632, WB_EF13, 2048, 16, 2, 16, 1)
        CVT_M(I_EF2, 5632, 2048, WB_EF2, 5632, 64, 1, 0, 1)
        CVT_M(I_OWIN, 2048, 1216, WB_OIN, 2048, 64, 1, 0, 1)
        CVT_M(I_UQ, 512, 2304, WB_UQ, 512, 64, 1, 0, 1)
        CVT_M(I_UKV, 128, 3072, WB_UKV, 256, 64, 1, 0, 1)
        CVT_M(I_SGLU, 512, 512, WB_GLU, 512, 64, 1, 0, 1)
        CVT_M(I_OWOUT, 2048, 2048, WB_OOUT, 2048, 64, 1, 0, 1)
        if (r < N_ADA) {
            const int chunk = r % 96, ks = r / 96, l = chunk / 48, n0 = (chunk % 48) * 256;
            const float* w = A.in[I_ADAW] + (size_t)l * D * 12288 + (size_t)(ks * 128) * 12288 + n0 + 4 * lane;
            f32x4 acc = {0.f, 0.f, 0.f, 0.f};
#pragma unroll 8
            for (int k = 0; k < 128; ++k) { const f32x4 v = *(const f32x4*)(w + (size_t)k * 12288); const float cv = condL[ks * 128 + k]; acc += v * cv; }
            *(f32x4*)((float*)(F.ws + WS_MODP) + (size_t)ks * 24576 + l * 12288 + n0 + 4 * lane) = acc;
            continue; }
        r -= N_ADA;
        if (r < N_ROPE) {
            const int idx = r * 64 + lane, pos = idx >> 5, j = idx & 31;
            double f = 1.0; for (int q = 0; q < j; ++q) f *= 0.74989420933245582730;
            const float ang = (float)pos * (float)f;
            double sn, cs; sincos_rev((double)ang * 0.15915494309189533577, sn, cs);
            ((float*)(F.ws + WS_COS))[idx] = (float)cs; ((float*)(F.ws + WS_SIN))[idx] = (float)sn;
            continue; }
        r -= N_ROPE;
        if (r < N_S5) {
            const int p = lane;
            const double are = (double)A.in[I_SARE][r * 64 + p], aim = (double)A.in[I_SAIM][r * 64 + p];
            const double dt = (double)fexp(A.in[I_SLDT][r]);
            const double er = exp_small(are * dt); double sn, cs; sincos_rev(aim * dt * 0.15915494309189533577, sn, cs);
            const double abr = er * cs, abi = er * sn;
            double eL = er; for (int q = 1; q < S5_CL; q <<= 1) eL *= eL;
            double snL, csL; sincos_rev(aim * dt * (double)S5_CL * 0.15915494309189533577, snL, csL);
            const double nr = abr - 1.0, ni = abi, den = are * are + aim * aim;
            const double qr = (nr * are + ni * aim) / den, qi = (ni * are - nr * aim) / den;
            float* o = (float*)(F.ws + WS_S5P) + (size_t)r * 36 * 64;
            o[0 * 64 + p] = (float)abr; o[1 * 64 + p] = (float)abi; o[2 * 64 + p] = (float)(eL * csL); o[3 * 64 + p] = (float)(eL * snL);
#pragma unroll
            for (int c = 0; c < 16; ++c) { const double br = (double)A.in[I_SBRE][(size_t)(r * 64 + p) * 16 + c], bi = (double)A.in[I_SBIM][(size_t)(r * 64 + p) * 16 + c];
                o[(4 + c) * 64 + p] = (float)(qr * br - qi * bi); o[(20 + c) * 64 + p] = (float)(qr * bi + qi * br); }
            continue; }
        r -= N_S5;
        if (r < N_Z1) { ((v4u*)(F.ws + WB_OIN + (size_t)1216 * 2048 * 2))[r * 64 + lane] = (v4u){0u, 0u, 0u, 0u}; continue; }
        r -= N_Z1;
        { const int ch = r * 64 + lane, row = ch >> 4, cc = ch & 15; *(v4u*)(F.ws + WB_UKV + (size_t)row * 512 + 256 + cc * 16) = (v4u){0u, 0u, 0u, 0u}; }
    }
#undef CVT_M
#undef CVT_M8
}

__device__ __forceinline__ float mod_val(Frame& F, int L, int chunk, int col) {
    const Args& A = *F.a; const int o = L * 12288 + chunk * 2048 + col;
    float s = A.in[I_ADAB][o]; const float* mp = (const float*)(F.ws + WS_MODP) + o;
#pragma unroll
    for (int ks = 0; ks < ADA_KS; ++ks) s += mp[(size_t)ks * 24576];
    return s;
}
__device__ __forceinline__ void moe_tail_plan(int nt, int& nfull, int& s) {
    nfull = nt & ~31; const int tl = nt - nfull;
    s = (tl == 0 || tl > 16) ? 1 : (tl <= 4 ? 7 : (tl <= 8 ? 4 : 2));
    if (s == 1) nfull = nt;
}
template <bool RES, bool HOUT, bool ROUTE, bool GATHER>
__device__ __forceinline__ void resnorm_phase(Frame& F, const float* xin, float* xout, const bf16* y, int Lr, int gchunk, int gi1, int Lh, int shchunk, int gi2) {
    const Args& A = *F.a;
    LAS float* A1 = (LAS float*)F.lds; LAS float* A2 = A1 + D; LAS float* B2 = A2 + D; LAS float* RT = B2 + D;
    for (int col = F.tid; col < D; col += NWAVES * 64) {
        if (RES) A1[col] = mod_val(F, Lr, gchunk, col) * A.in[I_NG][(Lr * 4 + gi1) * D + col];
        if (HOUT) { A2[col] = A.in[I_NG][(Lh * 4 + gi2) * D + col] * (1.0f + mod_val(F, Lh, shchunk + 1, col)); B2[col] = mod_val(F, Lh, shchunk, col); }
    }
    if (ROUTE) for (int i = F.tid; i < D * NE; i += NWAVES * 64) RT[(i & 7) * D + (i >> 3)] = A.in[I_RW][i];
    __syncthreads();
    const int lane = F.lane;
    bf16* hb = (bf16*)(F.ws + WS_HB);
    for (int row = F.gw; row < S; row += F.NGW) {
        f32x4 xv[8];
#pragma unroll
        for (int j = 0; j < 8; ++j) xv[j] = *(const f32x4*)(xin + (size_t)row * D + 4 * lane + 256 * j);
        if (RES) {
            f32x4 yv[8];
            if (GATHER) {
                const int* pos = (const int*)(F.ws + WS_ROUTE + RT_POS); const float* tg = (const float*)(F.ws + WS_ROUTE + RT_TOKG);
                const bf16* ys = (const bf16*)(F.ws + R_YS); const float* yt = (const float*)(F.ws + R_YT);
                int nfull, sp; const int ntl = __builtin_amdgcn_readfirstlane(*(const int*)(F.ws + WS_ROUTE + RT_NTILE)); moe_tail_plan(ntl, nfull, sp);
                const int ts = nfull * 256; const size_t sstr = (size_t)(ntl - nfull) * 256 * D;
#pragma unroll
                for (int j = 0; j < 8; ++j) yv[j] = (f32x4){0.f, 0.f, 0.f, 0.f};
#pragma unroll
                for (int hf = 0; hf < 2; ++hf) { const int p = __builtin_amdgcn_readfirstlane(pos[2 * row + hf]); const float g = tg[2 * row + hf];
                    if (p >= ts) {
                        const float* bp = yt + (size_t)(p - ts) * D + 4 * lane;
                        f32x4 t[8];
#pragma unroll
                        for (int j = 0; j < 8; ++j) t[j] = *(const f32x4*)(bp + 256 * j);
#pragma nounroll
                        for (int ks = 1; ks < sp; ++ks) {
#pragma unroll
                            for (int j = 0; j < 8; ++j) t[j] += *(const f32x4*)(bp + (size_t)ks * sstr + 256 * j); }
#pragma unroll
                        for (int j = 0; j < 8; ++j) yv[j] += t[j] * g;
                    } else {
#pragma unroll
                        for (int j = 0; j < 8; ++j) { const v2u a = *(const v2u*)(ys + (size_t)p * D + 4 * lane + 256 * j);
                            yv[j] += (f32x4){g * bflo(a.x), g * bfhi(a.x), g * bflo(a.y), g * bfhi(a.y)}; }
                    } }
            } else {
#pragma unroll
                for (int j = 0; j < 8; ++j) { const v2u a = *(const v2u*)(y + (size_t)row * D + 4 * lane + 256 * j); yv[j] = (f32x4){bflo(a.x), bfhi(a.x), bflo(a.y), bfhi(a.y)}; }
            }
            float ss = 0.f;
#pragma unroll
            for (int j = 0; j < 8; ++j) ss += (yv[j][0] * yv[j][0] + yv[j][1] * yv[j][1]) + (yv[j][2] * yv[j][2] + yv[j][3] * yv[j][3]);
            const float rstd = 1.0f / sqrtf(wave_sum(ss) * (1.0f / D) + 1e-6f);
#pragma unroll
            for (int j = 0; j < 8; ++j) { const f32x4 a1 = *(const LAS f32x4*)(A1 + 4 * lane + 256 * j); xv[j] += a1 * (yv[j] * rstd);
                *(f32x4*)(xout + (size_t)row * D + 4 * lane + 256 * j) = xv[j]; }
        }
        if (HOUT) {
            float ss = 0.f;
#pragma unroll
            for (int j = 0; j < 8; ++j) ss += (xv[j][0] * xv[j][0] + xv[j][1] * xv[j][1]) + (xv[j][2] * xv[j][2] + xv[j][3] * xv[j][3]);
            const float rstd = 1.0f / sqrtf(wave_sum(ss) * (1.0f / D) + 1e-6f);
#pragma unroll
            for (int j = 0; j < 8; ++j) { const f32x4 a2 = *(const LAS f32x4*)(A2 + 4 * lane + 256 * j), b2 = *(const LAS f32x4*)(B2 + 4 * lane + 256 * j);
                xv[j] = (xv[j] * rstd) * a2 + b2;
                if (ROUTE) { *(unsigned*)((unsigned char*)hb + (size_t)row * D + 4 * lane + 256 * j) = pk4_fp8(xv[j][0] * MOE_HSCALE, xv[j][1] * MOE_HSCALE, xv[j][2] * MOE_HSCALE, xv[j][3] * MOE_HSCALE); }
                else { v2u w; w.x = pk2(xv[j][0], xv[j][1]); w.y = pk2(xv[j][2], xv[j][3]);
                *(v2u*)(hb + (size_t)row * D + 4 * lane + 256 * j) = w; } }
            if (ROUTE) {
                int i0 = -1, i1 = -1; float v0 = -3.0e38f, v1 = -3.0e38f;
#pragma nounroll
                for (int e = 0; e < NE; ++e) { float s = 0.f;
#pragma unroll
                    for (int j = 0; j < 8; ++j) { const f32x4 w = *(const LAS f32x4*)(RT + e * D + 4 * lane + 256 * j); s += (xv[j][0] * w[0] + xv[j][1] * w[1]) + (xv[j][2] * w[2] + xv[j][3] * w[3]); }
                    s = wave_sum(s);
                    if (s > v0) { v1 = v0; i1 = i0; v0 = s; i0 = e; } else if (s > v1) { v1 = s; i1 = e; } }
                const float g0 = 1.0f / (1.0f + fexp(v1 - v0)), g1 = 1.0f - g0;
                if (lane == 0) {
                    int* te = (int*)(F.ws + WS_ROUTE + RT_TOKE); float* tg = (float*)(F.ws + WS_ROUTE + RT_TOKG);
                    te[2 * row] = i0; te[2 * row + 1] = i1; tg[2 * row] = g0; tg[2 * row + 1] = g1;
                    unsigned* cnt = (unsigned*)(F.ws + WS_CTL) + CW_TBCNT + (row >> 6) * NE;
                    atomicAdd(cnt + i0, 1u); atomicAdd(cnt + i1, 1u);
                }
            }
        }
    }
}

__device__ __forceinline__ void moe_slots_phase(Frame& F) {
    LAS int* cntL = (LAS int*)F.lds;
    LAS int* tot = cntL + 2048;
    LAS int* base = tot + 8; LAS int* tbase = base + 8; LAS int* texpL = tbase + 16;
    const unsigned* cnt = (const unsigned*)(F.ws + WS_CTL) + CW_TBCNT;
    for (int i = F.tid; i < 2048; i += NWAVES * 64) cntL[i] = (int)cnt[i];
    __syncthreads();
    if (F.tid < NE) { int s = 0; for (int b = 0; b < 256; ++b) s += cntL[b * 8 + F.tid]; tot[F.tid] = s; }
    __syncthreads();
    if (F.tid == 0) { int b = 0, tb = 0; for (int e = 0; e < NE; ++e) { base[e] = b; tbase[e] = tb; const int nt = (tot[e] + 255) >> 8; for (int q = 0; q < nt; ++q) texpL[tb + q] = e; tb += nt; b += nt * 256; } tbase[NE] = tb; }
    __syncthreads();
    const int NT = tbase[NE];
    int* rowidx = (int*)(F.ws + WS_ROUTE + RT_ROWIDX); int* pos = (int*)(F.ws + WS_ROUTE + RT_POS);
    const int* te = (const int*)(F.ws + WS_ROUTE + RT_TOKE);
    if (blockIdx.x == 0) { int* texp = (int*)(F.ws + WS_ROUTE + RT_TEXP); for (int i = F.tid; i < NT; i += NWAVES * 64) texp[i] = texpL[i]; if (F.tid == 0) *(int*)(F.ws + WS_ROUTE + RT_NTILE) = NT; }
    LAS int* slotL = texpL + 160;
    const unsigned char* hb8 = (const unsigned char*)(F.ws + WS_HB); unsigned char* hs8 = (unsigned char*)(F.ws + R_HS8);
    for (int tb = blockIdx.x; tb < 256; tb += F.G) {
        if (F.wave == 0) {
            const int tok = tb * 64 + F.lane;
            const int e0 = te[2 * tok], e1 = te[2 * tok + 1];
            const unsigned long long lt = (F.lane == 0) ? 0ull : (~0ull >> (64 - F.lane));
#pragma unroll
            for (int e = 0; e < NE; ++e) {
                int pre = 0; for (int b = 0; b < tb; ++b) pre += cntL[b * 8 + e];
                const unsigned long long m0 = __ballot(e0 == e), m1 = __ballot(e1 == e);
                const int st = base[e] + pre;
                if (e0 == e) { const int s = st + __popcll(m0 & lt); rowidx[s] = tok; pos[2 * tok] = s; slotL[2 * F.lane] = s; }
                if (e1 == e) { const int s = st + __popcll(m0) + __popcll(m1 & lt); rowidx[s] = tok; pos[2 * tok + 1] = s; slotL[2 * F.lane + 1] = s; }
            }
        }
        __syncthreads();
        for (int idx = F.tid; idx < 128 * 128; idx += NWAVES * 64) { const int si = idx >> 7, ch = idx & 127;
            const v4u v = *(const v4u*)(hb8 + (size_t)(tb * 64 + (si >> 1)) * D + ch * 16);
            *(v4u*)(hs8 + (size_t)slotL[si] * D + ch * 16) = v; }
        __syncthreads();
    }
}
__device__ __forceinline__ void conv_phase(Frame& F) {
    const Args& A = *F.a;
    const bf16* z = (const bf16*)(F.ws + R_Z); bf16* mix = (bf16*)(F.ws + R_MIX);
    LAS unsigned char* gl = F.lds;
    LAS float* part = (LAS float*)(F.lds + 126976);
    LAS float* stat = part + 512;
    const int tid = F.tid, ch = 2 * tid;
    float w0[CONVW], w1[CONVW];
#pragma unroll
    for (int w = 0; w < CONVW; ++w) { const f32x2 v = *(const f32x2*)(A.in[I_ECW] + w * CONVD + ch); w0[w] = v[0]; w1[w] = v[1]; }
    const f32x2 cb = *(const f32x2*)(A.in[I_ECB] + ch), lg = *(const f32x2*)(A.in[I_ECG] + ch), lb = *(const f32x2*)(A.in[I_ECLB] + ch);
    for (int tile = blockIdx.x; tile < S / 32; tile += F.G) {
        const int t0 = tile * 32;
        for (int idx = tid; idx < 62 * 128; idx += NWAVES * 64) {
            const int row = idx >> 7, c8 = (idx & 127) * 8, t = t0 - 15 + row;
            v4u o = {0u, 0u, 0u, 0u};
            if (t >= 0 && t < S) {
                const v4u a = *(const v4u*)(z + (size_t)t * E_IN + c8), g = *(const v4u*)(z + (size_t)t * E_IN + CONVD + c8);
#pragma unroll
                for (int q = 0; q < 4; ++q) o[q] = pk2(bflo(a[q]) * fsigmoid(bflo(g[q])), bfhi(a[q]) * fsigmoid(bfhi(g[q])));
            }
            *(LAS v4u*)(gl + row * 2048 + c8 * 2) = o;
        }
        __syncthreads();
#pragma nounroll
        for (int half = 0; half < 2; ++half) {
            float a0[16], a1[16];
#pragma unroll
            for (int i = 0; i < 16; ++i) { a0[i] = cb[0]; a1[i] = cb[1]; }
            const LAS unsigned char* gh = gl + half * 16 * 2048 + tid * 4;
#pragma unroll
            for (int r = 0; r < 46; ++r) {
                const unsigned v = *(const LAS unsigned*)(gh + r * 2048);
                const float v0 = bflo(v), v1 = bfhi(v);
#pragma unroll
                for (int i = 0; i < 16; ++i) { if (r - i >= 0 && r - i < CONVW) { a0[i] += v0 * w0[r - i]; a1[i] += v1 * w1[r - i]; } }
            }
#pragma unroll
            for (int i = 0; i < 16; ++i) {
                float s1 = a0[i] + a1[i], s2 = a0[i] * a0[i] + a1[i] * a1[i];
                s1 = wave_sum(s1); s2 = wave_sum(s2);
                if (F.lane == 0) { part[(F.wave * 16 + i) * 2] = s1; part[(F.wave * 16 + i) * 2 + 1] = s2; }
            }
            __syncthreads();
            if (tid < 16) { float s1 = 0.f, s2 = 0.f;
#pragma unroll
                for (int w = 0; w < NWAVES; ++w) { s1 += part[(w * 16 + tid) * 2]; s2 += part[(w * 16 + tid) * 2 + 1]; }
                const float mean = s1 * (1.0f / CONVD), var = fmaxf(s2 * (1.0f / CONVD) - mean * mean, 0.f);
                stat[tid * 2] = mean; stat[tid * 2 + 1] = 1.0f / sqrtf(var + 1e-5f); }
            __syncthreads();
#pragma unroll
            for (int i = 0; i < 16; ++i) {
                const float mean = stat[i * 2], rstd = stat[i * 2 + 1];
                const float y0 = (a0[i] - mean) * rstd * lg[0] + lb[0], y1 = (a1[i] - mean) * rstd * lg[1] + lb[1];
                *(unsigned*)(mix + (size_t)(t0 + half * 16 + i) * D + ch) = pk2(fsilu(y0), fsilu(y1));
            }
            __syncthreads();
        }
    }
}

__device__ __forceinline__ int t5_bucket_dev(int rel) {
    const int n = rel < 0 ? -rel : rel;
    int large = 8 + (int)(__logf((float)(n < 1 ? 1 : n) * 0.125f) / 4.852030263919617f * 8.0f);
    large = large < 15 ? large : 15;
    return (rel > 0 ? 16 : 0) + (n < 8 ? n : large);
}
__device__ __forceinline__ void latent_phase(Frame& F) {
    const Args& A = *F.a; const int lane = F.lane;
    const bf16* z1 = (const bf16*)(F.ws + R_Z1); bf16* cqn = (bf16*)(F.ws + R_CQN); bf16* ckvn = (bf16*)(F.ws + R_CKVN); bf16* kpe = (bf16*)(F.ws + R_KPE);
    const float* cosT = (const float*)(F.ws + WS_COS); const float* sinT = (const float*)(F.ws + WS_SIN);
    float qg[8]; { const f32x4 a = *(const f32x4*)(A.in[I_QNG] + 8 * lane), b = *(const f32x4*)(A.in[I_QNG] + 8 * lane + 4); qg[0] = a[0]; qg[1] = a[1]; qg[2] = a[2]; qg[3] = a[3]; qg[4] = b[0]; qg[5] = b[1]; qg[6] = b[2]; qg[7] = b[3]; }
    const f32x2 kg = *(const f32x2*)(A.in[I_KVNG] + 2 * lane);
    for (int row = F.gw; row < S; row += F.NGW) {
        const bf16* zr = z1 + (size_t)row * O_INP;
        const v4u q = *(const v4u*)(zr + 8 * lane);
        float v[8]; float ss = 0.f;
#pragma unroll
        for (int e = 0; e < 4; ++e) { v[2 * e] = bflo(q[e]); v[2 * e + 1] = bfhi(q[e]); ss += v[2 * e] * v[2 * e] + v[2 * e + 1] * v[2 * e + 1]; }
        const float r1 = 1.0f / sqrtf(wave_sum(ss) * (1.0f / QL) + 1e-6f);
        v4u o;
#pragma unroll
        for (int e = 0; e < 4; ++e) o[e] = pk2(v[2 * e] * r1 * qg[2 * e], v[2 * e + 1] * r1 * qg[2 * e + 1]);
        *(v4u*)(cqn + (size_t)row * QL + 8 * lane) = o;
        const unsigned kv = *(const unsigned*)(zr + 512 + 2 * lane);
        const float k0 = bflo(kv), k1 = bfhi(kv);
        const float r2 = 1.0f / sqrtf(wave_sum(k0 * k0 + k1 * k1) * (1.0f / KVL) + 1e-6f);
        *(unsigned*)(ckvn + (size_t)row * KVLP + 2 * lane) = pk2(k0 * r2 * kg[0], k1 * r2 * kg[1]);
        *(unsigned*)(ckvn + (size_t)row * KVLP + 128 + 2 * lane) = 0u;
        if (lane < 32) {
            const float x1 = bf1(zr[640 + lane]), x2 = bf1(zr[672 + lane]), cs = cosT[row * 32 + lane], sn = sinT[row * 32 + lane];
            kpe[(size_t)row * 64 + lane] = (bf16)f2bf(x1 * cs - x2 * sn); kpe[(size_t)row * 64 + 32 + lane] = (bf16)f2bf(x2 * cs + x1 * sn);
        }
    }
}

namespace s5 {
using bf16x8 = __attribute__((ext_vector_type(8))) short;
using f32x16 = __attribute__((ext_vector_type(16))) float;
constexpr int XS_ROW = 272;
constexpr int WAVE_LDS = 32 * XS_ROW + 2 * S5_CL * 16 * 2;
struct Par { float ar0, ai0, ar1, ai1, Lr0, Li0, Lr1, Li1; bf16x8 bt[4]; };
__device__ __forceinline__ void load_par(Frame& F, int dg, int n, int hb, Par& P) {
    const float* sp = (const float*)(F.ws + WS_S5P) + (size_t)dg * 36 * 64;
    P.ar0 = sp[n]; P.ai0 = sp[64 + n]; P.Lr0 = sp[128 + n]; P.Li0 = sp[192 + n];
    P.ar1 = sp[32 + n]; P.ai1 = sp[64 + 32 + n]; P.Lr1 = sp[128 + 32 + n]; P.Li1 = sp[192 + 32 + n];
#pragma unroll
    for (int t = 0; t < 4; ++t) { const float* b = sp + (size_t)((t < 2 ? 4 : 20) + 8 * hb) * 64 + 32 * (t & 1) + n;
        v4u w; w.x = pk2(b[0], b[64]); w.y = pk2(b[128], b[192]); w.z = pk2(b[256], b[320]); w.w = pk2(b[384], b[448]); P.bt[t] = __builtin_bit_cast(bf16x8, w); }
}
__device__ __forceinline__ int tok_of(int c0, int sp, int dir) { return dir ? (c0 + S5_CL - 1 - sp) : (c0 + sp); }
__device__ __forceinline__ void bu_block(Frame& F, const Par& P, int g, int ck, int blk, int dir, int lane, f32x16 (&D)[4]) {
    const bf16* z1 = (const bf16*)(F.ws + R_Z1);
    const int m = lane & 31, ha = lane >> 5, seg = (m >> 2) & 1, idx = 4 * (m >> 3) + (m & 3);
    const int t = tok_of((ck + 64 * seg) * S5_CL, 16 * blk + idx, dir);
    const bf16x8 ua = *(const bf16x8*)(z1 + (size_t)t * O_INP + 704 + g * 16 + 8 * ha);
#pragma unroll
    for (int q = 0; q < 4; ++q) D[q] = __builtin_amdgcn_mfma_f32_32x32x16_bf16(ua, P.bt[q], f32x16{}, 0, 0, 0);
}
__device__ __forceinline__ void scan16(const Par& P, f32x16 (&D)[4], float& x0r, float& x0i, float& x1r, float& x1i) {
#pragma unroll
    for (int r = 0; r < 16; ++r) {
        const float n0r = fmaf(P.ar0, x0r, fmaf(-P.ai0, x0i, D[0][r])), n0i = fmaf(P.ar0, x0i, fmaf(P.ai0, x0r, D[2][r]));
        const float n1r = fmaf(P.ar1, x1r, fmaf(-P.ai1, x1i, D[1][r])), n1i = fmaf(P.ar1, x1i, fmaf(P.ai1, x1r, D[3][r]));
        x0r = n0r; x0i = n0i; x1r = n1r; x1i = n1i; D[0][r] = n0r; D[2][r] = n0i; D[1][r] = n1r; D[3][r] = n1i; }
}
}

__device__ __forceinline__ void s5_pass1(Frame& F) {
    using namespace s5;
    float* E = (float*)(F.ws + WS_S5E);
    const int lane = F.lane, n = lane & 31, hd = lane >> 5;
    for (int task = F.gw; task < 32 * 64; task += F.NGW) {
        const int g = task >> 6, ck = task & 63;
        for (int dir = 0; dir < 2; ++dir) {
            Par P; load_par(F, dir * 32 + g, n, hd, P);
            float x0r = 0.f, x0i = 0.f, x1r = 0.f, x1i = 0.f;
            for (int blk = 0; blk < S5_CL / 16; ++blk) { f32x16 D[4]; bu_block(F, P, g, ck, blk, dir, lane, D); scan16(P, D, x0r, x0i, x1r, x1i); }
            float* e = E + ((size_t)((dir * 32 + g) * S5_NCH + ck + 64 * hd) * 2) * 64 + n;
            e[0] = x0r; e[64] = x0i; e[32] = x1r; e[96] = x1i;
        }
    }
}
__device__ __forceinline__ float gelu_tanh(float x) { const float u = 0.7978845608028654f * (x + 0.044715f * x * x * x); const float t = 1.0f - 2.0f * __builtin_amdgcn_rcpf(1.0f + fexp(2.0f * u)); return 0.5f * x * (1.0f + t); }
__device__ __forceinline__ void s5_pass3(Frame& F) {
    using namespace s5;
    const Args& A = *F.a;
    LAS unsigned char* xs = F.lds + F.wave * WAVE_LDS; LAS bf16* yfl = (LAS bf16*)(xs + 32 * XS_ROW);
    const float* E = (const float*)(F.ws + WS_S5E); bf16* YG = (bf16*)(F.ws + R_YG); const bf16* z1 = (const bf16*)(F.ws + R_Z1);
    const int lane = F.lane, n = lane & 31, hd = lane >> 5, cn = lane & 15, kq = lane >> 4;
    for (int task = F.gw; task < 32 * 64; task += F.NGW) {
        const int g = task >> 6, ck = task & 63, ckl = ck + 64 * hd;
        const float dsk = A.in[I_SD][g * 16 + cn];
        for (int dir = 0; dir < 2; ++dir) {
            const int dg = dir * 32 + g;
            Par P; load_par(F, dg, n, hd, P);
            float x0r = 0.f, x0i = 0.f, x1r = 0.f, x1i = 0.f;
            { const float* e = E + ((size_t)dg * S5_NCH * 2) * 64 + n; const int nprev = dir ? (S5_NCH - 1 - ckl) : ckl;
              const int nmax = dir ? (S5_NCH - 1 - ck) : (ck + 64);
              for (int j0 = 0; j0 < nmax; j0 += 8) {
                  float er0[8], ei0[8], er1[8], ei1[8];
#pragma unroll
                  for (int q = 0; q < 8; ++q) { const int jj = (j0 + q < nprev) ? (j0 + q) : 0; const int j = dir ? (S5_NCH - 1 - jj) : jj; const float* ej = e + (size_t)j * 128;
                      er0[q] = ej[0]; ei0[q] = ej[64]; er1[q] = ej[32]; ei1[q] = ej[96]; }
#pragma unroll
                  for (int q = 0; q < 8; ++q) { if (j0 + q < nprev) {
                      const float a = P.Lr0 * x0r - P.Li0 * x0i + er0[q], b = P.Lr0 * x0i + P.Li0 * x0r + ei0[q]; x0r = a; x0i = b;
                      const float c = P.Lr1 * x1r - P.Li1 * x1i + er1[q], d = P.Lr1 * x1i + P.Li1 * x1r + ei1[q]; x1r = c; x1i = d; } }
              } }
            bf16x8 Bc[4];
#pragma unroll
            for (int ks = 0; ks < 4; ++ks) { const int p0 = ks * 16 + kq * 4;
                const f32x4 cr = *(const f32x4*)(A.in[I_SCRE] + ((size_t)dg * 16 + cn) * 64 + p0), ci = *(const f32x4*)(A.in[I_SCIM] + ((size_t)dg * 16 + cn) * 64 + p0);
                v4u w; w.x = pk2(cr[0], -ci[0]); w.y = pk2(cr[1], -ci[1]); w.z = pk2(cr[2], -ci[2]); w.w = pk2(cr[3], -ci[3]); Bc[ks] = __builtin_bit_cast(bf16x8, w); }
            for (int blk = 0; blk < S5_CL / 16; ++blk) {
                f32x16 D[4]; bu_block(F, P, g, ck, blk, dir, lane, D); scan16(P, D, x0r, x0i, x1r, x1i);
#pragma unroll
                for (int r = 0; r < 16; ++r) { LAS unsigned char* row = xs + (16 * hd + r) * XS_ROW + 4 * n;
                    *(LAS unsigned*)row = pg8::cvt_pk_bf16(D[0][r], D[2][r]); *(LAS unsigned*)(row + 128) = pg8::cvt_pk_bf16(D[1][r], D[3][r]); }
#pragma unroll
                for (int sg = 0; sg < 2; ++sg) {
                    pg8::f32x4 acc = {0.f, 0.f, 0.f, 0.f};
#pragma unroll
                    for (int ks = 0; ks < 4; ++ks) { const bf16x8 af = *(const LAS bf16x8*)(xs + (16 * sg + cn) * XS_ROW + (ks * 32 + kq * 8) * 2);
                        acc = __builtin_amdgcn_mfma_f32_16x16x32_bf16(af, Bc[ks], acc, 0, 0, 0); }
#pragma unroll
                    for (int i = 0; i < 4; ++i) { const int sp = 16 * blk + 4 * kq + i; const int c0 = (ck + 64 * sg) * S5_CL; const int t = tok_of(c0, sp, dir), tl = t - c0;
                        if (dir == 0) yfl[(sg * S5_CL + tl) * 16 + cn] = (bf16)f2bf(acc[i]);
                        else { const float uu = bf1(z1[(size_t)t * O_INP + 704 + g * 16 + cn]); const float yv = acc[i] + bf1(yfl[(sg * S5_CL + tl) * 16 + cn]) + dsk * uu;
                            YG[(size_t)t * S5D + g * 16 + cn] = (bf16)f2bf(gelu_tanh(yv)); } }
                }
            }
        }
        LDS_WAIT();
    }
}
namespace dil {
using bf16x8 = __attribute__((ext_vector_type(8))) short;
using s16x4  = __attribute__((ext_vector_type(4))) short;
using f32x16 = __attribute__((ext_vector_type(16))) float;
using u32x4  = __attribute__((ext_vector_type(4))) unsigned;
constexpr int K_OFF = 0, V_OFF = 49152, BT_OFF = 98304, LI_OFF = 99328;
constexpr int NUNITS = 3 * 1024;
__device__ __forceinline__ int crow(int r, int hi) { return (r & 3) + 8 * (r >> 2) + 4 * hi; }
__device__ __forceinline__ unsigned cvtpk(float lo, float hi) { unsigned r; asm volatile("v_cvt_pk_bf16_f32 %0, %1, %2" : "=v"(r) : "v"(lo), "v"(hi)); return r; }
template <int OFF> __device__ __forceinline__ s16x4 tr_read(int vb) {
  s16x4 r; asm volatile("ds_read_b64_tr_b16 %0, %1 offset:%2" : "=&v"(r) : "v"(vb), "i"(OFF) : "memory"); return r;
}
struct UnitId { int c, d, r, qb, h, sub; };
__device__ __forceinline__ UnitId decode(int u) {
    UnitId U; U.c = u >> 10; const int rem = u & 1023; U.h = rem & 15; const int blk = rem >> 4;
    U.d = (U.c == 0) ? 1 : (U.c == 1) ? 4 : 16; U.sub = S / U.d; const int bpr = U.sub >> 8;
    U.r = blk / bpr; U.qb = blk - U.r * bpr; return U;
}
}

__device__ __forceinline__ void dilattn2_phase(Frame& F) {
    using namespace dil;
    const Args& A = *F.a;
    unsigned char* wsl = F.ws; int lane_l = F.lane, tid_l = F.tid; asm volatile("" : "+s"(wsl), "+v"(lane_l), "+v"(tid_l));
    const bf16* z = (const bf16*)(wsl + R_Z);
    bf16* PO = (bf16*)(wsl + R_PO); float* PML = (float*)(wsl + R_PML);
    LAS unsigned char* lds = F.lds;
    const int tid = tid_l, lane = lane_l, w = F.wave, r32 = lane & 31, hi = lane >> 5;
    for (int u = F.vcu; u < NUNITS; u += F.G) {
        const UnitId U = decode(u);
        const int d = U.d, h = U.h, sub = U.sub;
        {
            v4u kk[6], vv[6];
#pragma unroll
            for (int i = 0; i < 6; ++i) { const int idx = tid + 512 * i, key = idx >> 3, ch = idx & 7, sp = U.qb * 256 - 64 + key;
                kk[i] = (v4u){0u, 0u, 0u, 0u}; vv[i] = (v4u){0u, 0u, 0u, 0u};
                if (sp >= 0 && sp < sub) { const bf16* rp = z + ((size_t)sp * d + U.r) * E_IN + h * 64 + ch * 8; kk[i] = *(const v4u*)(rp + 3072); vv[i] = *(const v4u*)(rp + 4096); } }
#pragma unroll
            for (int i = 0; i < 6; ++i) { const int idx = tid + 512 * i, key = idx >> 3, ch = idx & 7;
                *(LAS v4u*)(lds + K_OFF + key * 128 + ((ch * 16) ^ (((key >> 1) & 7) << 4))) = kk[i];
                *(LAS v4u*)(lds + V_OFF + key * 128 + ((ch * 16) ^ (((key >> 1) & 1) << 6))) = vv[i]; }
            if (tid < 129) ((LAS float*)(lds + BT_OFF))[32 + tid] = A.in[I_T5][t5_bucket_dev(d * (tid - 64)) * DIL_H + h] * 1.4426950408889634f;
        }
        __syncthreads();
        f32x16 p[5];
        {
            const size_t qtok = (size_t)(U.qb * 256 + 32 * w + r32) * d + U.r;
            const bf16* qp = z + qtok * E_IN + 2048 + h * 64 + hi * 8;
            bf16x8 qf[4];
#pragma unroll
            for (int ks = 0; ks < 4; ++ks) qf[ks] = *(const bf16x8*)(qp + ks * 16);
            int ka[4];
#pragma unroll
            for (int ks = 0; ks < 4; ++ks) ka[ks] = K_OFF + (32 * w + r32) * 128 + ((ks * 32 + hi * 16) ^ (((r32 >> 1) & 7) << 4));
#pragma unroll
            for (int kt = 0; kt < 5; ++kt) { p[kt] = f32x16{};
#pragma unroll
                for (int ks = 0; ks < 4; ++ks) { const bf16x8 kf = *(const LAS bf16x8*)(lds + ka[ks] + kt * 4096); p[kt] = __builtin_amdgcn_mfma_f32_32x32x16_bf16(kf, qf[ks], p[kt], 0, 0, 0); } }
        }
        const int bidx = 4 * hi - r32;
        const int sp0 = U.qb * 256 + 32 * w - 64 + 4 * hi;
        const LAS float* btl = (const LAS float*)(lds + BT_OFF) + 32 + bidx;
        const bool edge = (U.qb * 256 + 32 * w - 64 < 0) || (U.qb * 256 + 32 * w + 96 > sub);
        constexpr float SC = 0.125f * 1.4426950408889634f;
#pragma unroll
        for (int kt = 0; kt < 5; ++kt)
#pragma unroll
            for (int rg = 0; rg < 16; ++rg) { const int cr = 32 * kt + (rg & 3) + 8 * (rg >> 2);
                float s = fmaf(p[kt][rg], SC, btl[cr]);
                if (kt == 0) s = (bidx + cr >= 0) ? s : -1e30f;
                if (kt >= 3) s = (bidx + cr <= 128) ? s : -1e30f;
                p[kt][rg] = s; }
        if (edge) {
#pragma unroll
            for (int kt = 0; kt < 5; ++kt)
#pragma unroll
                for (int rg = 0; rg < 16; ++rg) { const int cr = 32 * kt + (rg & 3) + 8 * (rg >> 2); const int sp = sp0 + cr; p[kt][rg] = (sp >= 0 && sp < sub) ? p[kt][rg] : -1e30f; }
        }
        float m2 = p[0][0];
#pragma unroll
        for (int kt = 0; kt < 5; ++kt)
#pragma unroll
            for (int rg = 0; rg < 16; ++rg) m2 = fmaxf(m2, p[kt][rg]);
        { auto rr = __builtin_amdgcn_permlane32_swap(__float_as_uint(m2), __float_as_uint(m2), false, false); m2 = fmaxf(__uint_as_float(rr[0]), __uint_as_float(rr[1])); }
        float l = 0.f;
#pragma unroll
        for (int kt = 0; kt < 5; ++kt)
#pragma unroll
            for (int rg = 0; rg < 16; ++rg) { const float e = __builtin_amdgcn_exp2f(p[kt][rg] - m2); p[kt][rg] = e; l += e; }
        { auto rr = __builtin_amdgcn_permlane32_swap(__float_as_uint(l), __float_as_uint(l), false, false); l = __uint_as_float(rr[0]) + __uint_as_float(rr[1]); }
        f32x16 o0 = {}, o1 = {};
        {
            const int q = (lane >> 2) & 3, pp = lane & 3, nh = (lane >> 4) & 1, qb1 = (q >> 1) & 1;
            const int vrow = V_OFF + (32 * w + 8 * hi + q) * 128;
            const int vb0 = (int)(uintptr_t)lds + vrow + ((32 * nh + 8 * pp) ^ (qb1 << 6));
            const int vb1 = (int)(uintptr_t)lds + vrow + ((64 + 32 * nh + 8 * pp) ^ (qb1 << 6));
#define DIL_PK4(P, BASE, OUT) do { unsigned a0 = cvtpk(P[BASE + 0], P[BASE + 1]), a1 = cvtpk(P[BASE + 2], P[BASE + 3]); unsigned b0 = cvtpk(P[BASE + 4], P[BASE + 5]), b1 = cvtpk(P[BASE + 6], P[BASE + 7]); \
    auto r0 = __builtin_amdgcn_permlane32_swap(a0, b0, false, false); auto r1 = __builtin_amdgcn_permlane32_swap(a1, b1, false, false); \
    u32x4 wv = {r0[0], r1[0], r0[1], r1[1]}; OUT = *reinterpret_cast<bf16x8*>(&wv); } while (0)
#define DIL_PK(L, H) (bf16x8){L[0], L[1], L[2], L[3], H[0], H[1], H[2], H[3]}
#define DIL_PV(KT) do { bf16x8 pa0, pa1; DIL_PK4(p[KT], 0, pa0); DIL_PK4(p[KT], 8, pa1); \
    const s16x4 l00 = tr_read<(KT) * 4096>(vb0), h00 = tr_read<(KT) * 4096 + 512>(vb0), l01 = tr_read<(KT) * 4096>(vb1), h01 = tr_read<(KT) * 4096 + 512>(vb1); \
    const s16x4 l10 = tr_read<(KT) * 4096 + 2048>(vb0), h10 = tr_read<(KT) * 4096 + 2048 + 512>(vb0), l11 = tr_read<(KT) * 4096 + 2048>(vb1), h11 = tr_read<(KT) * 4096 + 2048 + 512>(vb1); \
    asm volatile("s_waitcnt lgkmcnt(0)" ::: "memory"); __builtin_amdgcn_sched_barrier(0); \
    o0 = __builtin_amdgcn_mfma_f32_32x32x16_bf16(pa0, DIL_PK(l00, h00), o0, 0, 0, 0); o1 = __builtin_amdgcn_mfma_f32_32x32x16_bf16(pa0, DIL_PK(l01, h01), o1, 0, 0, 0); \
    o0 = __builtin_amdgcn_mfma_f32_32x32x16_bf16(pa1, DIL_PK(l10, h10), o0, 0, 0, 0); o1 = __builtin_amdgcn_mfma_f32_32x32x16_bf16(pa1, DIL_PK(l11, h11), o1, 0, 0, 0); } while (0)
            DIL_PV(0); DIL_PV(1); DIL_PV(2); DIL_PV(3); DIL_PV(4);
#undef DIL_PV
#undef DIL_PK
#undef DIL_PK4
        }
        LAS float* li = (LAS float*)(lds + LI_OFF) + w * 32;
        if (hi == 0) { li[r32] = l;
            const size_t tok = (size_t)(U.qb * 256 + 32 * w + r32) * d + U.r;
            *(f32x2*)(PML + (((size_t)U.c * S + tok) * DIL_H + h) * 2) = (f32x2){m2 * 0.6931471805599453f, l}; }
        LDS_WAIT();
#pragma unroll
        for (int rg = 0; rg < 16; ++rg) { const int qi = crow(rg, hi); const float rl = __builtin_amdgcn_rcpf(li[qi]);
            const size_t tok = (size_t)(U.qb * 256 + 32 * w + qi) * d + U.r;
            bf16* op = PO + ((size_t)U.c * S + tok) * 1024 + h * 64 + r32;
            op[0] = (bf16)f2bf(o0[rg] * rl); op[32] = (bf16)f2bf(o1[rg] * rl); }
        __syncthreads();
    }
}
__device__ __forceinline__ void dil_combine_phase(Frame& F) {
    const bf16* PO = (const bf16*)(F.ws + R_PO); const float* PML = (const float*)(F.ws + R_PML); bf16* mix = (bf16*)(F.ws + R_MIX);
    for (int idx = F.gw * 64 + F.lane; idx < S * 128; idx += F.NGW * 64) {
        const int tok = idx >> 7, ch = idx & 127, h = ch >> 3;
        f32x2 ml[3]; v4u ov[3];
#pragma unroll
        for (int c = 0; c < 3; ++c) { ml[c] = *(const f32x2*)(PML + (((size_t)c * S + tok) * DIL_H + h) * 2); ov[c] = *(const v4u*)(PO + ((size_t)c * S + tok) * 1024 + ch * 8); }
        const float M = fmaxf(ml[0][0], fmaxf(ml[1][0], ml[2][0]));
        float wc[3], ws = 0.f;
#pragma unroll
        for (int c = 0; c < 3; ++c) { wc[c] = ml[c][1] * fexp(ml[c][0] - M); ws += wc[c]; }
        const float rw = 1.0f / ws;
        v4u o;
#pragma unroll
        for (int e = 0; e < 4; ++e) { float a = 0.f, b = 0.f;
#pragma unroll
            for (int c = 0; c < 3; ++c) { a += wc[c] * bflo(ov[c][e]); b += wc[c] * bfhi(ov[c][e]); }
            o[e] = pk2(a * rw, b * rw); }
        *(v4u*)(mix + (size_t)tok * D + 1024 + ch * 8) = o;
    }
}
#ifndef MK_N_LAUNCHES
#define MK_N_LAUNCHES 1
#endif
constexpr int NPH = 20;
__global__ void __launch_bounds__(NWAVES * 64, 2) mk_fwd(Args args) {
    extern __shared__ __attribute__((aligned(16))) unsigned char lds_raw[];
    Frame F;
    F.lds = (LAS unsigned char*)lds_raw; F.a = &args; F.ws = args.ws;
    F.tid = threadIdx.x; F.lane = F.tid & 63; F.wave = __builtin_amdgcn_readfirstlane(F.tid >> 6);
    F.G = gridDim.x; { const int bx = blockIdx.x; F.vcu = (F.G % 8 == 0) ? (bx % 8) * (F.G / 8) + bx / 8 : bx; }
    F.gw = F.vcu * NWAVES + F.wave; F.NGW = F.G * NWAVES;
    volatile LAS unsigned* MISC = (volatile LAS unsigned*)(F.lds + MISC_OFF);
    for (int u = F.tid; u < 128; u += NWAVES * 64) MISC[u] = 0u;
    __syncthreads();
    XcdBarrier bar; bar.bar = (unsigned*)(F.ws + WS_CTL) + CW_BAR; bar.x = 0; bar.st = nullptr;
    if (MK_N_LAUNCHES == 1) bar = xcd_barrier_post((unsigned*)(F.ws + WS_CTL) + CW_BAR, MISC + 8);
    const int lo = args.ph_lo, hi = args.ph_hi;
#ifndef PH_MASK
#define PH_MASK 0xFFFFFFFFu
#endif
#define IN(k) (((PH_MASK >> (k)) & 1u) && lo <= (k) && (k) < hi)
#ifndef PH_TWICE
#define PH_TWICE 0u
#endif
#define TW(k) (((PH_TWICE >> (k)) & 1u) != 0u)
#define REP(k)
#define RB(k)
#define REFRESH() do { int t_ = (int)threadIdx.x; asm volatile("" : "+v"(t_)); F.tid = t_; F.lane = t_ & 63; } while (0)
#ifdef DOUBLE_BARRIERS
#define SEAM(k) do { if (IN(k) && IN((k) + 1)) { xcd_barrier(bar); xcd_barrier(bar); } else __syncthreads(); } while (0)
#else
#define SEAM(k) do { if (IN(k) && IN((k) + 1)) xcd_barrier(bar); else __syncthreads(); } while (0)
#endif
    typedef pg8::bf16_t b16;
    const float* x_in = args.in[I_X]; float* xo = args.out;
    b16* Y = (b16*)(F.ws + WS_Y); b16* HB = (b16*)(F.ws + WS_HB);
    const int bid = (int)blockIdx.x;

    if (IN(0)) REP(0) { REFRESH(); p0_prologue(F); RB(0); } SEAM(0);
    if (IN(1)) { REFRESH(); resnorm_phase<false, true, false, false>(F, x_in, nullptr, nullptr, 0, 0, 0, 0, 0, 0); } SEAM(1);
    if (IN(2)) REP(2) { REFRESH(); pg8::Gemm g{HB, (const b16*)(F.ws + WB_EIN), D}; pg8::StaticOrder so; so.init(S / 256, E_IN / 256, F.G, bid);
        pg8::EpiBf16 E{(b16*)(F.ws + R_Z), E_IN}; pg8::gemm_phase(F.lds, g, so, E); RB(2); } SEAM(2);
    if (IN(3)) REP(3) { REFRESH(); conv_phase(F); __syncthreads(); dilattn2_phase(F); RB(3); } SEAM(3);
    if (IN(4)) REP(4) { REFRESH(); dil_combine_phase(F); RB(4); } SEAM(4);
    if (IN(5)) REP(5) { REFRESH(); pg8::Gemm g{(const b16*)(F.ws + R_MIX), (const b16*)(F.ws + WB_EOUT), D}; pg8::StaticOrder so; so.init(S / 256, D / 256, F.G, bid);
        pg8::EpiBf16 E{Y, D}; pg8::gemm_phase(F.lds, g, so, E); RB(5); } SEAM(5);
    if (IN(6)) { REFRESH(); resnorm_phase<true, true, false, false>(F, x_in, xo, Y, 0, 2, 1, 0, 3, 2); } SEAM(6);
    if (IN(7)) REP(7) { REFRESH(); pg8::Gemm g{HB, (const b16*)(F.ws + WB_EF13), D}; pg8::StaticOrder so; so.init(S / 256, 2 * FD / 256, F.G, bid);
        pg8::EpiSwiGLU E{(b16*)(F.ws + R_ACT), FD}; pg8::gemm_phase(F.lds, g, so, E); RB(7); } SEAM(7);
    if (IN(8)) REP(8) { REFRESH(); pg8::Gemm g{(const b16*)(F.ws + R_ACT), (const b16*)(F.ws + WB_EF2), FD}; pg8::StaticOrder so; so.init(S / 256, D / 256, F.G, bid);
        pg8::EpiBf16 E{Y, D}; pg8::gemm_phase(F.lds, g, so, E); RB(8); } SEAM(8);
    if (IN(9)) { REFRESH(); resnorm_phase<true, true, false, false>(F, xo, xo, Y, 0, 5, 3, 1, 0, 0); } SEAM(9);
    if (IN(10)) REP(10) { REFRESH(); pg8::Gemm g{HB, (const b16*)(F.ws + WB_OIN), D}; pg8::StaticOrder so; so.init(S / 256, O_INP / 256, F.G, bid);
        pg8::EpiBf16 E{(b16*)(F.ws + R_Z1), O_INP}; pg8::gemm_phase(F.lds, g, so, E); RB(10); } SEAM(10);
    if (IN(11)) REP(11) { REFRESH(); latent_phase(F); s5_pass1(F); RB(11); } SEAM(11);
    if (IN(12)) REP(12) { REFRESH();
        { pg8::Gemm g{(const b16*)(F.ws + R_CQN), (const b16*)(F.ws + WB_UQ), QL}; pg8::StaticOrder so; so.init(S / 256, NQ / 256, F.G, bid);
          pg8::EpiBf16 E{(b16*)(F.ws + R_Q), NQ}; pg8::gemm_phase(F.lds, g, so, E); }
        { pg8::Gemm g{(const b16*)(F.ws + R_CKVN), (const b16*)(F.ws + WB_UKV), KVLP}; pg8::StaticOrder so; so.init(S / 256, NKV / 256, F.G, bid);
          pg8::EpiBf16 E{(b16*)(F.ws + R_KV), NKV}; pg8::gemm_phase(F.lds, g, so, E); }
        __syncthreads();
        s5_pass3(F);
    RB(12); } SEAM(12);
    if (IN(13)) REP(13) { REFRESH();
        { pg8::Gemm g{(const b16*)(F.ws + R_YG), (const b16*)(F.ws + WB_GLU), S5D}; pg8::StaticOrder so; so.init(S / 256, S5D / 256, F.G, bid);
          pg8::EpiGate E{(const b16*)(F.ws + R_YG), S5D, (b16*)(F.ws + R_MIX2), D, 1536}; pg8::gemm_phase(F.lds, g, so, E); }
        __syncthreads();
        mla2::CvJob J{args.in[I_M1], args.in[I_M3], args.in[I_M2], (unsigned char*)(F.ws + WB_M13), (unsigned char*)(F.ws + WB_M2), MOE_WSCALE, F.gw, F.NGW};
        for (int u = F.vcu; u < 12 * (S / 256); u += F.G) { const int h = u >> 6, qb = u & 63;
            mla2::attn_unit((const unsigned short*)(F.ws + R_Q), (const unsigned short*)(F.ws + R_KV), (const unsigned short*)(F.ws + R_KPE),
                           (const float*)(F.ws + WS_COS), (const float*)(F.ws + WS_SIN), (unsigned short*)(F.ws + R_MIX2), h, qb * 256, S, (char*)lds_raw, J); }
        while (J.next < mla2::CV_NG) { float cvr[16]; unsigned char* cvd; mla2::cv_issue(J, F.lane, cvr, cvd); mla2::cv_finish(J, cvr, cvd); J.next += J.stride; }
    RB(13); } SEAM(13);
    if (IN(14)) REP(14) { REFRESH(); pg8::Gemm g{(const b16*)(F.ws + R_MIX2), (const b16*)(F.ws + WB_OOUT), D}; pg8::StaticOrder so; so.init(S / 256, D / 256, F.G, bid);
        pg8::EpiBf16 E{Y, D}; pg8::gemm_phase(F.lds, g, so, E); RB(14); } SEAM(14);
    if (IN(15)) { REFRESH(); resnorm_phase<true, true, true, false>(F, xo, xo, Y, 1, 2, 1, 1, 3, 2); } SEAM(15);
    if (IN(16)) REP(16) { REFRESH(); moe_slots_phase(F); RB(16); } SEAM(16);
    if (IN(17)) REP(17) { REFRESH(); const int nt = __builtin_amdgcn_readfirstlane(*(const int*)(F.ws + WS_ROUTE + RT_NTILE));
        pg8::Gemm g{(const void*)(F.ws + R_HS8), (const void*)(F.ws + WB_M13), D}; pg8::StaticOrder so; so.init(nt, 2 * FE / 256, F.G, bid);
        so.texp = (const int*)(F.ws + WS_ROUTE + RT_TEXP); so.estride = (size_t)2 * FE * D;
        pg8::EpiSwiGLU8 E{(unsigned char*)(F.ws + R_ACTS), FE, 1.0f / (MOE_WSCALE * MOE_HSCALE), MOE_ASCALE}; pg8::gemm_phase<true, false>(F.lds, g, so, E); RB(17); } SEAM(17);
    if (IN(18)) REP(18) { REFRESH(); const int nt = __builtin_amdgcn_readfirstlane(*(const int*)(F.ws + WS_ROUTE + RT_NTILE)); int nfull, sp; moe_tail_plan(nt, nfull, sp);
        { pg8::Gemm g{(const void*)(F.ws + R_ACTS), (const void*)(F.ws + WB_M2), FE}; pg8::StaticOrder so; so.init(nfull, D / 256, F.G, bid);
          so.texp = (const int*)(F.ws + WS_ROUTE + RT_TEXP); so.estride = (size_t)D * FE;
          pg8::EpiBf16 E{(b16*)(F.ws + R_YS), D, 1.0f / (MOE_WSCALE * MOE_ASCALE)}; pg8::gemm_phase<true, false>(F.lds, g, so, E); }
        if (sp > 1) {
          pg8::Gemm g{(const void*)(F.ws + R_ACTS), (const void*)(F.ws + WB_M2), FE, FE / sp}; pg8::SplitOrder so; so.init(nfull, nt - nfull, sp, D / 256, F.G, F.vcu, (size_t)(FE / sp));
          so.texp = (const int*)(F.ws + WS_ROUTE + RT_TEXP); so.estride = (size_t)D * FE;
          pg8::EpiF32S E{(float*)(F.ws + R_YT), D, nfull, (size_t)(nt - nfull) * 256 * D, 1.0f / (MOE_WSCALE * MOE_ASCALE)}; pg8::gemm_phase<true, false>(F.lds, g, so, E); }
        RB(18); } SEAM(18);
    if (IN(19)) { REFRESH(); resnorm_phase<true, false, false, true>(F, xo, xo, nullptr, 1, 5, 3, 0, 0, 0); }
#undef IN
#undef SEAM
}

extern "C" void kernel_launch(void* const* d_in, const int* in_sizes, int n_in, void* d_out, int out_size, void* d_ws, size_t ws_size, hipStream_t stream) {
    static int grid = 0;
    if (grid == 0) {
        if (n_in != 34 || out_size != S * D || ws_size < WS_END) { fprintf(stderr, "kernel_launch: unexpected shapes: n_in %d out %d ws %zu (need %zu)\n", n_in, out_size, ws_size, (size_t)WS_END); grid = -1; return; }
        int dev = 0, cus = 0, per_cu = 0;
        if (hipGetDevice(&dev) != hipSuccess || hipDeviceGetAttribute(&cus, hipDeviceAttributeMultiprocessorCount, dev) != hipSuccess) { grid = -1; return; }
        if (hipFuncSetAttribute((const void*)mk_fwd, hipFuncAttributeMaxDynamicSharedMemorySize, LDS_BYTES) != hipSuccess) { fprintf(stderr, "kernel_launch: hipFuncSetAttribute failed\n"); grid = -1; return; }
        if (hipOccupancyMaxActiveBlocksPerMultiprocessor(&per_cu, (const void*)mk_fwd, NWAVES * 64, LDS_BYTES) != hipSuccess || per_cu < 1) { fprintf(stderr, "kernel_launch: note: occupancy query says %d\n", per_cu); (void)hipGetLastError(); }
        grid = cus;
    }
    if (grid < 0) return;
    if (hipMemsetAsync((char*)d_ws + WS_CTL, 0, CTL_ZERO_BYTES, stream) != hipSuccess) return;
    Args a{};
    for (int i = 0; i < 34; ++i) a.in[i] = (const float*)d_in[i];
    a.out = (float*)d_out; a.ws = (unsigned char*)d_ws;
#if MK_N_LAUNCHES == 1
    a.ph_lo = 0; a.ph_hi = NPH;
    hipLaunchKernelGGL(mk_fwd, dim3(grid), dim3(NWAVES * 64), LDS_BYTES, stream, a);
#else
    for (int p = 0; p < NPH; ++p) { a.ph_lo = p; a.ph_hi = p + 1; hipLaunchKernelGGL(mk_fwd, dim3(grid), dim3(NWAVES * 64), LDS_BYTES, stream, a);
        if (TW(p)) hipLaunchKernelGGL(mk_fwd, dim3(grid), dim3(NWAVES * 64), LDS_BYTES, stream, a); }
#endif
}
```

```cpp
#include <hip/hip_runtime.h>
#include <cstdio>
#include <cstdint>

namespace pg8 {
#define PG8_LAS __attribute__((address_space(3)))
typedef unsigned short bf16_t;
typedef short bf16x8 __attribute__((ext_vector_type(8)));
typedef float f32x4 __attribute__((ext_vector_type(4)));
typedef unsigned u32x4 __attribute__((ext_vector_type(4)));
typedef unsigned u32x2 __attribute__((ext_vector_type(2)));
constexpr int BM = 256, BK = 64, HALF = 128, HTB = HALF * BK * 2  , STAGE_BYTES = 8 * HTB, NXCD = 8, WGM = 8;

__host__ __device__ __forceinline__ int lds_byte(int r, int c) { const int st = (r >> 4) * 2 + (c >> 5), rr = r & 15, cc = c & 31, ob = rr * 64 + cc * 2; return st * 1024 + (ob ^ (((ob >> 9) & 1) << 5)); }
__host__ __device__ __forceinline__ void stage_rc(int b, int& R, int& C) { const int st = b / 1024, sb = b % 1024, swz = sb ^ (((sb >> 9) & 1) << 5); R = (st >> 1) * 16 + swz / 64; C = (st & 1) * 32 + (swz % 64) / 2; }
__host__ __device__ __forceinline__ int perm32(int rho) { const int n = rho >> 4, i = rho & 15; return 8 * (i >> 2) + 4 * n + (i & 3); }

struct Unit { int pm, pn, ks; };
struct Gemm { const void* A; const void* Bt; int K; int kl = 0; };

struct StaticOrder {
    int nM, nN, nwg, G, c;
    const int* texp; size_t estride;
    const int* rowidx;
    __device__ void init(int nM_, int nN_, int G_, int c_) { nM = nM_; nN = nN_; nwg = nM * nN; G = G_; c = c_; texp = nullptr; estride = 0; rowidx = nullptr; }
    __device__ bool next(int i, Unit& u) const {
        const long L = (long)i * G + c; if (L >= nwg) return false;
        int wgid = (int)L; { const int q = nwg / NXCD, r = nwg % NXCD, xcd = wgid % NXCD, off = wgid / NXCD; wgid = (xcd < r ? xcd * (q + 1) : r * (q + 1) + (xcd - r) * q) + off; }
        const int nig = WGM * nN, gid = wgid / nig, fm = gid * WGM, gsz = (nM - fm) < WGM ? (nM - fm) : WGM;
        u.pm = fm + ((wgid % nig) % gsz); u.pn = (wgid % nig) / gsz; return true;
    }
    __device__ __forceinline__ size_t b_off(const Unit& u) const { return texp ? (size_t)__builtin_amdgcn_readfirstlane(texp[u.pm]) * estride : (size_t)0; }
    __device__ __forceinline__ size_t k_off(const Unit&) const { return 0; }
};
struct SplitOrder {
    int pm0, ntail, s, nN, G, c; size_t kbytes;
    const int* texp; size_t estride; const int* rowidx;
    __device__ void init(int pm0_, int ntail_, int s_, int nN_, int G_, int c_, size_t kbytes_) { pm0 = pm0_; ntail = ntail_; s = s_; nN = nN_; G = G_; c = c_; kbytes = kbytes_; texp = nullptr; estride = 0; rowidx = nullptr; }
    __device__ bool next(int i, Unit& u) const {
        const long L = (long)i * G + c; if (L >= (long)ntail * s * nN) return false;
        const int g = (int)L / nN; u.pn = (int)L - g * nN; const int t = g / s; u.pm = pm0 + t; u.ks = g - t * s; return true;
    }
    __device__ __forceinline__ size_t b_off(const Unit& u) const { return texp ? (size_t)__builtin_amdgcn_readfirstlane(texp[u.pm]) * estride : (size_t)0; }
    __device__ __forceinline__ size_t k_off(const Unit& u) const { return (size_t)u.ks * kbytes; }
};

__device__ __forceinline__ unsigned cvt_pk_bf16(float lo, float hi) { unsigned r; asm volatile("v_cvt_pk_bf16_f32 %0, %1, %2" : "=v"(r) : "v"(lo), "v"(hi)); return r; }

struct EpiF32 {
    static constexpr bool PERM = false;
    float* C; int ldc;
    __device__ __forceinline__ void operator()(const f32x4 (&acc)[2][2][4][2], const Unit& u, int wr, int wc, int fr, int fq) const {
        const int row0 = u.pm * BM + wr * 64 + fr, col0 = u.pn * BM + wc * 32 + 4 * fq;
#pragma unroll
        for (int ai = 0; ai < 2; ++ai)
#pragma unroll
            for (int m = 0; m < 4; ++m) { float* rowp = C + (size_t)(row0 + ai * HALF + m * 16) * ldc + col0;
#pragma unroll
                for (int bj = 0; bj < 2; ++bj)
#pragma unroll
                    for (int n = 0; n < 2; ++n) *(f32x4*)(rowp + bj * HALF + n * 16) = acc[ai][bj][m][n]; }
    }
};
struct EpiF32S {
    static constexpr bool PERM = false;
    float* C; int ldc; int pm0; size_t sstride; float sc;
    __device__ __forceinline__ void operator()(const f32x4 (&acc)[2][2][4][2], const Unit& u, int wr, int wc, int fr, int fq) const {
        const int row0 = (u.pm - pm0) * BM + wr * 64 + fr, col0 = u.pn * BM + wc * 32 + 4 * fq;
        float* Cs = C + (size_t)u.ks * sstride;
#pragma unroll
        for (int ai = 0; ai < 2; ++ai)
#pragma unroll
            for (int m = 0; m < 4; ++m) { float* rowp = Cs + (size_t)(row0 + ai * HALF + m * 16) * ldc + col0;
#pragma unroll
                for (int bj = 0; bj < 2; ++bj)
#pragma unroll
                    for (int n = 0; n < 2; ++n) *(f32x4*)(rowp + bj * HALF + n * 16) = acc[ai][bj][m][n] * sc; }
    }
};
struct EpiBf16 {
    static constexpr bool PERM = true;
    bf16_t* O; int ldc; float sc = 1.0f;
    __device__ __forceinline__ void operator()(const f32x4 (&acc)[2][2][4][2], const Unit& u, int wr, int wc, int fr, int fq) const {
        const int row0 = u.pm * BM + wr * 64 + fr, col0 = u.pn * BM + wc * 32 + 8 * fq;
#pragma unroll
        for (int ai = 0; ai < 2; ++ai)
#pragma unroll
            for (int m = 0; m < 4; ++m) { bf16_t* rowp = O + (size_t)(row0 + ai * HALF + m * 16) * ldc + col0;
#pragma unroll
                for (int bj = 0; bj < 2; ++bj) { const f32x4 v0 = acc[ai][bj][m][0] * sc, v1 = acc[ai][bj][m][1] * sc;
                    u32x4 w; w.x = cvt_pk_bf16(v0[0], v0[1]); w.y = cvt_pk_bf16(v0[2], v0[3]); w.z = cvt_pk_bf16(v1[0], v1[1]); w.w = cvt_pk_bf16(v1[2], v1[3]);
                    *(u32x4*)(rowp + bj * HALF) = w; } }
    }
};
__device__ __forceinline__ float silu_f(float v) { return v * __builtin_amdgcn_rcpf(1.0f + __builtin_amdgcn_exp2f(-1.4426950408889634f * v)); }
__device__ __forceinline__ float sigmoid_f(float v) { return __builtin_amdgcn_rcpf(1.0f + __builtin_amdgcn_exp2f(-1.4426950408889634f * v)); }
struct EpiSwiGLU {
    static constexpr bool PERM = false;
    bf16_t* O; int ldc;
    __device__ __forceinline__ void operator()(const f32x4 (&acc)[2][2][4][2], const Unit& u, int wr, int wc, int fr, int fq) const {
        const int row0 = u.pm * BM + wr * 64 + fr, col0 = u.pn * (BM / 2) + wc * 16 + 4 * fq;
#pragma unroll
        for (int ai = 0; ai < 2; ++ai)
#pragma unroll
            for (int m = 0; m < 4; ++m) { bf16_t* rowp = O + (size_t)(row0 + ai * HALF + m * 16) * ldc + col0;
#pragma unroll
                for (int bj = 0; bj < 2; ++bj) { const f32x4 a = acc[ai][bj][m][0], b = acc[ai][bj][m][1];
                    u32x2 w; w.x = cvt_pk_bf16(silu_f(a[0]) * b[0], silu_f(a[1]) * b[1]); w.y = cvt_pk_bf16(silu_f(a[2]) * b[2], silu_f(a[3]) * b[3]);
                    *(u32x2*)(rowp + bj * (HALF / 2)) = w; } }
    }
};
struct EpiSwiGLU8 {
    static constexpr bool PERM = false;
    unsigned char* O; int ldc; float isc, osc;
    __device__ __forceinline__ void operator()(const f32x4 (&acc)[2][2][4][2], const Unit& u, int wr, int wc, int fr, int fq) const {
        const int row0 = u.pm * BM + wr * 64 + fr, col0 = u.pn * (BM / 2) + wc * 16 + 4 * fq;
#pragma unroll
        for (int ai = 0; ai < 2; ++ai)
#pragma unroll
            for (int m = 0; m < 4; ++m) { unsigned char* rowp = O + (size_t)(row0 + ai * HALF + m * 16) * ldc + col0;
#pragma unroll
                for (int bj = 0; bj < 2; ++bj) { const f32x4 a = acc[ai][bj][m][0] * isc, b = acc[ai][bj][m][1] * (isc * osc);
                    float v[4];
#pragma unroll
                    for (int e = 0; e < 4; ++e) v[e] = __builtin_fminf(__builtin_fmaxf(silu_f(a[e]) * b[e], -448.f), 448.f);
                    int w = 0; w = __builtin_amdgcn_cvt_pk_fp8_f32(v[0], v[1], w, false); w = __builtin_amdgcn_cvt_pk_fp8_f32(v[2], v[3], w, true);
                    *(int*)(rowp + bj * (HALF / 2)) = w; } }
    }
};
struct EpiGate {
    static constexpr bool PERM = false;
    const bf16_t* Y; int ldy; bf16_t* O; int ldc; int ocol0;
    __device__ __forceinline__ void operator()(const f32x4 (&acc)[2][2][4][2], const Unit& u, int wr, int wc, int fr, int fq) const {
        const int row0 = u.pm * BM + wr * 64 + fr, col0 = u.pn * BM + wc * 32 + 4 * fq;
#pragma unroll
        for (int ai = 0; ai < 2; ++ai)
#pragma unroll
            for (int m = 0; m < 4; ++m) { const size_t r = (size_t)(row0 + ai * HALF + m * 16);
#pragma unroll
                for (int bj = 0; bj < 2; ++bj)
#pragma unroll
                    for (int n = 0; n < 2; ++n) { const int c = col0 + bj * HALF + n * 16; const f32x4 a = acc[ai][bj][m][n];
                        const u32x2 y = *(const u32x2*)(Y + r * ldy + c);
                        const float y0 = __uint_as_float(y.x << 16), y1 = __uint_as_float(y.x & 0xffff0000u), y2 = __uint_as_float(y.y << 16), y3 = __uint_as_float(y.y & 0xffff0000u);
                        u32x2 w; w.x = cvt_pk_bf16(y0 * sigmoid_f(a[0]), y1 * sigmoid_f(a[1])); w.y = cvt_pk_bf16(y2 * sigmoid_f(a[2]), y3 * sigmoid_f(a[3]));
                        *(u32x2*)(O + r * ldc + ocol0 + c) = w; } }
    }
};

typedef int v8i32 __attribute__((ext_vector_type(8)));
__device__ __forceinline__ void glds16s(const void* sbase, unsigned voff, unsigned lds_dst) { unsigned keep;
    asm volatile("s_mov_b32 %0, m0\n\ts_mov_b32 m0, %3\n\ts_nop 0\n\tglobal_load_lds_dwordx4 %1, %2\n\ts_mov_b32 m0, %0" : "=&s"(keep) : "v"(voff), "s"(sbase), "s"(lds_dst) : "memory"); }
template <bool FP8 = false, bool GATHER = false, class Epi, class Sched>
__device__ __forceinline__ void gemm_phase(PG8_LAS unsigned char* lds, const Gemm g, const Sched& S, const Epi& E) {
    const int tid = threadIdx.x, wid = __builtin_amdgcn_readfirstlane(tid >> 6), lane = tid & 63, wr = wid >> 2, wc = wid & 3, fr = lane & 15, fq = lane >> 4;
    const int K = FP8 ? (g.K >> 1) : g.K, nt = (g.kl ? (FP8 ? (g.kl >> 1) : g.kl) : K) / BK;
    unsigned voffA[2], voffB[2];
#pragma unroll
    for (int i = 0; i < 2; ++i) { int R, C; stage_rc(tid * 16 + i * 8192, R, C); const int Rb = Epi::PERM ? ((R & ~31) + perm32(R & 31)) : R;
        voffA[i] = (unsigned)(R * K + C) * 2u; voffB[i] = (unsigned)(Rb * K + C) * 2u; }
    const size_t kstep = (size_t)(BK * 2);
    const size_t qstep = (size_t)64 * K * 2;
    const size_t hstep = (size_t)HALF * K * 2;
    const size_t tstep = 2 * hstep;
    const unsigned ldsw = (unsigned)wid * 1024u, ldsbase = (unsigned)(uintptr_t)lds;
    const int aoff = lds_byte(wr * 64 + fr, fq * 8), boff = lds_byte(wc * 32 + fr, fq * 8);
#define PG8_SA(b, h) (((b) * 2 + (h)) * HTB)
#define PG8_SB(b, h) ((4 + (b) * 2 + (h)) * HTB)
#define PG8_STAGE(bufoff, gbase, voff) do { _Pragma("unroll") for (int _i = 0; _i < 2; ++_i) glds16s((const void*)(gbase), (voff)[_i], ldsbase + (unsigned)(bufoff) + ldsw + (unsigned)_i * 8192u); } while (0)
#define PG8_STAGE1(bufoff, gbase, voff0) do { _Pragma("unroll") for (int _i = 0; _i < 2; ++_i) glds16s((const void*)((const char*)(gbase) + (size_t)_i * qstep), voff0, ldsbase + (unsigned)(bufoff) + ldsw + (unsigned)_i * 8192u); } while (0)
#define PG8_STAGE_A(bufoff, h, ap, og) do { if constexpr (GATHER) PG8_STAGE(bufoff, ap, (og)[h]); else PG8_STAGE1(bufoff, (ap) + (h) * hstep, voffA[0]); } while (0)
#define PG8_LDA(dst, b, h) do { _Pragma("unroll") for (int m = 0; m < 4; ++m) _Pragma("unroll") for (int k = 0; k < 2; ++k) dst[m][k] = *(const PG8_LAS bf16x8*)(lds + PG8_SA(b, h) + aoff + m * 2048 + k * 1024); } while (0)
#define PG8_LDB(dst, b, h) do { _Pragma("unroll") for (int n = 0; n < 2; ++n) _Pragma("unroll") for (int k = 0; k < 2; ++k) dst[n][k] = *(const PG8_LAS bf16x8*)(lds + PG8_SB(b, h) + boff + n * 2048 + k * 1024); } while (0)
#define PG8_MMA(ai, bj, At, Bt) do { __builtin_amdgcn_s_setprio(1); _Pragma("unroll") for (int m = 0; m < 4; ++m) _Pragma("unroll") for (int n = 0; n < 2; ++n) { \
        if constexpr (FP8) { const v8i32 bq = __builtin_bit_cast(v8i32, __builtin_shufflevector(Bt[n][0], Bt[n][1], 0, 1, 2, 3, 4, 5, 6, 7, 8, 9, 10, 11, 12, 13, 14, 15)); \
            const v8i32 aq = __builtin_bit_cast(v8i32, __builtin_shufflevector(At[m][0], At[m][1], 0, 1, 2, 3, 4, 5, 6, 7, 8, 9, 10, 11, 12, 13, 14, 15)); \
            acc[ai][bj][m][n] = __builtin_amdgcn_mfma_scale_f32_16x16x128_f8f6f4(bq, aq, acc[ai][bj][m][n], 0, 0, 0, 0, 0, 0);     } \
        else { _Pragma("unroll") for (int k = 0; k < 2; ++k) acc[ai][bj][m][n] = __builtin_amdgcn_mfma_f32_16x16x32_bf16(Bt[n][k], At[m][k], acc[ai][bj][m][n], 0, 0, 0); } } \
        __builtin_amdgcn_s_setprio(0); } while (0)
#define PG8_WAIT_V(n) asm volatile("s_waitcnt vmcnt(" #n ")" ::: "memory")
#define PG8_WAIT_L(n) asm volatile("s_waitcnt lgkmcnt(" #n ")" ::: "memory")
#define PG8_BAR __builtin_amdgcn_s_barrier()
#define PG8_SCHED __builtin_amdgcn_sched_barrier(0)
#define PG8_AOFF(dst, u) do { if constexpr (GATHER) { int t2_ = (int)threadIdx.x; asm volatile("" : "+v"(t2_)); _Pragma("unroll") for (int _i = 0; _i < 2; ++_i) { int R_, C_; stage_rc(t2_ * 16 + _i * 8192, R_, C_); \
        _Pragma("unroll") for (int _h = 0; _h < 2; ++_h) { const int _row = S.rowidx[(u).pm * BM + _h * HALF + R_]; dst[_h][_i] = (unsigned)((size_t)_row * K + C_) * 2u; } } } } while (0)
    Unit cur, nxt; int ui = 0;
    if (!S.next(0, cur)) return;
    f32x4 acc[2][2][4][2];
#pragma unroll
    for (int a = 0; a < 2; ++a)
#pragma unroll
        for (int b = 0; b < 2; ++b)
#pragma unroll
            for (int m = 0; m < 4; ++m)
#pragma unroll
                for (int n = 0; n < 2; ++n) acc[a][b][m][n] = (f32x4){0.f, 0.f, 0.f, 0.f};
    bf16x8 At[4][2], B0[2][2], B1[2][2];
    unsigned oC[2][2];
#define PG8_OSLOT ((PG8_LAS u32x4*)(lds + STAGE_BYTES) + (int)threadIdx.x)
    PG8_AOFF(oC, cur);
    const char* const gA = (const char*)g.A;
    const char* cA = (GATHER ? gA : gA + (size_t)cur.pm * tstep) + S.k_off(cur);
    const char* cB = (const char*)g.Bt + S.b_off(cur) + (size_t)cur.pn * tstep + S.k_off(cur);
    PG8_STAGE1(PG8_SB(0, 0), cB, voffB[0]); PG8_STAGE1(PG8_SB(0, 1), cB + hstep, voffB[0]); PG8_STAGE_A(PG8_SA(0, 0), 0, cA, oC); PG8_STAGE_A(PG8_SA(0, 1), 1, cA, oC);
    if (wr == 1) PG8_BAR;
    PG8_WAIT_V(2); PG8_BAR;
    PG8_STAGE1(PG8_SB(1, 0), cB + kstep, voffB[0]); PG8_STAGE_A(PG8_SA(1, 0), 0, cA + kstep, oC); PG8_STAGE1(PG8_SB(1, 1), cB + hstep + kstep, voffB[0]);
    PG8_WAIT_V(6); PG8_BAR;
    for (;;) {
        const bool has_next = S.next(ui + 1, nxt);
        const char* nB = cB; const char* nA = cA;
        if (has_next) { nB = (const char*)g.Bt + S.b_off(nxt) + (size_t)nxt.pn * tstep + S.k_off(nxt); nA = (GATHER ? gA : gA + (size_t)nxt.pm * tstep) + S.k_off(nxt);
            if constexpr (GATHER) { unsigned oN[2][2]; PG8_AOFF(oN, nxt); *PG8_OSLOT = (u32x4){oN[0][0], oN[0][1], oN[1][0], oN[1][1]}; } }
        for (int t = 0; t < nt; t += 2) {
            const bool last = (t == nt - 2);
            const char* a1 = cA + (size_t)(t + 1) * kstep;
            const char* a2 = last ? nA : cA + (size_t)(t + 2) * kstep; const char* b2 = last ? nB : cB + (size_t)(t + 2) * kstep;
            const char* a3 = a2 + kstep; const char* b3 = b2 + kstep;
            unsigned o2[2][2];
            if constexpr (GATHER) {
                if (last && has_next) { const u32x4 q = *PG8_OSLOT; o2[0][0] = q.x; o2[0][1] = q.y; o2[1][0] = q.z; o2[1][1] = q.w; }
                else { o2[0][0] = oC[0][0]; o2[0][1] = oC[0][1]; o2[1][0] = oC[1][0]; o2[1][1] = oC[1][1]; }
            }
            PG8_LDB(B0, 0, 0); PG8_LDB(B1, 0, 1); PG8_SCHED; PG8_LDA(At, 0, 0); PG8_STAGE_A(PG8_SA(1, 1), 1, a1, oC);
            PG8_WAIT_V(8); PG8_WAIT_L(0); PG8_BAR; PG8_MMA(0, 0, At, B0); PG8_MMA(0, 1, At, B1); PG8_BAR; PG8_SCHED;
            PG8_LDA(At, 0, 1); PG8_STAGE1(PG8_SB(0, 0), b2, voffB[0]); PG8_STAGE1(PG8_SB(0, 1), b2 + hstep, voffB[0]); PG8_STAGE_A(PG8_SA(0, 0), 0, a2, o2);
            PG8_WAIT_V(8); PG8_WAIT_L(0); PG8_BAR; PG8_MMA(1, 0, At, B0); PG8_MMA(1, 1, At, B1); PG8_BAR; PG8_SCHED;
            PG8_LDB(B0, 1, 0); PG8_LDB(B1, 1, 1); PG8_SCHED; PG8_LDA(At, 1, 0); PG8_STAGE_A(PG8_SA(0, 1), 1, a2, o2);
            PG8_WAIT_V(8); PG8_WAIT_L(0); PG8_BAR; PG8_MMA(0, 0, At, B0); PG8_MMA(0, 1, At, B1); PG8_BAR; PG8_SCHED;
            PG8_LDA(At, 1, 1); PG8_STAGE1(PG8_SB(1, 0), b3, voffB[0]); PG8_STAGE1(PG8_SB(1, 1), b3 + hstep, voffB[0]); PG8_STAGE_A(PG8_SA(1, 0), 0, a3, o2);
            PG8_WAIT_V(8); PG8_WAIT_L(0); PG8_BAR; PG8_MMA(1, 0, At, B0); PG8_MMA(1, 1, At, B1); PG8_BAR; PG8_SCHED;
        }
        if (wr == 0) PG8_BAR;
        { int t3 = (int)threadIdx.x; asm volatile("" : "+v"(t3)); E(acc, cur, wr, wc, t3 & 15, (t3 >> 4) & 3); }
        if (!has_next) break;
#pragma unroll
        for (int a = 0; a < 2; ++a)
#pragma unroll
            for (int b = 0; b < 2; ++b)
#pragma unroll
                for (int m = 0; m < 4; ++m)
#pragma unroll
                    for (int n = 0; n < 2; ++n) acc[a][b][m][n] = (f32x4){0.f, 0.f, 0.f, 0.f};
        cur = nxt; cB = nB; cA = nA; ++ui;
        if constexpr (GATHER) { const u32x4 q = *PG8_OSLOT; oC[0][0] = q.x; oC[0][1] = q.y; oC[1][0] = q.z; oC[1][1] = q.w; }
        if (wr == 1) PG8_BAR;
    }
    PG8_WAIT_V(0);
    PG8_BAR;
#undef PG8_SA
#undef PG8_SB
#undef PG8_STAGE
#undef PG8_STAGE_A
#undef PG8_STAGE1
#undef PG8_LDA
#undef PG8_LDB
#undef PG8_MMA
#undef PG8_WAIT_V
#undef PG8_WAIT_L
#undef PG8_BAR
#undef PG8_SCHED
#undef PG8_AOFF
#undef PG8_OSLOT
}
}
namespace mla2 {
using bf16x8 = __attribute__((ext_vector_type(8))) short;
using s16x4  = __attribute__((ext_vector_type(4))) short;
using f32x16 = __attribute__((ext_vector_type(16))) float;
using f32x4v = __attribute__((ext_vector_type(4))) float;
using u32x4  = __attribute__((ext_vector_type(4))) unsigned;
constexpr int NW = 8, QBLK = 32, KVBLK = 64;
constexpr float SCALE = 0.072168783648703220f;
constexpr float THR = 8.f;
constexpr int NQREG = 4, NQL = 12 - NQREG;
constexpr int LDQ = 2304, LDKV = 3072, LDKP = 64, LDO = 2048;
constexpr int SHM_V = KVBLK * 128 * 2, SHM_KN = KVBLK * 128 * 2, SHM_KP = KVBLK * 64 * 2;
constexpr int SHM_K = SHM_KN + SHM_KP;
constexpr int OFF_V = 0, OFF_KN = 2 * SHM_V, OFF_WS = OFF_KN + 2 * SHM_K, OFF_QS = OFF_WS + NW * 64 * 4, QS_WAVE = NQL * 1024, SHM_ATTN = OFF_QS + NW * QS_WAVE;
#define MLA2_QB(row, c16) ((((c16) >> 1) * 32 + (row)) * 32 + ((((c16) & 1) ^ (((row) >> 3) & 1)) << 4))
#define MLA2_SBAR() __builtin_amdgcn_sched_barrier(0)
#ifndef MLA2_WAIT0
#define MLA2_WAIT0 0
#endif
#if MLA2_WAIT0
#define MLA2_LWAIT(n) do { asm volatile("s_waitcnt lgkmcnt(0)" ::: "memory"); __builtin_amdgcn_sched_barrier(0); } while (0)
#else
#ifndef MLA2_SBMASK
#define MLA2_SBMASK 0x416
#endif
#define MLA2_LWAIT(n) do { asm volatile("s_waitcnt lgkmcnt(" #n ")" ::: "memory"); __builtin_amdgcn_sched_barrier(MLA2_SBMASK); } while (0)
#ifndef MLA2_FENCES
#define MLA2_FENCES 1
#endif
#if MLA2_FENCES
#define MLA2_FENCE() __builtin_amdgcn_sched_barrier(0)
#else
#define MLA2_FENCE() do {} while (0)
#endif
#define MLA2_W2(n, A, B) asm volatile("s_waitcnt lgkmcnt(" #n ")" : "+v"(A), "+v"(B) :: "memory")
#define MLA2_W3(n, A, B, C) asm volatile("s_waitcnt lgkmcnt(" #n ")" : "+v"(A), "+v"(B), "+v"(C) :: "memory")
#endif
__device__ __forceinline__ int crow(int r, int hi) { return (r & 3) + 8 * (r >> 2) + 4 * hi; }
__device__ __forceinline__ unsigned cvtpk(float lo, float hi) { unsigned r; asm volatile("v_cvt_pk_bf16_f32 %0, %1, %2" : "=v"(r) : "v"(lo), "v"(hi)); return r; }
#ifndef MLA2_PLAIN_RD
#define MLA2_PLAIN_RD 0
#endif
template <int OFF> __device__ __forceinline__ bf16x8 lds_rd(int addr) {
#if MLA2_PLAIN_RD
  return *(const __attribute__((address_space(3))) bf16x8*)(unsigned)(addr + OFF);
#else
  bf16x8 r; asm volatile("ds_read_b128 %0, %1 offset:%2" : "=v"(r) : "v"(addr), "i"(OFF) : "memory"); return r;
#endif
}
using f32x2v = __attribute__((ext_vector_type(2))) float;
__device__ __forceinline__ float max3f(float a, float b, float c) { float r; asm volatile("v_max3_f32 %0, %1, %2, %3" : "=v"(r) : "v"(a), "v"(b), "v"(c)); return r; }
template <int OFF> __device__ __forceinline__ s16x4 tr_read(int vb) { s16x4 r; asm volatile("ds_read_b64_tr_b16 %0, %1 offset:%2" : "=&v"(r) : "v"(vb), "i"(OFF) : "memory"); return r; }

__device__ __forceinline__ void partialSM(f32x16& p0, f32x16& p1, float& m_reg, float& mn, float& alpha) {
  constexpr float C = SCALE * 1.4426950408889634f;
  float pmax = p0[0];
#pragma unroll
  for (int r = 1; r < 16; ++r) pmax = fmaxf(pmax, p0[r]);
#pragma unroll
  for (int r = 0; r < 16; ++r) pmax = fmaxf(pmax, p1[r]);
  { auto rr = __builtin_amdgcn_permlane32_swap(__float_as_uint(pmax), __float_as_uint(pmax), false, false);
    pmax = fmaxf(__uint_as_float(rr[0]), __uint_as_float(rr[1])); }
  if (__builtin_expect(__all(pmax - m_reg <= THR / SCALE), 1)) { mn = m_reg; alpha = 1.f; }
  else { mn = fmaxf(m_reg, pmax); alpha = __builtin_amdgcn_exp2f((m_reg - mn) * C); m_reg = mn; }
  float mnC = -mn * C;
#pragma unroll
  for (int r = 0; r < 16; ++r) p0[r] = fmaf(p0[r], C, mnC);
#pragma unroll
  for (int r = 0; r < 16; ++r) p1[r] = fmaf(p1[r], C, mnC);
#pragma unroll
  for (int r = 0; r < 16; ++r) p0[r] = __builtin_amdgcn_exp2f(p0[r]);
}
__device__ __forceinline__ void finishSM(f32x16& p0, f32x16& p1, float alpha, float& l_reg, bf16x8& pa0, bf16x8& pa1, bf16x8& pa2, bf16x8& pa3) {
#pragma unroll
  for (int r = 0; r < 16; ++r) p1[r] = __builtin_amdgcn_exp2f(p1[r]);
  float ps = 0;
#pragma unroll
  for (int r = 0; r < 16; ++r) ps += p0[r];
#pragma unroll
  for (int r = 0; r < 16; ++r) ps += p1[r];
  { auto rr = __builtin_amdgcn_permlane32_swap(__float_as_uint(ps), __float_as_uint(ps), false, false);
    ps = __uint_as_float(rr[0]) + __uint_as_float(rr[1]); }
  l_reg = l_reg * alpha + ps;
#define MLA2_PK4(P, BASE, OUT) do { unsigned a0 = cvtpk(P[BASE + 0], P[BASE + 1]), a1 = cvtpk(P[BASE + 2], P[BASE + 3]);   \
    unsigned b0 = cvtpk(P[BASE + 4], P[BASE + 5]), b1 = cvtpk(P[BASE + 6], P[BASE + 7]);                              \
    auto r0 = __builtin_amdgcn_permlane32_swap(a0, b0, false, false); auto r1 = __builtin_amdgcn_permlane32_swap(a1, b1, false, false); \
    u32x4 w = {r0[0], r1[0], r0[1], r1[1]}; OUT = *reinterpret_cast<bf16x8*>(&w); } while (0)
  MLA2_PK4(p0, 0, pa0); MLA2_PK4(p0, 8, pa1); MLA2_PK4(p1, 0, pa2); MLA2_PK4(p1, 8, pa3);
#undef MLA2_PK4
}
constexpr int ko(int B, int s) { return B * SHM_K + (s >> 2) * 8192; }
constexpr int qo(int s) { return (s - NQREG) * 1024; }
template <int B> __device__ __forceinline__ void qkt(f32x16& p0, f32x16& p1, const int (&kb)[4], int qbase, const bf16x8 (&qr)[NQREG]) {
  p0 = f32x16{}; p1 = f32x16{};
  bf16x8 a0, a1, aq, c0, c1, cq;
#define MLA2_RD(s, X0, X1, XQ) do { X0 = lds_rd<ko(B, s)>(kb[(s) & 3]); X1 = lds_rd<ko(B, s) + 4096>(kb[(s) & 3]); if constexpr ((s) >= NQREG) XQ = lds_rd<qo((s) >= NQREG ? (s) : NQREG)>(qbase); } while (0)
#define MLA2_MM(s, X0, X1, XQ) do { const bf16x8 q_ = ((s) < NQREG) ? qr[(s) < NQREG ? (s) : 0] : XQ; \
    p0 = __builtin_amdgcn_mfma_f32_32x32x16_bf16(X0, q_, p0, 0, 0, 0); p1 = __builtin_amdgcn_mfma_f32_32x32x16_bf16(X1, q_, p1, 0, 0, 0); } while (0)
  MLA2_RD(0, a0, a1, aq); MLA2_RD(1, c0, c1, cq);
  MLA2_W2(2, a0, a1); MLA2_MM(0, a0, a1, aq); MLA2_RD(2, a0, a1, aq);
  MLA2_W2(2, c0, c1); MLA2_MM(1, c0, c1, cq); MLA2_RD(3, c0, c1, cq);
  MLA2_W2(2, a0, a1); MLA2_MM(2, a0, a1, aq); MLA2_RD(4, a0, a1, aq);
  MLA2_W2(3, c0, c1); MLA2_MM(3, c0, c1, cq); MLA2_RD(5, c0, c1, cq); MLA2_FENCE();
  MLA2_W3(3, a0, a1, aq); MLA2_MM(4, a0, a1, aq); MLA2_RD(6, a0, a1, aq);
  MLA2_W3(3, c0, c1, cq); MLA2_MM(5, c0, c1, cq); MLA2_RD(7, c0, c1, cq);
  MLA2_W3(3, a0, a1, aq); MLA2_MM(6, a0, a1, aq); MLA2_RD(8, a0, a1, aq);
  MLA2_W3(3, c0, c1, cq); MLA2_MM(7, c0, c1, cq); MLA2_RD(9, c0, c1, cq); MLA2_FENCE();
  MLA2_W3(3, a0, a1, aq); MLA2_MM(8, a0, a1, aq); MLA2_RD(10, a0, a1, aq);
  MLA2_W3(3, c0, c1, cq); MLA2_MM(9, c0, c1, cq); MLA2_RD(11, c0, c1, cq);
  MLA2_W3(3, a0, a1, aq); MLA2_MM(10, a0, a1, aq);
  MLA2_W3(0, c0, c1, cq); MLA2_MM(11, c0, c1, cq);
#undef MLA2_RD
#undef MLA2_MM
}
__device__ __forceinline__ int v_st(int k, int c) { const int kk = (k & ~0xC) | ((k & 4) << 1) | ((k & 8) >> 1); return ((kk >> 3) * 4 + (c >> 5)) * 512 + ((kk & 7) * 32 + (c & 31)) * 2; }
__device__ __forceinline__ int v_rd_base(int lane) { return ((lane & 3) << 3) | (((lane >> 2) & 3) << 6) | (((lane >> 4) & 1) << 5) | (((lane >> 5) & 1) << 8); }
constexpr int v_rd_off(int d0, int ks, int half) { return d0 * 512 + ks * 4096 + half * 2048; }
template <int B> __device__ __forceinline__ void pv(f32x16 (&o)[4], int vb, bf16x8 pa0, bf16x8 pa1, bf16x8 pa2, bf16x8 pa3) {
  s16x4 l0, h0, l1, h1, l2, h2;
#define MLA2_PK(L, H) (bf16x8){L[0], L[1], L[2], L[3], H[0], H[1], H[2], H[3]}
#define MLA2_PR(k, L, H) do { L = tr_read<B * SHM_V + v_rd_off((k) & 3, (k) >> 2, 0)>(vb); H = tr_read<B * SHM_V + v_rd_off((k) & 3, (k) >> 2, 1)>(vb); } while (0)
#define MLA2_PM(k, L, H) do { const bf16x8 pa_ = ((k) >> 2) == 0 ? pa0 : ((k) >> 2) == 1 ? pa1 : ((k) >> 2) == 2 ? pa2 : pa3; \
    o[(k) & 3] = __builtin_amdgcn_mfma_f32_32x32x16_bf16(pa_, MLA2_PK(L, H), o[(k) & 3], 0, 0, 0); } while (0)
  MLA2_PR(0, l0, h0); MLA2_PR(1, l1, h1); MLA2_PR(2, l2, h2);
  MLA2_W2(4, l0, h0); MLA2_PM(0, l0, h0); MLA2_PR(3, l0, h0);
  MLA2_W2(4, l1, h1); MLA2_PM(1, l1, h1); MLA2_PR(4, l1, h1);
  MLA2_W2(4, l2, h2); MLA2_PM(2, l2, h2); MLA2_PR(5, l2, h2);
  MLA2_W2(4, l0, h0); MLA2_PM(3, l0, h0); MLA2_PR(6, l0, h0); MLA2_FENCE();
  MLA2_W2(4, l1, h1); MLA2_PM(4, l1, h1); MLA2_PR(7, l1, h1);
  MLA2_W2(4, l2, h2); MLA2_PM(5, l2, h2); MLA2_PR(8, l2, h2);
  MLA2_W2(4, l0, h0); MLA2_PM(6, l0, h0); MLA2_PR(9, l0, h0);
  MLA2_W2(4, l1, h1); MLA2_PM(7, l1, h1); MLA2_PR(10, l1, h1); MLA2_FENCE();
  MLA2_W2(4, l2, h2); MLA2_PM(8, l2, h2); MLA2_PR(11, l2, h2);
  MLA2_W2(4, l0, h0); MLA2_PM(9, l0, h0); MLA2_PR(12, l0, h0);
  MLA2_W2(4, l1, h1); MLA2_PM(10, l1, h1); MLA2_PR(13, l1, h1);
  MLA2_W2(4, l2, h2); MLA2_PM(11, l2, h2); MLA2_PR(14, l2, h2); MLA2_FENCE();
  MLA2_W2(4, l0, h0); MLA2_PM(12, l0, h0); MLA2_PR(15, l0, h0);
  MLA2_W2(4, l1, h1); MLA2_PM(13, l1, h1);
  MLA2_W2(2, l2, h2); MLA2_PM(14, l2, h2);
  MLA2_W2(0, l0, h0); MLA2_PM(15, l0, h0);
#undef MLA2_PK
#undef MLA2_PR
#undef MLA2_PM
}
#define MLA2_PK4B(P, BASE, OUT) do { unsigned a0_ = cvtpk(P[BASE + 0], P[BASE + 1]), a1_ = cvtpk(P[BASE + 2], P[BASE + 3]);   \
    unsigned b0_ = cvtpk(P[BASE + 4], P[BASE + 5]), b1_ = cvtpk(P[BASE + 6], P[BASE + 7]);                              \
    auto r0_ = __builtin_amdgcn_permlane32_swap(a0_, b0_, false, false); auto r1_ = __builtin_amdgcn_permlane32_swap(a1_, b1_, false, false); \
    u32x4 w_ = {r0_[0], r1_[0], r0_[1], r1_[1]}; OUT = *reinterpret_cast<bf16x8*>(&w_); } while (0)
template <int B> __device__ __forceinline__ void r1(f32x16& n0, f32x16& n1, const int (&kb)[4], int qbase, const bf16x8 (&qr)[NQREG],
                                                    f32x16& p0, f32x16& p1, float alpha, float& l_reg, bf16x8& pa0, bf16x8& pa1, bf16x8& pa2, bf16x8& pa3) {
  bf16x8 a0, a1, aq, c0, c1, cq; f32x2v ps2 = {0.f, 0.f};
#define MLA2_RD(s, X0, X1, XQ) do { X0 = lds_rd<ko(B, s)>(kb[(s) & 3]); X1 = lds_rd<ko(B, s) + 4096>(kb[(s) & 3]); if constexpr ((s) >= NQREG) XQ = lds_rd<qo((s) >= NQREG ? (s) : NQREG)>(qbase); } while (0)
#define MLA2_MM(s, X0, X1, XQ) do { const bf16x8 q_ = ((s) < NQREG) ? qr[(s) < NQREG ? (s) : 0] : XQ; \
    if constexpr ((s) == 0) { n0 = __builtin_amdgcn_mfma_f32_32x32x16_bf16(X0, q_, f32x16{}, 0, 0, 0); n1 = __builtin_amdgcn_mfma_f32_32x32x16_bf16(X1, q_, f32x16{}, 0, 0, 0); }     \
    else { n0 = __builtin_amdgcn_mfma_f32_32x32x16_bf16(X0, q_, n0, 0, 0, 0); n1 = __builtin_amdgcn_mfma_f32_32x32x16_bf16(X1, q_, n1, 0, 0, 0); } } while (0)
#define MLA2_CE(k) do { p1[2 * (k)] = __builtin_amdgcn_exp2f(p1[2 * (k)]); p1[2 * (k) + 1] = __builtin_amdgcn_exp2f(p1[2 * (k) + 1]); ps2 += (f32x2v){p0[2 * (k)], p0[2 * (k) + 1]}; ps2 += (f32x2v){p1[2 * (k)], p1[2 * (k) + 1]}; \
    asm volatile("" : "+v"(p1), "+v"(ps2)); } while (0)
  MLA2_RD(0, a0, a1, aq); MLA2_RD(1, c0, c1, cq);
  MLA2_W2(2, a0, a1); MLA2_MM(0, a0, a1, aq); MLA2_RD(2, a0, a1, aq); MLA2_CE(0); MLA2_SBAR();
  MLA2_W2(2, c0, c1); MLA2_MM(1, c0, c1, cq); MLA2_RD(3, c0, c1, cq); MLA2_CE(1); MLA2_SBAR();
  MLA2_W2(2, a0, a1); MLA2_MM(2, a0, a1, aq); MLA2_RD(4, a0, a1, aq); MLA2_CE(2); MLA2_SBAR();
  MLA2_W2(3, c0, c1); MLA2_MM(3, c0, c1, cq); MLA2_RD(5, c0, c1, cq); MLA2_CE(3); MLA2_SBAR();
  MLA2_W3(3, a0, a1, aq); MLA2_MM(4, a0, a1, aq); MLA2_RD(6, a0, a1, aq); MLA2_CE(4); MLA2_SBAR();
  MLA2_W3(3, c0, c1, cq); MLA2_MM(5, c0, c1, cq); MLA2_RD(7, c0, c1, cq); MLA2_CE(5); MLA2_SBAR();
  MLA2_W3(3, a0, a1, aq); MLA2_MM(6, a0, a1, aq); MLA2_RD(8, a0, a1, aq); MLA2_CE(6); MLA2_SBAR();
  MLA2_W3(3, c0, c1, cq); MLA2_MM(7, c0, c1, cq); MLA2_RD(9, c0, c1, cq); MLA2_CE(7); MLA2_SBAR();
  MLA2_W3(3, a0, a1, aq); MLA2_MM(8, a0, a1, aq); MLA2_RD(10, a0, a1, aq);
  float ps = ps2[0] + ps2[1];
  { auto rr = __builtin_amdgcn_permlane32_swap(__float_as_uint(ps), __float_as_uint(ps), false, false); ps = __uint_as_float(rr[0]) + __uint_as_float(rr[1]); }
  l_reg = l_reg * alpha + ps; MLA2_PK4B(p0, 0, pa0); asm volatile("" : "+v"(l_reg), "+v"(pa0)); MLA2_SBAR();
  MLA2_W3(3, c0, c1, cq); MLA2_MM(9, c0, c1, cq); MLA2_RD(11, c0, c1, cq); MLA2_PK4B(p0, 8, pa1); asm volatile("" : "+v"(pa1)); MLA2_SBAR();
  MLA2_W3(3, a0, a1, aq); MLA2_MM(10, a0, a1, aq); MLA2_PK4B(p1, 0, pa2); asm volatile("" : "+v"(pa2)); MLA2_SBAR();
  MLA2_W3(0, c0, c1, cq); MLA2_MM(11, c0, c1, cq); MLA2_PK4B(p1, 8, pa3); asm volatile("" : "+v"(pa3)); MLA2_SBAR();
#undef MLA2_RD
#undef MLA2_MM
#undef MLA2_CE
}
template <int B> __device__ __forceinline__ void r2(f32x16 (&o)[4], int vb, bf16x8 pa0, bf16x8 pa1, bf16x8 pa2, bf16x8 pa3,
                                                    f32x16& q0, f32x16& q1, float& m_reg, float& alpha) {
  constexpr float C = SCALE * 1.4426950408889634f;
  s16x4 l0, h0, l1, h1, l2, h2; float mx, mnC;
#define MLA2_PK(L, H) (bf16x8){L[0], L[1], L[2], L[3], H[0], H[1], H[2], H[3]}
#define MLA2_PR(k, L, H) do { L = tr_read<B * SHM_V + v_rd_off((k) & 3, (k) >> 2, 0)>(vb); H = tr_read<B * SHM_V + v_rd_off((k) & 3, (k) >> 2, 1)>(vb); } while (0)
#define MLA2_PM(k, L, H) do { const bf16x8 pa_ = ((k) >> 2) == 0 ? pa0 : ((k) >> 2) == 1 ? pa1 : ((k) >> 2) == 2 ? pa2 : pa3; \
    o[(k) & 3] = __builtin_amdgcn_mfma_f32_32x32x16_bf16(pa_, MLA2_PK(L, H), o[(k) & 3], 0, 0, 0); } while (0)
#define MLA2_MX(Q, b) do { mx = max3f(mx, Q[b], Q[b + 1]); mx = max3f(mx, Q[b + 2], Q[b + 3]); mx = max3f(mx, Q[b + 4], Q[b + 5]); mx = max3f(mx, Q[b + 6], Q[b + 7]); } while (0)
#define MLA2_FM(Q, b) do { _Pragma("unroll") for (int e_ = 0; e_ < 4; e_ += 2) { f32x2v t_ = {Q[(b) + e_], Q[(b) + e_ + 1]}; t_ = t_ * C2 + M2; Q[(b) + e_] = t_[0]; Q[(b) + e_ + 1] = t_[1]; } asm volatile("" : "+v"(Q)); } while (0)
#define MLA2_EX(Q, b) do { _Pragma("unroll") for (int e_ = 0; e_ < 4; ++e_) Q[(b) + e_] = __builtin_amdgcn_exp2f(Q[(b) + e_]); asm volatile("" : "+v"(Q)); } while (0)
  MLA2_PR(0, l0, h0); MLA2_PR(1, l1, h1); MLA2_PR(2, l2, h2);
  mx = q0[0];
  MLA2_W2(4, l0, h0); MLA2_PM(0, l0, h0); MLA2_PR(3, l0, h0); MLA2_MX(q0, 0); MLA2_SBAR();
  MLA2_W2(4, l1, h1); MLA2_PM(1, l1, h1); MLA2_PR(4, l1, h1); MLA2_MX(q0, 8); MLA2_SBAR();
  MLA2_W2(4, l2, h2); MLA2_PM(2, l2, h2); MLA2_PR(5, l2, h2); MLA2_MX(q1, 0); MLA2_SBAR();
  MLA2_W2(4, l0, h0); MLA2_PM(3, l0, h0); MLA2_PR(6, l0, h0); MLA2_MX(q1, 8); MLA2_SBAR();
  MLA2_W2(4, l1, h1); MLA2_PM(4, l1, h1); MLA2_PR(7, l1, h1);
  { auto rr = __builtin_amdgcn_permlane32_swap(__float_as_uint(mx), __float_as_uint(mx), false, false); mx = fmaxf(__uint_as_float(rr[0]), __uint_as_float(rr[1])); }
  { const bool keep = __all(mx - m_reg <= THR / SCALE); const float mn = keep ? m_reg : fmaxf(m_reg, mx); const float al = __builtin_amdgcn_exp2f((m_reg - mn) * C);
    alpha = keep ? 1.f : al; m_reg = mn; mnC = -mn * C; asm volatile("" : "+v"(alpha), "+v"(m_reg), "+v"(mnC)); }
  const f32x2v C2 = {C, C}, M2 = {mnC, mnC};
  MLA2_SBAR();
  MLA2_W2(4, l2, h2); MLA2_PM(5, l2, h2); MLA2_PR(8, l2, h2); MLA2_FM(q0, 0); MLA2_FM(q0, 4); MLA2_SBAR();
  MLA2_W2(4, l0, h0); MLA2_PM(6, l0, h0); MLA2_PR(9, l0, h0); MLA2_FM(q0, 8); MLA2_FM(q0, 12); MLA2_SBAR();
  MLA2_W2(4, l1, h1); MLA2_PM(7, l1, h1); MLA2_PR(10, l1, h1); MLA2_FM(q1, 0); MLA2_FM(q1, 4); MLA2_SBAR();
  MLA2_W2(4, l2, h2); MLA2_PM(8, l2, h2); MLA2_PR(11, l2, h2); MLA2_FM(q1, 8); MLA2_FM(q1, 12); MLA2_SBAR();
  MLA2_W2(4, l0, h0); MLA2_PM(9, l0, h0); MLA2_PR(12, l0, h0); MLA2_EX(q0, 0); MLA2_SBAR();
  MLA2_W2(4, l1, h1); MLA2_PM(10, l1, h1); MLA2_PR(13, l1, h1); MLA2_EX(q0, 4); MLA2_SBAR();
  MLA2_W2(4, l2, h2); MLA2_PM(11, l2, h2); MLA2_PR(14, l2, h2); MLA2_EX(q0, 8); MLA2_SBAR();
  MLA2_W2(4, l0, h0); MLA2_PM(12, l0, h0); MLA2_PR(15, l0, h0); MLA2_EX(q0, 12); MLA2_SBAR();
  MLA2_W2(4, l1, h1); MLA2_PM(13, l1, h1); MLA2_SBAR();
  MLA2_W2(2, l2, h2); MLA2_PM(14, l2, h2); MLA2_SBAR();
  MLA2_W2(0, l0, h0); MLA2_PM(15, l0, h0); MLA2_SBAR();
#undef MLA2_PK
#undef MLA2_PR
#undef MLA2_PM
#undef MLA2_MX
#undef MLA2_FM
#undef MLA2_EX
}
__device__ __forceinline__ float bflo(unsigned u) { return __uint_as_float(u << 16); }
__device__ __forceinline__ float bfhi(unsigned u) { return __uint_as_float(u & 0xffff0000u); }

struct CvJob { const float* w1; const float* w3; const float* w2; unsigned char* d13; unsigned char* d2; float scale; int next, stride; };
constexpr int CV_G13 = 8 * (2048 / 16) * (7168 / 64), CV_G2 = 8 * (7168 / 16) * (2048 / 64), CV_NG = 2 * CV_G13 + CV_G2;
__device__ __forceinline__ void cv_issue(const CvJob& J, int lane, float (&r)[16], unsigned char*& dst) {
  const int g = J.next;
  if (g < 2 * CV_G13) { const int mm = g / CV_G13, rem = g - mm * CV_G13, e = rem / 14336, r2 = rem - e * 14336, nb = r2 >> 7, kb = r2 & 127;
    const float* src = (mm ? J.w3 : J.w1) + (size_t)e * 2048 * 7168 + (size_t)(kb * 16) * 7168 + nb * 64 + lane;
#pragma unroll
    for (int i = 0; i < 16; ++i) r[i] = src[(size_t)i * 7168];
    const int n = nb * 64 + lane; dst = J.d13 + (size_t)e * 14336 * 2048 + (size_t)((n >> 4) * 32 + mm * 16 + (n & 15)) * 2048 + kb * 16;
  } else { const int g2 = g - 2 * CV_G13, e = g2 / 14336, r2 = g2 - e * 14336, nb = r2 / 448, kb = r2 - nb * 448;
    const float* src = J.w2 + (size_t)e * 7168 * 2048 + (size_t)(kb * 16) * 2048 + nb * 64 + lane;
#pragma unroll
    for (int i = 0; i < 16; ++i) r[i] = src[(size_t)i * 2048];
    dst = J.d2 + (size_t)e * 2048 * 7168 + (size_t)(nb * 64 + lane) * 7168 + kb * 16; }
}
__device__ __forceinline__ unsigned cv_pk4(float a, float b, float c, float d, float s) {
  a = __builtin_fminf(__builtin_fmaxf(a * s, -448.f), 448.f); b = __builtin_fminf(__builtin_fmaxf(b * s, -448.f), 448.f); c = __builtin_fminf(__builtin_fmaxf(c * s, -448.f), 448.f); d = __builtin_fminf(__builtin_fmaxf(d * s, -448.f), 448.f);
  int w = 0; w = __builtin_amdgcn_cvt_pk_fp8_f32(a, b, w, false); w = __builtin_amdgcn_cvt_pk_fp8_f32(c, d, w, true); return (unsigned)w; }
__device__ __forceinline__ void cv_finish(const CvJob& J, const float (&r)[16], unsigned char* dst) {
  u32x4 o; o[0] = cv_pk4(r[0], r[1], r[2], r[3], J.scale); o[1] = cv_pk4(r[4], r[5], r[6], r[7], J.scale); o[2] = cv_pk4(r[8], r[9], r[10], r[11], J.scale); o[3] = cv_pk4(r[12], r[13], r[14], r[15], J.scale);
  *reinterpret_cast<u32x4*>(dst) = o;
}
__device__ __forceinline__ void attn_unit(const unsigned short* __restrict__ Qg, const unsigned short* __restrict__ KVg, const unsigned short* __restrict__ KPg,
                                          const float* __restrict__ cosT, const float* __restrict__ sinT, unsigned short* __restrict__ Og, int h, int q0, int seq, char* lds, CvJob& J) {
  const int tid = threadIdx.x, wid = tid >> 6, lane = tid & 63, r32 = lane & 31, hi = lane >> 5;
  char* V_lds = lds + OFF_V; char* KN_lds = lds + OFF_KN;
  float* ws = (float*)(lds + OFF_WS) + wid * 64; float* li_l = ws; float* al_l = ws + 32;
  float m_reg = -1e30f, l_reg = 0; f32x16 o[4] = {}; bf16x8 qr[NQREG];
  char* Qs = lds + OFF_QS + wid * QS_WAVE;
  {
    const int qrow = q0 + wid * QBLK + r32;
    const unsigned short* Qw = Qg + (size_t)qrow * LDQ + h * 192 + hi * 8;
#pragma unroll
    for (int d0 = 0; d0 < 8; ++d0) { const bf16x8 v = *reinterpret_cast<const bf16x8*>(Qw + d0 * 16);
      if (d0 < NQREG) qr[d0 < NQREG ? d0 : 0] = v; else *reinterpret_cast<bf16x8*>(Qs + MLA2_QB(r32, (d0 - NQREG) * 2 + hi)) = v; }
#pragma unroll
    for (int ab = 0; ab < 2; ++ab) {
      const u32x4 x1 = *reinterpret_cast<const u32x4*>(Qw + 128 + ab * 16), x2 = *reinterpret_cast<const u32x4*>(Qw + 128 + 32 + ab * 16);
      const float* cp = cosT + (size_t)qrow * 32 + ab * 16 + hi * 8; const float* sp = sinT + (size_t)qrow * 32 + ab * 16 + hi * 8;
      const f32x4v c0 = *reinterpret_cast<const f32x4v*>(cp), c1 = *reinterpret_cast<const f32x4v*>(cp + 4), s0 = *reinterpret_cast<const f32x4v*>(sp), s1 = *reinterpret_cast<const f32x4v*>(sp + 4);
      u32x4 o1, o2;
#define MLA2_ROT(W, CL, CH, SL, SH) do { const float a0 = bflo(x1[W]), a1 = bfhi(x1[W]), b0 = bflo(x2[W]), b1 = bfhi(x2[W]); \
        o1[W] = cvtpk(a0 * (CL) - b0 * (SL), a1 * (CH) - b1 * (SH)); o2[W] = cvtpk(b0 * (CL) + a0 * (SL), b1 * (CH) + a1 * (SH)); } while (0)
      MLA2_ROT(0, c0[0], c0[1], s0[0], s0[1]); MLA2_ROT(1, c0[2], c0[3], s0[2], s0[3]); MLA2_ROT(2, c1[0], c1[1], s1[0], s1[1]); MLA2_ROT(3, c1[2], c1[3], s1[2], s1[3]);
#undef MLA2_ROT
      *reinterpret_cast<u32x4*>(Qs + MLA2_QB(r32, (8 + ab - NQREG) * 2 + hi)) = o1;
      *reinterpret_cast<u32x4*>(Qs + MLA2_QB(r32, (10 + ab - NQREG) * 2 + hi)) = o2;
    }
  }
  const int lo = r32 * 32 + ((hi ^ ((r32 >> 3) & 1)) << 4);
  const int qbase = (int)(uintptr_t)Qs + lo;
  int kb[4];
#pragma unroll
  for (int j = 0; j < 4; ++j) kb[j] = (int)(uintptr_t)KN_lds + r32 * 128 + (((j * 2 + hi) ^ ((r32 >> 1) & 7)) << 4);
  const int vb0 = (int)(uintptr_t)V_lds + v_rd_base(lane);
  const unsigned short* Kh = KVg + h * 256; const unsigned short* Vh = KVg + h * 256 + 128;
  const int wu = __builtin_amdgcn_readfirstlane(wid);
  unsigned kd_off[3], kd_lds[3]; const unsigned short* kd_base[3]; int kd_stride[3];
#pragma unroll
  for (int i = 0; i < 3; ++i) { const int pi = 3 * wu + i, img = pi >> 3, grp = pi & 7, row = 8 * grp + (lane >> 3), c8 = (lane & 7) ^ ((row >> 1) & 7);
    kd_lds[i] = (unsigned)(uintptr_t)KN_lds + (unsigned)pi * 1024u;
    if (img < 2) { kd_base[i] = Kh + img * 64; kd_stride[i] = LDKV; kd_off[i] = (unsigned)(row * LDKV + c8 * 8) * 2u; }
    else { kd_base[i] = KPg; kd_stride[i] = LDKP; kd_off[i] = (unsigned)(row * LDKP + c8 * 8) * 2u; } }
  const int vkk = wu * 8 + ((lane & 31) >> 2), vk = (vkk & ~0xC) | ((vkk & 4) << 1) | ((vkk & 8) >> 1);
  const unsigned v_off = (unsigned)(vk * LDKV + (lane >> 5) * 32 + (lane & 3) * 8) * 2u;
  const unsigned ldsV = (unsigned)(uintptr_t)V_lds + (unsigned)wu * 2048u;
#define MLA2_DMA_K(b, k0) do { _Pragma("unroll") for (int i_ = 0; i_ < 3; ++i_) pg8::glds16s(kd_base[i_] + (size_t)(k0) * kd_stride[i_], kd_off[i_], kd_lds[i_] + (b) * SHM_K); } while (0)
#define MLA2_DMA_V(b, k0) do { const unsigned short* vb_ = Vh + (size_t)(k0) * LDKV; \
    pg8::glds16s(vb_, v_off, ldsV + (b) * SHM_V); pg8::glds16s(vb_ + 64, v_off, ldsV + (b) * SHM_V + 1024u); } while (0)
#define MLA2_LANDED() do { asm volatile("s_waitcnt vmcnt(0)" ::: "memory"); __syncthreads(); } while (0)
#define MLA2_RESC(a) do { if (__any((a) < 1.f)) { if (hi == 0) al_l[r32] = (a); asm volatile("s_waitcnt lgkmcnt(0)" ::: "memory"); \
    _Pragma("unroll") for (int d = 0; d < 4; ++d) _Pragma("unroll") for (int r = 0; r < 16; ++r) o[d][r] *= al_l[crow(r, hi)]; } } while (0)
  f32x16 pA0, pA1, pB0, pB1; float mnA, alA, alB; bf16x8 pa0, pa1, pa2, pa3; const int NT = seq / KVBLK;
  MLA2_DMA_K(0, 0); MLA2_DMA_V(0, 0); MLA2_DMA_K(1, KVBLK);
  MLA2_LANDED();
  qkt<0>(pA0, pA1, kb, qbase, qr); partialSM(pA0, pA1, m_reg, mnA, alA);
  __syncthreads();
  if (2 < NT) MLA2_DMA_K(0, 2 * KVBLK); MLA2_DMA_V(1, KVBLK);
  for (int j = 1; j + 1 < NT; j += 2) {
    float cvr[16]; unsigned char* cvd = nullptr; const bool cv_on = J.next < CV_NG;
    if (cv_on) cv_issue(J, lane, cvr, cvd);
    MLA2_SBAR(); r1<1>(pB0, pB1, kb, qbase, qr, pA0, pA1, alA, l_reg, pa0, pa1, pa2, pa3);
    r2<0>(o, vb0, pa0, pa1, pa2, pa3, pB0, pB1, m_reg, alB);
    MLA2_RESC(alB); MLA2_LANDED();
    if (j + 2 < NT) MLA2_DMA_K(1, (j + 2) * KVBLK); MLA2_DMA_V(0, (j + 1) * KVBLK);
    MLA2_SBAR(); r1<0>(pA0, pA1, kb, qbase, qr, pB0, pB1, alB, l_reg, pa0, pa1, pa2, pa3);
    r2<1>(o, vb0, pa0, pa1, pa2, pa3, pA0, pA1, m_reg, alA);
    if (cv_on) { cv_finish(J, cvr, cvd); J.next += J.stride; }
    MLA2_RESC(alA); MLA2_LANDED();
    if (j + 3 < NT) MLA2_DMA_K(0, (j + 3) * KVBLK); MLA2_DMA_V(1, (j + 2) * KVBLK);
  }
  MLA2_SBAR(); r1<1>(pB0, pB1, kb, qbase, qr, pA0, pA1, alA, l_reg, pa0, pa1, pa2, pa3);
  r2<0>(o, vb0, pa0, pa1, pa2, pa3, pB0, pB1, m_reg, alB);
  MLA2_RESC(alB); MLA2_LANDED();
  finishSM(pB0, pB1, alB, l_reg, pa0, pa1, pa2, pa3); MLA2_SBAR();
  pv<1>(o, vb0, pa0, pa1, pa2, pa3);
  if (hi == 0) li_l[r32] = l_reg; asm volatile("s_waitcnt lgkmcnt(0)" ::: "memory");
  float rli[16];
#pragma unroll
  for (int r = 0; r < 16; ++r) rli[r] = __builtin_amdgcn_rcpf(li_l[crow(r, hi)]);
  unsigned short* Ow = Og + (size_t)(q0 + wid * QBLK) * LDO + h * 128;
#pragma unroll
  for (int r = 0; r < 16; ++r) { const int orow = crow(r, hi);
#pragma unroll
    for (int d0 = 0; d0 < 4; ++d0) { const float v = o[d0][r] * rli[r]; unsigned u = __float_as_uint(v); u = (u + 0x7fffu + ((u >> 16) & 1u)) >> 16; Ow[(size_t)orow * LDO + d0 * 32 + r32] = (unsigned short)u; } }
  __syncthreads();
#undef MLA2_DMA_K
#undef MLA2_DMA_V
#undef MLA2_LANDED
#undef MLA2_RESC
}
}
constexpr int S = 16384, D = 2048;
constexpr int E_IN = 5120, CONVD = 1024, CONVW = 31, DIL_H = 16;
constexpr int FD = 5632;
constexpr int O_INP = 1280;
constexpr int QL = 512, KVL = 128, KVLP = 256, S5D = 512;
constexpr int NQ = 2304, NKV = 3072;
constexpr int NE = 8, FE = 7168;
constexpr int MAXROWS = 34816, MAXTILES = 136;
constexpr int S5_CL = 128, S5_NCH = S / S5_CL;
constexpr int ADA_KS = 16;
constexpr float MOE_WSCALE = 1024.f, MOE_HSCALE = 16.f, MOE_ASCALE = 8.f;

constexpr size_t MiB = 1u << 20;
constexpr size_t WS_CTL = 0, CTL_ZERO_BYTES = 1 * MiB;
constexpr size_t WS_MODP = 1 * MiB;
constexpr size_t WS_COS = 3 * MiB, WS_SIN = 5 * MiB;
constexpr size_t WS_S5P = 7 * MiB;
constexpr size_t WS_S5E = 384 * MiB;
constexpr size_t WS_ROUTE = 10 * MiB;
constexpr size_t RT_TOKE = 0, RT_TOKG = 128 * 1024, RT_POS = 256 * 1024, RT_ROWIDX = 384 * 1024, RT_TEXP = 528 * 1024, RT_NTILE = 529 * 1024;
constexpr size_t WS_YF = 11 * MiB;
constexpr size_t WS_WB = 44 * MiB;
constexpr size_t WB_EIN = WS_WB, WB_EOUT = WS_WB + 20 * MiB, WB_EF13 = WS_WB + 28 * MiB, WB_EF2 = WS_WB + 72 * MiB, WB_OIN = WS_WB + 94 * MiB,
                 WB_UQ = WS_WB + 99 * MiB, WB_UKV = WS_WB + 102 * MiB, WB_GLU = WS_WB + 104 * MiB, WB_OOUT = WS_WB + 105 * MiB, WB_M13 = WS_WB + 113 * MiB, WB_M2 = WS_WB + 561 * MiB;
constexpr size_t WS_HB = 830 * MiB;
constexpr size_t WS_Y = 894 * MiB;
constexpr size_t WS_R = 1022 * MiB;
constexpr size_t R_Z = WS_R, R_MIX = WS_R + 160 * MiB, R_ACT = WS_R + 224 * MiB, R_PO = WS_R + 400 * MiB, R_PML = WS_R + 496 * MiB;
constexpr size_t R_Z1 = WS_R, R_CQN = WS_R + 40 * MiB, R_CKVN = WS_R + 56 * MiB, R_KPE = WS_R + 64 * MiB, R_Q = WS_R + 66 * MiB, R_KV = WS_R + 138 * MiB,
                 R_MIX2 = WS_R + 234 * MiB, R_YG = WS_R + 298 * MiB;
constexpr size_t R_YT = WS_R + 240 * MiB;
constexpr size_t R_ACTS = WS_R, R_HS8 = WS_R + 240 * MiB, R_YS = WS_R + 476 * MiB;
constexpr size_t WS_END = WS_R + 612 * MiB;
constexpr int CW_BAR = 4096;
constexpr int CW_TBCNT = 16384;

constexpr int LDS_BYTES = 163840;
constexpr int COND_OFF = 133120;
constexpr int MISC_OFF = LDS_BYTES - 512;
constexpr int NWAVES = 8;

#define GAS __attribute__((address_space(1)))
#define LAS __attribute__((address_space(3)))
typedef unsigned short bf16;
typedef unsigned v4u __attribute__((ext_vector_type(4)));
typedef unsigned v2u __attribute__((ext_vector_type(2)));
typedef float f32x4 __attribute__((ext_vector_type(4)));
typedef float f32x2 __attribute__((ext_vector_type(2)));
typedef short bf16x8 __attribute__((ext_vector_type(8)));
#define LDS_WAIT() asm volatile("s_waitcnt lgkmcnt(0)" ::: "memory")
#define VM_WAIT() asm volatile("s_waitcnt vmcnt(0)" ::: "memory")
__device__ __forceinline__ unsigned f2bf(float f) { unsigned u = __builtin_bit_cast(unsigned, f); return (u + 0x7fffu + ((u >> 16) & 1u)) >> 16; }
__device__ __forceinline__ unsigned pk2(float lo, float hi) { return f2bf(lo) | (f2bf(hi) << 16); }
__device__ __forceinline__ float bflo(unsigned u) { return __uint_as_float(u << 16); }
__device__ __forceinline__ float bfhi(unsigned u) { return __uint_as_float(u & 0xffff0000u); }
__device__ __forceinline__ float bf1(unsigned short b) { return __uint_as_float(((unsigned)b) << 16); }
__device__ __forceinline__ float fexp(float x) { return __builtin_amdgcn_exp2f(1.4426950408889634f * x); }
__device__ __forceinline__ float fsilu(float v) { return v * __builtin_amdgcn_rcpf(1.0f + fexp(-v)); }
__device__ __forceinline__ float fsigmoid(float v) { return __builtin_amdgcn_rcpf(1.0f + fexp(-v)); }
__device__ __forceinline__ float wave_sum(float v) {
#pragma unroll
    for (int o = 1; o < 64; o <<= 1) v += __shfl_xor(v, o);
    return v;
}
__device__ __forceinline__ void sincos_rev(double rev, double& s, double& c) {
    rev -= __builtin_floor(rev);
    const double q4 = __builtin_floor(rev * 4.0 + 0.5);
    const double r = rev - q4 * 0.25;
    const double th = r * 6.283185307179586476925;
    const double t2 = th * th;
    double sp = 1.0 / 1307674368000.0; sp = sp * (-t2) + 1.0 / 6227020800.0; sp = sp * (-t2) + 1.0 / 39916800.0; sp = sp * (-t2) + 1.0 / 362880.0; sp = sp * (-t2) + 1.0 / 5040.0; sp = sp * (-t2) + 1.0 / 120.0; sp = sp * (-t2) + 1.0 / 6.0; sp = sp * (-t2) + 1.0;
    const double sn = sp * th;
    double cp = 1.0 / 87178291200.0; cp = cp * (-t2) + 1.0 / 479001600.0; cp = cp * (-t2) + 1.0 / 3628800.0; cp = cp * (-t2) + 1.0 / 40320.0; cp = cp * (-t2) + 1.0 / 720.0; cp = cp * (-t2) + 1.0 / 24.0; cp = cp * (-t2) + 0.5; cp = cp * (-t2) + 1.0;
    const int q = ((int)q4) & 3;
    s = (q == 0) ? sn : (q == 1) ? cp : (q == 2) ? -sn : -cp;
    c = (q == 0) ? cp : (q == 1) ? -sn : (q == 2) ? -cp : sn;
}
__device__ __forceinline__ double exp_small(double x) {
    double p = 1.0 / 3628800.0; p = p * x + 1.0 / 362880.0; p = p * x + 1.0 / 40320.0; p = p * x + 1.0 / 5040.0; p = p * x + 1.0 / 720.0; p = p * x + 1.0 / 120.0; p = p * x + 1.0 / 24.0; p = p * x + 1.0 / 6.0; p = p * x + 0.5; p = p * x + 1.0; p = p * x + 1.0;
    return p;
}

#define XB_TMO      128
#define XB_XCNT(j)  (256  + 64 * (j))
#define XB_XSUB(j)  (1280 + 64 * (j))
#define XB_XGEN(j)  (2304 + 64 * (j))
#define XB_TOP      3328
#define XB_TOPGEN   3392
#define XCD_BAR_WORDS 3456
#define XB_SPIN_CAP (1u << 20)
__device__ __forceinline__ unsigned xb_ld(unsigned* p)              { return __hip_atomic_load(p, __ATOMIC_RELAXED, __HIP_MEMORY_SCOPE_AGENT); }
__device__ __forceinline__ unsigned xb_add(unsigned* p, unsigned v) { return __hip_atomic_fetch_add(p, v, __ATOMIC_RELAXED, __HIP_MEMORY_SCOPE_AGENT); }
__device__ __forceinline__ unsigned xb_xcc_id() { return (unsigned)__builtin_amdgcn_s_getreg((3 << 11) | 20) & 0xFu; }
#define XB_SPIN(cond, bar) do { unsigned _sp = 0; while (cond) { __builtin_amdgcn_s_sleep(1); \
    if ((++_sp & 255u) == 0u) { if (xb_ld(&(bar)[XB_TMO])) break; if (_sp > XB_SPIN_CAP) { atomicAdd(&(bar)[XB_TMO], 1u); break; } } } } while (0)
struct XcdBarrier { unsigned* bar; unsigned x; volatile LAS unsigned* st; };
__device__ __forceinline__ XcdBarrier xcd_barrier_post(unsigned* bar, volatile LAS unsigned* st) {
    XcdBarrier b; b.bar = bar; b.x = xb_xcc_id(); b.st = st;
    if (threadIdx.x == 0) (void)xb_add(&bar[XB_XCNT(b.x)], 1u);
    return b;
}
__device__ __forceinline__ void xcd_barrier_complete(unsigned* bar, unsigned x, unsigned& nloc, unsigned& nx) {
    const unsigned G = gridDim.x * gridDim.y * gridDim.z;
    unsigned sum, cnt, mine, sp = 0u;
    for (;;) {
        sum = 0u; cnt = 0u; mine = 0u;
#pragma unroll
        for (unsigned j = 0; j < 16; ++j) { const unsigned c = xb_ld(&bar[XB_XCNT(j)]); sum += c; cnt += (c > 0u) ? 1u : 0u; mine = (j == x) ? c : mine; }
        if (sum == G) break;
        __builtin_amdgcn_s_sleep(1);
        if ((++sp & 255u) == 0u) { if (xb_ld(&bar[XB_TMO])) break; if (sp > XB_SPIN_CAP) { atomicAdd(&bar[XB_TMO], 1u); break; } }
    }
    nloc = mine > 0u ? mine : 1u; nx = cnt > 0u ? cnt : 1u;
}
__device__ __forceinline__ void xcd_barrier(const XcdBarrier& b) {
    asm volatile("s_waitcnt vmcnt(0)" ::: "memory");
    __syncthreads();
    if (threadIdx.x == 0) {
        unsigned* bar = b.bar;
        __builtin_amdgcn_s_waitcnt(0);
        unsigned nloc = b.st[0], nx = b.st[1];
        if (nloc == 0u) { xcd_barrier_complete(bar, b.x, nloc, nx); b.st[0] = nloc; b.st[1] = nx; }
        const unsigned old = xb_add(&bar[XB_XSUB(b.x)], 1u);
        const unsigned gen = old / nloc;
        if (old + 1u == (gen + 1u) * nloc) {
            __builtin_amdgcn_fence(__ATOMIC_RELEASE, "agent");
            asm volatile("s_waitcnt vmcnt(0)" ::: "memory");
            const unsigned og = xb_add(&bar[XB_TOP], 1u);
            const unsigned tg = og / nx;
            if (og + 1u == (tg + 1u) * nx) xb_add(&bar[XB_TOPGEN], 1u);
            else XB_SPIN(xb_ld(&bar[XB_TOPGEN]) == tg, bar);
            __builtin_amdgcn_fence(__ATOMIC_ACQUIRE, "agent");
            xb_add(&bar[XB_XGEN(b.x)], 1u);
            asm volatile("s_waitcnt vmcnt(0)" ::: "memory");
        } else {
            XB_SPIN(xb_ld(&bar[XB_XGEN(b.x)]) == gen, bar);
            __builtin_amdgcn_fence(__ATOMIC_ACQUIRE, "agent");
            asm volatile("s_waitcnt vmcnt(0)" ::: "memory");
        }
    }
    __syncthreads();
}

struct Args { const float* in[34]; float* out; unsigned char* ws; int ph_lo, ph_hi; };
enum { I_X = 0, I_C, I_T5, I_NG, I_ADAW, I_ADAB, I_EWIN, I_ECW, I_ECB, I_ECG, I_ECLB, I_EWOUT, I_EF1, I_EF3, I_EF2, I_OWIN, I_QNG, I_UQ, I_KVNG, I_UKV,
       I_SARE, I_SAIM, I_SLDT, I_SBRE, I_SBIM, I_SCRE, I_SCIM, I_SD, I_SGLU, I_OWOUT, I_RW, I_M1, I_M3, I_M2 };
struct Frame {
    LAS unsigned char* lds;
    const Args* a;
    unsigned char* ws;
    int tid, lane, wave, vcu, G, gw, NGW;
};

__device__ __forceinline__ void cvt_tile(const float* __restrict__ W, int K, int N, bf16* __restrict__ Wt, int ldk, int grp, int mul, int off, int item, LAS float* scr, int lane) {
    const int nblk = N >> 6, kb = item / nblk, nb = item - kb * nblk, k0 = kb << 6, n0 = nb << 6;
    const int lc = (lane & 15) * 4, lr = lane >> 4;
    f32x4 v[16];
#pragma unroll
    for (int i = 0; i < 16; ++i) v[i] = *(const f32x4*)(W + (size_t)(k0 + lr + 4 * i) * N + n0 + lc);
#pragma unroll
    for (int i = 0; i < 16; ++i) { LAS float* d = scr + (lr + 4 * i) * 65 + lc; d[0] = v[i][0]; d[1] = v[i][1]; d[2] = v[i][2]; d[3] = v[i][3]; }
    LDS_WAIT();
    const int c = lane & 7;
#pragma unroll
    for (int j = 0; j < 8; ++j) { const int n = (lane >> 3) + 8 * j; const LAS float* s = scr + (8 * c) * 65 + n;
        v4u o; o.x = pk2(s[0 * 65], s[1 * 65]); o.y = pk2(s[2 * 65], s[3 * 65]); o.z = pk2(s[4 * 65], s[5 * 65]); o.w = pk2(s[6 * 65], s[7 * 65]);
        const int nn = n0 + n, drow = (nn / grp) * (grp * mul) + off + (nn % grp);
        *(v4u*)(Wt + (size_t)drow * ldk + k0 + 8 * c) = o; }
    LDS_WAIT();
}

__device__ __forceinline__ unsigned pk4_fp8(float a, float b, float c, float d) {
    a = __builtin_fminf(__builtin_fmaxf(a, -448.f), 448.f); b = __builtin_fminf(__builtin_fmaxf(b, -448.f), 448.f); c = __builtin_fminf(__builtin_fmaxf(c, -448.f), 448.f); d = __builtin_fminf(__builtin_fmaxf(d, -448.f), 448.f);
    int w = 0; w = __builtin_amdgcn_cvt_pk_fp8_f32(a, b, w, false); w = __builtin_amdgcn_cvt_pk_fp8_f32(c, d, w, true); return (unsigned)w; }
__device__ __forceinline__ void cvt_tile8(const float* __restrict__ W, int K, int N, unsigned char* __restrict__ Wt, int ldk, int grp, int mul, int off, float scale, int item, LAS float* scr, int lane) {
    const int nblk = N >> 6, kb = item / nblk, nb = item - kb * nblk, k0 = kb << 6, n0 = nb << 6;
    const int lc = (lane & 15) * 4, lr = lane >> 4;
    f32x4 v[16];
#pragma unroll
    for (int i = 0; i < 16; ++i) v[i] = *(const f32x4*)(W + (size_t)(k0 + lr + 4 * i) * N + n0 + lc);
#pragma unroll
    for (int i = 0; i < 16; ++i) { LAS float* d = scr + (lr + 4 * i) * 65 + lc; d[0] = v[i][0] * scale; d[1] = v[i][1] * scale; d[2] = v[i][2] * scale; d[3] = v[i][3] * scale; }
    LDS_WAIT();
    const int c = lane & 3;
#pragma unroll
    for (int j = 0; j < 4; ++j) { const int n = (lane >> 2) + 16 * j; const LAS float* s = scr + (16 * c) * 65 + n;
        v4u o; o.x = pk4_fp8(s[0 * 65], s[1 * 65], s[2 * 65], s[3 * 65]); o.y = pk4_fp8(s[4 * 65], s[5 * 65], s[6 * 65], s[7 * 65]);
        o.z = pk4_fp8(s[8 * 65], s[9 * 65], s[10 * 65], s[11 * 65]); o.w = pk4_fp8(s[12 * 65], s[13 * 65], s[14 * 65], s[15 * 65]);
        const int nn = n0 + n, drow = (nn / grp) * (grp * mul) + off + (nn % grp);
        *(v4u*)(Wt + (size_t)drow * ldk + k0 + 16 * c) = o; }
    LDS_WAIT();
}

__device__ __forceinline__ void p0_prologue(Frame& F) {
    const Args& A = *F.a;
    LAS float* condL = (LAS float*)(F.lds + COND_OFF);
    for (int i = F.tid; i < D; i += NWAVES * 64) condL[i] = fsilu(A.in[I_C][i]);
    __syncthreads();
    LAS float* scr = (LAS float*)(F.lds + F.wave * 16640);
    const int lane = F.lane;
    constexpr int N_ADA = 96 * ADA_KS, N_ROPE = S * 32 / 64, N_S5 = 64, N_Z1 = 256, N_Z2 = 768;
#define CVT_M(SRC, KK, NN, DSTOFF, LDK, GRP, MUL, OFF, NEXP) { constexpr int per = ((KK) / 64) * ((NN) / 64); constexpr int tot = per * (NEXP); \
        if (r < tot) { const int e = r / per, t = r - e * per; cvt_tile(A.in[SRC] + (size_t)e * (KK) * (NN), KK, NN, (bf16*)(F.ws + (DSTOFF)) + (size_t)e * ((NN) * (MUL)) * (LDK), LDK, GRP, MUL, OFF, t, scr, lane); continue; } r -= tot; }
#define CVT_M8(SRC, KK, NN, DSTOFF, LDK, GRP, MUL, OFF, NEXP) { constexpr int per = ((KK) / 64) * ((NN) / 64); constexpr int tot = per * (NEXP); \
        if (r < tot) { const int e = r / per, t = r - e * per; cvt_tile8(A.in[SRC] + (size_t)e * (KK) * (NN), KK, NN, (unsigned char*)(F.ws + (DSTOFF)) + (size_t)e * ((NN) * (MUL)) * (LDK), LDK, GRP, MUL, OFF, MOE_WSCALE, t, scr, lane); continue; } r -= tot; }
    constexpr int N_CVT = (32 * 80) + (32 * 32) + 2 * (32 * 88) + (88 * 32) + (32 * 19) + (8 * 36) + (2 * 48) + (8 * 8) + (32 * 32);
    constexpr int N_ITEMS = N_CVT + N_ADA + N_ROPE + N_S5 + N_Z1 + N_Z2;
    for (int it = F.gw; it < N_ITEMS; it += F.NGW) {
        int r = it;
        CVT_M(I_EWIN, 2048, 5120, WB_EIN, 2048, 64, 1, 0, 1)
        CVT_M(I_EWOUT, 2048, 2048, WB_EOUT, 2048, 64, 1, 0, 1)
        CVT_M(I_EF1, 2048, 5632, WB_EF13, 2048, 16, 2, 0, 1)
        CVT_M(I_EF3, 2048, 5632, WB_EF13, 2048, 16, 2, 16, 1)
        CVT_M(I_EF2, 5632, 2048, WB_EF2, 5632, 64, 1, 0, 1)
        CVT_M(I_OWIN, 2048, 1216, WB_OIN, 2048, 64, 1, 0, 1)
        CVT_M(I_UQ, 512, 2304, WB_UQ, 512, 64, 1, 0, 1)
        CVT_M(I_UKV, 128, 3072, WB_UKV, 256, 64, 1, 0, 1)
        CVT_M(I_SGLU, 512, 512, WB_GLU, 512, 64, 1, 0, 1)
        CVT_M(I_OWOUT, 2048, 2048, WB_OOUT, 2048, 64, 1, 0, 1)
        if (r < N_ADA) {
            const int chunk = r % 96, ks = r / 96, l = chunk / 48, n0 = (chunk % 48) * 256;
            const float* w = A.in[I_ADAW] + (size_t)l * D * 12288 + (size_t)(ks * 128) * 12288 + n0 + 4 * lane;
            f32x4 acc = {0.f, 0.f, 0.f, 0.f};
#pragma unroll 8
            for (int k = 0; k < 128; ++k) { const f32x4 v = *(const f32x4*)(w + (size_t)k * 12288); const float cv = condL[ks * 128 + k]; acc += v * cv; }
            *(f32x4*)((float*)(F.ws + WS_MODP) + (size_t)ks * 24576 + l * 12288 + n0 + 4 * lane) = acc;
            continue; }
        r -= N_ADA;
        if (r < N_ROPE) {
            const int idx = r * 64 + lane, pos = idx >> 5, j = idx & 31;
            double f = 1.0; for (int q = 0; q < j; ++q) f *= 0.74989420933245582730;
            const float ang = (float)pos * (float)f;
            double sn, cs; sincos_rev((double)ang * 0.15915494309189533577, sn, cs);
            ((float*)(F.ws + WS_COS))[idx] = (float)cs; ((float*)(F.ws + WS_SIN))[idx] = (float)sn;
            continue; }
        r -= N_ROPE;
        if (r < N_S5) {
            const int p = lane;
            const double are = (double)A.in[I_SARE][r * 64 + p], aim = (double)A.in[I_SAIM][r * 64 + p];
            const double dt = (double)fexp(A.in[I_SLDT][r]);
            const double er = exp_small(are * dt); double sn, cs; sincos_rev(aim * dt * 0.15915494309189533577, sn, cs);
            const double abr = er * cs, abi = er * sn;
            double eL = er; for (int q = 1; q < S5_CL; q <<= 1) eL *= eL;
            double snL, csL; sincos_rev(aim * dt * (double)S5_CL * 0.15915494309189533577, snL, csL);
            const double nr = abr - 1.0, ni = abi, den = are * are + aim * aim;
            const double qr = (nr * are + ni * aim) / den, qi = (ni * are - nr * aim) / den;
            float* o = (float*)(F.ws + WS_S5P) + (size_t)r * 36 * 64;
            o[0 * 64 + p] = (float)abr; o[1 * 64 + p] = (float)abi; o[2 * 64 + p] = (float)(eL * csL); o[3 * 64 + p] = (float)(eL * snL);
#pragma unroll
            for (int c = 0; c < 16; ++c) { const double br = (double)A.in[I_SBRE][(size_t)(r * 64 + p) * 16 + c], bi = (double)A.in[I_SBIM][(size_t)(r * 64 + p) * 16 + c];
                o[(4 + c) * 64 + p] = (float)(qr * br - qi * bi); o[(20 + c) * 64 + p] = (float)(qr * bi + qi * br); }
            continue; }
        r -= N_S5;
        if (r < N_Z1) { ((v4u*)(F.ws + WB_OIN + (size_t)1216 * 2048 * 2))[r * 64 + lane] = (v4u){0u, 0u, 0u, 0u}; continue; }
        r -= N_Z1;
        { const int ch = r * 64 + lane, row = ch >> 4, cc = ch & 15; *(v4u*)(F.ws + WB_UKV + (size_t)row * 512 + 256 + cc * 16) = (v4u){0u, 0u, 0u, 0u}; }
    }
#undef CVT_M
#undef CVT_M8
}

__device__ __forceinline__ float mod_val(Frame& F, int L, int chunk, int col) {
    const Args& A = *F.a; const int o = L * 12288 + chunk * 2048 + col;
    float s = A.in[I_ADAB][o]; const float* mp = (const float*)(F.ws + WS_MODP) + o;
#pragma unroll
    for (int ks = 0; ks < ADA_KS; ++ks) s += mp[(size_t)ks * 24576];
    return s;
}
__device__ __forceinline__ void moe_tail_plan(int nt, int& nfull, int& s) {
    nfull = nt & ~31; const int tl = nt - nfull;
    s = (tl == 0 || tl > 16) ? 1 : (tl <= 4 ? 7 : (tl <= 8 ? 4 : 2));
    if (s == 1) nfull = nt;
}
template <bool RES, bool HOUT, bool ROUTE, bool GATHER>
__device__ __forceinline__ void resnorm_phase(Frame& F, const float* xin, float* xout, const bf16* y, int Lr, int gchunk, int gi1, int Lh, int shchunk, int gi2) {
    const Args& A = *F.a;
    LAS float* A1 = (LAS float*)F.lds; LAS float* A2 = A1 + D; LAS float* B2 = A2 + D; LAS float* RT = B2 + D;
    for (int col = F.tid; col < D; col += NWAVES * 64) {
        if (RES) A1[col] = mod_val(F, Lr, gchunk, col) * A.in[I_NG][(Lr * 4 + gi1) * D + col];
        if (HOUT) { A2[col] = A.in[I_NG][(Lh * 4 + gi2) * D + col] * (1.0f + mod_val(F, Lh, shchunk + 1, col)); B2[col] = mod_val(F, Lh, shchunk, col); }
    }
    if (ROUTE) for (int i = F.tid; i < D * NE; i += NWAVES * 64) RT[(i & 7) * D + (i >> 3)] = A.in[I_RW][i];
    __syncthreads();
    const int lane = F.lane;
    bf16* hb = (bf16*)(F.ws + WS_HB);
    for (int row = F.gw; row < S; row += F.NGW) {
        f32x4 xv[8];
#pragma unroll
        for (int j = 0; j < 8; ++j) xv[j] = *(const f32x4*)(xin + (size_t)row * D + 4 * lane + 256 * j);
        if (RES) {
            f32x4 yv[8];
            if (GATHER) {
                const int* pos = (const int*)(F.ws + WS_ROUTE + RT_POS); const float* tg = (const float*)(F.ws + WS_ROUTE + RT_TOKG);
                const bf16* ys = (const bf16*)(F.ws + R_YS); const float* yt = (const float*)(F.ws + R_YT);
                int nfull, sp; const int ntl = __builtin_amdgcn_readfirstlane(*(const int*)(F.ws + WS_ROUTE + RT_NTILE)); moe_tail_plan(ntl, nfull, sp);
                const int ts = nfull * 256; const size_t sstr = (size_t)(ntl - nfull) * 256 * D;
                const int p0 = __builtin_amdgcn_readfirstlane(pos[2 * row]), p1 = __builtin_amdgcn_readfirstlane(pos[2 * row + 1]);
                if (p0 < ts && p1 < ts) {
                    const float g0 = tg[2 * row], g1 = tg[2 * row + 1];
#pragma unroll
                    for (int j = 0; j < 8; ++j) { const v2u a = *(const v2u*)(ys + (size_t)p0 * D + 4 * lane + 256 * j), b = *(const v2u*)(ys + (size_t)p1 * D + 4 * lane + 256 * j);
                        yv[j] = (f32x4){g0 * bflo(a.x) + g1 * bflo(b.x), g0 * bfhi(a.x) + g1 * bfhi(b.x), g0 * bflo(a.y) + g1 * bflo(b.y), g0 * bfhi(a.y) + g1 * bfhi(b.y)}; }
                } else {
#pragma unroll
                for (int j = 0; j < 8; ++j) yv[j] = (f32x4){0.f, 0.f, 0.f, 0.f};
#pragma unroll
                for (int hf = 0; hf < 2; ++hf) { const int p = hf ? p1 : p0; const float g = tg[2 * row + hf];
                    if (p >= ts) {
                        const float* bp = yt + (size_t)(p - ts) * D + 4 * lane;
                        f32x4 t[8];
#pragma unroll
                        for (int j = 0; j < 8; ++j) t[j] = *(const f32x4*)(bp + 256 * j);
#pragma nounroll
                        for (int ks = 1; ks < sp; ++ks) {
#pragma unroll
                            for (int j = 0; j < 8; ++j) t[j] += *(const f32x4*)(bp + (size_t)ks * sstr + 256 * j); }
#pragma unroll
                        for (int j = 0; j < 8; ++j) yv[j] += t[j] * g;
                    } else {
#pragma unroll
                        for (int j = 0; j < 8; ++j) { const v2u a = *(const v2u*)(ys + (size_t)p * D + 4 * lane + 256 * j);
                            yv[j] += (f32x4){g * bflo(a.x), g * bfhi(a.x), g * bflo(a.y), g * bfhi(a.y)}; }
                    } }
                }
            } else {
#pragma unroll
                for (int j = 0; j < 8; ++j) { const v2u a = *(const v2u*)(y + (size_t)row * D + 4 * lane + 256 * j); yv[j] = (f32x4){bflo(a.x), bfhi(a.x), bflo(a.y), bfhi(a.y)}; }
            }
            float ss = 0.f;
#pragma unroll
            for (int j = 0; j < 8; ++j) ss += (yv[j][0] * yv[j][0] + yv[j][1] * yv[j][1]) + (yv[j][2] * yv[j][2] + yv[j][3] * yv[j][3]);
            const float rstd = 1.0f / sqrtf(wave_sum(ss) * (1.0f / D) + 1e-6f);
#pragma unroll
            for (int j = 0; j < 8; ++j) { const f32x4 a1 = *(const LAS f32x4*)(A1 + 4 * lane + 256 * j); xv[j] += a1 * (yv[j] * rstd);
                *(f32x4*)(xout + (size_t)row * D + 4 * lane + 256 * j) = xv[j]; }
        }
        if (HOUT) {
            float ss = 0.f;
#pragma unroll
            for (int j = 0; j < 8; ++j) ss += (xv[j][0] * xv[j][0] + xv[j][1] * xv[j][1]) + (xv[j][2] * xv[j][2] + xv[j][3] * xv[j][3]);
            const float rstd = 1.0f / sqrtf(wave_sum(ss) * (1.0f / D) + 1e-6f);
#pragma unroll
            for (int j = 0; j < 8; ++j) { const f32x4 a2 = *(const LAS f32x4*)(A2 + 4 * lane + 256 * j), b2 = *(const LAS f32x4*)(B2 + 4 * lane + 256 * j);
                xv[j] = (xv[j] * rstd) * a2 + b2;
                if (ROUTE) { *(unsigned*)((unsigned char*)hb + (size_t)row * D + 4 * lane + 256 * j) = pk4_fp8(xv[j][0] * MOE_HSCALE, xv[j][1] * MOE_HSCALE, xv[j][2] * MOE_HSCALE, xv[j][3] * MOE_HSCALE); }
                else { v2u w; w.x = pk2(xv[j][0], xv[j][1]); w.y = pk2(xv[j][2], xv[j][3]);
                *(v2u*)(hb + (size_t)row * D + 4 * lane + 256 * j) = w; } }
            if (ROUTE) {
                int i0 = -1, i1 = -1; float v0 = -3.0e38f, v1 = -3.0e38f;
#pragma nounroll
                for (int e = 0; e < NE; ++e) { float s = 0.f;
#pragma unroll
                    for (int j = 0; j < 8; ++j) { const f32x4 w = *(const LAS f32x4*)(RT + e * D + 4 * lane + 256 * j); s += (xv[j][0] * w[0] + xv[j][1] * w[1]) + (xv[j][2] * w[2] + xv[j][3] * w[3]); }
                    s = wave_sum(s);
                    if (s > v0) { v1 = v0; i1 = i0; v0 = s; i0 = e; } else if (s > v1) { v1 = s; i1 = e; } }
                const float g0 = 1.0f / (1.0f + fexp(v1 - v0)), g1 = 1.0f - g0;
                if (lane == 0) {
                    int* te = (int*)(F.ws + WS_ROUTE + RT_TOKE); float* tg = (float*)(F.ws + WS_ROUTE + RT_TOKG);
                    te[2 * row] = i0; te[2 * row + 1] = i1; tg[2 * row] = g0; tg[2 * row + 1] = g1;
                    unsigned* cnt = (unsigned*)(F.ws + WS_CTL) + CW_TBCNT + (row >> 6) * NE;
                    atomicAdd(cnt + i0, 1u); atomicAdd(cnt + i1, 1u);
                }
            }
        }
    }
}

__device__ __forceinline__ void moe_slots_phase(Frame& F) {
    LAS int* cntL = (LAS int*)F.lds;
    LAS int* tot = cntL + 2048;
    LAS int* base = tot + 8; LAS int* tbase = base + 8; LAS int* texpL = tbase + 16;
    const unsigned* cnt = (const unsigned*)(F.ws + WS_CTL) + CW_TBCNT;
    for (int i = F.tid; i < 2048; i += NWAVES * 64) cntL[i] = (int)cnt[i];
    __syncthreads();
    if (F.tid < NE) { int s = 0; for (int b = 0; b < 256; ++b) s += cntL[b * 8 + F.tid]; tot[F.tid] = s; }
    __syncthreads();
    if (F.tid == 0) { int b = 0, tb = 0; for (int e = 0; e < NE; ++e) { base[e] = b; tbase[e] = tb; const int nt = (tot[e] + 255) >> 8; for (int q = 0; q < nt; ++q) texpL[tb + q] = e; tb += nt; b += nt * 256; } tbase[NE] = tb; }
    __syncthreads();
    const int NT = tbase[NE];
    int* rowidx = (int*)(F.ws + WS_ROUTE + RT_ROWIDX); int* pos = (int*)(F.ws + WS_ROUTE + RT_POS);
    const int* te = (const int*)(F.ws + WS_ROUTE + RT_TOKE);
    if (blockIdx.x == 0) { int* texp = (int*)(F.ws + WS_ROUTE + RT_TEXP); for (int i = F.tid; i < NT; i += NWAVES * 64) texp[i] = texpL[i]; if (F.tid == 0) *(int*)(F.ws + WS_ROUTE + RT_NTILE) = NT; }
    LAS int* slotL = texpL + 160;
    const unsigned char* hb8 = (const unsigned char*)(F.ws + WS_HB); unsigned char* hs8 = (unsigned char*)(F.ws + R_HS8);
    for (int tb = blockIdx.x; tb < 256; tb += F.G) {
        if (F.wave == 0) {
            const int tok = tb * 64 + F.lane;
            const int e0 = te[2 * tok], e1 = te[2 * tok + 1];
            const unsigned long long lt = (F.lane == 0) ? 0ull : (~0ull >> (64 - F.lane));
#pragma unroll
            for (int e = 0; e < NE; ++e) {
                int pre = 0; for (int b = 0; b < tb; ++b) pre += cntL[b * 8 + e];
                const unsigned long long m0 = __ballot(e0 == e), m1 = __ballot(e1 == e);
                const int st = base[e] + pre;
                if (e0 == e) { const int s = st + __popcll(m0 & lt); rowidx[s] = tok; pos[2 * tok] = s; slotL[2 * F.lane] = s; }
                if (e1 == e) { const int s = st + __popcll(m0) + __popcll(m1 & lt); rowidx[s] = tok; pos[2 * tok + 1] = s; slotL[2 * F.lane + 1] = s; }
            }
        }
        __syncthreads();
        for (int idx = F.tid; idx < 128 * 128; idx += NWAVES * 64) { const int si = idx >> 7, ch = idx & 127;
            const v4u v = *(const v4u*)(hb8 + (size_t)(tb * 64 + (si >> 1)) * D + ch * 16);
            *(v4u*)(hs8 + (size_t)slotL[si] * D + ch * 16) = v; }
        __syncthreads();
    }
}
__device__ __forceinline__ void conv_phase(Frame& F) {
    const Args& A = *F.a;
    const bf16* z = (const bf16*)(F.ws + R_Z); bf16* mix = (bf16*)(F.ws + R_MIX);
    LAS unsigned char* gl = F.lds;
    LAS float* part = (LAS float*)(F.lds + 126976);
    LAS float* stat = part + 512;
    const int tid = F.tid, ch = 2 * tid;
    float w0[CONVW], w1[CONVW];
#pragma unroll
    for (int w = 0; w < CONVW; ++w) { const f32x2 v = *(const f32x2*)(A.in[I_ECW] + w * CONVD + ch); w0[w] = v[0]; w1[w] = v[1]; }
    const f32x2 cb = *(const f32x2*)(A.in[I_ECB] + ch), lg = *(const f32x2*)(A.in[I_ECG] + ch), lb = *(const f32x2*)(A.in[I_ECLB] + ch);
    for (int tile = blockIdx.x; tile < S / 32; tile += F.G) {
        const int t0 = tile * 32;
        for (int idx = tid; idx < 62 * 128; idx += NWAVES * 64) {
            const int row = idx >> 7, c8 = (idx & 127) * 8, t = t0 - 15 + row;
            v4u o = {0u, 0u, 0u, 0u};
            if (t >= 0 && t < S) {
                const v4u a = *(const v4u*)(z + (size_t)t * E_IN + c8), g = *(const v4u*)(z + (size_t)t * E_IN + CONVD + c8);
#pragma unroll
                for (int q = 0; q < 4; ++q) o[q] = pk2(bflo(a[q]) * fsigmoid(bflo(g[q])), bfhi(a[q]) * fsigmoid(bfhi(g[q])));
            }
            *(LAS v4u*)(gl + row * 2048 + c8 * 2) = o;
        }
        __syncthreads();
#pragma nounroll
        for (int half = 0; half < 2; ++half) {
            float a0[16], a1[16];
#pragma unroll
            for (int i = 0; i < 16; ++i) { a0[i] = cb[0]; a1[i] = cb[1]; }
            const LAS unsigned char* gh = gl + half * 16 * 2048 + tid * 4;
#pragma unroll
            for (int r = 0; r < 46; ++r) {
                const unsigned v = *(const LAS unsigned*)(gh + r * 2048);
                const float v0 = bflo(v), v1 = bfhi(v);
#pragma unroll
                for (int i = 0; i < 16; ++i) { if (r - i >= 0 && r - i < CONVW) { a0[i] += v0 * w0[r - i]; a1[i] += v1 * w1[r - i]; } }
            }
#pragma unroll
            for (int i = 0; i < 16; ++i) {
                float s1 = a0[i] + a1[i], s2 = a0[i] * a0[i] + a1[i] * a1[i];
                s1 = wave_sum(s1); s2 = wave_sum(s2);
                if (F.lane == 0) { part[(F.wave * 16 + i) * 2] = s1; part[(F.wave * 16 + i) * 2 + 1] = s2; }
            }
            __syncthreads();
            if (tid < 16) { float s1 = 0.f, s2 = 0.f;
#pragma unroll
                for (int w = 0; w < NWAVES; ++w) { s1 += part[(w * 16 + tid) * 2]; s2 += part[(w * 16 + tid) * 2 + 1]; }
                const float mean = s1 * (1.0f / CONVD), var = fmaxf(s2 * (1.0f / CONVD) - mean * mean, 0.f);
                stat[tid * 2] = mean; stat[tid * 2 + 1] = 1.0f / sqrtf(var + 1e-5f); }
            __syncthreads();
#pragma unroll
            for (int i = 0; i < 16; ++i) {
                const float mean = stat[i * 2], rstd = stat[i * 2 + 1];
                const float y0 = (a0[i] - mean) * rstd * lg[0] + lb[0], y1 = (a1[i] - mean) * rstd * lg[1] + lb[1];
                *(unsigned*)(mix + (size_t)(t0 + half * 16 + i) * D + ch) = pk2(fsilu(y0), fsilu(y1));
            }
            __syncthreads();
        }
    }
}

__device__ __forceinline__ int t5_bucket_dev(int rel) {
    const int n = rel < 0 ? -rel : rel;
    int large = 8 + (int)(__logf((float)(n < 1 ? 1 : n) * 0.125f) / 4.852030263919617f * 8.0f);
    large = large < 15 ? large : 15;
    return (rel > 0 ? 16 : 0) + (n < 8 ? n : large);
}
__device__ __forceinline__ void latent_phase(Frame& F) {
    const Args& A = *F.a; const int lane = F.lane;
    const bf16* z1 = (const bf16*)(F.ws + R_Z1); bf16* cqn = (bf16*)(F.ws + R_CQN); bf16* ckvn = (bf16*)(F.ws + R_CKVN); bf16* kpe = (bf16*)(F.ws + R_KPE);
    const float* cosT = (const float*)(F.ws + WS_COS); const float* sinT = (const float*)(F.ws + WS_SIN);
    float qg[8]; { const f32x4 a = *(const f32x4*)(A.in[I_QNG] + 8 * lane), b = *(const f32x4*)(A.in[I_QNG] + 8 * lane + 4); qg[0] = a[0]; qg[1] = a[1]; qg[2] = a[2]; qg[3] = a[3]; qg[4] = b[0]; qg[5] = b[1]; qg[6] = b[2]; qg[7] = b[3]; }
    const f32x2 kg = *(const f32x2*)(A.in[I_KVNG] + 2 * lane);
    for (int row = F.gw; row < S; row += F.NGW) {
        const bf16* zr = z1 + (size_t)row * O_INP;
        const v4u q = *(const v4u*)(zr + 8 * lane);
        float v[8]; float ss = 0.f;
#pragma unroll
        for (int e = 0; e < 4; ++e) { v[2 * e] = bflo(q[e]); v[2 * e + 1] = bfhi(q[e]); ss += v[2 * e] * v[2 * e] + v[2 * e + 1] * v[2 * e + 1]; }
        const float r1 = 1.0f / sqrtf(wave_sum(ss) * (1.0f / QL) + 1e-6f);
        v4u o;
#pragma unroll
        for (int e = 0; e < 4; ++e) o[e] = pk2(v[2 * e] * r1 * qg[2 * e], v[2 * e + 1] * r1 * qg[2 * e + 1]);
        *(v4u*)(cqn + (size_t)row * QL + 8 * lane) = o;
        const unsigned kv = *(const unsigned*)(zr + 512 + 2 * lane);
        const float k0 = bflo(kv), k1 = bfhi(kv);
        const float r2 = 1.0f / sqrtf(wave_sum(k0 * k0 + k1 * k1) * (1.0f / KVL) + 1e-6f);
        *(unsigned*)(ckvn + (size_t)row * KVLP + 2 * lane) = pk2(k0 * r2 * kg[0], k1 * r2 * kg[1]);
        *(unsigned*)(ckvn + (size_t)row * KVLP + 128 + 2 * lane) = 0u;
        if (lane < 32) {
            const float x1 = bf1(zr[640 + lane]), x2 = bf1(zr[672 + lane]), cs = cosT[row * 32 + lane], sn = sinT[row * 32 + lane];
            kpe[(size_t)row * 64 + lane] = (bf16)f2bf(x1 * cs - x2 * sn); kpe[(size_t)row * 64 + 32 + lane] = (bf16)f2bf(x2 * cs + x1 * sn);
        }
    }
}

namespace s5 {
using bf16x8 = __attribute__((ext_vector_type(8))) short;
using f32x16 = __attribute__((ext_vector_type(16))) float;
constexpr int XS_ROW = 272;
constexpr int WAVE_LDS = 32 * XS_ROW + 2 * S5_CL * 16 * 2;
struct Par { float ar0, ai0, ar1, ai1, Lr0, Li0, Lr1, Li1; bf16x8 bt[4]; };
__device__ __forceinline__ void load_par(Frame& F, int dg, int n, int hb, Par& P) {
    const float* sp = (const float*)(F.ws + WS_S5P) + (size_t)dg * 36 * 64;
    P.ar0 = sp[n]; P.ai0 = sp[64 + n]; P.Lr0 = sp[128 + n]; P.Li0 = sp[192 + n];
    P.ar1 = sp[32 + n]; P.ai1 = sp[64 + 32 + n]; P.Lr1 = sp[128 + 32 + n]; P.Li1 = sp[192 + 32 + n];
#pragma unroll
    for (int t = 0; t < 4; ++t) { const float* b = sp + (size_t)((t < 2 ? 4 : 20) + 8 * hb) * 64 + 32 * (t & 1) + n;
        v4u w; w.x = pk2(b[0], b[64]); w.y = pk2(b[128], b[192]); w.z = pk2(b[256], b[320]); w.w = pk2(b[384], b[448]); P.bt[t] = __builtin_bit_cast(bf16x8, w); }
}
__device__ __forceinline__ int tok_of(int c0, int sp, int dir) { return dir ? (c0 + S5_CL - 1 - sp) : (c0 + sp); }
__device__ __forceinline__ void bu_block(Frame& F, const Par& P, int g, int ck, int blk, int dir, int lane, f32x16 (&D)[4]) {
    const bf16* z1 = (const bf16*)(F.ws + R_Z1);
    const int m = lane & 31, ha = lane >> 5, seg = (m >> 2) & 1, idx = 4 * (m >> 3) + (m & 3);
    const int t = tok_of((ck + 64 * seg) * S5_CL, 16 * blk + idx, dir);
    const bf16x8 ua = *(const bf16x8*)(z1 + (size_t)t * O_INP + 704 + g * 16 + 8 * ha);
#pragma unroll
    for (int q = 0; q < 4; ++q) D[q] = __builtin_amdgcn_mfma_f32_32x32x16_bf16(ua, P.bt[q], f32x16{}, 0, 0, 0);
}
__device__ __forceinline__ void scan16(const Par& P, f32x16 (&D)[4], float& x0r, float& x0i, float& x1r, float& x1i) {
#pragma unroll
    for (int r = 0; r < 16; ++r) {
        const float n0r = fmaf(P.ar0, x0r, fmaf(-P.ai0, x0i, D[0][r])), n0i = fmaf(P.ar0, x0i, fmaf(P.ai0, x0r, D[2][r]));
        const float n1r = fmaf(P.ar1, x1r, fmaf(-P.ai1, x1i, D[1][r])), n1i = fmaf(P.ar1, x1i, fmaf(P.ai1, x1r, D[3][r]));
        x0r = n0r; x0i = n0i; x1r = n1r; x1i = n1i; D[0][r] = n0r; D[2][r] = n0i; D[1][r] = n1r; D[3][r] = n1i; }
}
}

__device__ __forceinline__ void s5_pass1(Frame& F) {
    using namespace s5;
    float* E = (float*)(F.ws + WS_S5E);
    const int lane = F.lane, n = lane & 31, hd = lane >> 5;
    for (int task = F.gw; task < 32 * 64; task += F.NGW) {
        const int g = task >> 6, ck = task & 63;
        for (int dir = 0; dir < 2; ++dir) {
            Par P; load_par(F, dir * 32 + g, n, hd, P);
            float x0r = 0.f, x0i = 0.f, x1r = 0.f, x1i = 0.f;
            for (int blk = 0; blk < S5_CL / 16; ++blk) { f32x16 D[4]; bu_block(F, P, g, ck, blk, dir, lane, D); scan16(P, D, x0r, x0i, x1r, x1i); }
            float* e = E + ((size_t)((dir * 32 + g) * S5_NCH + ck + 64 * hd) * 2) * 64 + n;
            e[0] = x0r; e[64] = x0i; e[32] = x1r; e[96] = x1i;
        }
    }
}
__device__ __forceinline__ float gelu_tanh(float x) { const float u = 0.7978845608028654f * (x + 0.044715f * x * x * x); const float t = 1.0f - 2.0f * __builtin_amdgcn_rcpf(1.0f + fexp(2.0f * u)); return 0.5f * x * (1.0f + t); }
__device__ __forceinline__ void s5_pass3(Frame& F) {
    using namespace s5;
    const Args& A = *F.a;
    LAS unsigned char* xs = F.lds + F.wave * WAVE_LDS; LAS bf16* yfl = (LAS bf16*)(xs + 32 * XS_ROW);
    const float* E = (const float*)(F.ws + WS_S5E); bf16* YG = (bf16*)(F.ws + R_YG); const bf16* z1 = (const bf16*)(F.ws + R_Z1);
    const int lane = F.lane, n = lane & 31, hd = lane >> 5, cn = lane & 15, kq = lane >> 4;
    for (int task = F.gw; task < 32 * 64; task += F.NGW) {
        const int g = task >> 6, ck = task & 63, ckl = ck + 64 * hd;
        const float dsk = A.in[I_SD][g * 16 + cn];
        for (int dir = 0; dir < 2; ++dir) {
            const int dg = dir * 32 + g;
            Par P; load_par(F, dg, n, hd, P);
            float x0r = 0.f, x0i = 0.f, x1r = 0.f, x1i = 0.f;
            { const float* e = E + ((size_t)dg * S5_NCH * 2) * 64 + n; const int nprev = dir ? (S5_NCH - 1 - ckl) : ckl;
              const int nmax = dir ? (S5_NCH - 1 - ck) : (ck + 64);
              for (int j0 = 0; j0 < nmax; j0 += 8) {
                  float er0[8], ei0[8], er1[8], ei1[8];
#pragma unroll
                  for (int q = 0; q < 8; ++q) { const int jj = (j0 + q < nprev) ? (j0 + q) : 0; const int j = dir ? (S5_NCH - 1 - jj) : jj; const float* ej = e + (size_t)j * 128;
                      er0[q] = ej[0]; ei0[q] = ej[64]; er1[q] = ej[32]; ei1[q] = ej[96]; }
#pragma unroll
                  for (int q = 0; q < 8; ++q) { if (j0 + q < nprev) {
                      const float a = P.Lr0 * x0r - P.Li0 * x0i + er0[q], b = P.Lr0 * x0i + P.Li0 * x0r + ei0[q]; x0r = a; x0i = b;
                      const float c = P.Lr1 * x1r - P.Li1 * x1i + er1[q], d = P.Lr1 * x1i + P.Li1 * x1r + ei1[q]; x1r = c; x1i = d; } }
              } }
            bf16x8 Bc[4];
#pragma unroll
            for (int ks = 0; ks < 4; ++ks) { const int p0 = ks * 16 + kq * 4;
                const f32x4 cr = *(const f32x4*)(A.in[I_SCRE] + ((size_t)dg * 16 + cn) * 64 + p0), ci = *(const f32x4*)(A.in[I_SCIM] + ((size_t)dg * 16 + cn) * 64 + p0);
                v4u w; w.x = pk2(cr[0], -ci[0]); w.y = pk2(cr[1], -ci[1]); w.z = pk2(cr[2], -ci[2]); w.w = pk2(cr[3], -ci[3]); Bc[ks] = __builtin_bit_cast(bf16x8, w); }
            for (int blk = 0; blk < S5_CL / 16; ++blk) {
                f32x16 D[4]; bu_block(F, P, g, ck, blk, dir, lane, D); scan16(P, D, x0r, x0i, x1r, x1i);
#pragma unroll
                for (int r = 0; r < 16; ++r) { LAS unsigned char* row = xs + (16 * hd + r) * XS_ROW + 4 * n;
                    *(LAS unsigned*)row = pg8::cvt_pk_bf16(D[0][r], D[2][r]); *(LAS unsigned*)(row + 128) = pg8::cvt_pk_bf16(D[1][r], D[3][r]); }
#pragma unroll
                for (int sg = 0; sg < 2; ++sg) {
                    pg8::f32x4 acc = {0.f, 0.f, 0.f, 0.f};
#pragma unroll
                    for (int ks = 0; ks < 4; ++ks) { const bf16x8 af = *(const LAS bf16x8*)(xs + (16 * sg + cn) * XS_ROW + (ks * 32 + kq * 8) * 2);
                        acc = __builtin_amdgcn_mfma_f32_16x16x32_bf16(af, Bc[ks], acc, 0, 0, 0); }
#pragma unroll
                    for (int i = 0; i < 4; ++i) { const int sp = 16 * blk + 4 * kq + i; const int c0 = (ck + 64 * sg) * S5_CL; const int t = tok_of(c0, sp, dir), tl = t - c0;
                        if (dir == 0) yfl[(sg * S5_CL + tl) * 16 + cn] = (bf16)f2bf(acc[i]);
                        else { const float uu = bf1(z1[(size_t)t * O_INP + 704 + g * 16 + cn]); const float yv = acc[i] + bf1(yfl[(sg * S5_CL + tl) * 16 + cn]) + dsk * uu;
                            YG[(size_t)t * S5D + g * 16 + cn] = (bf16)f2bf(gelu_tanh(yv)); } }
                }
            }
        }
        LDS_WAIT();
    }
}
namespace dil {
using bf16x8 = __attribute__((ext_vector_type(8))) short;
using s16x4  = __attribute__((ext_vector_type(4))) short;
using f32x16 = __attribute__((ext_vector_type(16))) float;
using u32x4  = __attribute__((ext_vector_type(4))) unsigned;
constexpr int K_OFF = 0, V_OFF = 49152, BT_OFF = 98304, LI_OFF = 99328;
constexpr int NUNITS = 3 * 1024;
__device__ __forceinline__ int crow(int r, int hi) { return (r & 3) + 8 * (r >> 2) + 4 * hi; }
__device__ __forceinline__ unsigned cvtpk(float lo, float hi) { unsigned r; asm volatile("v_cvt_pk_bf16_f32 %0, %1, %2" : "=v"(r) : "v"(lo), "v"(hi)); return r; }
template <int OFF> __device__ __forceinline__ s16x4 tr_read(int vb) {
  s16x4 r; asm volatile("ds_read_b64_tr_b16 %0, %1 offset:%2" : "=&v"(r) : "v"(vb), "i"(OFF) : "memory"); return r;
}
struct UnitId { int c, d, r, qb, h, sub; };
__device__ __forceinline__ UnitId decode(int u) {
    UnitId U; U.c = u >> 10; const int rem = u & 1023; U.h = rem & 15; const int blk = rem >> 4;
    U.d = (U.c == 0) ? 1 : (U.c == 1) ? 4 : 16; U.sub = S / U.d; const int bpr = U.sub >> 8;
    U.r = blk / bpr; U.qb = blk - U.r * bpr; return U;
}
}

__device__ __forceinline__ void dilattn2_phase(Frame& F) {
    using namespace dil;
    const Args& A = *F.a;
    unsigned char* wsl = F.ws; int lane_l = F.lane, tid_l = F.tid; asm volatile("" : "+s"(wsl), "+v"(lane_l), "+v"(tid_l));
    const bf16* z = (const bf16*)(wsl + R_Z);
    bf16* PO = (bf16*)(wsl + R_PO); float* PML = (float*)(wsl + R_PML);
    LAS unsigned char* lds = F.lds;
    const int tid = tid_l, lane = lane_l, w = F.wave, r32 = lane & 31, hi = lane >> 5;
    for (int u = F.vcu; u < NUNITS; u += F.G) {
        const UnitId U = decode(u);
        const int d = U.d, h = U.h, sub = U.sub;
        {
            v4u kk[6], vv[6];
#pragma unroll
            for (int i = 0; i < 6; ++i) { const int idx = tid + 512 * i, key = idx >> 3, ch = idx & 7, sp = U.qb * 256 - 64 + key;
                kk[i] = (v4u){0u, 0u, 0u, 0u}; vv[i] = (v4u){0u, 0u, 0u, 0u};
                if (sp >= 0 && sp < sub) { const bf16* rp = z + ((size_t)sp * d + U.r) * E_IN + h * 64 + ch * 8; kk[i] = *(const v4u*)(rp + 3072); vv[i] = *(const v4u*)(rp + 4096); } }
#pragma unroll
            for (int i = 0; i < 6; ++i) { const int idx = tid + 512 * i, key = idx >> 3, ch = idx & 7;
                *(LAS v4u*)(lds + K_OFF + key * 128 + ((ch * 16) ^ (((key >> 1) & 7) << 4))) = kk[i];
                *(LAS v4u*)(lds + V_OFF + key * 128 + ((ch * 16) ^ (((key >> 1) & 1) << 6))) = vv[i]; }
            if (tid < 129) ((LAS float*)(lds + BT_OFF))[32 + tid] = A.in[I_T5][t5_bucket_dev(d * (tid - 64)) * DIL_H + h] * 1.4426950408889634f;
        }
        __syncthreads();
        f32x16 p[5];
        {
            const size_t qtok = (size_t)(U.qb * 256 + 32 * w + r32) * d + U.r;
            const bf16* qp = z + qtok * E_IN + 2048 + h * 64 + hi * 8;
            bf16x8 qf[4];
#pragma unroll
            for (int ks = 0; ks < 4; ++ks) qf[ks] = *(const bf16x8*)(qp + ks * 16);
            int ka[4];
#pragma unroll
            for (int ks = 0; ks < 4; ++ks) ka[ks] = K_OFF + (32 * w + r32) * 128 + ((ks * 32 + hi * 16) ^ (((r32 >> 1) & 7) << 4));
#pragma unroll
            for (int kt = 0; kt < 5; ++kt) { p[kt] = f32x16{};
#pragma unroll
                for (int ks = 0; ks < 4; ++ks) { const bf16x8 kf = *(const LAS bf16x8*)(lds + ka[ks] + kt * 4096); p[kt] = __builtin_amdgcn_mfma_f32_32x32x16_bf16(kf, qf[ks], p[kt], 0, 0, 0); } }
        }
        const int bidx = 4 * hi - r32;
        const int sp0 = U.qb * 256 + 32 * w - 64 + 4 * hi;
        const LAS float* btl = (const LAS float*)(lds + BT_OFF) + 32 + bidx;
        const bool edge = (U.qb * 256 + 32 * w - 64 < 0) || (U.qb * 256 + 32 * w + 96 > sub);
        constexpr float SC = 0.125f * 1.4426950408889634f;
#pragma unroll
        for (int kt = 0; kt < 5; ++kt)
#pragma unroll
            for (int rg = 0; rg < 16; ++rg) { const int cr = 32 * kt + (rg & 3) + 8 * (rg >> 2);
                float s = fmaf(p[kt][rg], SC, btl[cr]);
                if (kt == 0) s = (bidx + cr >= 0) ? s : -1e30f;
                if (kt >= 3) s = (bidx + cr <= 128) ? s : -1e30f;
                p[kt][rg] = s; }
        if (edge) {
#pragma unroll
            for (int kt = 0; kt < 5; ++kt)
#pragma unroll
                for (int rg = 0; rg < 16; ++rg) { const int cr = 32 * kt + (rg & 3) + 8 * (rg >> 2); const int sp = sp0 + cr; p[kt][rg] = (sp >= 0 && sp < sub) ? p[kt][rg] : -1e30f; }
        }
        float m2 = p[0][0];
#pragma unroll
        for (int kt = 0; kt < 5; ++kt)
#pragma unroll
            for (int rg = 0; rg < 16; ++rg) m2 = fmaxf(m2, p[kt][rg]);
        { auto rr = __builtin_amdgcn_permlane32_swap(__float_as_uint(m2), __float_as_uint(m2), false, false); m2 = fmaxf(__uint_as_float(rr[0]), __uint_as_float(rr[1])); }
        float l = 0.f;
#pragma unroll
        for (int kt = 0; kt < 5; ++kt)
#pragma unroll
            for (int rg = 0; rg < 16; ++rg) { const float e = __builtin_amdgcn_exp2f(p[kt][rg] - m2); p[kt][rg] = e; l += e; }
        { auto rr = __builtin_amdgcn_permlane32_swap(__float_as_uint(l), __float_as_uint(l), false, false); l = __uint_as_float(rr[0]) + __uint_as_float(rr[1]); }
        f32x16 o0 = {}, o1 = {};
        {
            const int q = (lane >> 2) & 3, pp = lane & 3, nh = (lane >> 4) & 1, qb1 = (q >> 1) & 1;
            const int vrow = V_OFF + (32 * w + 8 * hi + q) * 128;
            const int vb0 = (int)(uintptr_t)lds + vrow + ((32 * nh + 8 * pp) ^ (qb1 << 6));
            const int vb1 = (int)(uintptr_t)lds + vrow + ((64 + 32 * nh + 8 * pp) ^ (qb1 << 6));
#define DIL_PK4(P, BASE, OUT) do { unsigned a0 = cvtpk(P[BASE + 0], P[BASE + 1]), a1 = cvtpk(P[BASE + 2], P[BASE + 3]); unsigned b0 = cvtpk(P[BASE + 4], P[BASE + 5]), b1 = cvtpk(P[BASE + 6], P[BASE + 7]); \
    auto r0 = __builtin_amdgcn_permlane32_swap(a0, b0, false, false); auto r1 = __builtin_amdgcn_permlane32_swap(a1, b1, false, false); \
    u32x4 wv = {r0[0], r1[0], r0[1], r1[1]}; OUT = *reinterpret_cast<bf16x8*>(&wv); } while (0)
#define DIL_PK(L, H) (bf16x8){L[0], L[1], L[2], L[3], H[0], H[1], H[2], H[3]}
#define DIL_PV(KT) do { bf16x8 pa0, pa1; DIL_PK4(p[KT], 0, pa0); DIL_PK4(p[KT], 8, pa1); \
    const s16x4 l00 = tr_read<(KT) * 4096>(vb0), h00 = tr_read<(KT) * 4096 + 512>(vb0), l01 = tr_read<(KT) * 4096>(vb1), h01 = tr_read<(KT) * 4096 + 512>(vb1); \
    const s16x4 l10 = tr_read<(KT) * 4096 + 2048>(vb0), h10 = tr_read<(KT) * 4096 + 2048 + 512>(vb0), l11 = tr_read<(KT) * 4096 + 2048>(vb1), h11 = tr_read<(KT) * 4096 + 2048 + 512>(vb1); \
    asm volatile("s_waitcnt lgkmcnt(0)" ::: "memory"); __builtin_amdgcn_sched_barrier(0); \
    o0 = __builtin_amdgcn_mfma_f32_32x32x16_bf16(pa0, DIL_PK(l00, h00), o0, 0, 0, 0); o1 = __builtin_amdgcn_mfma_f32_32x32x16_bf16(pa0, DIL_PK(l01, h01), o1, 0, 0, 0); \
    o0 = __builtin_amdgcn_mfma_f32_32x32x16_bf16(pa1, DIL_PK(l10, h10), o0, 0, 0, 0); o1 = __builtin_amdgcn_mfma_f32_32x32x16_bf16(pa1, DIL_PK(l11, h11), o1, 0, 0, 0); } while (0)
            DIL_PV(0); DIL_PV(1); DIL_PV(2); DIL_PV(3); DIL_PV(4);
#undef DIL_PV
#undef DIL_PK
#undef DIL_PK4
        }
        LAS float* li = (LAS float*)(lds + LI_OFF) + w * 32;
        if (hi == 0) { li[r32] = l;
            const size_t tok = (size_t)(U.qb * 256 + 32 * w + r32) * d + U.r;
            *(f32x2*)(PML + (((size_t)U.c * S + tok) * DIL_H + h) * 2) = (f32x2){m2 * 0.6931471805599453f, l}; }
        LDS_WAIT();
#pragma unroll
        for (int rg = 0; rg < 16; ++rg) { const int qi = crow(rg, hi); const float rl = __builtin_amdgcn_rcpf(li[qi]);
            const size_t tok = (size_t)(U.qb * 256 + 32 * w + qi) * d + U.r;
            bf16* op = PO + ((size_t)U.c * S + tok) * 1024 + h * 64 + r32;
            op[0] = (bf16)f2bf(o0[rg] * rl); op[32] = (bf16)f2bf(o1[rg] * rl); }
        __syncthreads();
    }
}
__device__ __forceinline__ void dil_combine_phase(Frame& F) {
    const bf16* PO = (const bf16*)(F.ws + R_PO); const float* PML = (const float*)(F.ws + R_PML); bf16* mix = (bf16*)(F.ws + R_MIX);
    for (int idx = F.gw * 64 + F.lane; idx < S * 128; idx += F.NGW * 64) {
        const int tok = idx >> 7, ch = idx & 127, h = ch >> 3;
        f32x2 ml[3]; v4u ov[3];
#pragma unroll
        for (int c = 0; c < 3; ++c) { ml[c] = *(const f32x2*)(PML + (((size_t)c * S + tok) * DIL_H + h) * 2); ov[c] = *(const v4u*)(PO + ((size_t)c * S + tok) * 1024 + ch * 8); }
        const float M = fmaxf(ml[0][0], fmaxf(ml[1][0], ml[2][0]));
        float wc[3], ws = 0.f;
#pragma unroll
        for (int c = 0; c < 3; ++c) { wc[c] = ml[c][1] * fexp(ml[c][0] - M); ws += wc[c]; }
        const float rw = 1.0f / ws;
        v4u o;
#pragma unroll
        for (int e = 0; e < 4; ++e) { float a = 0.f, b = 0.f;
#pragma unroll
            for (int c = 0; c < 3; ++c) { a += wc[c] * bflo(ov[c][e]); b += wc[c] * bfhi(ov[c][e]); }
            o[e] = pk2(a * rw, b * rw); }
        *(v4u*)(mix + (size_t)tok * D + 1024 + ch * 8) = o;
    }
}
#ifndef MK_N_LAUNCHES
#define MK_N_LAUNCHES 1
#endif
constexpr int NPH = 20;
__global__ void __launch_bounds__(NWAVES * 64, 2) mk_fwd(Args args) {
    extern __shared__ __attribute__((aligned(16))) unsigned char lds_raw[];
    Frame F;
    F.lds = (LAS unsigned char*)lds_raw; F.a = &args; F.ws = args.ws;
    F.tid = threadIdx.x; F.lane = F.tid & 63; F.wave = __builtin_amdgcn_readfirstlane(F.tid >> 6);
    F.G = gridDim.x; { const int bx = blockIdx.x; F.vcu = (F.G % 8 == 0) ? (bx % 8) * (F.G / 8) + bx / 8 : bx; }
    F.gw = F.vcu * NWAVES + F.wave; F.NGW = F.G * NWAVES;
    volatile LAS unsigned* MISC = (volatile LAS unsigned*)(F.lds + MISC_OFF);
    for (int u = F.tid; u < 128; u += NWAVES * 64) MISC[u] = 0u;
    __syncthreads();
    XcdBarrier bar; bar.bar = (unsigned*)(F.ws + WS_CTL) + CW_BAR; bar.x = 0; bar.st = nullptr;
    if (MK_N_LAUNCHES == 1) bar = xcd_barrier_post((unsigned*)(F.ws + WS_CTL) + CW_BAR, MISC + 8);
    const int lo = args.ph_lo, hi = args.ph_hi;
#ifndef PH_MASK
#define PH_MASK 0xFFFFFFFFu
#endif
#define IN(k) (((PH_MASK >> (k)) & 1u) && lo <= (k) && (k) < hi)
#ifndef PH_TWICE
#define PH_TWICE 0u
#endif
#define TW(k) (((PH_TWICE >> (k)) & 1u) != 0u)
#define REP(k)
#define RB(k)
#define REFRESH() do { int t_ = (int)threadIdx.x; asm volatile("" : "+v"(t_)); F.tid = t_; F.lane = t_ & 63; } while (0)
#ifdef DOUBLE_BARRIERS
#define SEAM(k) do { if (IN(k) && IN((k) + 1)) { xcd_barrier(bar); xcd_barrier(bar); } else __syncthreads(); } while (0)
#else
#define SEAM(k) do { if (IN(k) && IN((k) + 1)) xcd_barrier(bar); else __syncthreads(); } while (0)
#endif
    typedef pg8::bf16_t b16;
    const float* x_in = args.in[I_X]; float* xo = args.out;
    b16* Y = (b16*)(F.ws + WS_Y); b16* HB = (b16*)(F.ws + WS_HB);
    const int bid = (int)blockIdx.x;

    if (IN(0)) REP(0) { REFRESH(); p0_prologue(F); RB(0); } SEAM(0);
    if (IN(1)) { REFRESH(); resnorm_phase<false, true, false, false>(F, x_in, nullptr, nullptr, 0, 0, 0, 0, 0, 0); } SEAM(1);
    if (IN(2)) REP(2) { REFRESH(); pg8::Gemm g{HB, (const b16*)(F.ws + WB_EIN), D}; pg8::StaticOrder so; so.init(S / 256, E_IN / 256, F.G, bid);
        pg8::EpiBf16 E{(b16*)(F.ws + R_Z), E_IN}; pg8::gemm_phase(F.lds, g, so, E); RB(2); } SEAM(2);
    if (IN(3)) REP(3) { REFRESH(); conv_phase(F); __syncthreads(); dilattn2_phase(F); RB(3); } SEAM(3);
    if (IN(4)) REP(4) { REFRESH(); dil_combine_phase(F); RB(4); } SEAM(4);
    if (IN(5)) REP(5) { REFRESH(); pg8::Gemm g{(const b16*)(F.ws + R_MIX), (const b16*)(F.ws + WB_EOUT), D}; pg8::StaticOrder so; so.init(S / 256, D / 256, F.G, bid);
        pg8::EpiBf16 E{Y, D}; pg8::gemm_phase(F.lds, g, so, E); RB(5); } SEAM(5);
    if (IN(6)) { REFRESH(); resnorm_phase<true, true, false, false>(F, x_in, xo, Y, 0, 2, 1, 0, 3, 2); } SEAM(6);
    if (IN(7)) REP(7) { REFRESH(); pg8::Gemm g{HB, (const b16*)(F.ws + WB_EF13), D}; pg8::StaticOrder so; so.init(S / 256, 2 * FD / 256, F.G, bid);
        pg8::EpiSwiGLU E{(b16*)(F.ws + R_ACT), FD}; pg8::gemm_phase(F.lds, g, so, E); RB(7); } SEAM(7);
    if (IN(8)) REP(8) { REFRESH(); pg8::Gemm g{(const b16*)(F.ws + R_ACT), (const b16*)(F.ws + WB_EF2), FD}; pg8::StaticOrder so; so.init(S / 256, D / 256, F.G, bid);
        pg8::EpiBf16 E{Y, D}; pg8::gemm_phase(F.lds, g, so, E); RB(8); } SEAM(8);
    if (IN(9)) { REFRESH(); resnorm_phase<true, true, false, false>(F, xo, xo, Y, 0, 5, 3, 1, 0, 0); } SEAM(9);
    if (IN(10)) REP(10) { REFRESH(); pg8::Gemm g{HB, (const b16*)(F.ws + WB_OIN), D}; pg8::StaticOrder so; so.init(S / 256, O_INP / 256, F.G, bid);
        pg8::EpiBf16 E{(b16*)(F.ws + R_Z1), O_INP}; pg8::gemm_phase(F.lds, g, so, E); RB(10); } SEAM(10);
    if (IN(11)) REP(11) { REFRESH(); latent_phase(F); s5_pass1(F); RB(11); } SEAM(11);
    if (IN(12)) REP(12) { REFRESH();
        { pg8::Gemm g{(const b16*)(F.ws + R_CQN), (const b16*)(F.ws + WB_UQ), QL}; pg8::StaticOrder so; so.init(S / 256, NQ / 256, F.G, bid);
          pg8::EpiBf16 E{(b16*)(F.ws + R_Q), NQ}; pg8::gemm_phase(F.lds, g, so, E); }
        { pg8::Gemm g{(const b16*)(F.ws + R_CKVN), (const b16*)(F.ws + WB_UKV), KVLP}; pg8::StaticOrder so; so.init(S / 256, NKV / 256, F.G, bid);
          pg8::EpiBf16 E{(b16*)(F.ws + R_KV), NKV}; pg8::gemm_phase(F.lds, g, so, E); }
        __syncthreads();
        s5_pass3(F);
    RB(12); } SEAM(12);
    if (IN(13)) REP(13) { REFRESH();
        { pg8::Gemm g{(const b16*)(F.ws + R_YG), (const b16*)(F.ws + WB_GLU), S5D}; pg8::StaticOrder so; so.init(S / 256, S5D / 256, F.G, bid);
          pg8::EpiGate E{(const b16*)(F.ws + R_YG), S5D, (b16*)(F.ws + R_MIX2), D, 1536}; pg8::gemm_phase(F.lds, g, so, E); }
        __syncthreads();
        mla2::CvJob J{args.in[I_M1], args.in[I_M3], args.in[I_M2], (unsigned char*)(F.ws + WB_M13), (unsigned char*)(F.ws + WB_M2), MOE_WSCALE, F.gw, F.NGW};
        for (int u = F.vcu; u < 12 * (S / 256); u += F.G) { const int h = u >> 6, qb = u & 63;
            mla2::attn_unit((const unsigned short*)(F.ws + R_Q), (const unsigned short*)(F.ws + R_KV), (const unsigned short*)(F.ws + R_KPE),
                           (const float*)(F.ws + WS_COS), (const float*)(F.ws + WS_SIN), (unsigned short*)(F.ws + R_MIX2), h, qb * 256, S, (char*)lds_raw, J); }
        while (J.next < mla2::CV_NG) { float cvr[16]; unsigned char* cvd; mla2::cv_issue(J, F.lane, cvr, cvd); mla2::cv_finish(J, cvr, cvd); J.next += J.stride; }
    RB(13); } SEAM(13);
    if (IN(14)) REP(14) { REFRESH(); pg8::Gemm g{(const b16*)(F.ws + R_MIX2), (const b16*)(F.ws + WB_OOUT), D}; pg8::StaticOrder so; so.init(S / 256, D / 256, F.G, bid);
        pg8::EpiBf16 E{Y, D}; pg8::gemm_phase(F.lds, g, so, E); RB(14); } SEAM(14);
    if (IN(15)) { REFRESH(); resnorm_phase<true, true, true, false>(F, xo, xo, Y, 1, 2, 1, 1, 3, 2); } SEAM(15);
    if (IN(16)) REP(16) { REFRESH(); moe_slots_phase(F); RB(16); } SEAM(16);
    if (IN(17)) REP(17) { REFRESH(); const int nt = __builtin_amdgcn_readfirstlane(*(const int*)(F.ws + WS_ROUTE + RT_NTILE));
        pg8::Gemm g{(const void*)(F.ws + R_HS8), (const void*)(F.ws + WB_M13), D}; pg8::StaticOrder so; so.init(nt, 2 * FE / 256, F.G, bid);
        so.texp = (const int*)(F.ws + WS_ROUTE + RT_TEXP); so.estride = (size_t)2 * FE * D;
        pg8::EpiSwiGLU8 E{(unsigned char*)(F.ws + R_ACTS), FE, 1.0f / (MOE_WSCALE * MOE_HSCALE), MOE_ASCALE}; pg8::gemm_phase<true, false>(F.lds, g, so, E); RB(17); } SEAM(17);
    if (IN(18)) REP(18) { REFRESH(); const int nt = __builtin_amdgcn_readfirstlane(*(const int*)(F.ws + WS_ROUTE + RT_NTILE)); int nfull, sp; moe_tail_plan(nt, nfull, sp);
        { pg8::Gemm g{(const void*)(F.ws + R_ACTS), (const void*)(F.ws + WB_M2), FE}; pg8::StaticOrder so; so.init(nfull, D / 256, F.G, bid);
          so.texp = (const int*)(F.ws + WS_ROUTE + RT_TEXP); so.estride = (size_t)D * FE;
          pg8::EpiBf16 E{(b16*)(F.ws + R_YS), D, 1.0f / (MOE_WSCALE * MOE_ASCALE)}; pg8::gemm_phase<true, false>(F.lds, g, so, E); }
        if (sp > 1) {
          pg8::Gemm g{(const void*)(F.ws + R_ACTS), (const void*)(F.ws + WB_M2), FE, FE / sp}; pg8::SplitOrder so; so.init(nfull, nt - nfull, sp, D / 256, F.G, F.vcu, (size_t)(FE / sp));
          so.texp = (const int*)(F.ws + WS_ROUTE + RT_TEXP); so.estride = (size_t)D * FE;
          pg8::EpiF32S E{(float*)(F.ws + R_YT), D, nfull, (size_t)(nt - nfull) * 256 * D, 1.0f / (MOE_WSCALE * MOE_ASCALE)}; pg8::gemm_phase<true, false>(F.lds, g, so, E); }
        RB(18); } SEAM(18);
    if (IN(19)) { REFRESH(); resnorm_phase<true, false, false, true>(F, xo, xo, nullptr, 1, 5, 3, 0, 0, 0); }
#undef IN
#undef SEAM
}

extern "C" void kernel_launch(void* const* d_in, const int* in_sizes, int n_in, void* d_out, int out_size, void* d_ws, size_t ws_size, hipStream_t stream) {
    static int grid = 0;
    if (grid == 0) {
        if (n_in != 34 || out_size != S * D || ws_size < WS_END) { fprintf(stderr, "kernel_launch: unexpected shapes: n_in %d out %d ws %zu (need %zu)\n", n_in, out_size, ws_size, (size_t)WS_END); grid = -1; return; }
        int dev = 0, cus = 0, per_cu = 0;
        if (hipGetDevice(&dev) != hipSuccess || hipDeviceGetAttribute(&cus, hipDeviceAttributeMultiprocessorCount, dev) != hipSuccess) { grid = -1; return; }
        if (hipFuncSetAttribute((const void*)mk_fwd, hipFuncAttributeMaxDynamicSharedMemorySize, LDS_BYTES) != hipSuccess) { fprintf(stderr, "kernel_launch: hipFuncSetAttribute failed\n"); grid = -1; return; }
        if (hipOccupancyMaxActiveBlocksPerMultiprocessor(&per_cu, (const void*)mk_fwd, NWAVES * 64, LDS_BYTES) != hipSuccess || per_cu < 1) { fprintf(stderr, "kernel_launch: note: occupancy query says %d\n", per_cu); (void)hipGetLastError(); }
        grid = cus;
    }
    if (grid < 0) return;
    if (hipMemsetAsync((char*)d_ws + WS_CTL, 0, CTL_ZERO_BYTES, stream) != hipSuccess) return;
    Args a{};
    for (int i = 0; i < 34; ++i) a.in[i] = (const float*)d_in[i];
    a.out = (float*)d_out; a.ws = (unsigned char*)d_ws;
#if MK_N_LAUNCHES == 1
    a.ph_lo = 0; a.ph_hi = NPH;
    hipLaunchKernelGGL(mk_fwd, dim3(grid), dim3(NWAVES * 64), LDS_BYTES, stream, a);
#else
    for (int p = 0; p < NPH; ++p) { a.ph_lo = p; a.ph_hi = p + 1; hipLaunchKernelGGL(mk_fwd, dim3(grid), dim3(NWAVES * 64), LDS_BYTES, stream, a);
        if (TW(p)) hipLaunchKernelGGL(mk_fwd, dim3(grid), dim3(NWAVES * 64), LDS_BYTES, stream, a); }
#endif
}
```

```cpp
#include <hip/hip_runtime.h>
#include <cstdio>
#include <cstdint>

namespace pg8 {
#define PG8_LAS __attribute__((address_space(3)))
typedef unsigned short bf16_t;
typedef short bf16x8 __attribute__((ext_vector_type(8)));
typedef float f32x4 __attribute__((ext_vector_type(4)));
typedef unsigned u32x4 __attribute__((ext_vector_type(4)));
typedef unsigned u32x2 __attribute__((ext_vector_type(2)));
constexpr int BM = 256, BK = 64, HALF = 128, HTB = HALF * BK * 2  , STAGE_BYTES = 8 * HTB, NXCD = 8, WGM = 8;

__host__ __device__ __forceinline__ int lds_byte(int r, int c) { const int st = (r >> 4) * 2 + (c >> 5), rr = r & 15, cc = c & 31, ob = rr * 64 + cc * 2; return st * 1024 + (ob ^ (((ob >> 9) & 1) << 5)); }
__host__ __device__ __forceinline__ void stage_rc(int b, int& R, int& C) { const int st = b / 1024, sb = b % 1024, swz = sb ^ (((sb >> 9) & 1) << 5); R = (st >> 1) * 16 + swz / 64; C = (st & 1) * 32 + (swz % 64) / 2; }
__host__ __device__ __forceinline__ int perm32(int rho) { const int n = rho >> 4, i = rho & 15; return 8 * (i >> 2) + 4 * n + (i & 3); }

struct Unit { int pm, pn, ks; };
struct Gemm { const void* A; const void* Bt; int K; int kl = 0; };

struct StaticOrder {
    int nM, nN, nwg, G, c;
    const int* texp; size_t estride;
    const int* rowidx;
    __device__ void init(int nM_, int nN_, int G_, int c_) { nM = nM_; nN = nN_; nwg = nM * nN; G = G_; c = c_; texp = nullptr; estride = 0; rowidx = nullptr; }
    __device__ bool next(int i, Unit& u) const {
        const long L = (long)i * G + c; if (L >= nwg) return false;
        int wgid = (int)L; { const int q = nwg / NXCD, r = nwg % NXCD, xcd = wgid % NXCD, off = wgid / NXCD; wgid = (xcd < r ? xcd * (q + 1) : r * (q + 1) + (xcd - r) * q) + off; }
        const int nig = WGM * nN, gid = wgid / nig, fm = gid * WGM, gsz = (nM - fm) < WGM ? (nM - fm) : WGM;
        u.pm = fm + ((wgid % nig) % gsz); u.pn = (wgid % nig) / gsz; return true;
    }
    __device__ __forceinline__ size_t b_off(const Unit& u) const { return texp ? (size_t)__builtin_amdgcn_readfirstlane(texp[u.pm]) * estride : (size_t)0; }
    __device__ __forceinline__ size_t k_off(const Unit&) const { return 0; }
};
struct FixedUnit {
    int pm, pn; const int* rowidx;
    __device__ bool next(int i, Unit& u) const { if (i != 0) return false; u.pm = pm; u.pn = pn; return true; }
    __device__ __forceinline__ size_t b_off(const Unit&) const { return 0; }
    __device__ __forceinline__ size_t k_off(const Unit&) const { return 0; }
};
struct SplitOrder {
    int pm0, ntail, s, nN, G, c; size_t kbytes;
    const int* texp; size_t estride; const int* rowidx;
    __device__ void init(int pm0_, int ntail_, int s_, int nN_, int G_, int c_, size_t kbytes_) { pm0 = pm0_; ntail = ntail_; s = s_; nN = nN_; G = G_; c = c_; kbytes = kbytes_; texp = nullptr; estride = 0; rowidx = nullptr; }
    __device__ bool next(int i, Unit& u) const {
        const long L = (long)i * G + c; if (L >= (long)ntail * s * nN) return false;
        const int g = (int)L / nN; u.pn = (int)L - g * nN; const int t = g / s; u.pm = pm0 + t; u.ks = g - t * s; return true;
    }
    __device__ __forceinline__ size_t b_off(const Unit& u) const { return texp ? (size_t)__builtin_amdgcn_readfirstlane(texp[u.pm]) * estride : (size_t)0; }
    __device__ __forceinline__ size_t k_off(const Unit& u) const { return (size_t)u.ks * kbytes; }
};

__device__ __forceinline__ unsigned cvt_pk_bf16(float lo, float hi) { unsigned r; asm volatile("v_cvt_pk_bf16_f32 %0, %1, %2" : "=v"(r) : "v"(lo), "v"(hi)); return r; }

struct EpiF32 {
    static constexpr bool PERM = false;
    float* C; int ldc;
    __device__ __forceinline__ void operator()(const f32x4 (&acc)[2][2][4][2], const Unit& u, int wr, int wc, int fr, int fq) const {
        const int row0 = u.pm * BM + wr * 64 + fr, col0 = u.pn * BM + wc * 32 + 4 * fq;
#pragma unroll
        for (int ai = 0; ai < 2; ++ai)
#pragma unroll
            for (int m = 0; m < 4; ++m) { float* rowp = C + (size_t)(row0 + ai * HALF + m * 16) * ldc + col0;
#pragma unroll
                for (int bj = 0; bj < 2; ++bj)
#pragma unroll
                    for (int n = 0; n < 2; ++n) *(f32x4*)(rowp + bj * HALF + n * 16) = acc[ai][bj][m][n]; }
    }
};
struct EpiF32S {
    static constexpr bool PERM = false;
    float* C; int ldc; int pm0; size_t sstride; float sc;
    __device__ __forceinline__ void operator()(const f32x4 (&acc)[2][2][4][2], const Unit& u, int wr, int wc, int fr, int fq) const {
        const int row0 = (u.pm - pm0) * BM + wr * 64 + fr, col0 = u.pn * BM + wc * 32 + 4 * fq;
        float* Cs = C + (size_t)u.ks * sstride;
#pragma unroll
        for (int ai = 0; ai < 2; ++ai)
#pragma unroll
            for (int m = 0; m < 4; ++m) { float* rowp = Cs + (size_t)(row0 + ai * HALF + m * 16) * ldc + col0;
#pragma unroll
                for (int bj = 0; bj < 2; ++bj)
#pragma unroll
                    for (int n = 0; n < 2; ++n) *(f32x4*)(rowp + bj * HALF + n * 16) = acc[ai][bj][m][n] * sc; }
    }
};
struct EpiBf16S {
    static constexpr bool PERM = true;
    bf16_t* O; int ldc; int pm0; size_t sstride; float sc;
    __device__ __forceinline__ void operator()(const f32x4 (&acc)[2][2][4][2], const Unit& u, int wr, int wc, int fr, int fq) const {
        const int row0 = (u.pm - pm0) * BM + wr * 64 + fr, col0 = u.pn * BM + wc * 32 + 8 * fq;
        bf16_t* Os = O + (size_t)u.ks * sstride;
#pragma unroll
        for (int ai = 0; ai < 2; ++ai)
#pragma unroll
            for (int m = 0; m < 4; ++m) { bf16_t* rowp = Os + (size_t)(row0 + ai * HALF + m * 16) * ldc + col0;
#pragma unroll
                for (int bj = 0; bj < 2; ++bj) { const f32x4 v0 = acc[ai][bj][m][0] * sc, v1 = acc[ai][bj][m][1] * sc;
                    u32x4 w; w.x = cvt_pk_bf16(v0[0], v0[1]); w.y = cvt_pk_bf16(v0[2], v0[3]); w.z = cvt_pk_bf16(v1[0], v1[1]); w.w = cvt_pk_bf16(v1[2], v1[3]);
                    *(u32x4*)(rowp + bj * HALF) = w; } }
    }
};
struct EpiFp8 {
    static constexpr bool PERM = true;
    unsigned char* O; int ldc; float sc;
    __device__ __forceinline__ void operator()(const f32x4 (&acc)[2][2][4][2], const Unit& u, int wr, int wc, int fr, int fq) const {
        const int row0 = u.pm * BM + wr * 64 + fr, col0 = u.pn * BM + wc * 32 + 8 * fq;
#pragma unroll
        for (int ai = 0; ai < 2; ++ai)
#pragma unroll
            for (int m = 0; m < 4; ++m) { unsigned char* rowp = O + (size_t)(row0 + ai * HALF + m * 16) * ldc + col0;
#pragma unroll
                for (int bj = 0; bj < 2; ++bj) { u32x2 w;
#pragma unroll
                    for (int n = 0; n < 2; ++n) { const f32x4 v = acc[ai][bj][m][n] * sc; int q = 0;
                        q = __builtin_amdgcn_cvt_pk_fp8_f32(__builtin_amdgcn_fmed3f(v[0], -448.f, 448.f), __builtin_amdgcn_fmed3f(v[1], -448.f, 448.f), q, false);
                        q = __builtin_amdgcn_cvt_pk_fp8_f32(__builtin_amdgcn_fmed3f(v[2], -448.f, 448.f), __builtin_amdgcn_fmed3f(v[3], -448.f, 448.f), q, true);
                        if (n == 0) w.x = (unsigned)q; else w.y = (unsigned)q; }
                    *(u32x2*)(rowp + bj * HALF) = w; } }
    }
};
struct EpiBf16 {
    static constexpr bool PERM = true;
    bf16_t* O; int ldc; float sc = 1.0f;
    __device__ __forceinline__ void operator()(const f32x4 (&acc)[2][2][4][2], const Unit& u, int wr, int wc, int fr, int fq) const {
        const int row0 = u.pm * BM + wr * 64 + fr, col0 = u.pn * BM + wc * 32 + 8 * fq;
#pragma unroll
        for (int ai = 0; ai < 2; ++ai)
#pragma unroll
            for (int m = 0; m < 4; ++m) { bf16_t* rowp = O + (size_t)(row0 + ai * HALF + m * 16) * ldc + col0;
#pragma unroll
                for (int bj = 0; bj < 2; ++bj) { const f32x4 v0 = acc[ai][bj][m][0] * sc, v1 = acc[ai][bj][m][1] * sc;
                    u32x4 w; w.x = cvt_pk_bf16(v0[0], v0[1]); w.y = cvt_pk_bf16(v0[2], v0[3]); w.z = cvt_pk_bf16(v1[0], v1[1]); w.w = cvt_pk_bf16(v1[2], v1[3]);
                    *(u32x4*)(rowp + bj * HALF) = w; } }
    }
};
__device__ __forceinline__ float silu_f(float v) { return v * __builtin_amdgcn_rcpf(1.0f + __builtin_amdgcn_exp2f(-1.4426950408889634f * v)); }
__device__ __forceinline__ float sigmoid_f(float v) { return __builtin_amdgcn_rcpf(1.0f + __builtin_amdgcn_exp2f(-1.4426950408889634f * v)); }
struct EpiSwiGLU {
    static constexpr bool PERM = false;
    bf16_t* O; int ldc;
    __device__ __forceinline__ void operator()(const f32x4 (&acc)[2][2][4][2], const Unit& u, int wr, int wc, int fr, int fq) const {
        const int row0 = u.pm * BM + wr * 64 + fr, col0 = u.pn * (BM / 2) + wc * 16 + 4 * fq;
#pragma unroll
        for (int ai = 0; ai < 2; ++ai)
#pragma unroll
            for (int m = 0; m < 4; ++m) { bf16_t* rowp = O + (size_t)(row0 + ai * HALF + m * 16) * ldc + col0;
#pragma unroll
                for (int bj = 0; bj < 2; ++bj) { const f32x4 a = acc[ai][bj][m][0], b = acc[ai][bj][m][1];
                    u32x2 w; w.x = cvt_pk_bf16(silu_f(a[0]) * b[0], silu_f(a[1]) * b[1]); w.y = cvt_pk_bf16(silu_f(a[2]) * b[2], silu_f(a[3]) * b[3]);
                    *(u32x2*)(rowp + bj * (HALF / 2)) = w; } }
    }
};
struct EpiSwiGLU8 {
    static constexpr bool PERM = false;
    unsigned char* O; int ldc; float isc, osc;
    __device__ __forceinline__ void operator()(const f32x4 (&acc)[2][2][4][2], const Unit& u, int wr, int wc, int fr, int fq) const {
        const int row0 = u.pm * BM + wr * 64 + fr, col0 = u.pn * (BM / 2) + wc * 16 + 4 * fq;
#pragma unroll
        for (int ai = 0; ai < 2; ++ai)
#pragma unroll
            for (int m = 0; m < 4; ++m) { unsigned char* rowp = O + (size_t)(row0 + ai * HALF + m * 16) * ldc + col0;
#pragma unroll
                for (int bj = 0; bj < 2; ++bj) { const f32x4 a = acc[ai][bj][m][0], b = acc[ai][bj][m][1];
                    const float c1 = -1.4426950408889634f * isc, c2 = 1.0f / (isc * isc * osc);
                    float v[4];
#pragma unroll
                    for (int e = 0; e < 4; ++e) v[e] = __builtin_amdgcn_fmed3f((a[e] * b[e]) * __builtin_amdgcn_rcpf(__builtin_fmaf(__builtin_amdgcn_exp2f(a[e] * c1), c2, c2)), -448.f, 448.f);
                    int w = 0; w = __builtin_amdgcn_cvt_pk_fp8_f32(v[0], v[1], w, false); w = __builtin_amdgcn_cvt_pk_fp8_f32(v[2], v[3], w, true);
                    *(int*)(rowp + bj * (HALF / 2)) = w; } }
    }
};
struct EpiGate {
    static constexpr bool PERM = false;
    const bf16_t* Y; int ldy; bf16_t* O; int ldc; int ocol0;
    __device__ __forceinline__ void operator()(const f32x4 (&acc)[2][2][4][2], const Unit& u, int wr, int wc, int fr, int fq) const {
        const int row0 = u.pm * BM + wr * 64 + fr, col0 = u.pn * BM + wc * 32 + 4 * fq;
#pragma unroll
        for (int ai = 0; ai < 2; ++ai)
#pragma unroll
            for (int m = 0; m < 4; ++m) { const size_t r = (size_t)(row0 + ai * HALF + m * 16);
#pragma unroll
                for (int bj = 0; bj < 2; ++bj)
#pragma unroll
                    for (int n = 0; n < 2; ++n) { const int c = col0 + bj * HALF + n * 16; const f32x4 a = acc[ai][bj][m][n];
                        const u32x2 y = *(const u32x2*)(Y + r * ldy + c);
                        const float y0 = __uint_as_float(y.x << 16), y1 = __uint_as_float(y.x & 0xffff0000u), y2 = __uint_as_float(y.y << 16), y3 = __uint_as_float(y.y & 0xffff0000u);
                        u32x2 w; w.x = cvt_pk_bf16(y0 * sigmoid_f(a[0]), y1 * sigmoid_f(a[1])); w.y = cvt_pk_bf16(y2 * sigmoid_f(a[2]), y3 * sigmoid_f(a[3]));
                        *(u32x2*)(O + r * ldc + ocol0 + c) = w; } }
    }
};

typedef int v8i32 __attribute__((ext_vector_type(8)));
__device__ __forceinline__ void glds16s(const void* sbase, unsigned voff, unsigned lds_dst) { unsigned keep;
    asm volatile("s_mov_b32 %0, m0\n\ts_mov_b32 m0, %3\n\ts_nop 0\n\tglobal_load_lds_dwordx4 %1, %2\n\ts_mov_b32 m0, %0" : "=&s"(keep) : "v"(voff), "s"(sbase), "s"(lds_dst) : "memory"); }
template <bool FP8 = false, bool GATHER = false, class Epi, class Sched>
__device__ __forceinline__ void gemm_phase(PG8_LAS unsigned char* lds, const Gemm g, const Sched& S, const Epi& E) {
    int tid_ = (int)threadIdx.x; asm volatile("" : "+v"(tid_));
    const int tid = tid_, wid = __builtin_amdgcn_readfirstlane(tid >> 6), lane = tid & 63, wr = wid >> 2, wc = wid & 3, fr = lane & 15, fq = lane >> 4;
    const int K = FP8 ? (g.K >> 1) : g.K, nt = (g.kl ? (FP8 ? (g.kl >> 1) : g.kl) : K) / BK;
    unsigned voffA[2], voffB[2];
#pragma unroll
    for (int i = 0; i < 2; ++i) { int R, C; stage_rc(tid * 16 + i * 8192, R, C); const int Rb = Epi::PERM ? ((R & ~31) + perm32(R & 31)) : R;
        voffA[i] = (unsigned)(R * K + C) * 2u; voffB[i] = (unsigned)(Rb * K + C) * 2u; }
    const size_t kstep = (size_t)(BK * 2);
    const size_t qstep = (size_t)64 * K * 2;
    const size_t hstep = (size_t)HALF * K * 2;
    const size_t tstep = 2 * hstep;
    const unsigned ldsw = (unsigned)wid * 1024u, ldsbase = (unsigned)(uintptr_t)lds;
    const int aoff = lds_byte(wr * 64 + fr, fq * 8), boff = lds_byte(wc * 32 + fr, fq * 8);
#define PG8_SA(b, h) (((b) * 2 + (h)) * HTB)
#define PG8_SB(b, h) ((4 + (b) * 2 + (h)) * HTB)
#define PG8_STAGE(bufoff, gbase, voff) do { _Pragma("unroll") for (int _i = 0; _i < 2; ++_i) glds16s((const void*)(gbase), (voff)[_i], ldsbase + (unsigned)(bufoff) + ldsw + (unsigned)_i * 8192u); } while (0)
#define PG8_STAGE1(bufoff, gbase, voff0) do { _Pragma("unroll") for (int _i = 0; _i < 2; ++_i) glds16s((const void*)((const char*)(gbase) + (size_t)_i * qstep), voff0, ldsbase + (unsigned)(bufoff) + ldsw + (unsigned)_i * 8192u); } while (0)
#define PG8_STAGE_A(bufoff, h, ap, og) do { if constexpr (GATHER) PG8_STAGE(bufoff, ap, (og)[h]); else PG8_STAGE1(bufoff, (ap) + (h) * hstep, voffA[0]); } while (0)
#define PG8_LDA(dst, b, h) do { _Pragma("unroll") for (int m = 0; m < 4; ++m) _Pragma("unroll") for (int k = 0; k < 2; ++k) dst[m][k] = *(const PG8_LAS bf16x8*)(lds + PG8_SA(b, h) + aoff + m * 2048 + k * 1024); } while (0)
#define PG8_LDB(dst, b, h) do { _Pragma("unroll") for (int n = 0; n < 2; ++n) _Pragma("unroll") for (int k = 0; k < 2; ++k) dst[n][k] = *(const PG8_LAS bf16x8*)(lds + PG8_SB(b, h) + boff + n * 2048 + k * 1024); } while (0)
#define PG8_MMA(ai, bj, At, Bt) do { __builtin_amdgcn_s_setprio(1); _Pragma("unroll") for (int m = 0; m < 4; ++m) _Pragma("unroll") for (int n = 0; n < 2; ++n) { \
        if constexpr (FP8) { const v8i32 bq = __builtin_bit_cast(v8i32, __builtin_shufflevector(Bt[n][0], Bt[n][1], 0, 1, 2, 3, 4, 5, 6, 7, 8, 9, 10, 11, 12, 13, 14, 15)); \
            const v8i32 aq = __builtin_bit_cast(v8i32, __builtin_shufflevector(At[m][0], At[m][1], 0, 1, 2, 3, 4, 5, 6, 7, 8, 9, 10, 11, 12, 13, 14, 15)); \
            acc[ai][bj][m][n] = __builtin_amdgcn_mfma_scale_f32_16x16x128_f8f6f4(bq, aq, acc[ai][bj][m][n], 0, 0, 0, 0, 0, 0);     } \
        else { _Pragma("unroll") for (int k = 0; k < 2; ++k) acc[ai][bj][m][n] = __builtin_amdgcn_mfma_f32_16x16x32_bf16(Bt[n][k], At[m][k], acc[ai][bj][m][n], 0, 0, 0); } } \
        __builtin_amdgcn_s_setprio(0); } while (0)
#define PG8_WAIT_V(n) asm volatile("s_waitcnt vmcnt(" #n ")" ::: "memory")
#define PG8_WAIT_L(n) asm volatile("s_waitcnt lgkmcnt(" #n ")" ::: "memory")
#define PG8_BAR __builtin_amdgcn_s_barrier()
#define PG8_SCHED __builtin_amdgcn_sched_barrier(0)
#define PG8_AOFF(dst, u) do { if constexpr (GATHER) { int t2_ = (int)threadIdx.x; asm volatile("" : "+v"(t2_)); _Pragma("unroll") for (int _i = 0; _i < 2; ++_i) { int R_, C_; stage_rc(t2_ * 16 + _i * 8192, R_, C_); \
        _Pragma("unroll") for (int _h = 0; _h < 2; ++_h) { const int _row = S.rowidx[(u).pm * BM + _h * HALF + R_]; dst[_h][_i] = (unsigned)((size_t)_row * K + C_) * 2u; } } } } while (0)
    Unit cur, nxt; int ui = 0;
    if (!S.next(0, cur)) return;
    f32x4 acc[2][2][4][2];
#pragma unroll
    for (int a = 0; a < 2; ++a)
#pragma unroll
        for (int b = 0; b < 2; ++b)
#pragma unroll
            for (int m = 0; m < 4; ++m)
#pragma unroll
                for (int n = 0; n < 2; ++n) acc[a][b][m][n] = (f32x4){0.f, 0.f, 0.f, 0.f};
    bf16x8 At[4][2], B0[2][2], B1[2][2];
    unsigned oC[2][2];
#define PG8_OSLOT ((PG8_LAS u32x4*)(lds + STAGE_BYTES) + (int)threadIdx.x)
    PG8_AOFF(oC, cur);
    const char* const gA = (const char*)g.A;
    const char* cA = (GATHER ? gA : gA + (size_t)cur.pm * tstep) + S.k_off(cur);
    const char* cB = (const char*)g.Bt + S.b_off(cur) + (size_t)cur.pn * tstep + S.k_off(cur);
    PG8_STAGE1(PG8_SB(0, 0), cB, voffB[0]); PG8_STAGE1(PG8_SB(0, 1), cB + hstep, voffB[0]); PG8_STAGE_A(PG8_SA(0, 0), 0, cA, oC); PG8_STAGE_A(PG8_SA(0, 1), 1, cA, oC);
    if (wr == 1) PG8_BAR;
    PG8_WAIT_V(2); PG8_BAR;
    PG8_STAGE1(PG8_SB(1, 0), cB + kstep, voffB[0]); PG8_STAGE_A(PG8_SA(1, 0), 0, cA + kstep, oC); PG8_STAGE1(PG8_SB(1, 1), cB + hstep + kstep, voffB[0]);
    PG8_WAIT_V(6); PG8_BAR;
    for (;;) {
        const bool has_next = S.next(ui + 1, nxt);
        const char* nB = cB; const char* nA = cA;
        if (has_next) { nB = (const char*)g.Bt + S.b_off(nxt) + (size_t)nxt.pn * tstep + S.k_off(nxt); nA = (GATHER ? gA : gA + (size_t)nxt.pm * tstep) + S.k_off(nxt);
            if constexpr (GATHER) { unsigned oN[2][2]; PG8_AOFF(oN, nxt); *PG8_OSLOT = (u32x4){oN[0][0], oN[0][1], oN[1][0], oN[1][1]}; } }
        for (int t = 0; t < nt; t += 2) {
            const bool last = (t == nt - 2);
            const char* a1 = cA + (size_t)(t + 1) * kstep;
            const char* a2 = last ? nA : cA + (size_t)(t + 2) * kstep; const char* b2 = last ? nB : cB + (size_t)(t + 2) * kstep;
            const char* a3 = a2 + kstep; const char* b3 = b2 + kstep;
            unsigned o2[2][2];
            if constexpr (GATHER) {
                if (last && has_next) { const u32x4 q = *PG8_OSLOT; o2[0][0] = q.x; o2[0][1] = q.y; o2[1][0] = q.z; o2[1][1] = q.w; }
                else { o2[0][0] = oC[0][0]; o2[0][1] = oC[0][1]; o2[1][0] = oC[1][0]; o2[1][1] = oC[1][1]; }
            }
            PG8_LDB(B0, 0, 0); PG8_LDB(B1, 0, 1); PG8_SCHED; PG8_LDA(At, 0, 0); PG8_STAGE_A(PG8_SA(1, 1), 1, a1, oC);
            PG8_WAIT_V(8); PG8_WAIT_L(0); PG8_BAR; PG8_MMA(0, 0, At, B0); PG8_MMA(0, 1, At, B1); PG8_BAR; PG8_SCHED;
            PG8_LDA(At, 0, 1); PG8_STAGE1(PG8_SB(0, 0), b2, voffB[0]); PG8_STAGE1(PG8_SB(0, 1), b2 + hstep, voffB[0]); PG8_STAGE_A(PG8_SA(0, 0), 0, a2, o2);
            PG8_WAIT_V(8); PG8_WAIT_L(0); PG8_BAR; PG8_MMA(1, 0, At, B0); PG8_MMA(1, 1, At, B1); PG8_BAR; PG8_SCHED;
            PG8_LDB(B0, 1, 0); PG8_LDB(B1, 1, 1); PG8_SCHED; PG8_LDA(At, 1, 0); PG8_STAGE_A(PG8_SA(0, 1), 1, a2, o2);
            PG8_WAIT_V(8); PG8_WAIT_L(0); PG8_BAR; PG8_MMA(0, 0, At, B0); PG8_MMA(0, 1, At, B1); PG8_BAR; PG8_SCHED;
            PG8_LDA(At, 1, 1); PG8_STAGE1(PG8_SB(1, 0), b3, voffB[0]); PG8_STAGE1(PG8_SB(1, 1), b3 + hstep, voffB[0]); PG8_STAGE_A(PG8_SA(1, 0), 0, a3, o2);
            PG8_WAIT_V(8); PG8_WAIT_L(0); PG8_BAR; PG8_MMA(1, 0, At, B0); PG8_MMA(1, 1, At, B1); PG8_BAR; PG8_SCHED;
        }
        if (wr == 0) PG8_BAR;
        { int t3 = (int)threadIdx.x; asm volatile("" : "+v"(t3)); E(acc, cur, wr, wc, t3 & 15, (t3 >> 4) & 3); }
        if (!has_next) break;
#pragma unroll
        for (int a = 0; a < 2; ++a)
#pragma unroll
            for (int b = 0; b < 2; ++b)
#pragma unroll
                for (int m = 0; m < 4; ++m)
#pragma unroll
                    for (int n = 0; n < 2; ++n) acc[a][b][m][n] = (f32x4){0.f, 0.f, 0.f, 0.f};
        cur = nxt; cB = nB; cA = nA; ++ui;
        if constexpr (GATHER) { const u32x4 q = *PG8_OSLOT; oC[0][0] = q.x; oC[0][1] = q.y; oC[1][0] = q.z; oC[1][1] = q.w; }
        if (wr == 1) PG8_BAR;
    }
    PG8_WAIT_V(0);
    PG8_BAR;
#undef PG8_SA
#undef PG8_SB
#undef PG8_STAGE
#undef PG8_STAGE_A
#undef PG8_STAGE1
#undef PG8_LDA
#undef PG8_LDB
#undef PG8_MMA
#undef PG8_WAIT_V
#undef PG8_WAIT_L
#undef PG8_BAR
#undef PG8_SCHED
#undef PG8_AOFF
#undef PG8_OSLOT
}
}
namespace mla2 {
using bf16x8 = __attribute__((ext_vector_type(8))) short;
using s16x4  = __attribute__((ext_vector_type(4))) short;
using f32x16 = __attribute__((ext_vector_type(16))) float;
using f32x4v = __attribute__((ext_vector_type(4))) float;
using u32x4  = __attribute__((ext_vector_type(4))) unsigned;
constexpr int NW = 8, QBLK = 32, KVBLK = 64;
constexpr float SCALE = 0.072168783648703220f;
constexpr float THR = 8.f;
constexpr int NQREG = 4, NQL = 12 - NQREG;
constexpr int LDQ = 2304, LDKV = 3072, LDKP = 64, LDO = 2048;
constexpr int SHM_V = KVBLK * 128 * 2, SHM_KN = KVBLK * 128 * 2, SHM_KP = KVBLK * 64 * 2;
constexpr int SHM_K = SHM_KN + SHM_KP;
constexpr int OFF_V = 0, OFF_KN = 2 * SHM_V, OFF_WS = OFF_KN + 2 * SHM_K, OFF_QS = OFF_WS + NW * 64 * 4, QS_WAVE = NQL * 1024, SHM_ATTN = OFF_QS + NW * QS_WAVE;
#define MLA2_QB(row, c16) ((((c16) >> 1) * 32 + (row)) * 32 + ((((c16) & 1) ^ (((row) >> 3) & 1)) << 4))
#define MLA2_SBAR() __builtin_amdgcn_sched_barrier(0)
#ifndef MLA2_WAIT0
#define MLA2_WAIT0 0
#endif
#if MLA2_WAIT0
#define MLA2_LWAIT(n) do { asm volatile("s_waitcnt lgkmcnt(0)" ::: "memory"); __builtin_amdgcn_sched_barrier(0); } while (0)
#else
#ifndef MLA2_SBMASK
#define MLA2_SBMASK 0x416
#endif
#define MLA2_LWAIT(n) do { asm volatile("s_waitcnt lgkmcnt(" #n ")" ::: "memory"); __builtin_amdgcn_sched_barrier(MLA2_SBMASK); } while (0)
#ifndef MLA2_FENCES
#define MLA2_FENCES 1
#endif
#if MLA2_FENCES
#define MLA2_FENCE() __builtin_amdgcn_sched_barrier(0)
#else
#define MLA2_FENCE() do {} while (0)
#endif
#define MLA2_W2(n, A, B) asm volatile("s_waitcnt lgkmcnt(" #n ")" : "+v"(A), "+v"(B) :: "memory")
#define MLA2_W3(n, A, B, C) asm volatile("s_waitcnt lgkmcnt(" #n ")" : "+v"(A), "+v"(B), "+v"(C) :: "memory")
#define MLA2_NRD(s) (((s) < 12) ? (((s) >= NQREG) ? 3 : 2) : 0)
#define MLA2_WS(s, X0, X1, XQ) do { if constexpr ((s) >= NQREG) asm volatile("s_waitcnt lgkmcnt(%3)" : "+v"(X0), "+v"(X1), "+v"(XQ) : "i"(MLA2_NRD((s) + 1)) : "memory"); \
    else asm volatile("s_waitcnt lgkmcnt(%2)" : "+v"(X0), "+v"(X1) : "i"(MLA2_NRD((s) + 1)) : "memory"); } while (0)
#endif
__device__ __forceinline__ int crow(int r, int hi) { return (r & 3) + 8 * (r >> 2) + 4 * hi; }
__device__ __forceinline__ unsigned cvtpk(float lo, float hi) { unsigned r; asm volatile("v_cvt_pk_bf16_f32 %0, %1, %2" : "=v"(r) : "v"(lo), "v"(hi)); return r; }
#ifndef MLA2_PLAIN_RD
#define MLA2_PLAIN_RD 0
#endif
template <int OFF> __device__ __forceinline__ bf16x8 lds_rd(int addr) {
#if MLA2_PLAIN_RD
  return *(const __attribute__((address_space(3))) bf16x8*)(unsigned)(addr + OFF);
#else
  bf16x8 r; asm volatile("ds_read_b128 %0, %1 offset:%2" : "=v"(r) : "v"(addr), "i"(OFF) : "memory"); return r;
#endif
}
using f32x2v = __attribute__((ext_vector_type(2))) float;
__device__ __forceinline__ float max3f(float a, float b, float c) { float r; asm volatile("v_max3_f32 %0, %1, %2, %3" : "=v"(r) : "v"(a), "v"(b), "v"(c)); return r; }
template <int OFF> __device__ __forceinline__ s16x4 tr_read(int vb) { s16x4 r; asm volatile("ds_read_b64_tr_b16 %0, %1 offset:%2" : "=&v"(r) : "v"(vb), "i"(OFF) : "memory"); return r; }

constexpr float THRL = THR * 1.4426950408889634f;
__device__ __forceinline__ void partialSM0(f32x16& p0, f32x16& p1, float& m_reg, f32x16& Mt) {
  float pmax = p0[0];
#pragma unroll
  for (int r = 1; r < 16; ++r) pmax = fmaxf(pmax, p0[r]);
#pragma unroll
  for (int r = 0; r < 16; ++r) pmax = fmaxf(pmax, p1[r]);
  { auto rr = __builtin_amdgcn_permlane32_swap(__float_as_uint(pmax), __float_as_uint(pmax), false, false);
    pmax = fmaxf(__uint_as_float(rr[0]), __uint_as_float(rr[1])); }
  m_reg = pmax;
#pragma unroll
  for (int r = 0; r < 16; ++r) { p0[r] -= pmax; p1[r] -= pmax; Mt[r] = -pmax; }
#pragma unroll
  for (int r = 0; r < 16; ++r) p0[r] = __builtin_amdgcn_exp2f(p0[r]);
}
__device__ __forceinline__ void partialSM(f32x16& p0, f32x16& p1, float& m_reg, float& mn, float& alpha) {
  constexpr float C = SCALE * 1.4426950408889634f;
  float pmax = p0[0];
#pragma unroll
  for (int r = 1; r < 16; ++r) pmax = fmaxf(pmax, p0[r]);
#pragma unroll
  for (int r = 0; r < 16; ++r) pmax = fmaxf(pmax, p1[r]);
  { auto rr = __builtin_amdgcn_permlane32_swap(__float_as_uint(pmax), __float_as_uint(pmax), false, false);
    pmax = fmaxf(__uint_as_float(rr[0]), __uint_as_float(rr[1])); }
  if (__builtin_expect(__all(pmax - m_reg <= THR / SCALE), 1)) { mn = m_reg; alpha = 1.f; }
  else { mn = fmaxf(m_reg, pmax); alpha = __builtin_amdgcn_exp2f((m_reg - mn) * C); m_reg = mn; }
  float mnC = -mn * C;
#pragma unroll
  for (int r = 0; r < 16; ++r) p0[r] = fmaf(p0[r], C, mnC);
#pragma unroll
  for (int r = 0; r < 16; ++r) p1[r] = fmaf(p1[r], C, mnC);
#pragma unroll
  for (int r = 0; r < 16; ++r) p0[r] = __builtin_amdgcn_exp2f(p0[r]);
}
template <bool FAST = false> __device__ __forceinline__ void finishSM(f32x16& p0, f32x16& p1, float alpha, float& l_reg, bf16x8& pa0, bf16x8& pa1, bf16x8& pa2, bf16x8& pa3) {
#pragma unroll
  for (int r = 0; r < 16; ++r) p1[r] = __builtin_amdgcn_exp2f(p1[r]);
  if constexpr (!FAST) {
  float ps = 0;
#pragma unroll
  for (int r = 0; r < 16; ++r) ps += p0[r];
#pragma unroll
  for (int r = 0; r < 16; ++r) ps += p1[r];
  { auto rr = __builtin_amdgcn_permlane32_swap(__float_as_uint(ps), __float_as_uint(ps), false, false);
    ps = __uint_as_float(rr[0]) + __uint_as_float(rr[1]); }
  l_reg = l_reg * alpha + ps; }
#define MLA2_PK4(P, BASE, OUT) do { unsigned a0 = cvtpk(P[BASE + 0], P[BASE + 1]), a1 = cvtpk(P[BASE + 2], P[BASE + 3]);   \
    unsigned b0 = cvtpk(P[BASE + 4], P[BASE + 5]), b1 = cvtpk(P[BASE + 6], P[BASE + 7]);                              \
    auto r0 = __builtin_amdgcn_permlane32_swap(a0, b0, false, false); auto r1 = __builtin_amdgcn_permlane32_swap(a1, b1, false, false); \
    u32x4 w = {r0[0], r1[0], r0[1], r1[1]}; OUT = *reinterpret_cast<bf16x8*>(&w); } while (0)
  MLA2_PK4(p0, 0, pa0); MLA2_PK4(p0, 8, pa1); MLA2_PK4(p1, 0, pa2); MLA2_PK4(p1, 8, pa3);
#undef MLA2_PK4
}
constexpr int ko(int B, int s) { return B * SHM_K + (s >> 2) * 8192; }
constexpr int qo(int s) { return (s - NQREG) * 1024; }
template <int B> __device__ __forceinline__ void qkt(f32x16& p0, f32x16& p1, const int (&kb)[4], int qbase, const bf16x8 (&qr)[NQREG]) {
  p0 = f32x16{}; p1 = f32x16{};
  bf16x8 a0, a1, aq, c0, c1, cq;
#define MLA2_RD(s, X0, X1, XQ) do { X0 = lds_rd<ko(B, s)>(kb[(s) & 3]); X1 = lds_rd<ko(B, s) + 4096>(kb[(s) & 3]); if constexpr ((s) >= NQREG) XQ = lds_rd<qo((s) >= NQREG ? (s) : NQREG)>(qbase); } while (0)
#define MLA2_MM(s, X0, X1, XQ) do { const bf16x8 q_ = ((s) < NQREG) ? qr[(s) < NQREG ? (s) : 0] : XQ; \
    p0 = __builtin_amdgcn_mfma_f32_32x32x16_bf16(X0, q_, p0, 0, 0, 0); p1 = __builtin_amdgcn_mfma_f32_32x32x16_bf16(X1, q_, p1, 0, 0, 0); } while (0)
  MLA2_RD(0, a0, a1, aq); MLA2_RD(1, c0, c1, cq);
  MLA2_WS(0, a0, a1, aq); MLA2_MM(0, a0, a1, aq); MLA2_RD(2, a0, a1, aq);
  MLA2_WS(1, c0, c1, cq); MLA2_MM(1, c0, c1, cq); MLA2_RD(3, c0, c1, cq);
  MLA2_WS(2, a0, a1, aq); MLA2_MM(2, a0, a1, aq); MLA2_RD(4, a0, a1, aq);
  MLA2_WS(3, c0, c1, cq); MLA2_MM(3, c0, c1, cq); MLA2_RD(5, c0, c1, cq); MLA2_FENCE();
  MLA2_WS(4, a0, a1, aq); MLA2_MM(4, a0, a1, aq); MLA2_RD(6, a0, a1, aq);
  MLA2_WS(5, c0, c1, cq); MLA2_MM(5, c0, c1, cq); MLA2_RD(7, c0, c1, cq);
  MLA2_WS(6, a0, a1, aq); MLA2_MM(6, a0, a1, aq); MLA2_RD(8, a0, a1, aq);
  MLA2_WS(7, c0, c1, cq); MLA2_MM(7, c0, c1, cq); MLA2_RD(9, c0, c1, cq); MLA2_FENCE();
  MLA2_WS(8, a0, a1, aq); MLA2_MM(8, a0, a1, aq); MLA2_RD(10, a0, a1, aq);
  MLA2_WS(9, c0, c1, cq); MLA2_MM(9, c0, c1, cq); MLA2_RD(11, c0, c1, cq);
  MLA2_WS(10, a0, a1, aq); MLA2_MM(10, a0, a1, aq);
  MLA2_WS(11, c0, c1, cq); MLA2_MM(11, c0, c1, cq);
#undef MLA2_RD
#undef MLA2_MM
}
__device__ __forceinline__ int v_st(int k, int c) { const int kk = (k & ~0xC) | ((k & 4) << 1) | ((k & 8) >> 1); return ((kk >> 3) * 4 + (c >> 5)) * 512 + ((kk & 7) * 32 + (c & 31)) * 2; }
__device__ __forceinline__ int v_rd_base(int lane) { return ((lane & 3) << 3) | (((lane >> 2) & 3) << 6) | (((lane >> 4) & 1) << 5) | (((lane >> 5) & 1) << 8); }
constexpr int v_rd_off(int d0, int ks, int half) { return d0 * 512 + ks * 4096 + half * 2048; }
template <int B> __device__ __forceinline__ void pv(f32x16 (&o)[4], int vb, bf16x8 pa0, bf16x8 pa1, bf16x8 pa2, bf16x8 pa3) {
  s16x4 l0, h0, l1, h1, l2, h2;
#define MLA2_PK(L, H) (bf16x8){L[0], L[1], L[2], L[3], H[0], H[1], H[2], H[3]}
#define MLA2_PR(k, L, H) do { L = tr_read<B * SHM_V + v_rd_off((k) & 3, (k) >> 2, 0)>(vb); H = tr_read<B * SHM_V + v_rd_off((k) & 3, (k) >> 2, 1)>(vb); } while (0)
#define MLA2_PM(k, L, H) do { const bf16x8 pa_ = ((k) >> 2) == 0 ? pa0 : ((k) >> 2) == 1 ? pa1 : ((k) >> 2) == 2 ? pa2 : pa3; \
    o[(k) & 3] = __builtin_amdgcn_mfma_f32_32x32x16_bf16(pa_, MLA2_PK(L, H), o[(k) & 3], 0, 0, 0); } while (0)
  MLA2_PR(0, l0, h0); MLA2_PR(1, l1, h1); MLA2_PR(2, l2, h2);
  MLA2_W2(4, l0, h0); MLA2_PM(0, l0, h0); MLA2_PR(3, l0, h0);
  MLA2_W2(4, l1, h1); MLA2_PM(1, l1, h1); MLA2_PR(4, l1, h1);
  MLA2_W2(4, l2, h2); MLA2_PM(2, l2, h2); MLA2_PR(5, l2, h2);
  MLA2_W2(4, l0, h0); MLA2_PM(3, l0, h0); MLA2_PR(6, l0, h0); MLA2_FENCE();
  MLA2_W2(4, l1, h1); MLA2_PM(4, l1, h1); MLA2_PR(7, l1, h1);
  MLA2_W2(4, l2, h2); MLA2_PM(5, l2, h2); MLA2_PR(8, l2, h2);
  MLA2_W2(4, l0, h0); MLA2_PM(6, l0, h0); MLA2_PR(9, l0, h0);
  MLA2_W2(4, l1, h1); MLA2_PM(7, l1, h1); MLA2_PR(10, l1, h1); MLA2_FENCE();
  MLA2_W2(4, l2, h2); MLA2_PM(8, l2, h2); MLA2_PR(11, l2, h2);
  MLA2_W2(4, l0, h0); MLA2_PM(9, l0, h0); MLA2_PR(12, l0, h0);
  MLA2_W2(4, l1, h1); MLA2_PM(10, l1, h1); MLA2_PR(13, l1, h1);
  MLA2_W2(4, l2, h2); MLA2_PM(11, l2, h2); MLA2_PR(14, l2, h2); MLA2_FENCE();
  MLA2_W2(4, l0, h0); MLA2_PM(12, l0, h0); MLA2_PR(15, l0, h0);
  MLA2_W2(4, l1, h1); MLA2_PM(13, l1, h1);
  MLA2_W2(2, l2, h2); MLA2_PM(14, l2, h2);
  MLA2_W2(0, l0, h0); MLA2_PM(15, l0, h0);
#undef MLA2_PK
#undef MLA2_PR
#undef MLA2_PM
}
#define MLA2_PK4B(P, BASE, OUT) do { unsigned a0_ = cvtpk(P[BASE + 0], P[BASE + 1]), a1_ = cvtpk(P[BASE + 2], P[BASE + 3]);   \
    unsigned b0_ = cvtpk(P[BASE + 4], P[BASE + 5]), b1_ = cvtpk(P[BASE + 6], P[BASE + 7]);                              \
    auto r0_ = __builtin_amdgcn_permlane32_swap(a0_, b0_, false, false); auto r1_ = __builtin_amdgcn_permlane32_swap(a1_, b1_, false, false); \
    u32x4 w_ = {r0_[0], r1_[0], r0_[1], r1_[1]}; OUT = *reinterpret_cast<bf16x8*>(&w_); } while (0)
template <int B, bool FAST> __device__ __forceinline__ void r1(f32x16& n0, f32x16& n1, const int (&kb)[4], int qbase, const bf16x8 (&qr)[NQREG],
                                                    f32x16& p0, f32x16& p1, float alpha, float& l_reg, bf16x8& pa0, bf16x8& pa1, bf16x8& pa2, bf16x8& pa3, const f32x16& Mt) {
  bf16x8 a0, a1, aq, c0, c1, cq; float psa = 0.f, psb = 0.f;
#define MLA2_RD(s, X0, X1, XQ) do { X0 = lds_rd<ko(B, s)>(kb[(s) & 3]); X1 = lds_rd<ko(B, s) + 4096>(kb[(s) & 3]); if constexpr ((s) >= NQREG) XQ = lds_rd<qo((s) >= NQREG ? (s) : NQREG)>(qbase); } while (0)
#define MLA2_MM(s, X0, X1, XQ) do { const bf16x8 q_ = ((s) < NQREG) ? qr[(s) < NQREG ? (s) : 0] : XQ; \
    if constexpr ((s) == 0) { n0 = __builtin_amdgcn_mfma_f32_32x32x16_bf16(X0, q_, Mt, 0, 0, 0); n1 = __builtin_amdgcn_mfma_f32_32x32x16_bf16(X1, q_, Mt, 0, 0, 0); }     \
    else { n0 = __builtin_amdgcn_mfma_f32_32x32x16_bf16(X0, q_, n0, 0, 0, 0); n1 = __builtin_amdgcn_mfma_f32_32x32x16_bf16(X1, q_, n1, 0, 0, 0); } } while (0)
#define MLA2_ADD(ACC, X) asm volatile("v_add_f32 %0, %0, %1" : "+v"(ACC) : "v"(X))
#define MLA2_CE(k) do { p1[2 * (k)] = __builtin_amdgcn_exp2f(p1[2 * (k)]); p1[2 * (k) + 1] = __builtin_amdgcn_exp2f(p1[2 * (k) + 1]); \
    if constexpr (!FAST) { MLA2_ADD(psa, p0[2 * (k)]); MLA2_ADD(psb, p0[2 * (k) + 1]); MLA2_ADD(psa, p1[2 * (k)]); MLA2_ADD(psb, p1[2 * (k) + 1]); } asm volatile("" : "+v"(p1)); } while (0)
  MLA2_RD(0, a0, a1, aq); MLA2_RD(1, c0, c1, cq);
  MLA2_WS(0, a0, a1, aq); MLA2_MM(0, a0, a1, aq); MLA2_RD(2, a0, a1, aq); MLA2_CE(0); MLA2_SBAR();
  MLA2_WS(1, c0, c1, cq); MLA2_MM(1, c0, c1, cq); MLA2_RD(3, c0, c1, cq); MLA2_CE(1); MLA2_SBAR();
  MLA2_WS(2, a0, a1, aq); MLA2_MM(2, a0, a1, aq); MLA2_RD(4, a0, a1, aq); MLA2_CE(2); MLA2_SBAR();
  MLA2_WS(3, c0, c1, cq); MLA2_MM(3, c0, c1, cq); MLA2_RD(5, c0, c1, cq); MLA2_CE(3); MLA2_SBAR();
  MLA2_WS(4, a0, a1, aq); MLA2_MM(4, a0, a1, aq); MLA2_RD(6, a0, a1, aq); MLA2_CE(4); MLA2_SBAR();
  MLA2_WS(5, c0, c1, cq); MLA2_MM(5, c0, c1, cq); MLA2_RD(7, c0, c1, cq); MLA2_CE(5); MLA2_SBAR();
  MLA2_WS(6, a0, a1, aq); MLA2_MM(6, a0, a1, aq); MLA2_RD(8, a0, a1, aq); MLA2_CE(6); MLA2_SBAR();
  MLA2_WS(7, c0, c1, cq); MLA2_MM(7, c0, c1, cq); MLA2_RD(9, c0, c1, cq); MLA2_CE(7); MLA2_SBAR();
  MLA2_WS(8, a0, a1, aq); MLA2_MM(8, a0, a1, aq); MLA2_RD(10, a0, a1, aq);
  if constexpr (!FAST) { float ps = psa + psb;
    { auto rr = __builtin_amdgcn_permlane32_swap(__float_as_uint(ps), __float_as_uint(ps), false, false); ps = __uint_as_float(rr[0]) + __uint_as_float(rr[1]); }
    l_reg = l_reg * alpha + ps; }
  MLA2_PK4B(p0, 0, pa0); asm volatile("" : "+v"(l_reg), "+v"(pa0)); MLA2_SBAR();
  MLA2_WS(9, c0, c1, cq); MLA2_MM(9, c0, c1, cq); MLA2_RD(11, c0, c1, cq); MLA2_PK4B(p0, 8, pa1); asm volatile("" : "+v"(pa1)); MLA2_SBAR();
  MLA2_WS(10, a0, a1, aq); MLA2_MM(10, a0, a1, aq); MLA2_PK4B(p1, 0, pa2); asm volatile("" : "+v"(pa2)); MLA2_SBAR();
  MLA2_WS(11, c0, c1, cq); MLA2_MM(11, c0, c1, cq); MLA2_PK4B(p1, 8, pa3); asm volatile("" : "+v"(pa3)); MLA2_SBAR();
#undef MLA2_RD
#undef MLA2_MM
#undef MLA2_CE
#undef MLA2_ADD
}
template <int B, bool FAST> __device__ __forceinline__ void r2(f32x16 (&o)[4], int vb, bf16x8 pa0, bf16x8 pa1, bf16x8 pa2, bf16x8 pa3,
                                                    f32x16& q0, f32x16& q1, float& m_reg, float& alpha, f32x16& Mt, f32x16& lacc) {
  s16x4 l0, h0, l1, h1, l2, h2; float mx;
  const bf16x8 ones = {0x3F80, 0x3F80, 0x3F80, 0x3F80, 0x3F80, 0x3F80, 0x3F80, 0x3F80};
#define MLA2_LS(PA) do { if constexpr (FAST) lacc = __builtin_amdgcn_mfma_f32_32x32x16_bf16(PA, ones, lacc, 0, 0, 0); } while (0)
#define MLA2_PK(L, H) (bf16x8){L[0], L[1], L[2], L[3], H[0], H[1], H[2], H[3]}
#define MLA2_PR(k, L, H) do { L = tr_read<B * SHM_V + v_rd_off((k) & 3, (k) >> 2, 0)>(vb); H = tr_read<B * SHM_V + v_rd_off((k) & 3, (k) >> 2, 1)>(vb); } while (0)
#define MLA2_PM(k, L, H) do { const bf16x8 pa_ = ((k) >> 2) == 0 ? pa0 : ((k) >> 2) == 1 ? pa1 : ((k) >> 2) == 2 ? pa2 : pa3; \
    o[(k) & 3] = __builtin_amdgcn_mfma_f32_32x32x16_bf16(pa_, MLA2_PK(L, H), o[(k) & 3], 0, 0, 0); } while (0)
#define MLA2_MX(Q, b) do { mx = max3f(mx, Q[b], Q[b + 1]); mx = max3f(mx, Q[b + 2], Q[b + 3]); mx = max3f(mx, Q[b + 4], Q[b + 5]); mx = max3f(mx, Q[b + 6], Q[b + 7]); } while (0)
#define MLA2_EX(Q, b) do { _Pragma("unroll") for (int e_ = 0; e_ < 2; ++e_) Q[(b) + e_] = __builtin_amdgcn_exp2f(Q[(b) + e_]); asm volatile("" : "+v"(Q)); } while (0)
  MLA2_PR(0, l0, h0); MLA2_PR(1, l1, h1); MLA2_PR(2, l2, h2);
  mx = q0[0];
  MLA2_W2(4, l0, h0); MLA2_PM(0, l0, h0); MLA2_PR(3, l0, h0); if constexpr (!FAST) MLA2_MX(q0, 0); MLA2_SBAR();
  MLA2_W2(4, l1, h1); MLA2_PM(1, l1, h1); MLA2_PR(4, l1, h1); if constexpr (!FAST) MLA2_MX(q0, 8); MLA2_SBAR();
  MLA2_W2(4, l2, h2); MLA2_PM(2, l2, h2); MLA2_PR(5, l2, h2); if constexpr (!FAST) MLA2_MX(q1, 0); MLA2_SBAR();
  MLA2_W2(4, l0, h0); MLA2_PM(3, l0, h0); MLA2_PR(6, l0, h0); if constexpr (!FAST) MLA2_MX(q1, 8); MLA2_SBAR();
  MLA2_W2(4, l1, h1); MLA2_PM(4, l1, h1); MLA2_PR(7, l1, h1);
  if constexpr (!FAST) { auto rr = __builtin_amdgcn_permlane32_swap(__float_as_uint(mx), __float_as_uint(mx), false, false); mx = fmaxf(__uint_as_float(rr[0]), __uint_as_float(rr[1])); }
  alpha = 1.f;
  if (!FAST && __builtin_expect(!__all(mx <= THRL), 0)) {
    const float dl = fmaxf(mx, 0.f); alpha = __builtin_amdgcn_exp2f(-dl); m_reg += dl;
#pragma unroll
    for (int r = 0; r < 16; ++r) { q0[r] -= dl; q1[r] -= dl; Mt[r] -= dl; } }
  asm volatile("" : "+v"(alpha), "+v"(m_reg));
  MLA2_SBAR();
  MLA2_W2(4, l2, h2); MLA2_PM(5, l2, h2); MLA2_PR(8, l2, h2); MLA2_EX(q0, 0); MLA2_SBAR();
  MLA2_W2(4, l0, h0); MLA2_PM(6, l0, h0); MLA2_PR(9, l0, h0); MLA2_EX(q0, 2); MLA2_SBAR();
  MLA2_W2(4, l1, h1); MLA2_PM(7, l1, h1); MLA2_PR(10, l1, h1); MLA2_EX(q0, 4); MLA2_SBAR();
  MLA2_W2(4, l2, h2); MLA2_PM(8, l2, h2); MLA2_PR(11, l2, h2); MLA2_EX(q0, 6); MLA2_SBAR();
  MLA2_W2(4, l0, h0); MLA2_PM(9, l0, h0); MLA2_PR(12, l0, h0); MLA2_EX(q0, 8); MLA2_SBAR();
  MLA2_W2(4, l1, h1); MLA2_PM(10, l1, h1); MLA2_PR(13, l1, h1); MLA2_EX(q0, 10); MLA2_SBAR();
  MLA2_W2(4, l2, h2); MLA2_PM(11, l2, h2); MLA2_PR(14, l2, h2); MLA2_EX(q0, 12); MLA2_SBAR();
  MLA2_W2(4, l0, h0); MLA2_PM(12, l0, h0); MLA2_PR(15, l0, h0); MLA2_EX(q0, 14); MLA2_SBAR();
  MLA2_LS(pa0);
  MLA2_W2(4, l1, h1); MLA2_PM(13, l1, h1); MLA2_LS(pa1); MLA2_SBAR();
  MLA2_W2(2, l2, h2); MLA2_PM(14, l2, h2); MLA2_LS(pa2); MLA2_SBAR();
  MLA2_W2(0, l0, h0); MLA2_PM(15, l0, h0); MLA2_LS(pa3); MLA2_SBAR();
#undef MLA2_LS
#undef MLA2_PK
#undef MLA2_PR
#undef MLA2_PM
#undef MLA2_MX
#undef MLA2_EX
}
__device__ __forceinline__ float bflo(unsigned u) { return __uint_as_float(u << 16); }
__device__ __forceinline__ float bfhi(unsigned u) { return __uint_as_float(u & 0xffff0000u); }

struct CvJob { const float* w1; const float* w3; const float* w2; unsigned char* d13; unsigned char* d2; float scale; int next, stride; };
constexpr int CV_G13 = 8 * (2048 / 16) * (7168 / 64), CV_G2 = 8 * (7168 / 16) * (2048 / 64), CV_NG = 2 * CV_G13 + CV_G2;
__device__ __forceinline__ void cv_issue(const CvJob& J, int lane, float (&r)[16], unsigned char*& dst) {
  const int g = J.next;
  if (g < 2 * CV_G13) { const int mm = g / CV_G13, rem = g - mm * CV_G13, e = rem / 14336, r2 = rem - e * 14336, nb = r2 >> 7, kb = r2 & 127;
    const float* src = (mm ? J.w3 : J.w1) + (size_t)e * 2048 * 7168 + (size_t)(kb * 16) * 7168 + nb * 64 + lane;
#pragma unroll
    for (int i = 0; i < 16; ++i) r[i] = src[(size_t)i * 7168];
    const int n = nb * 64 + lane; dst = J.d13 + (size_t)e * 14336 * 2048 + (size_t)((n >> 4) * 32 + mm * 16 + (n & 15)) * 2048 + kb * 16;
  } else { const int g2 = g - 2 * CV_G13, e = g2 / 14336, r2 = g2 - e * 14336, nb = r2 / 448, kb = r2 - nb * 448;
    const float* src = J.w2 + (size_t)e * 7168 * 2048 + (size_t)(kb * 16) * 2048 + nb * 64 + lane;
#pragma unroll
    for (int i = 0; i < 16; ++i) r[i] = src[(size_t)i * 2048];
    dst = J.d2 + (size_t)e * 2048 * 7168 + (size_t)(nb * 64 + lane) * 7168 + kb * 16; }
}
__device__ __forceinline__ unsigned cv_pk4(float a, float b, float c, float d, float s) {
  a = __builtin_amdgcn_fmed3f(a * s, -448.f, 448.f); b = __builtin_amdgcn_fmed3f(b * s, -448.f, 448.f); c = __builtin_amdgcn_fmed3f(c * s, -448.f, 448.f); d = __builtin_amdgcn_fmed3f(d * s, -448.f, 448.f);
  int w = 0; w = __builtin_amdgcn_cvt_pk_fp8_f32(a, b, w, false); w = __builtin_amdgcn_cvt_pk_fp8_f32(c, d, w, true); return (unsigned)w; }
__device__ __forceinline__ void cv_finish(const CvJob& J, const float (&r)[16], unsigned char* dst) {
  u32x4 o; o[0] = cv_pk4(r[0], r[1], r[2], r[3], J.scale); o[1] = cv_pk4(r[4], r[5], r[6], r[7], J.scale); o[2] = cv_pk4(r[8], r[9], r[10], r[11], J.scale); o[3] = cv_pk4(r[12], r[13], r[14], r[15], J.scale);
  *reinterpret_cast<u32x4*>(dst) = o;
}
constexpr int OFF_BADFLAG = 163840 - 512 + 96;
template <bool FAST> __device__ __forceinline__ bool attn_unit(const unsigned short* __restrict__ Qg, const unsigned short* __restrict__ KVg, const unsigned short* __restrict__ KPg,
                                          const float* __restrict__ cosT, const float* __restrict__ sinT, unsigned short* __restrict__ Og, int h, int q0, int seq, char* lds, CvJob& J) {
  int tid_ = (int)threadIdx.x; asm volatile("" : "+v"(tid_));
  const int tid = tid_, wid = tid >> 6, lane = tid & 63, r32 = lane & 31, hi = lane >> 5;
  char* V_lds = lds + OFF_V; char* KN_lds = lds + OFF_KN;
  float* ws = (float*)(lds + OFF_WS) + wid * 64; float* li_l = ws; float* al_l = ws + 32;
  float m_reg = 0.f, l_reg = 0; f32x16 o[4] = {}; f32x16 Mt; f32x16 lacc = {}; bf16x8 qr[NQREG];
  char* Qs = lds + OFF_QS + wid * QS_WAVE;
  {
    const int qrow = q0 + wid * QBLK + r32;
    const unsigned short* Qw = Qg + (size_t)qrow * LDQ + h * 192 + hi * 8;
#pragma unroll
    for (int d0 = 0; d0 < 8; ++d0) { const bf16x8 v = *reinterpret_cast<const bf16x8*>(Qw + d0 * 16);
      if (d0 < NQREG) qr[d0 < NQREG ? d0 : 0] = v; else *reinterpret_cast<bf16x8*>(Qs + MLA2_QB(r32, (d0 - NQREG) * 2 + hi)) = v; }
#pragma unroll
    for (int ab = 0; ab < 2; ++ab) {
      const u32x4 x1 = *reinterpret_cast<const u32x4*>(Qw + 128 + ab * 16), x2 = *reinterpret_cast<const u32x4*>(Qw + 128 + 32 + ab * 16);
      const float* cp = cosT + (size_t)qrow * 32 + ab * 16 + hi * 8; const float* sp = sinT + (size_t)qrow * 32 + ab * 16 + hi * 8;
      const f32x4v c0 = *reinterpret_cast<const f32x4v*>(cp), c1 = *reinterpret_cast<const f32x4v*>(cp + 4), s0 = *reinterpret_cast<const f32x4v*>(sp), s1 = *reinterpret_cast<const f32x4v*>(sp + 4);
      u32x4 o1, o2;
#define MLA2_ROT(W, CL, CH, SL, SH) do { const float a0 = bflo(x1[W]), a1 = bfhi(x1[W]), b0 = bflo(x2[W]), b1 = bfhi(x2[W]); \
        o1[W] = cvtpk(a0 * (CL) - b0 * (SL), a1 * (CH) - b1 * (SH)); o2[W] = cvtpk(b0 * (CL) + a0 * (SL), b1 * (CH) + a1 * (SH)); } while (0)
      MLA2_ROT(0, c0[0], c0[1], s0[0], s0[1]); MLA2_ROT(1, c0[2], c0[3], s0[2], s0[3]); MLA2_ROT(2, c1[0], c1[1], s1[0], s1[1]); MLA2_ROT(3, c1[2], c1[3], s1[2], s1[3]);
#undef MLA2_ROT
      *reinterpret_cast<u32x4*>(Qs + MLA2_QB(r32, (8 + ab - NQREG) * 2 + hi)) = o1;
      *reinterpret_cast<u32x4*>(Qs + MLA2_QB(r32, (10 + ab - NQREG) * 2 + hi)) = o2;
    }
  }
  const int lo = r32 * 32 + ((hi ^ ((r32 >> 3) & 1)) << 4);
  const int qbase = (int)(uintptr_t)Qs + lo;
  int kb[4];
#pragma unroll
  for (int j = 0; j < 4; ++j) kb[j] = (int)(uintptr_t)KN_lds + r32 * 128 + (((j * 2 + hi) ^ ((r32 >> 1) & 7)) << 4);
  const int vb0 = (int)(uintptr_t)V_lds + v_rd_base(lane);
  const unsigned short* Kh = KVg + h * 256; const unsigned short* Vh = KVg + h * 256 + 128;
  const int wu = __builtin_amdgcn_readfirstlane(wid);
  unsigned kd_off[3], kd_lds[3]; const unsigned short* kd_base[3]; int kd_stride[3];
#pragma unroll
  for (int i = 0; i < 3; ++i) { const int pi = 3 * wu + i, img = pi >> 3, grp = pi & 7, row = 8 * grp + (lane >> 3), c8 = (lane & 7) ^ ((row >> 1) & 7);
    kd_lds[i] = (unsigned)(uintptr_t)KN_lds + (unsigned)pi * 1024u;
    if (img < 2) { kd_base[i] = Kh + img * 64; kd_stride[i] = LDKV; kd_off[i] = (unsigned)(row * LDKV + c8 * 8) * 2u; }
    else { kd_base[i] = KPg; kd_stride[i] = LDKP; kd_off[i] = (unsigned)(row * LDKP + c8 * 8) * 2u; } }
  const int vkk = wu * 8 + ((lane & 31) >> 2), vk = (vkk & ~0xC) | ((vkk & 4) << 1) | ((vkk & 8) >> 1);
  const unsigned v_off = (unsigned)(vk * LDKV + (lane >> 5) * 32 + (lane & 3) * 8) * 2u;
  const unsigned ldsV = (unsigned)(uintptr_t)V_lds + (unsigned)wu * 2048u;
#define MLA2_DMA_K(b, k0) do { _Pragma("unroll") for (int i_ = 0; i_ < 3; ++i_) pg8::glds16s(kd_base[i_] + (size_t)(k0) * kd_stride[i_], kd_off[i_], kd_lds[i_] + (b) * SHM_K); } while (0)
#define MLA2_DMA_V(b, k0) do { const unsigned short* vb_ = Vh + (size_t)(k0) * LDKV; \
    pg8::glds16s(vb_, v_off, ldsV + (b) * SHM_V); pg8::glds16s(vb_ + 64, v_off, ldsV + (b) * SHM_V + 1024u); } while (0)
#define MLA2_LANDED() do { asm volatile("s_waitcnt vmcnt(0)" ::: "memory"); __syncthreads(); } while (0)
#define MLA2_RESC(a) do { if (__any((a) < 1.f)) { if (hi == 0) al_l[r32] = (a); asm volatile("s_waitcnt lgkmcnt(0)" ::: "memory"); \
    _Pragma("unroll") for (int d = 0; d < 4; ++d) _Pragma("unroll") for (int r = 0; r < 16; ++r) o[d][r] *= al_l[crow(r, hi)]; } } while (0)
  f32x16 pA0, pA1, pB0, pB1; float mnA, alA, alB; bf16x8 pa0, pa1, pa2, pa3; const int NT = seq / KVBLK;
  MLA2_DMA_K(0, 0); MLA2_DMA_V(0, 0); MLA2_DMA_K(1, KVBLK);
  MLA2_LANDED();
  qkt<0>(pA0, pA1, kb, qbase, qr); partialSM0(pA0, pA1, m_reg, Mt); alA = 1.f;
  __syncthreads();
  if (2 < NT) MLA2_DMA_K(0, 2 * KVBLK); MLA2_DMA_V(1, KVBLK);
  for (int j = 1; j + 1 < NT; j += 2) {
    float cvr[16]; unsigned char* cvd = nullptr; const bool cv_on = J.next < CV_NG;
    if (cv_on) cv_issue(J, lane, cvr, cvd);
    MLA2_SBAR(); r1<1, FAST>(pB0, pB1, kb, qbase, qr, pA0, pA1, alA, l_reg, pa0, pa1, pa2, pa3, Mt);
    r2<0, FAST>(o, vb0, pa0, pa1, pa2, pa3, pB0, pB1, m_reg, alB, Mt, lacc);
    MLA2_RESC(alB); MLA2_LANDED();
    if (j + 2 < NT) MLA2_DMA_K(1, (j + 2) * KVBLK); MLA2_DMA_V(0, (j + 1) * KVBLK);
    MLA2_SBAR(); r1<0, FAST>(pA0, pA1, kb, qbase, qr, pB0, pB1, alB, l_reg, pa0, pa1, pa2, pa3, Mt);
    r2<1, FAST>(o, vb0, pa0, pa1, pa2, pa3, pA0, pA1, m_reg, alA, Mt, lacc);
    if (cv_on) { cv_finish(J, cvr, cvd); J.next += J.stride; }
    MLA2_RESC(alA); MLA2_LANDED();
    if (j + 3 < NT) MLA2_DMA_K(0, (j + 3) * KVBLK); MLA2_DMA_V(1, (j + 2) * KVBLK);
  }
  MLA2_SBAR(); r1<1, FAST>(pB0, pB1, kb, qbase, qr, pA0, pA1, alA, l_reg, pa0, pa1, pa2, pa3, Mt);
  r2<0, FAST>(o, vb0, pa0, pa1, pa2, pa3, pB0, pB1, m_reg, alB, Mt, lacc);
  MLA2_RESC(alB); MLA2_LANDED();
  finishSM<FAST>(pB0, pB1, alB, l_reg, pa0, pa1, pa2, pa3); MLA2_SBAR();
  pv<1>(o, vb0, pa0, pa1, pa2, pa3);
  float rli[16];
  if constexpr (FAST) { const bf16x8 ones = {0x3F80, 0x3F80, 0x3F80, 0x3F80, 0x3F80, 0x3F80, 0x3F80, 0x3F80};
    lacc = __builtin_amdgcn_mfma_f32_32x32x16_bf16(pa0, ones, lacc, 0, 0, 0); lacc = __builtin_amdgcn_mfma_f32_32x32x16_bf16(pa1, ones, lacc, 0, 0, 0);
    lacc = __builtin_amdgcn_mfma_f32_32x32x16_bf16(pa2, ones, lacc, 0, 0, 0); lacc = __builtin_amdgcn_mfma_f32_32x32x16_bf16(pa3, ones, lacc, 0, 0, 0);
    l_reg = 0.f;
#pragma unroll
    for (int r = 0; r < 16; ++r) { rli[r] = __builtin_amdgcn_rcpf(lacc[r]); l_reg += lacc[r]; }
  } else {
  if (hi == 0) li_l[r32] = l_reg; asm volatile("s_waitcnt lgkmcnt(0)" ::: "memory");
#pragma unroll
  for (int r = 0; r < 16; ++r) rli[r] = __builtin_amdgcn_rcpf(li_l[crow(r, hi)]); }
  unsigned short* Ow = Og + (size_t)(q0 + wid * QBLK) * LDO + h * 128;
#pragma unroll
  for (int r = 0; r < 16; ++r) { const int orow = crow(r, hi);
#pragma unroll
    for (int d0 = 0; d0 < 4; ++d0) { const float v = o[d0][r] * rli[r]; unsigned u = __float_as_uint(v); u = (u + 0x7fffu + ((u >> 16) & 1u)) >> 16; Ow[(size_t)orow * LDO + d0 * 32 + r32] = (unsigned short)u; } }
  bool ok = true;
  if constexpr (FAST) { volatile unsigned* flag = reinterpret_cast<volatile unsigned*>(lds + OFF_BADFLAG);
    const bool bad = !(l_reg < 1.0e30f);
    if (__any(bad) && lane == 0) *flag = 1u;
    __syncthreads(); ok = (*flag == 0u); }
  __syncthreads();
  return ok;
#undef MLA2_DMA_K
#undef MLA2_DMA_V
#undef MLA2_LANDED
#undef MLA2_RESC
}
}
constexpr int S = 16384, D = 2048;
constexpr int E_IN = 5120, CONVD = 1024, CONVW = 31, DIL_H = 16;
constexpr int FD = 5632;
constexpr int O_INP = 1280;
constexpr int QL = 512, KVL = 128, KVLP = 128, S5D = 512;
constexpr int NQ = 2304, NKV = 3072;
constexpr int NE = 8, FE = 7168;
constexpr int MAXROWS = 34816, MAXTILES = 136;
constexpr int S5_CL = 128, S5_NCH = S / S5_CL;
constexpr int ADA_KS = 16;
constexpr float MOE_WSCALE = 1024.f, MOE_HSCALE = 16.f, MOE_ASCALE = 8.f, MOE_YSCALE = 64.f;

constexpr size_t MiB = 1u << 20;
constexpr size_t WS_CTL = 0, CTL_ZERO_BYTES = 1 * MiB;
constexpr size_t WS_MODP = 1 * MiB;
constexpr size_t WS_COS = 3 * MiB, WS_SIN = 5 * MiB;
constexpr size_t WS_S5P = 7 * MiB;
constexpr size_t WS_S5E = 384 * MiB;
constexpr size_t WS_ROUTE = 10 * MiB;
constexpr size_t RT_TOKE = 0, RT_TOKG = 128 * 1024, RT_POS = 256 * 1024, RT_ROWIDX = 384 * 1024, RT_TEXP = 528 * 1024, RT_NTILE = 529 * 1024;
constexpr size_t WS_YF = 11 * MiB;
constexpr size_t WS_WB = 44 * MiB;
constexpr size_t WB_EIN = WS_WB, WB_EOUT = WS_WB + 20 * MiB, WB_EF13 = WS_WB + 28 * MiB, WB_EF2 = WS_WB + 72 * MiB, WB_OIN = WS_WB + 94 * MiB,
                 WB_UQ = WS_WB + 99 * MiB, WB_UKV = WS_WB + 102 * MiB, WB_GLU = WS_WB + 104 * MiB, WB_OOUT = WS_WB + 105 * MiB, WB_M13 = WS_WB + 113 * MiB, WB_M2 = WS_WB + 561 * MiB;
constexpr size_t WS_HB = 830 * MiB;
constexpr size_t WS_Y = 894 * MiB;
constexpr size_t WS_XB = 958 * MiB;
constexpr size_t WS_R = 1022 * MiB;
constexpr size_t R_Z = WS_R, R_MIX = WS_R + 160 * MiB, R_ACT = WS_R + 224 * MiB, R_PO = WS_R + 400 * MiB, R_PML = WS_R + 496 * MiB;
constexpr size_t R_Z1 = WS_R, R_CQN = WS_R + 40 * MiB, R_CKVN = WS_R + 56 * MiB, R_KPE = WS_R + 64 * MiB, R_Q = WS_R + 66 * MiB, R_KV = WS_R + 138 * MiB,
                 R_MIX2 = WS_R + 234 * MiB, R_YG = WS_R + 298 * MiB;
constexpr size_t R_YT = WS_R + 240 * MiB;
constexpr size_t R_ACTS = WS_R, R_HS8 = WS_R + 240 * MiB, R_YS = WS_R + 476 * MiB;
constexpr size_t WS_END = WS_R + 612 * MiB;
constexpr int CW_BAR = 4096;
constexpr int CW_TBCNT = 16384;
constexpr int CW_GLUCTR = 20480;

constexpr int LDS_BYTES = 163840;
constexpr int COND_OFF = 133120;
constexpr int MISC_OFF = LDS_BYTES - 512;
constexpr int NWAVES = 8;

#define GAS __attribute__((address_space(1)))
#define LAS __attribute__((address_space(3)))
typedef unsigned short bf16;
typedef unsigned v4u __attribute__((ext_vector_type(4)));
typedef unsigned v2u __attribute__((ext_vector_type(2)));
typedef float f32x4 __attribute__((ext_vector_type(4)));
typedef float f32x2 __attribute__((ext_vector_type(2)));
typedef short bf16x8 __attribute__((ext_vector_type(8)));
#define LDS_WAIT() asm volatile("s_waitcnt lgkmcnt(0)" ::: "memory")
#define VM_WAIT() asm volatile("s_waitcnt vmcnt(0)" ::: "memory")
__device__ __forceinline__ unsigned f2bf(float f) { unsigned u = __builtin_bit_cast(unsigned, f); return (u + 0x7fffu + ((u >> 16) & 1u)) >> 16; }
__device__ __forceinline__ unsigned pk2(float lo, float hi) { return f2bf(lo) | (f2bf(hi) << 16); }
__device__ __forceinline__ float bflo(unsigned u) { return __uint_as_float(u << 16); }
__device__ __forceinline__ float bfhi(unsigned u) { return __uint_as_float(u & 0xffff0000u); }
__device__ __forceinline__ float bf1(unsigned short b) { return __uint_as_float(((unsigned)b) << 16); }
__device__ __forceinline__ float fexp(float x) { return __builtin_amdgcn_exp2f(1.4426950408889634f * x); }
__device__ __forceinline__ float fsilu(float v) { return v * __builtin_amdgcn_rcpf(1.0f + fexp(-v)); }
__device__ __forceinline__ float fsigmoid(float v) { return __builtin_amdgcn_rcpf(1.0f + fexp(-v)); }
__device__ __forceinline__ float wave_sum(float v) {
#define WS_DPP(X, CTRL, RMASK) __int_as_float(__builtin_amdgcn_update_dpp(0, __float_as_int(X), CTRL, RMASK, 0xF, false))
    v += WS_DPP(v, 0xB1, 0xF);
    v += WS_DPP(v, 0x4E, 0xF);
    v += WS_DPP(v, 0x141, 0xF);
    v += WS_DPP(v, 0x140, 0xF);
    v += WS_DPP(v, 0x142, 0xA);
    v += WS_DPP(v, 0x143, 0xC);
#undef WS_DPP
    return __int_as_float(__builtin_amdgcn_readlane(__float_as_int(v), 63));
}
__device__ __forceinline__ void sincos_rev(double rev, double& s, double& c) {
    rev -= __builtin_floor(rev);
    const double q4 = __builtin_floor(rev * 4.0 + 0.5);
    const double r = rev - q4 * 0.25;
    const double th = r * 6.283185307179586476925;
    const double t2 = th * th;
    double sp = 1.0 / 1307674368000.0; sp = sp * (-t2) + 1.0 / 6227020800.0; sp = sp * (-t2) + 1.0 / 39916800.0; sp = sp * (-t2) + 1.0 / 362880.0; sp = sp * (-t2) + 1.0 / 5040.0; sp = sp * (-t2) + 1.0 / 120.0; sp = sp * (-t2) + 1.0 / 6.0; sp = sp * (-t2) + 1.0;
    const double sn = sp * th;
    double cp = 1.0 / 87178291200.0; cp = cp * (-t2) + 1.0 / 479001600.0; cp = cp * (-t2) + 1.0 / 3628800.0; cp = cp * (-t2) + 1.0 / 40320.0; cp = cp * (-t2) + 1.0 / 720.0; cp = cp * (-t2) + 1.0 / 24.0; cp = cp * (-t2) + 0.5; cp = cp * (-t2) + 1.0;
    const int q = ((int)q4) & 3;
    s = (q == 0) ? sn : (q == 1) ? cp : (q == 2) ? -sn : -cp;
    c = (q == 0) ? cp : (q == 1) ? -sn : (q == 2) ? -cp : sn;
}
__device__ __forceinline__ double exp_small(double x) {
    double p = 1.0 / 3628800.0; p = p * x + 1.0 / 362880.0; p = p * x + 1.0 / 40320.0; p = p * x + 1.0 / 5040.0; p = p * x + 1.0 / 720.0; p = p * x + 1.0 / 120.0; p = p * x + 1.0 / 24.0; p = p * x + 1.0 / 6.0; p = p * x + 0.5; p = p * x + 1.0; p = p * x + 1.0;
    return p;
}

#define XB_TMO      128
#define XB_XCNT(j)  (256  + 64 * (j))
#define XB_XSUB(j)  (1280 + 64 * (j))
#define XB_XGEN(j)  (2304 + 64 * (j))
#define XB_TOP      3328
#define XB_TOPGEN   3392
#define XCD_BAR_WORDS 3456
#define XB_SPIN_CAP (1u << 20)
__device__ __forceinline__ unsigned xb_ld(unsigned* p)              { return __hip_atomic_load(p, __ATOMIC_RELAXED, __HIP_MEMORY_SCOPE_AGENT); }
__device__ __forceinline__ unsigned xb_add(unsigned* p, unsigned v) { return __hip_atomic_fetch_add(p, v, __ATOMIC_RELAXED, __HIP_MEMORY_SCOPE_AGENT); }
__device__ __forceinline__ unsigned xb_xcc_id() { return (unsigned)__builtin_amdgcn_s_getreg((3 << 11) | 20) & 0xFu; }
#define XB_SPIN(cond, bar) do { unsigned _sp = 0; while (cond) { __builtin_amdgcn_s_sleep(1); \
    if ((++_sp & 255u) == 0u) { if (xb_ld(&(bar)[XB_TMO])) break; if (_sp > XB_SPIN_CAP) { atomicAdd(&(bar)[XB_TMO], 1u); break; } } } } while (0)
struct XcdBarrier { unsigned* bar; unsigned x; volatile LAS unsigned* st; };
__device__ __forceinline__ XcdBarrier xcd_barrier_post(unsigned* bar, volatile LAS unsigned* st) {
    XcdBarrier b; b.bar = bar; b.x = xb_xcc_id(); b.st = st;
    if (threadIdx.x == 0) (void)xb_add(&bar[XB_XCNT(b.x)], 1u);
    return b;
}
__device__ __forceinline__ void xcd_barrier_complete(unsigned* bar, unsigned x, unsigned& nloc, unsigned& nx) {
    const unsigned G = gridDim.x * gridDim.y * gridDim.z;
    unsigned sum, cnt, mine, sp = 0u;
    for (;;) {
        sum = 0u; cnt = 0u; mine = 0u;
#pragma unroll
        for (unsigned j = 0; j < 16; ++j) { const unsigned c = xb_ld(&bar[XB_XCNT(j)]); sum += c; cnt += (c > 0u) ? 1u : 0u; mine = (j == x) ? c : mine; }
        if (sum == G) break;
        __builtin_amdgcn_s_sleep(1);
        if ((++sp & 255u) == 0u) { if (xb_ld(&bar[XB_TMO])) break; if (sp > XB_SPIN_CAP) { atomicAdd(&bar[XB_TMO], 1u); break; } }
    }
    nloc = mine > 0u ? mine : 1u; nx = cnt > 0u ? cnt : 1u;
}
__device__ __forceinline__ void xcd_barrier(const XcdBarrier& b) {
    asm volatile("s_waitcnt vmcnt(0)" ::: "memory");
    __syncthreads();
    if (threadIdx.x == 0) {
        unsigned* bar = b.bar;
        __builtin_amdgcn_s_waitcnt(0);
        unsigned nloc = b.st[0], nx = b.st[1];
        if (nloc == 0u) { xcd_barrier_complete(bar, b.x, nloc, nx); b.st[0] = nloc; b.st[1] = nx; }
        const unsigned old = xb_add(&bar[XB_XSUB(b.x)], 1u);
        const unsigned gen = old / nloc;
        if (old + 1u == (gen + 1u) * nloc) {
            __builtin_amdgcn_fence(__ATOMIC_RELEASE, "agent");
            asm volatile("s_waitcnt vmcnt(0)" ::: "memory");
            const unsigned og = xb_add(&bar[XB_TOP], 1u);
            const unsigned tg = og / nx;
            if (og + 1u == (tg + 1u) * nx) xb_add(&bar[XB_TOPGEN], 1u);
            else XB_SPIN(xb_ld(&bar[XB_TOPGEN]) == tg, bar);
            __builtin_amdgcn_fence(__ATOMIC_ACQUIRE, "agent");
            xb_add(&bar[XB_XGEN(b.x)], 1u);
            asm volatile("s_waitcnt vmcnt(0)" ::: "memory");
        } else {
            XB_SPIN(xb_ld(&bar[XB_XGEN(b.x)]) == gen, bar);
            __builtin_amdgcn_fence(__ATOMIC_ACQUIRE, "agent");
            asm volatile("s_waitcnt vmcnt(0)" ::: "memory");
        }
    }
    __syncthreads();
}

struct Args { const float* in[34]; float* out; unsigned char* ws; int ph_lo, ph_hi; };
enum { I_X = 0, I_C, I_T5, I_NG, I_ADAW, I_ADAB, I_EWIN, I_ECW, I_ECB, I_ECG, I_ECLB, I_EWOUT, I_EF1, I_EF3, I_EF2, I_OWIN, I_QNG, I_UQ, I_KVNG, I_UKV,
       I_SARE, I_SAIM, I_SLDT, I_SBRE, I_SBIM, I_SCRE, I_SCIM, I_SD, I_SGLU, I_OWOUT, I_RW, I_M1, I_M3, I_M2 };
struct Frame {
    LAS unsigned char* lds;
    const Args* a;
    unsigned char* ws;
    int tid, lane, wave, vcu, G, gw, NGW;
};

__device__ __forceinline__ void cvt_tile(const float* __restrict__ W, int K, int N, bf16* __restrict__ Wt, int ldk, int grp, int mul, int off, int item, LAS float* scr, int lane) {
    const int nblk = N >> 6, kb = item / nblk, nb = item - kb * nblk, k0 = kb << 6, n0 = nb << 6;
    const int lc = (lane & 15) * 4, lr = lane >> 4;
    f32x4 v[16];
#pragma unroll
    for (int i = 0; i < 16; ++i) v[i] = *(const f32x4*)(W + (size_t)(k0 + lr + 4 * i) * N + n0 + lc);
#pragma unroll
    for (int i = 0; i < 16; ++i) { LAS float* d = scr + (lr + 4 * i) * 65 + lc; d[0] = v[i][0]; d[1] = v[i][1]; d[2] = v[i][2]; d[3] = v[i][3]; }
    LDS_WAIT();
    const int c = lane & 7;
#pragma unroll
    for (int j = 0; j < 8; ++j) { const int n = (lane >> 3) + 8 * j; const LAS float* s = scr + (8 * c) * 65 + n;
        v4u o; o.x = pk2(s[0 * 65], s[1 * 65]); o.y = pk2(s[2 * 65], s[3 * 65]); o.z = pk2(s[4 * 65], s[5 * 65]); o.w = pk2(s[6 * 65], s[7 * 65]);
        const int nn = n0 + n, drow = (nn / grp) * (grp * mul) + off + (nn % grp);
        *(v4u*)(Wt + (size_t)drow * ldk + k0 + 8 * c) = o; }
    LDS_WAIT();
}

__device__ __forceinline__ unsigned pk4_fp8(float a, float b, float c, float d) {
    a = __builtin_fminf(__builtin_fmaxf(a, -448.f), 448.f); b = __builtin_fminf(__builtin_fmaxf(b, -448.f), 448.f); c = __builtin_fminf(__builtin_fmaxf(c, -448.f), 448.f); d = __builtin_fminf(__builtin_fmaxf(d, -448.f), 448.f);
    int w = 0; w = __builtin_amdgcn_cvt_pk_fp8_f32(a, b, w, false); w = __builtin_amdgcn_cvt_pk_fp8_f32(c, d, w, true); return (unsigned)w; }
__device__ __forceinline__ void cvt_tile8(const float* __restrict__ W, int K, int N, unsigned char* __restrict__ Wt, int ldk, int grp, int mul, int off, float scale, int item, LAS float* scr, int lane) {
    const int nblk = N >> 6, kb = item / nblk, nb = item - kb * nblk, k0 = kb << 6, n0 = nb << 6;
    const int lc = (lane & 15) * 4, lr = lane >> 4;
    f32x4 v[16];
#pragma unroll
    for (int i = 0; i < 16; ++i) v[i] = *(const f32x4*)(W + (size_t)(k0 + lr + 4 * i) * N + n0 + lc);
#pragma unroll
    for (int i = 0; i < 16; ++i) { LAS float* d = scr + (lr + 4 * i) * 65 + lc; d[0] = v[i][0] * scale; d[1] = v[i][1] * scale; d[2] = v[i][2] * scale; d[3] = v[i][3] * scale; }
    LDS_WAIT();
    const int c = lane & 3;
#pragma unroll
    for (int j = 0; j < 4; ++j) { const int n = (lane >> 2) + 16 * j; const LAS float* s = scr + (16 * c) * 65 + n;
        v4u o; o.x = pk4_fp8(s[0 * 65], s[1 * 65], s[2 * 65], s[3 * 65]); o.y = pk4_fp8(s[4 * 65], s[5 * 65], s[6 * 65], s[7 * 65]);
        o.z = pk4_fp8(s[8 * 65], s[9 * 65], s[10 * 65], s[11 * 65]); o.w = pk4_fp8(s[12 * 65], s[13 * 65], s[14 * 65], s[15 * 65]);
        const int nn = n0 + n, drow = (nn / grp) * (grp * mul) + off + (nn % grp);
        *(v4u*)(Wt + (size_t)drow * ldk + k0 + 16 * c) = o; }
    LDS_WAIT();
}

__device__ __forceinline__ void p0_prologue(Frame& F) {
    const Args& A = *F.a;
    LAS float* condL = (LAS float*)(F.lds + COND_OFF);
    for (int i = F.tid; i < D; i += NWAVES * 64) condL[i] = fsilu(A.in[I_C][i]);
    __syncthreads();
    LAS float* scr = (LAS float*)(F.lds + F.wave * 16640);
    const int lane = F.lane;
    constexpr int N_ADA = 96 * ADA_KS, N_ROPE = S * 32 / 64, N_S5 = 64, N_Z1 = 256, N_Z2 = 0;
#define CVT_M(SRC, KK, NN, DSTOFF, LDK, GRP, MUL, OFF, NEXP) { constexpr int per = ((KK) / 64) * ((NN) / 64); constexpr int tot = per * (NEXP); \
        if (r < tot) { const int e = r / per, t = r - e * per; cvt_tile(A.in[SRC] + (size_t)e * (KK) * (NN), KK, NN, (bf16*)(F.ws + (DSTOFF)) + (size_t)e * ((NN) * (MUL)) * (LDK), LDK, GRP, MUL, OFF, t, scr, lane); continue; } r -= tot; }
#define CVT_M8(SRC, KK, NN, DSTOFF, LDK, GRP, MUL, OFF, NEXP) { constexpr int per = ((KK) / 64) * ((NN) / 64); constexpr int tot = per * (NEXP); \
        if (r < tot) { const int e = r / per, t = r - e * per; cvt_tile8(A.in[SRC] + (size_t)e * (KK) * (NN), KK, NN, (unsigned char*)(F.ws + (DSTOFF)) + (size_t)e * ((NN) * (MUL)) * (LDK), LDK, GRP, MUL, OFF, MOE_WSCALE, t, scr, lane); continue; } r -= tot; }
    constexpr int N_CVT = (32 * 80) + (32 * 32) + 2 * (32 * 88) + (88 * 32) + (32 * 19) + (8 * 36) + (2 * 48) + (8 * 8) + (32 * 32);
    constexpr int N_ITEMS = N_CVT + N_ADA + N_ROPE + N_S5 + N_Z1 + N_Z2;
    LAS unsigned* p0ctr = (LAS unsigned*)(F.lds + MISC_OFF) + 16;
    int it, nx = 0;
#define P0_GRAB(dst) do { unsigned v_ = 0u; if (lane == 0) v_ = __hip_atomic_fetch_add(p0ctr, 1u, __ATOMIC_RELAXED, __HIP_MEMORY_SCOPE_WORKGROUP); dst = (int)__builtin_amdgcn_readfirstlane(v_) * F.G + F.vcu; } while (0)
    P0_GRAB(it);
    for (; it < N_ITEMS; it = nx) {
        P0_GRAB(nx);
        int r = it;
        if (r < N_ADA) {
            const int chunk = r % 96, ks = r / 96, l = chunk / 48, n0 = (chunk % 48) * 256;
            const float* w = A.in[I_ADAW] + (size_t)l * D * 12288 + (size_t)(ks * 128) * 12288 + n0 + 4 * lane;
            f32x4 acc = {0.f, 0.f, 0.f, 0.f};
#pragma unroll 16
            for (int k = 0; k < 128; ++k) { const f32x4 v = *(const f32x4*)(w + (size_t)k * 12288); const float cv = condL[ks * 128 + k]; acc += v * cv; }
            *(f32x4*)((float*)(F.ws + WS_MODP) + (size_t)ks * 24576 + l * 12288 + n0 + 4 * lane) = acc;
            continue; }
        r -= N_ADA;
        CVT_M(I_EWIN, 2048, 5120, WB_EIN, 2048, 64, 1, 0, 1)
        CVT_M(I_EWOUT, 2048, 2048, WB_EOUT, 2048, 64, 1, 0, 1)
        CVT_M(I_EF1, 2048, 5632, WB_EF13, 2048, 16, 2, 0, 1)
        CVT_M(I_EF3, 2048, 5632, WB_EF13, 2048, 16, 2, 16, 1)
        CVT_M(I_EF2, 5632, 2048, WB_EF2, 5632, 64, 1, 0, 1)
        CVT_M(I_OWIN, 2048, 1216, WB_OIN, 2048, 64, 1, 0, 1)
        CVT_M(I_UQ, 512, 2304, WB_UQ, 512, 64, 1, 0, 1)
        CVT_M(I_UKV, 128, 3072, WB_UKV, KVLP, 64, 1, 0, 1)
        CVT_M(I_SGLU, 512, 512, WB_GLU, 512, 64, 1, 0, 1)
        CVT_M(I_OWOUT, 2048, 2048, WB_OOUT, 2048, 64, 1, 0, 1)
        if (r < N_ROPE) {
            const int idx = r * 64 + lane, pos = idx >> 5, j = idx & 31;
            double f = 1.0; for (int q = 0; q < j; ++q) f *= 0.74989420933245582730;
            const float ang = (float)pos * (float)f;
            double sn, cs; sincos_rev((double)ang * 0.15915494309189533577, sn, cs);
            ((float*)(F.ws + WS_COS))[idx] = (float)cs; ((float*)(F.ws + WS_SIN))[idx] = (float)sn;
            continue; }
        r -= N_ROPE;
        if (r < N_S5) {
            const int p = lane;
            const double are = (double)A.in[I_SARE][r * 64 + p], aim = (double)A.in[I_SAIM][r * 64 + p];
            const double dt = (double)fexp(A.in[I_SLDT][r]);
            const double er = exp_small(are * dt); double sn, cs; sincos_rev(aim * dt * 0.15915494309189533577, sn, cs);
            const double abr = er * cs, abi = er * sn;
            double eL = er; for (int q = 1; q < S5_CL; q <<= 1) eL *= eL;
            double snL, csL; sincos_rev(aim * dt * (double)S5_CL * 0.15915494309189533577, snL, csL);
            const double nr = abr - 1.0, ni = abi, den = are * are + aim * aim;
            const double qr = (nr * are + ni * aim) / den, qi = (ni * are - nr * aim) / den;
            float* o = (float*)(F.ws + WS_S5P) + (size_t)r * 36 * 64;
            o[0 * 64 + p] = (float)abr; o[1 * 64 + p] = (float)abi; o[2 * 64 + p] = (float)(eL * csL); o[3 * 64 + p] = (float)(eL * snL);
#pragma unroll
            for (int c = 0; c < 16; ++c) { const double br = (double)A.in[I_SBRE][(size_t)(r * 64 + p) * 16 + c], bi = (double)A.in[I_SBIM][(size_t)(r * 64 + p) * 16 + c];
                o[(4 + c) * 64 + p] = (float)(qr * br - qi * bi); o[(20 + c) * 64 + p] = (float)(qr * bi + qi * br); }
            continue; }
        r -= N_S5;
        if (r < N_Z1) { ((v4u*)(F.ws + WB_OIN + (size_t)1216 * 2048 * 2))[r * 64 + lane] = (v4u){0u, 0u, 0u, 0u}; continue; }
        r -= N_Z1;
        (void)r;
    }
#undef CVT_M
#undef CVT_M8
#undef P0_GRAB
}

__device__ __forceinline__ float mod_val(Frame& F, int L, int chunk, int col) {
    const Args& A = *F.a; const int o = L * 12288 + chunk * 2048 + col;
    float s = A.in[I_ADAB][o]; const float* mp = (const float*)(F.ws + WS_MODP) + o;
#pragma unroll
    for (int ks = 0; ks < ADA_KS; ++ks) s += mp[(size_t)ks * 24576];
    return s;
}
__device__ __forceinline__ void moe_tail_plan(int nt, int& nfull, int& s) {
    nfull = nt & ~31; const int tl = nt - nfull;
    s = (tl == 0 || tl > 16) ? 1 : (tl <= 4 ? 7 : (tl <= 8 ? 4 : 2));
    if (s == 1) nfull = nt;
}
template <bool RES, bool HOUT, bool ROUTE, bool GATHER, bool XIB = false, bool XOB = false>
__device__ __forceinline__ void resnorm_phase(Frame& F, const void* xin_, void* xout_, const bf16* y, int Lr, int gchunk, int gi1, int Lh, int shchunk, int gi2) {
    const Args& A = *F.a;
    LAS float* A1 = (LAS float*)F.lds; LAS float* A2 = A1 + D; LAS float* B2 = A2 + D; LAS float* RT = B2 + D;
    for (int col = F.tid; col < D; col += NWAVES * 64) {
        if (RES) A1[col] = mod_val(F, Lr, gchunk, col) * A.in[I_NG][(Lr * 4 + gi1) * D + col];
        if (HOUT) { A2[col] = A.in[I_NG][(Lh * 4 + gi2) * D + col] * (1.0f + mod_val(F, Lh, shchunk + 1, col)); B2[col] = mod_val(F, Lh, shchunk, col); }
    }
    if (ROUTE) for (int i = F.tid; i < D * NE; i += NWAVES * 64) RT[(i & 7) * D + (i >> 3)] = A.in[I_RW][i];
    __syncthreads();
    const int lane = F.lane;
    bf16* hb = (bf16*)(F.ws + WS_HB);
    for (int row = F.gw; row < S; row += F.NGW) {
        f32x4 xv[8];
        if (XIB) { const bf16* xin = (const bf16*)xin_;
#pragma unroll
            for (int j = 0; j < 8; ++j) { const v2u a = *(const v2u*)(xin + (size_t)row * D + 4 * lane + 256 * j); xv[j] = (f32x4){bflo(a.x), bfhi(a.x), bflo(a.y), bfhi(a.y)}; }
        } else { const float* xin = (const float*)xin_;
#pragma unroll
            for (int j = 0; j < 8; ++j) xv[j] = *(const f32x4*)(xin + (size_t)row * D + 4 * lane + 256 * j); }
        if (RES) {
            f32x4 yv[8];
            if (GATHER) {
                const int* pos = (const int*)(F.ws + WS_ROUTE + RT_POS); const float* tg = (const float*)(F.ws + WS_ROUTE + RT_TOKG);
                const unsigned char* ys = (const unsigned char*)(F.ws + R_YS); const bf16* yt = (const bf16*)(F.ws + R_YT);
                int nfull, sp; const int ntl = __builtin_amdgcn_readfirstlane(*(const int*)(F.ws + WS_ROUTE + RT_NTILE)); moe_tail_plan(ntl, nfull, sp);
                const int ts = nfull * 256; const size_t sstr = (size_t)(ntl - nfull) * 256 * D;
                const int p0 = __builtin_amdgcn_readfirstlane(pos[2 * row]), p1 = __builtin_amdgcn_readfirstlane(pos[2 * row + 1]);
                if (p0 < ts && p1 < ts) {
                    const float g0 = tg[2 * row] * (1.0f / MOE_YSCALE), g1 = tg[2 * row + 1] * (1.0f / MOE_YSCALE);
#pragma unroll
                    for (int j = 0; j < 8; ++j) { const unsigned a = *(const unsigned*)(ys + (size_t)p0 * D + 4 * lane + 256 * j), b = *(const unsigned*)(ys + (size_t)p1 * D + 4 * lane + 256 * j);
                        const f32x2 a0 = __builtin_amdgcn_cvt_pk_f32_fp8((int)a, false), a1 = __builtin_amdgcn_cvt_pk_f32_fp8((int)a, true), b0 = __builtin_amdgcn_cvt_pk_f32_fp8((int)b, false), b1 = __builtin_amdgcn_cvt_pk_f32_fp8((int)b, true);
                        yv[j] = (f32x4){g0 * a0[0] + g1 * b0[0], g0 * a0[1] + g1 * b0[1], g0 * a1[0] + g1 * b1[0], g0 * a1[1] + g1 * b1[1]}; }
                } else {
#pragma unroll
                for (int j = 0; j < 8; ++j) yv[j] = (f32x4){0.f, 0.f, 0.f, 0.f};
#pragma unroll
                for (int hf = 0; hf < 2; ++hf) { const int p = hf ? p1 : p0; const float g = tg[2 * row + hf];
                    if (p >= ts) {
                        const bf16* bp = yt + (size_t)(p - ts) * D + 4 * lane;
                        f32x4 t[8];
#pragma unroll
                        for (int j = 0; j < 8; ++j) t[j] = (f32x4){0.f, 0.f, 0.f, 0.f};
#pragma nounroll
                        for (int ks = 0; ks < sp; ++ks) {
#pragma unroll
                            for (int j = 0; j < 8; ++j) { const v2u a = *(const v2u*)(bp + (size_t)ks * sstr + 256 * j); t[j] += (f32x4){bflo(a.x), bfhi(a.x), bflo(a.y), bfhi(a.y)}; } }
#pragma unroll
                        for (int j = 0; j < 8; ++j) yv[j] += t[j] * g;
                    } else {
#pragma unroll
                        for (int j = 0; j < 8; ++j) { const unsigned a = *(const unsigned*)(ys + (size_t)p * D + 4 * lane + 256 * j); const float gs = g * (1.0f / MOE_YSCALE);
                            const f32x2 a0 = __builtin_amdgcn_cvt_pk_f32_fp8((int)a, false), a1 = __builtin_amdgcn_cvt_pk_f32_fp8((int)a, true);
                            yv[j] += (f32x4){gs * a0[0], gs * a0[1], gs * a1[0], gs * a1[1]}; }
                    } }
                }
            } else {
#pragma unroll
                for (int j = 0; j < 8; ++j) { const v2u a = *(const v2u*)(y + (size_t)row * D + 4 * lane + 256 * j); yv[j] = (f32x4){bflo(a.x), bfhi(a.x), bflo(a.y), bfhi(a.y)}; }
            }
            float ss = 0.f;
#pragma unroll
            for (int j = 0; j < 8; ++j) ss += (yv[j][0] * yv[j][0] + yv[j][1] * yv[j][1]) + (yv[j][2] * yv[j][2] + yv[j][3] * yv[j][3]);
            const float rstd = 1.0f / sqrtf(wave_sum(ss) * (1.0f / D) + 1e-6f);
#pragma unroll
            for (int j = 0; j < 8; ++j) { const f32x4 a1 = *(const LAS f32x4*)(A1 + 4 * lane + 256 * j); xv[j] += a1 * (yv[j] * rstd);
                if (XOB) { v2u w; w.x = pk2(xv[j][0], xv[j][1]); w.y = pk2(xv[j][2], xv[j][3]); *(v2u*)((bf16*)xout_ + (size_t)row * D + 4 * lane + 256 * j) = w; }
                else *(f32x4*)((float*)xout_ + (size_t)row * D + 4 * lane + 256 * j) = xv[j]; }
        }
        if (HOUT) {
            float ss = 0.f;
#pragma unroll
            for (int j = 0; j < 8; ++j) ss += (xv[j][0] * xv[j][0] + xv[j][1] * xv[j][1]) + (xv[j][2] * xv[j][2] + xv[j][3] * xv[j][3]);
            const float rstd = 1.0f / sqrtf(wave_sum(ss) * (1.0f / D) + 1e-6f);
#pragma unroll
            for (int j = 0; j < 8; ++j) { const f32x4 a2 = *(const LAS f32x4*)(A2 + 4 * lane + 256 * j), b2 = *(const LAS f32x4*)(B2 + 4 * lane + 256 * j);
                xv[j] = (xv[j] * rstd) * a2 + b2;
                if (ROUTE) { *(unsigned*)((unsigned char*)hb + (size_t)row * D + 4 * lane + 256 * j) = pk4_fp8(xv[j][0] * MOE_HSCALE, xv[j][1] * MOE_HSCALE, xv[j][2] * MOE_HSCALE, xv[j][3] * MOE_HSCALE); }
                else { v2u w; w.x = pk2(xv[j][0], xv[j][1]); w.y = pk2(xv[j][2], xv[j][3]);
                *(v2u*)(hb + (size_t)row * D + 4 * lane + 256 * j) = w; } }
            if (ROUTE) {
                int i0 = -1, i1 = -1; float v0 = -3.0e38f, v1 = -3.0e38f;
#pragma nounroll
                for (int e = 0; e < NE; ++e) { float s = 0.f;
#pragma unroll
                    for (int j = 0; j < 8; ++j) { const f32x4 w = *(const LAS f32x4*)(RT + e * D + 4 * lane + 256 * j); s += (xv[j][0] * w[0] + xv[j][1] * w[1]) + (xv[j][2] * w[2] + xv[j][3] * w[3]); }
                    s = wave_sum(s);
                    if (s > v0) { v1 = v0; i1 = i0; v0 = s; i0 = e; } else if (s > v1) { v1 = s; i1 = e; } }
                const float g0 = 1.0f / (1.0f + fexp(v1 - v0)), g1 = 1.0f - g0;
                if (lane == 0) {
                    int* te = (int*)(F.ws + WS_ROUTE + RT_TOKE); float* tg = (float*)(F.ws + WS_ROUTE + RT_TOKG);
                    te[2 * row] = i0; te[2 * row + 1] = i1; tg[2 * row] = g0; tg[2 * row + 1] = g1;
                    unsigned* cnt = (unsigned*)(F.ws + WS_CTL) + CW_TBCNT + (row >> 6) * NE;
                    atomicAdd(cnt + i0, 1u); atomicAdd(cnt + i1, 1u);
                }
            }
        }
    }
}

__device__ __forceinline__ void moe_slots_phase(Frame& F) {
    LAS int* cntL = (LAS int*)F.lds;
    LAS int* tot = cntL + 2048;
    LAS int* base = tot + 8; LAS int* tbase = base + 8; LAS int* texpL = tbase + 16;
    const unsigned* cnt = (const unsigned*)(F.ws + WS_CTL) + CW_TBCNT;
    for (int i = F.tid; i < 2048; i += NWAVES * 64) cntL[i] = (int)cnt[i];
    __syncthreads();
    if (F.tid < NE) { int s = 0; for (int b = 0; b < 256; ++b) s += cntL[b * 8 + F.tid]; tot[F.tid] = s; }
    __syncthreads();
    if (F.tid == 0) { int b = 0, tb = 0; for (int e = 0; e < NE; ++e) { base[e] = b; tbase[e] = tb; const int nt = (tot[e] + 255) >> 8; for (int q = 0; q < nt; ++q) texpL[tb + q] = e; tb += nt; b += nt * 256; } tbase[NE] = tb; }
    __syncthreads();
    const int NT = tbase[NE];
    int* rowidx = (int*)(F.ws + WS_ROUTE + RT_ROWIDX); int* pos = (int*)(F.ws + WS_ROUTE + RT_POS);
    const int* te = (const int*)(F.ws + WS_ROUTE + RT_TOKE);
    if (blockIdx.x == 0) { int* texp = (int*)(F.ws + WS_ROUTE + RT_TEXP); for (int i = F.tid; i < NT; i += NWAVES * 64) texp[i] = texpL[i]; if (F.tid == 0) *(int*)(F.ws + WS_ROUTE + RT_NTILE) = NT; }
    LAS int* slotL = texpL + 160;
    const unsigned char* hb8 = (const unsigned char*)(F.ws + WS_HB); unsigned char* hs8 = (unsigned char*)(F.ws + R_HS8);
    for (int tb = blockIdx.x; tb < 256; tb += F.G) {
        if (F.wave == 0) {
            const int tok = tb * 64 + F.lane;
            const int e0 = te[2 * tok], e1 = te[2 * tok + 1];
            const unsigned long long lt = (F.lane == 0) ? 0ull : (~0ull >> (64 - F.lane));
#pragma unroll
            for (int e = 0; e < NE; ++e) {
                float pf = 0.f;
#pragma unroll
                for (int q = 0; q < 4; ++q) { const int b = 4 * F.lane + q; pf += (b < tb) ? (float)cntL[b * 8 + e] : 0.f; }
                const int pre = (int)wave_sum(pf);
                const unsigned long long m0 = __ballot(e0 == e), m1 = __ballot(e1 == e);
                const int st = base[e] + pre;
                if (e0 == e) { const int s = st + __popcll(m0 & lt); rowidx[s] = tok; pos[2 * tok] = s; slotL[2 * F.lane] = s; }
                if (e1 == e) { const int s = st + __popcll(m0) + __popcll(m1 & lt); rowidx[s] = tok; pos[2 * tok + 1] = s; slotL[2 * F.lane + 1] = s; }
            }
        }
        __syncthreads();
        for (int idx = F.tid; idx < 128 * 128; idx += NWAVES * 64) { const int si = idx >> 7, ch = idx & 127;
            const v4u v = *(const v4u*)(hb8 + (size_t)(tb * 64 + (si >> 1)) * D + ch * 16);
            *(v4u*)(hs8 + (size_t)slotL[si] * D + ch * 16) = v; }
        __syncthreads();
    }
}
__device__ __forceinline__ void conv_phase(Frame& F) {
    const Args& A = *F.a;
    const bf16* z = (const bf16*)(F.ws + R_Z); bf16* mix = (bf16*)(F.ws + R_MIX);
    LAS unsigned char* gl = F.lds;
    LAS float* part = (LAS float*)(F.lds + 126976);
    LAS float* stat = part + 512;
    const int tid = F.tid, ch = 2 * tid;
    f32x2 wk[CONVW];
#pragma unroll
    for (int w = 0; w < CONVW; ++w) wk[w] = *(const f32x2*)(A.in[I_ECW] + w * CONVD + ch);
    const f32x2 cb = *(const f32x2*)(A.in[I_ECB] + ch), lg = *(const f32x2*)(A.in[I_ECG] + ch), lb = *(const f32x2*)(A.in[I_ECLB] + ch);
    for (int tile = blockIdx.x; tile < S / 32; tile += F.G) {
        const int t0 = tile * 32;
        for (int idx = tid; idx < 62 * 128; idx += NWAVES * 64) {
            const int row = idx >> 7, c8 = (idx & 127) * 8, t = t0 - 15 + row;
            v4u o = {0u, 0u, 0u, 0u};
            if (t >= 0 && t < S) {
                const v4u a = *(const v4u*)(z + (size_t)t * E_IN + c8), g = *(const v4u*)(z + (size_t)t * E_IN + CONVD + c8);
#pragma unroll
                for (int q = 0; q < 4; ++q) o[q] = pk2(bflo(a[q]) * fsigmoid(bflo(g[q])), bfhi(a[q]) * fsigmoid(bfhi(g[q])));
            }
            *(LAS v4u*)(gl + row * 2048 + c8 * 2) = o;
        }
        __syncthreads();
#pragma nounroll
        for (int half = 0; half < 2; ++half) {
            f32x2 ac[16];
#pragma unroll
            for (int i = 0; i < 16; ++i) ac[i] = cb;
            const LAS unsigned char* gh = gl + half * 16 * 2048 + tid * 4;
#pragma unroll
            for (int r = 0; r < 46; ++r) {
                const unsigned v = *(const LAS unsigned*)(gh + r * 2048);
                const f32x2 v2 = {bflo(v), bfhi(v)};
#pragma unroll
                for (int i = 0; i < 16; ++i) { if (r - i >= 0 && r - i < CONVW) ac[i] = __builtin_elementwise_fma(v2, wk[r - i], ac[i]); }
            }
            float a0[16], a1[16];
#pragma unroll
            for (int i = 0; i < 16; ++i) { a0[i] = ac[i][0]; a1[i] = ac[i][1]; }
#pragma unroll
            for (int i = 0; i < 16; ++i) {
                float s1 = a0[i] + a1[i], s2 = a0[i] * a0[i] + a1[i] * a1[i];
                s1 = wave_sum(s1); s2 = wave_sum(s2);
                if (F.lane == 0) { part[(F.wave * 16 + i) * 2] = s1; part[(F.wave * 16 + i) * 2 + 1] = s2; }
            }
            __syncthreads();
            if (tid < 16) { float s1 = 0.f, s2 = 0.f;
#pragma unroll
                for (int w = 0; w < NWAVES; ++w) { s1 += part[(w * 16 + tid) * 2]; s2 += part[(w * 16 + tid) * 2 + 1]; }
                const float mean = s1 * (1.0f / CONVD), var = fmaxf(s2 * (1.0f / CONVD) - mean * mean, 0.f);
                stat[tid * 2] = mean; stat[tid * 2 + 1] = 1.0f / sqrtf(var + 1e-5f); }
            __syncthreads();
#pragma unroll
            for (int i = 0; i < 16; ++i) {
                const float mean = stat[i * 2], rstd = stat[i * 2 + 1];
                const float y0 = (a0[i] - mean) * rstd * lg[0] + lb[0], y1 = (a1[i] - mean) * rstd * lg[1] + lb[1];
                *(unsigned*)(mix + (size_t)(t0 + half * 16 + i) * D + ch) = pk2(fsilu(y0), fsilu(y1));
            }
            __syncthreads();
        }
    }
}

__device__ __forceinline__ int t5_bucket_dev(int rel) {
    const int n = rel < 0 ? -rel : rel;
    int large = 8 + (int)(__logf((float)(n < 1 ? 1 : n) * 0.125f) / 4.852030263919617f * 8.0f);
    large = large < 15 ? large : 15;
    return (rel > 0 ? 16 : 0) + (n < 8 ? n : large);
}
__device__ __forceinline__ void latent_phase(Frame& F) {
    const Args& A = *F.a; const int lane = F.lane;
    const bf16* z1 = (const bf16*)(F.ws + R_Z1); bf16* cqn = (bf16*)(F.ws + R_CQN); bf16* ckvn = (bf16*)(F.ws + R_CKVN); bf16* kpe = (bf16*)(F.ws + R_KPE);
    const float* cosT = (const float*)(F.ws + WS_COS); const float* sinT = (const float*)(F.ws + WS_SIN);
    float qg[8]; { const f32x4 a = *(const f32x4*)(A.in[I_QNG] + 8 * lane), b = *(const f32x4*)(A.in[I_QNG] + 8 * lane + 4); qg[0] = a[0]; qg[1] = a[1]; qg[2] = a[2]; qg[3] = a[3]; qg[4] = b[0]; qg[5] = b[1]; qg[6] = b[2]; qg[7] = b[3]; }
    const f32x2 kg = *(const f32x2*)(A.in[I_KVNG] + 2 * lane);
    for (int row = F.gw; row < S; row += F.NGW) {
        const bf16* zr = z1 + (size_t)row * O_INP;
        const v4u q = *(const v4u*)(zr + 8 * lane);
        float v[8]; float ss = 0.f;
#pragma unroll
        for (int e = 0; e < 4; ++e) { v[2 * e] = bflo(q[e]); v[2 * e + 1] = bfhi(q[e]); ss += v[2 * e] * v[2 * e] + v[2 * e + 1] * v[2 * e + 1]; }
        const float r1 = 1.0f / sqrtf(wave_sum(ss) * (1.0f / QL) + 1e-6f);
        v4u o;
#pragma unroll
        for (int e = 0; e < 4; ++e) o[e] = pk2(v[2 * e] * r1 * qg[2 * e], v[2 * e + 1] * r1 * qg[2 * e + 1]);
        *(v4u*)(cqn + (size_t)row * QL + 8 * lane) = o;
        const unsigned kv = *(const unsigned*)(zr + 512 + 2 * lane);
        const float k0 = bflo(kv), k1 = bfhi(kv);
        const float r2 = 1.0f / sqrtf(wave_sum(k0 * k0 + k1 * k1) * (1.0f / KVL) + 1e-6f);
        *(unsigned*)(ckvn + (size_t)row * KVLP + 2 * lane) = pk2(k0 * r2 * kg[0], k1 * r2 * kg[1]);
        if (lane < 32) {
            const float x1 = bf1(zr[640 + lane]), x2 = bf1(zr[672 + lane]), cs = cosT[row * 32 + lane], sn = sinT[row * 32 + lane];
            kpe[(size_t)row * 64 + lane] = (bf16)f2bf(x1 * cs - x2 * sn); kpe[(size_t)row * 64 + 32 + lane] = (bf16)f2bf(x2 * cs + x1 * sn);
        }
    }
}

namespace s5 {
using bf16x8 = __attribute__((ext_vector_type(8))) short;
using f32x16 = __attribute__((ext_vector_type(16))) float;
constexpr int XS_ROW = 272;
constexpr int WAVE_LDS = 32 * XS_ROW + 2 * S5_CL * 16 * 2;
struct Par { float ar0, ai0, ar1, ai1, Lr0, Li0, Lr1, Li1; bf16x8 bt[4]; };
__device__ __forceinline__ void load_par(Frame& F, int dg, int n, int hb, Par& P) {
    const float* sp = (const float*)(F.ws + WS_S5P) + (size_t)dg * 36 * 64;
    P.ar0 = sp[n]; P.ai0 = sp[64 + n]; P.Lr0 = sp[128 + n]; P.Li0 = sp[192 + n];
    P.ar1 = sp[32 + n]; P.ai1 = sp[64 + 32 + n]; P.Lr1 = sp[128 + 32 + n]; P.Li1 = sp[192 + 32 + n];
#pragma unroll
    for (int t = 0; t < 4; ++t) { const float* b = sp + (size_t)((t < 2 ? 4 : 20) + 8 * hb) * 64 + 32 * (t & 1) + n;
        v4u w; w.x = pk2(b[0], b[64]); w.y = pk2(b[128], b[192]); w.z = pk2(b[256], b[320]); w.w = pk2(b[384], b[448]); P.bt[t] = __builtin_bit_cast(bf16x8, w); }
}
__device__ __forceinline__ int tok_of(int c0, int sp, int dir) { return dir ? (c0 + S5_CL - 1 - sp) : (c0 + sp); }
__device__ __forceinline__ void bu_block(Frame& F, const Par& P, int g, int ck, int blk, int dir, int lane, f32x16 (&D)[4]) {
    const bf16* z1 = (const bf16*)(F.ws + R_Z1);
    const int m = lane & 31, ha = lane >> 5, seg = (m >> 2) & 1, idx = 4 * (m >> 3) + (m & 3);
    const int t = tok_of((ck + 64 * seg) * S5_CL, 16 * blk + idx, dir);
    const bf16x8 ua = *(const bf16x8*)(z1 + (size_t)t * O_INP + 704 + g * 16 + 8 * ha);
#pragma unroll
    for (int q = 0; q < 4; ++q) D[q] = __builtin_amdgcn_mfma_f32_32x32x16_bf16(ua, P.bt[q], f32x16{}, 0, 0, 0);
}
__device__ __forceinline__ void scan16(const Par& P, f32x16 (&D)[4], float& x0r, float& x0i, float& x1r, float& x1i) {
#pragma unroll
    for (int r = 0; r < 16; ++r) {
        const float n0r = fmaf(P.ar0, x0r, fmaf(-P.ai0, x0i, D[0][r])), n0i = fmaf(P.ar0, x0i, fmaf(P.ai0, x0r, D[2][r]));
        const float n1r = fmaf(P.ar1, x1r, fmaf(-P.ai1, x1i, D[1][r])), n1i = fmaf(P.ar1, x1i, fmaf(P.ai1, x1r, D[3][r]));
        x0r = n0r; x0i = n0i; x1r = n1r; x1i = n1i; D[0][r] = n0r; D[2][r] = n0i; D[1][r] = n1r; D[3][r] = n1i; }
}
}

__device__ __forceinline__ void s5_pass1(Frame& F) {
    using namespace s5;
    float* E = (float*)(F.ws + WS_S5E);
    const int lane = F.lane, n = lane & 31, hd = lane >> 5;
    for (int task = F.gw; task < 32 * 64; task += F.NGW) {
        const int g = task >> 6, ck = task & 63;
        for (int dir = 0; dir < 2; ++dir) {
            Par P; load_par(F, dir * 32 + g, n, hd, P);
            float x0r = 0.f, x0i = 0.f, x1r = 0.f, x1i = 0.f;
            for (int blk = 0; blk < S5_CL / 16; ++blk) { f32x16 D[4]; bu_block(F, P, g, ck, blk, dir, lane, D); scan16(P, D, x0r, x0i, x1r, x1i); }
            float* e = E + ((size_t)((dir * 32 + g) * S5_NCH + ck + 64 * hd) * 2) * 64 + n;
            e[0] = x0r; e[64] = x0i; e[32] = x1r; e[96] = x1i;
        }
    }
}
__device__ __forceinline__ float gelu_tanh(float x) { const float u = 0.7978845608028654f * (x + 0.044715f * x * x * x); const float t = 1.0f - 2.0f * __builtin_amdgcn_rcpf(1.0f + fexp(2.0f * u)); return 0.5f * x * (1.0f + t); }
__device__ __forceinline__ void s5_pass3(Frame& F) {
    using namespace s5;
    const Args& A = *F.a;
    LAS unsigned char* xs = F.lds + F.wave * WAVE_LDS; LAS bf16* yfl = (LAS bf16*)(xs + 32 * XS_ROW);
    const float* E = (const float*)(F.ws + WS_S5E); bf16* YG = (bf16*)(F.ws + R_YG); const bf16* z1 = (const bf16*)(F.ws + R_Z1);
    const int lane = F.lane, n = lane & 31, hd = lane >> 5, cn = lane & 15, kq = lane >> 4;
    for (int task = F.gw; task < 32 * 64; task += F.NGW) {
        const int g = task >> 6, ck = task & 63, ckl = ck + 64 * hd;
        const float dsk = A.in[I_SD][g * 16 + cn];
        for (int dir = 0; dir < 2; ++dir) {
            const int dg = dir * 32 + g;
            Par P; load_par(F, dg, n, hd, P);
            float x0r = 0.f, x0i = 0.f, x1r = 0.f, x1i = 0.f;
            { const float* e = E + ((size_t)dg * S5_NCH * 2) * 64 + n; const int nprev = dir ? (S5_NCH - 1 - ckl) : ckl;
              const int nmax = dir ? (S5_NCH - 1 - ck) : (ck + 64);
              for (int j0 = 0; j0 < nmax; j0 += 8) {
                  float er0[8], ei0[8], er1[8], ei1[8];
#pragma unroll
                  for (int q = 0; q < 8; ++q) { const int jj = (j0 + q < nprev) ? (j0 + q) : 0; const int j = dir ? (S5_NCH - 1 - jj) : jj; const float* ej = e + (size_t)j * 128;
                      er0[q] = ej[0]; ei0[q] = ej[64]; er1[q] = ej[32]; ei1[q] = ej[96]; }
#pragma unroll
                  for (int q = 0; q < 8; ++q) { if (j0 + q < nprev) {
                      const float a = P.Lr0 * x0r - P.Li0 * x0i + er0[q], b = P.Lr0 * x0i + P.Li0 * x0r + ei0[q]; x0r = a; x0i = b;
                      const float c = P.Lr1 * x1r - P.Li1 * x1i + er1[q], d = P.Lr1 * x1i + P.Li1 * x1r + ei1[q]; x1r = c; x1i = d; } }
              } }
            bf16x8 Bc[4];
#pragma unroll
            for (int ks = 0; ks < 4; ++ks) { const int p0 = ks * 16 + kq * 4;
                const f32x4 cr = *(const f32x4*)(A.in[I_SCRE] + ((size_t)dg * 16 + cn) * 64 + p0), ci = *(const f32x4*)(A.in[I_SCIM] + ((size_t)dg * 16 + cn) * 64 + p0);
                v4u w; w.x = pk2(cr[0], -ci[0]); w.y = pk2(cr[1], -ci[1]); w.z = pk2(cr[2], -ci[2]); w.w = pk2(cr[3], -ci[3]); Bc[ks] = __builtin_bit_cast(bf16x8, w); }
            for (int blk = 0; blk < S5_CL / 16; ++blk) {
                f32x16 D[4]; bu_block(F, P, g, ck, blk, dir, lane, D); scan16(P, D, x0r, x0i, x1r, x1i);
#pragma unroll
                for (int r = 0; r < 16; ++r) { LAS unsigned char* row = xs + (16 * hd + r) * XS_ROW + 4 * n;
                    *(LAS unsigned*)row = pg8::cvt_pk_bf16(D[0][r], D[2][r]); *(LAS unsigned*)(row + 128) = pg8::cvt_pk_bf16(D[1][r], D[3][r]); }
#pragma unroll
                for (int sg = 0; sg < 2; ++sg) {
                    pg8::f32x4 acc = {0.f, 0.f, 0.f, 0.f};
#pragma unroll
                    for (int ks = 0; ks < 4; ++ks) { const bf16x8 af = *(const LAS bf16x8*)(xs + (16 * sg + cn) * XS_ROW + (ks * 32 + kq * 8) * 2);
                        acc = __builtin_amdgcn_mfma_f32_16x16x32_bf16(af, Bc[ks], acc, 0, 0, 0); }
#pragma unroll
                    for (int i = 0; i < 4; ++i) { const int sp = 16 * blk + 4 * kq + i; const int c0 = (ck + 64 * sg) * S5_CL; const int t = tok_of(c0, sp, dir), tl = t - c0;
                        if (dir == 0) yfl[(sg * S5_CL + tl) * 16 + cn] = (bf16)f2bf(acc[i]);
                        else { const float uu = bf1(z1[(size_t)t * O_INP + 704 + g * 16 + cn]); const float yv = acc[i] + bf1(yfl[(sg * S5_CL + tl) * 16 + cn]) + dsk * uu;
                            YG[(size_t)t * S5D + g * 16 + cn] = (bf16)f2bf(gelu_tanh(yv)); } }
                }
            }
        }
        LDS_WAIT();
    }
}
namespace dil {
using bf16x8 = __attribute__((ext_vector_type(8))) short;
using s16x4  = __attribute__((ext_vector_type(4))) short;
using f32x16 = __attribute__((ext_vector_type(16))) float;
using u32x4  = __attribute__((ext_vector_type(4))) unsigned;
constexpr int K_OFF = 0, V_OFF = 49152, BT_OFF = 98304, LI_OFF = 99328;
constexpr int NUNITS = 3 * 1024;
__device__ __forceinline__ int crow(int r, int hi) { return (r & 3) + 8 * (r >> 2) + 4 * hi; }
__device__ __forceinline__ unsigned cvtpk(float lo, float hi) { unsigned r; asm volatile("v_cvt_pk_bf16_f32 %0, %1, %2" : "=v"(r) : "v"(lo), "v"(hi)); return r; }
template <int OFF> __device__ __forceinline__ s16x4 tr_read(int vb) {
  s16x4 r; asm volatile("ds_read_b64_tr_b16 %0, %1 offset:%2" : "=&v"(r) : "v"(vb), "i"(OFF) : "memory"); return r;
}
struct UnitId { int c, d, r, qb, h, sub; };
__device__ __forceinline__ UnitId decode(int u) {
    UnitId U; U.c = u >> 10; const int rem = u & 1023; U.h = rem & 15; const int blk = rem >> 4;
    U.d = (U.c == 0) ? 1 : (U.c == 1) ? 4 : 16; U.sub = S / U.d; const int bpr = U.sub >> 8;
    U.r = blk / bpr; U.qb = blk - U.r * bpr; return U;
}
}

__device__ __forceinline__ void dilattn2_phase(Frame& F) {
    using namespace dil;
    const Args& A = *F.a;
    unsigned char* wsl = F.ws; int lane_l = F.lane, tid_l = F.tid; asm volatile("" : "+s"(wsl), "+v"(lane_l), "+v"(tid_l));
    const bf16* z = (const bf16*)(wsl + R_Z);
    bf16* PO = (bf16*)(wsl + R_PO); float* PML = (float*)(wsl + R_PML);
    LAS unsigned char* lds = F.lds;
    const int tid = tid_l, lane = lane_l, w = F.wave, r32 = lane & 31, hi = lane >> 5;
    for (int u = F.vcu; u < NUNITS; u += F.G) {
        const UnitId U = decode(u);
        const int d = U.d, h = U.h, sub = U.sub;
        {
            v4u kk[6], vv[6];
#pragma unroll
            for (int i = 0; i < 6; ++i) { const int idx = tid + 512 * i, key = idx >> 3, ch = idx & 7, sp = U.qb * 256 - 64 + key;
                kk[i] = (v4u){0u, 0u, 0u, 0u}; vv[i] = (v4u){0u, 0u, 0u, 0u};
                if (sp >= 0 && sp < sub) { const bf16* rp = z + ((size_t)sp * d + U.r) * E_IN + h * 64 + ch * 8; kk[i] = *(const v4u*)(rp + 3072); vv[i] = *(const v4u*)(rp + 4096); } }
#pragma unroll
            for (int i = 0; i < 6; ++i) { const int idx = tid + 512 * i, key = idx >> 3, ch = idx & 7;
                *(LAS v4u*)(lds + K_OFF + key * 128 + ((ch * 16) ^ (((key >> 1) & 7) << 4))) = kk[i];
                *(LAS v4u*)(lds + V_OFF + key * 128 + ((ch * 16) ^ (((key >> 1) & 1) << 6))) = vv[i]; }
            if (tid < 256) ((LAS float*)(lds + BT_OFF))[tid] = (tid >= 32 && tid < 161) ? A.in[I_T5][t5_bucket_dev(d * (tid - 96)) * DIL_H + h] * 1.4426950408889634f : -1e30f;
        }
        __syncthreads();
        f32x16 p[5];
        {
            const size_t qtok = (size_t)(U.qb * 256 + 32 * w + r32) * d + U.r;
            const bf16* qp = z + qtok * E_IN + 2048 + h * 64 + hi * 8;
            bf16x8 qf[4];
#pragma unroll
            for (int ks = 0; ks < 4; ++ks) qf[ks] = *(const bf16x8*)(qp + ks * 16);
            int ka[4];
#pragma unroll
            for (int ks = 0; ks < 4; ++ks) ka[ks] = K_OFF + (32 * w + r32) * 128 + ((ks * 32 + hi * 16) ^ (((r32 >> 1) & 7) << 4));
#pragma unroll
            for (int kt = 0; kt < 5; ++kt) { p[kt] = f32x16{};
#pragma unroll
                for (int ks = 0; ks < 4; ++ks) { const bf16x8 kf = *(const LAS bf16x8*)(lds + ka[ks] + kt * 4096); p[kt] = __builtin_amdgcn_mfma_f32_32x32x16_bf16(kf, qf[ks], p[kt], 0, 0, 0); } }
        }
        const int bidx = 4 * hi - r32;
        const int sp0 = U.qb * 256 + 32 * w - 64 + 4 * hi;
        const LAS float* btl = (const LAS float*)(lds + BT_OFF) + 32 + bidx;
        const bool edge = (U.qb * 256 + 32 * w - 64 < 0) || (U.qb * 256 + 32 * w + 96 > sub);
        constexpr float SC = 0.125f * 1.4426950408889634f;
#pragma unroll
        for (int kt = 0; kt < 5; ++kt)
#pragma unroll
            for (int rg = 0; rg < 16; ++rg) { const int cr = 32 * kt + (rg & 3) + 8 * (rg >> 2);
                float s = fmaf(p[kt][rg], SC, btl[cr]);
                p[kt][rg] = s; }
        if (edge) {
#pragma unroll
            for (int kt = 0; kt < 5; ++kt)
#pragma unroll
                for (int rg = 0; rg < 16; ++rg) { const int cr = 32 * kt + (rg & 3) + 8 * (rg >> 2); const int sp = sp0 + cr; p[kt][rg] = (sp >= 0 && sp < sub) ? p[kt][rg] : -1e30f; }
        }
        float m2 = p[0][0];
#pragma unroll
        for (int kt = 0; kt < 5; ++kt)
#pragma unroll
            for (int rg = 0; rg < 16; ++rg) m2 = fmaxf(m2, p[kt][rg]);
        { auto rr = __builtin_amdgcn_permlane32_swap(__float_as_uint(m2), __float_as_uint(m2), false, false); m2 = fmaxf(__uint_as_float(rr[0]), __uint_as_float(rr[1])); }
        float l = 0.f;
#pragma unroll
        for (int kt = 0; kt < 5; ++kt)
#pragma unroll
            for (int rg = 0; rg < 16; ++rg) { const float e = __builtin_amdgcn_exp2f(p[kt][rg] - m2); p[kt][rg] = e; l += e; }
        { auto rr = __builtin_amdgcn_permlane32_swap(__float_as_uint(l), __float_as_uint(l), false, false); l = __uint_as_float(rr[0]) + __uint_as_float(rr[1]); }
        f32x16 o0 = {}, o1 = {};
        {
            const int q = (lane >> 2) & 3, pp = lane & 3, nh = (lane >> 4) & 1, qb1 = (q >> 1) & 1;
            const int vrow = V_OFF + (32 * w + 8 * hi + q) * 128;
            const int vb0 = (int)(uintptr_t)lds + vrow + ((32 * nh + 8 * pp) ^ (qb1 << 6));
            const int vb1 = (int)(uintptr_t)lds + vrow + ((64 + 32 * nh + 8 * pp) ^ (qb1 << 6));
#define DIL_PK4(P, BASE, OUT) do { unsigned a0 = cvtpk(P[BASE + 0], P[BASE + 1]), a1 = cvtpk(P[BASE + 2], P[BASE + 3]); unsigned b0 = cvtpk(P[BASE + 4], P[BASE + 5]), b1 = cvtpk(P[BASE + 6], P[BASE + 7]); \
    auto r0 = __builtin_amdgcn_permlane32_swap(a0, b0, false, false); auto r1 = __builtin_amdgcn_permlane32_swap(a1, b1, false, false); \
    u32x4 wv = {r0[0], r1[0], r0[1], r1[1]}; OUT = *reinterpret_cast<bf16x8*>(&wv); } while (0)
#define DIL_PK(L, H) (bf16x8){L[0], L[1], L[2], L[3], H[0], H[1], H[2], H[3]}
#define DIL_PV(KT) do { bf16x8 pa0, pa1; DIL_PK4(p[KT], 0, pa0); DIL_PK4(p[KT], 8, pa1); \
    const s16x4 l00 = tr_read<(KT) * 4096>(vb0), h00 = tr_read<(KT) * 4096 + 512>(vb0), l01 = tr_read<(KT) * 4096>(vb1), h01 = tr_read<(KT) * 4096 + 512>(vb1); \
    const s16x4 l10 = tr_read<(KT) * 4096 + 2048>(vb0), h10 = tr_read<(KT) * 4096 + 2048 + 512>(vb0), l11 = tr_read<(KT) * 4096 + 2048>(vb1), h11 = tr_read<(KT) * 4096 + 2048 + 512>(vb1); \
    asm volatile("s_waitcnt lgkmcnt(0)" ::: "memory"); __builtin_amdgcn_sched_barrier(0); \
    o0 = __builtin_amdgcn_mfma_f32_32x32x16_bf16(pa0, DIL_PK(l00, h00), o0, 0, 0, 0); o1 = __builtin_amdgcn_mfma_f32_32x32x16_bf16(pa0, DIL_PK(l01, h01), o1, 0, 0, 0); \
    o0 = __builtin_amdgcn_mfma_f32_32x32x16_bf16(pa1, DIL_PK(l10, h10), o0, 0, 0, 0); o1 = __builtin_amdgcn_mfma_f32_32x32x16_bf16(pa1, DIL_PK(l11, h11), o1, 0, 0, 0); } while (0)
            DIL_PV(0); DIL_PV(1); DIL_PV(2); DIL_PV(3); DIL_PV(4);
#undef DIL_PV
#undef DIL_PK
#undef DIL_PK4
        }
        LAS float* li = (LAS float*)(lds + LI_OFF) + w * 32;
        if (hi == 0) { li[r32] = l;
            const size_t tok = (size_t)(U.qb * 256 + 32 * w + r32) * d + U.r;
            *(f32x2*)(PML + (((size_t)U.c * S + tok) * DIL_H + h) * 2) = (f32x2){m2 * 0.6931471805599453f, l}; }
        LDS_WAIT();
#pragma unroll
        for (int rg = 0; rg < 16; ++rg) { const int qi = crow(rg, hi); const float rl = __builtin_amdgcn_rcpf(li[qi]);
            const size_t tok = (size_t)(U.qb * 256 + 32 * w + qi) * d + U.r;
            bf16* op = PO + ((size_t)U.c * S + tok) * 1024 + h * 64 + r32;
            op[0] = (bf16)f2bf(o0[rg] * rl); op[32] = (bf16)f2bf(o1[rg] * rl); }
        __syncthreads();
    }
}
__device__ __forceinline__ void dil_combine_phase(Frame& F) {
    const bf16* PO = (const bf16*)(F.ws + R_PO); const float* PML = (const float*)(F.ws + R_PML); bf16* mix = (bf16*)(F.ws + R_MIX);
    for (int idx = F.gw * 64 + F.lane; idx < S * 128; idx += F.NGW * 64) {
        const int tok = idx >> 7, ch = idx & 127, h = ch >> 3;
        f32x2 ml[3]; v4u ov[3];
#pragma unroll
        for (int c = 0; c < 3; ++c) { ml[c] = *(const f32x2*)(PML + (((size_t)c * S + tok) * DIL_H + h) * 2); ov[c] = *(const v4u*)(PO + ((size_t)c * S + tok) * 1024 + ch * 8); }
        const float M = fmaxf(ml[0][0], fmaxf(ml[1][0], ml[2][0]));
        float wc[3], ws = 0.f;
#pragma unroll
        for (int c = 0; c < 3; ++c) { wc[c] = ml[c][1] * fexp(ml[c][0] - M); ws += wc[c]; }
        const float rw = 1.0f / ws;
        v4u o;
#pragma unroll
        for (int e = 0; e < 4; ++e) { float a = 0.f, b = 0.f;
#pragma unroll
            for (int c = 0; c < 3; ++c) { a += wc[c] * bflo(ov[c][e]); b += wc[c] * bfhi(ov[c][e]); }
            o[e] = pk2(a * rw, b * rw); }
        *(v4u*)(mix + (size_t)tok * D + 1024 + ch * 8) = o;
    }
}
#ifndef MK_N_LAUNCHES
#define MK_N_LAUNCHES 1
#endif
constexpr int NPH = 20;
__global__ void __launch_bounds__(NWAVES * 64, 2) mk_fwd(Args args) {
    extern __shared__ __attribute__((aligned(16))) unsigned char lds_raw[];
    Frame F;
    F.lds = (LAS unsigned char*)lds_raw; F.a = &args; F.ws = args.ws;
    F.tid = threadIdx.x; F.lane = F.tid & 63; F.wave = __builtin_amdgcn_readfirstlane(F.tid >> 6);
    F.G = gridDim.x; { const int bx = blockIdx.x; F.vcu = (F.G % 8 == 0) ? (bx % 8) * (F.G / 8) + bx / 8 : bx; }
    F.gw = F.vcu * NWAVES + F.wave; F.NGW = F.G * NWAVES;
    volatile LAS unsigned* MISC = (volatile LAS unsigned*)(F.lds + MISC_OFF);
    for (int u = F.tid; u < 128; u += NWAVES * 64) MISC[u] = 0u;
    __syncthreads();
    XcdBarrier bar; bar.bar = (unsigned*)(F.ws + WS_CTL) + CW_BAR; bar.x = 0; bar.st = nullptr;
    if (MK_N_LAUNCHES == 1) bar = xcd_barrier_post((unsigned*)(F.ws + WS_CTL) + CW_BAR, MISC + 8);
    const int lo = args.ph_lo, hi = args.ph_hi;
#ifndef PH_MASK
#define PH_MASK 0xFFFFFFFFu
#endif
#define IN(k) (((PH_MASK >> (k)) & 1u) && lo <= (k) && (k) < hi)
#ifndef PH_TWICE
#define PH_TWICE 0u
#endif
#define TW(k) (((PH_TWICE >> (k)) & 1u) != 0u)
#define REP(k)
#define RB(k)
#define REFRESH() do { int t_ = (int)threadIdx.x; asm volatile("" : "+v"(t_)); F.tid = t_; F.lane = t_ & 63; } while (0)
#ifdef SPREAD_MASK
#define SEAM(k) do { if (IN(k) && IN((k) + 1)) { __syncthreads(); unsigned long long* W_ = (unsigned long long*)(F.ws + WS_CTL + 131072) + 4 * (k); \
        if (threadIdx.x == 0 && ((SPREAD_MASK >> (k)) & 1u)) { const unsigned long long t_ = __builtin_amdgcn_s_memrealtime(); atomicMax(W_, t_); atomicAdd(W_ + 1, t_); } \
        xcd_barrier(bar); \
        if (threadIdx.x == 0 && ((SPREAD_MASK >> (k)) & 1u)) { const unsigned long long t0_ = __builtin_amdgcn_s_memrealtime(); \
            const unsigned long long mx_ = __hip_atomic_load(W_, __ATOMIC_RELAXED, __HIP_MEMORY_SCOPE_AGENT), sm_ = __hip_atomic_load(W_ + 1, __ATOMIC_RELAXED, __HIP_MEMORY_SCOPE_AGENT); \
            const long long d_ = (long long)(mx_ - sm_ / (unsigned long long)F.G) * SPREAD_MULT; \
            while ((long long)(__builtin_amdgcn_s_memrealtime() - t0_) < d_) __builtin_amdgcn_s_sleep(8); } \
        __syncthreads(); } else __syncthreads(); } while (0)
#elif defined(DOUBLE_BARRIERS)
#define SEAM(k) do { if (IN(k) && IN((k) + 1)) { xcd_barrier(bar); xcd_barrier(bar); } else __syncthreads(); } while (0)
#else
#define SEAM(k) do { if (IN(k) && IN((k) + 1)) xcd_barrier(bar); else __syncthreads(); } while (0)
#endif
    typedef pg8::bf16_t b16;
    const float* x_in = args.in[I_X]; float* xo = args.out;
    b16* Y = (b16*)(F.ws + WS_Y); b16* HB = (b16*)(F.ws + WS_HB); b16* XB = (b16*)(F.ws + WS_XB);
    const int bid = (int)blockIdx.x;

    if (IN(0)) REP(0) { REFRESH(); p0_prologue(F); RB(0); } SEAM(0);
    if (IN(1)) { REFRESH(); resnorm_phase<false, true, false, false>(F, x_in, nullptr, nullptr, 0, 0, 0, 0, 0, 0); } SEAM(1);
    if (IN(2)) REP(2) { REFRESH(); pg8::Gemm g{HB, (const b16*)(F.ws + WB_EIN), D}; pg8::StaticOrder so; so.init(S / 256, E_IN / 256, F.G, bid);
        pg8::EpiBf16 E{(b16*)(F.ws + R_Z), E_IN}; pg8::gemm_phase(F.lds, g, so, E); RB(2); } SEAM(2);
    if (IN(3)) REP(3) { REFRESH(); conv_phase(F); __syncthreads(); dilattn2_phase(F); RB(3); } SEAM(3);
    if (IN(4)) REP(4) { REFRESH(); dil_combine_phase(F); RB(4); } SEAM(4);
    if (IN(5)) REP(5) { REFRESH(); pg8::Gemm g{(const b16*)(F.ws + R_MIX), (const b16*)(F.ws + WB_EOUT), D}; pg8::StaticOrder so; so.init(S / 256, D / 256, F.G, bid);
        pg8::EpiBf16 E{Y, D}; pg8::gemm_phase(F.lds, g, so, E); RB(5); } SEAM(5);
    if (IN(6)) { REFRESH(); resnorm_phase<true, true, false, false, false, true>(F, x_in, XB, Y, 0, 2, 1, 0, 3, 2); } SEAM(6);
    if (IN(7)) REP(7) { REFRESH(); pg8::Gemm g{HB, (const b16*)(F.ws + WB_EF13), D}; pg8::StaticOrder so; so.init(S / 256, 2 * FD / 256, F.G, bid);
        pg8::EpiSwiGLU E{(b16*)(F.ws + R_ACT), FD}; pg8::gemm_phase(F.lds, g, so, E); RB(7); } SEAM(7);
    if (IN(8)) REP(8) { REFRESH(); pg8::Gemm g{(const b16*)(F.ws + R_ACT), (const b16*)(F.ws + WB_EF2), FD}; pg8::StaticOrder so; so.init(S / 256, D / 256, F.G, bid);
        pg8::EpiBf16 E{Y, D}; pg8::gemm_phase(F.lds, g, so, E); RB(8); } SEAM(8);
    if (IN(9)) { REFRESH(); resnorm_phase<true, true, false, false, true, true>(F, XB, XB, Y, 0, 5, 3, 1, 0, 0); } SEAM(9);
    if (IN(10)) REP(10) { REFRESH(); pg8::Gemm g{HB, (const b16*)(F.ws + WB_OIN), D}; pg8::StaticOrder so; so.init(S / 256, O_INP / 256, F.G, bid);
        pg8::EpiBf16 E{(b16*)(F.ws + R_Z1), O_INP}; pg8::gemm_phase(F.lds, g, so, E); RB(10); } SEAM(10);
    if (IN(11)) REP(11) { REFRESH(); latent_phase(F); s5_pass1(F); RB(11); } SEAM(11);
    if (IN(12)) REP(12) { REFRESH();
        { pg8::Gemm g{(const b16*)(F.ws + R_CQN), (const b16*)(F.ws + WB_UQ), QL}; pg8::StaticOrder so; so.init(S / 256, NQ / 256, F.G, bid);
          pg8::EpiBf16 E{(b16*)(F.ws + R_Q), NQ, mla2::SCALE * 1.4426950408889634f}; pg8::gemm_phase(F.lds, g, so, E); }
        { int kvk = KVLP; asm volatile("" : "+s"(kvk));
          pg8::Gemm g{(const b16*)(F.ws + R_CKVN), (const b16*)(F.ws + WB_UKV), kvk}; pg8::StaticOrder so; so.init(S / 256, NKV / 256, F.G, bid);
          pg8::EpiBf16 E{(b16*)(F.ws + R_KV), NKV}; pg8::gemm_phase(F.lds, g, so, E); }
        __syncthreads();
        s5_pass3(F);
    RB(12); } SEAM(12);
    if (IN(13)) REP(13) { REFRESH();
        mla2::CvJob J{args.in[I_M1], args.in[I_M3], args.in[I_M2], (unsigned char*)(F.ws + WB_M13), (unsigned char*)(F.ws + WB_M2), MOE_WSCALE, F.gw, F.NGW};
        for (int u = F.vcu; u < 12 * (S / 256); u += F.G) { const int h = u >> 6, qb = u & 63;
            static_assert(mla2::OFF_BADFLAG == MISC_OFF + 96, "bad-unit flag = control word 24");
            if (!mla2::attn_unit<true>((const unsigned short*)(F.ws + R_Q), (const unsigned short*)(F.ws + R_KV), (const unsigned short*)(F.ws + R_KPE),
                           (const float*)(F.ws + WS_COS), (const float*)(F.ws + WS_SIN), (unsigned short*)(F.ws + R_MIX2), h, qb * 256, S, (char*)lds_raw, J)) {
                if (F.tid == 0) MISC[24] = 0u;
                __syncthreads();
                mla2::attn_unit<false>((const unsigned short*)(F.ws + R_Q), (const unsigned short*)(F.ws + R_KV), (const unsigned short*)(F.ws + R_KPE),
                           (const float*)(F.ws + WS_COS), (const float*)(F.ws + WS_SIN), (unsigned short*)(F.ws + R_MIX2), h, qb * 256, S, (char*)lds_raw, J); } }
        while (J.next < mla2::CV_NG) { float cvr[16]; unsigned char* cvd; mla2::cv_issue(J, F.lane, cvr, cvd); mla2::cv_finish(J, cvr, cvd); J.next += J.stride; }
        for (;;) {
            __syncthreads();
            if (F.tid == 0) MISC[17] = atomicAdd((unsigned*)(F.ws + WS_CTL) + CW_GLUCTR, 1u);
            __syncthreads();
            const int gu = (int)__builtin_amdgcn_readfirstlane(MISC[17]);
            if (gu >= (S / 256) * (S5D / 256)) break;
            pg8::Gemm g{(const b16*)(F.ws + R_YG), (const b16*)(F.ws + WB_GLU), S5D}; pg8::FixedUnit so{gu >> 1, gu & 1, nullptr};
            pg8::EpiGate E{(const b16*)(F.ws + R_YG), S5D, (b16*)(F.ws + R_MIX2), D, 1536}; pg8::gemm_phase(F.lds, g, so, E);
        }
    RB(13); } SEAM(13);
    if (IN(14)) REP(14) { REFRESH(); pg8::Gemm g{(const b16*)(F.ws + R_MIX2), (const b16*)(F.ws + WB_OOUT), D}; pg8::StaticOrder so; so.init(S / 256, D / 256, F.G, bid);
        pg8::EpiBf16 E{Y, D}; pg8::gemm_phase(F.lds, g, so, E); RB(14); } SEAM(14);
    if (IN(15)) { REFRESH(); resnorm_phase<true, true, true, false, true, true>(F, XB, XB, Y, 1, 2, 1, 1, 3, 2); } SEAM(15);
    if (IN(16)) REP(16) { REFRESH(); moe_slots_phase(F); RB(16); } SEAM(16);
    if (IN(17)) REP(17) { REFRESH(); const int nt = __builtin_amdgcn_readfirstlane(*(const int*)(F.ws + WS_ROUTE + RT_NTILE));
        pg8::Gemm g{(const void*)(F.ws + R_HS8), (const void*)(F.ws + WB_M13), D}; pg8::StaticOrder so; so.init(nt, 2 * FE / 256, F.G, bid);
        so.texp = (const int*)(F.ws + WS_ROUTE + RT_TEXP); so.estride = (size_t)2 * FE * D;
        pg8::EpiSwiGLU8 E{(unsigned char*)(F.ws + R_ACTS), FE, 1.0f / (MOE_WSCALE * MOE_HSCALE), MOE_ASCALE}; pg8::gemm_phase<true, false>(F.lds, g, so, E); RB(17); } SEAM(17);
    if (IN(18)) REP(18) { REFRESH(); const int nt = __builtin_amdgcn_readfirstlane(*(const int*)(F.ws + WS_ROUTE + RT_NTILE)); int nfull, sp; moe_tail_plan(nt, nfull, sp);
        { pg8::Gemm g{(const void*)(F.ws + R_ACTS), (const void*)(F.ws + WB_M2), FE}; pg8::StaticOrder so; so.init(nfull, D / 256, F.G, bid);
          so.texp = (const int*)(F.ws + WS_ROUTE + RT_TEXP); so.estride = (size_t)D * FE;
          pg8::EpiFp8 E{(unsigned char*)(F.ws + R_YS), D, MOE_YSCALE / (MOE_WSCALE * MOE_ASCALE)}; pg8::gemm_phase<true, false>(F.lds, g, so, E); }
        if (sp > 1) {
          pg8::Gemm g{(const void*)(F.ws + R_ACTS), (const void*)(F.ws + WB_M2), FE, FE / sp}; pg8::SplitOrder so; so.init(nfull, nt - nfull, sp, D / 256, F.G, F.vcu, (size_t)(FE / sp));
          so.texp = (const int*)(F.ws + WS_ROUTE + RT_TEXP); so.estride = (size_t)D * FE;
          pg8::EpiBf16S E{(b16*)(F.ws + R_YT), D, nfull, (size_t)(nt - nfull) * 256 * D, 1.0f / (MOE_WSCALE * MOE_ASCALE)}; pg8::gemm_phase<true, false>(F.lds, g, so, E); }
        RB(18); } SEAM(18);
    if (IN(19)) { REFRESH(); resnorm_phase<true, false, false, true, true, false>(F, XB, xo, nullptr, 1, 5, 3, 0, 0, 0); }
#undef IN
#undef SEAM
}

extern "C" void kernel_launch(void* const* d_in, const int* in_sizes, int n_in, void* d_out, int out_size, void* d_ws, size_t ws_size, hipStream_t stream) {
    static int grid = 0;
    if (grid == 0) {
        if (n_in != 34 || out_size != S * D || ws_size < WS_END) { fprintf(stderr, "kernel_launch: unexpected shapes: n_in %d out %d ws %zu (need %zu)\n", n_in, out_size, ws_size, (size_t)WS_END); grid = -1; return; }
        int dev = 0, cus = 0, per_cu = 0;
        if (hipGetDevice(&dev) != hipSuccess || hipDeviceGetAttribute(&cus, hipDeviceAttributeMultiprocessorCount, dev) != hipSuccess) { grid = -1; return; }
        if (hipFuncSetAttribute((const void*)mk_fwd, hipFuncAttributeMaxDynamicSharedMemorySize, LDS_BYTES) != hipSuccess) { fprintf(stderr, "kernel_launch: hipFuncSetAttribute failed\n"); grid = -1; return; }
        if (hipOccupancyMaxActiveBlocksPerMultiprocessor(&per_cu, (const void*)mk_fwd, NWAVES * 64, LDS_BYTES) != hipSuccess || per_cu < 1) { fprintf(stderr, "kernel_launch: note: occupancy query says %d\n", per_cu); (void)hipGetLastError(); }
        grid = cus;
    }
    if (grid < 0) return;
    if (hipMemsetAsync((char*)d_ws + WS_CTL, 0, CTL_ZERO_BYTES, stream) != hipSuccess) return;
    Args a{};
    for (int i = 0; i < 34; ++i) a.in[i] = (const float*)d_in[i];
    a.out = (float*)d_out; a.ws = (unsigned char*)d_ws;
#if MK_N_LAUNCHES == 1
    a.ph_lo = 0; a.ph_hi = NPH;
    hipLaunchKernelGGL(mk_fwd, dim3(grid), dim3(NWAVES * 64), LDS_BYTES, stream, a);
#else
    for (int p = 0; p < NPH; ++p) { a.ph_lo = p; a.ph_hi = p + 1; hipLaunchKernelGGL(mk_fwd, dim3(grid), dim3(NWAVES * 64), LDS_BYTES, stream, a);
        if (TW(p)) hipLaunchKernelGGL(mk_fwd, dim3(grid), dim3(NWAVES * 64), LDS_BYTES, stream, a); }
#endif
}
```

```cpp
#include <hip/hip_runtime.h>
#include <cstdio>
#include <cstdint>

namespace pg8 {
#define PG8_LAS __attribute__((address_space(3)))
typedef unsigned short bf16_t;
typedef short bf16x8 __attribute__((ext_vector_type(8)));
typedef float f32x4 __attribute__((ext_vector_type(4)));
typedef unsigned u32x4 __attribute__((ext_vector_type(4)));
typedef unsigned u32x2 __attribute__((ext_vector_type(2)));
constexpr int BM = 256, BK = 64, HALF = 128, HTB = HALF * BK * 2  , STAGE_BYTES = 8 * HTB, NXCD = 8, WGM = 8;

__host__ __device__ __forceinline__ int lds_byte(int r, int c) { const int st = (r >> 4) * 2 + (c >> 5), rr = r & 15, cc = c & 31, ob = rr * 64 + cc * 2; return st * 1024 + (ob ^ (((ob >> 9) & 1) << 5)); }
__host__ __device__ __forceinline__ void stage_rc(int b, int& R, int& C) { const int st = b / 1024, sb = b % 1024, swz = sb ^ (((sb >> 9) & 1) << 5); R = (st >> 1) * 16 + swz / 64; C = (st & 1) * 32 + (swz % 64) / 2; }
__host__ __device__ __forceinline__ int perm32(int rho) { const int n = rho >> 4, i = rho & 15; return 8 * (i >> 2) + 4 * n + (i & 3); }

struct Unit { int pm, pn, ks; };
struct Gemm { const void* A; const void* Bt; int K; int kl = 0; };

struct StaticOrder {
    int nM, nN, nwg, G, c;
    const int* texp; size_t estride;
    const int* rowidx;
    __device__ void init(int nM_, int nN_, int G_, int c_) { nM = nM_; nN = nN_; nwg = nM * nN; G = G_; c = c_; texp = nullptr; estride = 0; rowidx = nullptr; }
    __device__ bool next(int i, Unit& u) const {
        const long L = (long)i * G + c; if (L >= nwg) return false;
        int wgid = (int)L; { const int q = nwg / NXCD, r = nwg % NXCD, xcd = wgid % NXCD, off = wgid / NXCD; wgid = (xcd < r ? xcd * (q + 1) : r * (q + 1) + (xcd - r) * q) + off; }
        const int nig = WGM * nN, gid = wgid / nig, fm = gid * WGM, gsz = (nM - fm) < WGM ? (nM - fm) : WGM;
        u.pm = fm + ((wgid % nig) % gsz); u.pn = (wgid % nig) / gsz; return true;
    }
    __device__ __forceinline__ size_t b_off(const Unit& u) const { return texp ? (size_t)__builtin_amdgcn_readfirstlane(texp[u.pm]) * estride : (size_t)0; }
    __device__ __forceinline__ size_t k_off(const Unit&) const { return 0; }
};
struct FixedUnit {
    int pm, pn; const int* rowidx;
    __device__ bool next(int i, Unit& u) const { if (i != 0) return false; u.pm = pm; u.pn = pn; return true; }
    __device__ __forceinline__ size_t b_off(const Unit&) const { return 0; }
    __device__ __forceinline__ size_t k_off(const Unit&) const { return 0; }
};
struct SplitOrder {
    int pm0, ntail, s, nN, G, c; size_t kbytes;
    const int* texp; size_t estride; const int* rowidx;
    __device__ void init(int pm0_, int ntail_, int s_, int nN_, int G_, int c_, size_t kbytes_) { pm0 = pm0_; ntail = ntail_; s = s_; nN = nN_; G = G_; c = c_; kbytes = kbytes_; texp = nullptr; estride = 0; rowidx = nullptr; }
    __device__ bool next(int i, Unit& u) const {
        const long L = (long)i * G + c; if (L >= (long)ntail * s * nN) return false;
        const int g = (int)L / nN; u.pn = (int)L - g * nN; const int t = g / s; u.pm = pm0 + t; u.ks = g - t * s; return true;
    }
    __device__ __forceinline__ size_t b_off(const Unit& u) const { return texp ? (size_t)__builtin_amdgcn_readfirstlane(texp[u.pm]) * estride : (size_t)0; }
    __device__ __forceinline__ size_t k_off(const Unit& u) const { return (size_t)u.ks * kbytes; }
};

__device__ __forceinline__ unsigned cvt_pk_bf16(float lo, float hi) { unsigned r; asm volatile("v_cvt_pk_bf16_f32 %0, %1, %2" : "=v"(r) : "v"(lo), "v"(hi)); return r; }

struct EpiF32 {
    static constexpr bool PERM = false;
    float* C; int ldc;
    __device__ __forceinline__ void operator()(const f32x4 (&acc)[2][2][4][2], const Unit& u, int wr, int wc, int fr, int fq) const {
        const int row0 = u.pm * BM + wr * 64 + fr, col0 = u.pn * BM + wc * 32 + 4 * fq;
#pragma unroll
        for (int ai = 0; ai < 2; ++ai)
#pragma unroll
            for (int m = 0; m < 4; ++m) { float* rowp = C + (size_t)(row0 + ai * HALF + m * 16) * ldc + col0;
#pragma unroll
                for (int bj = 0; bj < 2; ++bj)
#pragma unroll
                    for (int n = 0; n < 2; ++n) *(f32x4*)(rowp + bj * HALF + n * 16) = acc[ai][bj][m][n]; }
    }
};
struct EpiF32S {
    static constexpr bool PERM = false;
    float* C; int ldc; int pm0; size_t sstride; float sc;
    __device__ __forceinline__ void operator()(const f32x4 (&acc)[2][2][4][2], const Unit& u, int wr, int wc, int fr, int fq) const {
        const int row0 = (u.pm - pm0) * BM + wr * 64 + fr, col0 = u.pn * BM + wc * 32 + 4 * fq;
        float* Cs = C + (size_t)u.ks * sstride;
#pragma unroll
        for (int ai = 0; ai < 2; ++ai)
#pragma unroll
            for (int m = 0; m < 4; ++m) { float* rowp = Cs + (size_t)(row0 + ai * HALF + m * 16) * ldc + col0;
#pragma unroll
                for (int bj = 0; bj < 2; ++bj)
#pragma unroll
                    for (int n = 0; n < 2; ++n) *(f32x4*)(rowp + bj * HALF + n * 16) = acc[ai][bj][m][n] * sc; }
    }
};
struct EpiBf16S {
    static constexpr bool PERM = true;
    bf16_t* O; int ldc; int pm0; size_t sstride; float sc;
    __device__ __forceinline__ void operator()(const f32x4 (&acc)[2][2][4][2], const Unit& u, int wr, int wc, int fr, int fq) const {
        const int row0 = (u.pm - pm0) * BM + wr * 64 + fr, col0 = u.pn * BM + wc * 32 + 8 * fq;
        bf16_t* Os = O + (size_t)u.ks * sstride;
#pragma unroll
        for (int ai = 0; ai < 2; ++ai)
#pragma unroll
            for (int m = 0; m < 4; ++m) { bf16_t* rowp = Os + (size_t)(row0 + ai * HALF + m * 16) * ldc + col0;
#pragma unroll
                for (int bj = 0; bj < 2; ++bj) { const f32x4 v0 = acc[ai][bj][m][0] * sc, v1 = acc[ai][bj][m][1] * sc;
                    u32x4 w; w.x = cvt_pk_bf16(v0[0], v0[1]); w.y = cvt_pk_bf16(v0[2], v0[3]); w.z = cvt_pk_bf16(v1[0], v1[1]); w.w = cvt_pk_bf16(v1[2], v1[3]);
                    *(u32x4*)(rowp + bj * HALF) = w; } }
    }
};
struct EpiFp8 {
    static constexpr bool PERM = true;
    unsigned char* O; int ldc; float sc;
    __device__ __forceinline__ void operator()(const f32x4 (&acc)[2][2][4][2], const Unit& u, int wr, int wc, int fr, int fq) const {
        const int row0 = u.pm * BM + wr * 64 + fr, col0 = u.pn * BM + wc * 32 + 8 * fq;
#pragma unroll
        for (int ai = 0; ai < 2; ++ai)
#pragma unroll
            for (int m = 0; m < 4; ++m) { unsigned char* rowp = O + (size_t)(row0 + ai * HALF + m * 16) * ldc + col0;
#pragma unroll
                for (int bj = 0; bj < 2; ++bj) { u32x2 w;
#pragma unroll
                    for (int n = 0; n < 2; ++n) { const f32x4 v = acc[ai][bj][m][n] * sc; int q = 0;
                        q = __builtin_amdgcn_cvt_pk_fp8_f32(__builtin_amdgcn_fmed3f(v[0], -448.f, 448.f), __builtin_amdgcn_fmed3f(v[1], -448.f, 448.f), q, false);
                        q = __builtin_amdgcn_cvt_pk_fp8_f32(__builtin_amdgcn_fmed3f(v[2], -448.f, 448.f), __builtin_amdgcn_fmed3f(v[3], -448.f, 448.f), q, true);
                        if (n == 0) w.x = (unsigned)q; else w.y = (unsigned)q; }
                    *(u32x2*)(rowp + bj * HALF) = w; } }
    }
};
struct EpiBf16 {
    static constexpr bool PERM = true;
    bf16_t* O; int ldc; float sc = 1.0f;
    __device__ __forceinline__ void operator()(const f32x4 (&acc)[2][2][4][2], const Unit& u, int wr, int wc, int fr, int fq) const {
        const int row0 = u.pm * BM + wr * 64 + fr, col0 = u.pn * BM + wc * 32 + 8 * fq;
#pragma unroll
        for (int ai = 0; ai < 2; ++ai)
#pragma unroll
            for (int m = 0; m < 4; ++m) { bf16_t* rowp = O + (size_t)(row0 + ai * HALF + m * 16) * ldc + col0;
#pragma unroll
                for (int bj = 0; bj < 2; ++bj) { const f32x4 v0 = acc[ai][bj][m][0] * sc, v1 = acc[ai][bj][m][1] * sc;
                    u32x4 w; w.x = cvt_pk_bf16(v0[0], v0[1]); w.y = cvt_pk_bf16(v0[2], v0[3]); w.z = cvt_pk_bf16(v1[0], v1[1]); w.w = cvt_pk_bf16(v1[2], v1[3]);
                    *(u32x4*)(rowp + bj * HALF) = w; } }
    }
};
__device__ __forceinline__ float silu_f(float v) { return v * __builtin_amdgcn_rcpf(1.0f + __builtin_amdgcn_exp2f(-1.4426950408889634f * v)); }
__device__ __forceinline__ float sigmoid_f(float v) { return __builtin_amdgcn_rcpf(1.0f + __builtin_amdgcn_exp2f(-1.4426950408889634f * v)); }
struct EpiSwiGLU {
    static constexpr bool PERM = false;
    bf16_t* O; int ldc;
    __device__ __forceinline__ void operator()(const f32x4 (&acc)[2][2][4][2], const Unit& u, int wr, int wc, int fr, int fq) const {
        const int row0 = u.pm * BM + wr * 64 + fr, col0 = u.pn * (BM / 2) + wc * 16 + 4 * fq;
#pragma unroll
        for (int ai = 0; ai < 2; ++ai)
#pragma unroll
            for (int m = 0; m < 4; ++m) { bf16_t* rowp = O + (size_t)(row0 + ai * HALF + m * 16) * ldc + col0;
#pragma unroll
                for (int bj = 0; bj < 2; ++bj) { const f32x4 a = acc[ai][bj][m][0], b = acc[ai][bj][m][1];
                    u32x2 w; w.x = cvt_pk_bf16(silu_f(a[0]) * b[0], silu_f(a[1]) * b[1]); w.y = cvt_pk_bf16(silu_f(a[2]) * b[2], silu_f(a[3]) * b[3]);
                    *(u32x2*)(rowp + bj * (HALF / 2)) = w; } }
    }
};
struct EpiSwiGLU8 {
    static constexpr bool PERM = false;
    unsigned char* O; int ldc; float isc, osc;
    __device__ __forceinline__ void operator()(const f32x4 (&acc)[2][2][4][2], const Unit& u, int wr, int wc, int fr, int fq) const {
        const int row0 = u.pm * BM + wr * 64 + fr, col0 = u.pn * (BM / 2) + wc * 16 + 4 * fq;
#pragma unroll
        for (int ai = 0; ai < 2; ++ai)
#pragma unroll
            for (int m = 0; m < 4; ++m) { unsigned char* rowp = O + (size_t)(row0 + ai * HALF + m * 16) * ldc + col0;
#pragma unroll
                for (int bj = 0; bj < 2; ++bj) { const f32x4 a = acc[ai][bj][m][0], b = acc[ai][bj][m][1];
                    const float c1 = -1.4426950408889634f * isc, c2 = 1.0f / (isc * isc * osc);
                    float v[4];
#pragma unroll
                    for (int e = 0; e < 4; ++e) v[e] = __builtin_amdgcn_fmed3f((a[e] * b[e]) * __builtin_amdgcn_rcpf(__builtin_fmaf(__builtin_amdgcn_exp2f(a[e] * c1), c2, c2)), -448.f, 448.f);
                    int w = 0; w = __builtin_amdgcn_cvt_pk_fp8_f32(v[0], v[1], w, false); w = __builtin_amdgcn_cvt_pk_fp8_f32(v[2], v[3], w, true);
                    *(int*)(rowp + bj * (HALF / 2)) = w; } }
    }
};
struct EpiGate {
    static constexpr bool PERM = false;
    const bf16_t* Y; int ldy; bf16_t* O; int ldc; int ocol0;
    __device__ __forceinline__ void operator()(const f32x4 (&acc)[2][2][4][2], const Unit& u, int wr, int wc, int fr, int fq) const {
        const int row0 = u.pm * BM + wr * 64 + fr, col0 = u.pn * BM + wc * 32 + 4 * fq;
#pragma unroll
        for (int ai = 0; ai < 2; ++ai)
#pragma unroll
            for (int m = 0; m < 4; ++m) { const size_t r = (size_t)(row0 + ai * HALF + m * 16);
#pragma unroll
                for (int bj = 0; bj < 2; ++bj)
#pragma unroll
                    for (int n = 0; n < 2; ++n) { const int c = col0 + bj * HALF + n * 16; const f32x4 a = acc[ai][bj][m][n];
                        const u32x2 y = *(const u32x2*)(Y + r * ldy + c);
                        const float y0 = __uint_as_float(y.x << 16), y1 = __uint_as_float(y.x & 0xffff0000u), y2 = __uint_as_float(y.y << 16), y3 = __uint_as_float(y.y & 0xffff0000u);
                        u32x2 w; w.x = cvt_pk_bf16(y0 * sigmoid_f(a[0]), y1 * sigmoid_f(a[1])); w.y = cvt_pk_bf16(y2 * sigmoid_f(a[2]), y3 * sigmoid_f(a[3]));
                        *(u32x2*)(O + r * ldc + ocol0 + c) = w; } }
    }
};

typedef int v8i32 __attribute__((ext_vector_type(8)));
__device__ __forceinline__ void glds16s(const void* sbase, unsigned voff, unsigned lds_dst) { unsigned keep;
    asm volatile("s_mov_b32 %0, m0\n\ts_mov_b32 m0, %3\n\ts_nop 0\n\tglobal_load_lds_dwordx4 %1, %2\n\ts_mov_b32 m0, %0" : "=&s"(keep) : "v"(voff), "s"(sbase), "s"(lds_dst) : "memory"); }
template <bool FP8 = false, bool GATHER = false, class Epi, class Sched>
__device__ __forceinline__ void gemm_phase(PG8_LAS unsigned char* lds, const Gemm g, const Sched& S, const Epi& E) {
    int tid_ = (int)threadIdx.x; asm volatile("" : "+v"(tid_));
    const int tid = tid_, wid = __builtin_amdgcn_readfirstlane(tid >> 6), lane = tid & 63, wr = wid >> 2, wc = wid & 3, fr = lane & 15, fq = lane >> 4;
    const int K = FP8 ? (g.K >> 1) : g.K, nt = (g.kl ? (FP8 ? (g.kl >> 1) : g.kl) : K) / BK;
    unsigned voffA[2], voffB[2];
#pragma unroll
    for (int i = 0; i < 2; ++i) { int R, C; stage_rc(tid * 16 + i * 8192, R, C); const int Rb = Epi::PERM ? ((R & ~31) + perm32(R & 31)) : R;
        voffA[i] = (unsigned)(R * K + C) * 2u; voffB[i] = (unsigned)(Rb * K + C) * 2u; }
    const size_t kstep = (size_t)(BK * 2);
    const size_t qstep = (size_t)64 * K * 2;
    const size_t hstep = (size_t)HALF * K * 2;
    const size_t tstep = 2 * hstep;
    const unsigned ldsw = (unsigned)wid * 1024u, ldsbase = (unsigned)(uintptr_t)lds;
    const int aoff = lds_byte(wr * 64 + fr, fq * 8), boff = lds_byte(wc * 32 + fr, fq * 8);
#define PG8_SA(b, h) (((b) * 2 + (h)) * HTB)
#define PG8_SB(b, h) ((4 + (b) * 2 + (h)) * HTB)
#define PG8_STAGE(bufoff, gbase, voff) do { _Pragma("unroll") for (int _i = 0; _i < 2; ++_i) glds16s((const void*)(gbase), (voff)[_i], ldsbase + (unsigned)(bufoff) + ldsw + (unsigned)_i * 8192u); } while (0)
#define PG8_STAGE1(bufoff, gbase, voff0) do { _Pragma("unroll") for (int _i = 0; _i < 2; ++_i) glds16s((const void*)((const char*)(gbase) + (size_t)_i * qstep), voff0, ldsbase + (unsigned)(bufoff) + ldsw + (unsigned)_i * 8192u); } while (0)
#define PG8_STAGE_A(bufoff, h, ap, og) do { if constexpr (GATHER) PG8_STAGE(bufoff, ap, (og)[h]); else PG8_STAGE1(bufoff, (ap) + (h) * hstep, voffA[0]); } while (0)
#define PG8_LDA(dst, b, h) do { _Pragma("unroll") for (int m = 0; m < 4; ++m) _Pragma("unroll") for (int k = 0; k < 2; ++k) dst[m][k] = *(const PG8_LAS bf16x8*)(lds + PG8_SA(b, h) + aoff + m * 2048 + k * 1024); } while (0)
#define PG8_LDB(dst, b, h) do { _Pragma("unroll") for (int n = 0; n < 2; ++n) _Pragma("unroll") for (int k = 0; k < 2; ++k) dst[n][k] = *(const PG8_LAS bf16x8*)(lds + PG8_SB(b, h) + boff + n * 2048 + k * 1024); } while (0)
#define PG8_MMA(ai, bj, At, Bt) do { __builtin_amdgcn_s_setprio(1); _Pragma("unroll") for (int m = 0; m < 4; ++m) _Pragma("unroll") for (int n = 0; n < 2; ++n) { \
        if constexpr (FP8) { const v8i32 bq = __builtin_bit_cast(v8i32, __builtin_shufflevector(Bt[n][0], Bt[n][1], 0, 1, 2, 3, 4, 5, 6, 7, 8, 9, 10, 11, 12, 13, 14, 15)); \
            const v8i32 aq = __builtin_bit_cast(v8i32, __builtin_shufflevector(At[m][0], At[m][1], 0, 1, 2, 3, 4, 5, 6, 7, 8, 9, 10, 11, 12, 13, 14, 15)); \
            acc[ai][bj][m][n] = __builtin_amdgcn_mfma_scale_f32_16x16x128_f8f6f4(bq, aq, acc[ai][bj][m][n], 0, 0, 0, 0, 0, 0);     } \
        else { _Pragma("unroll") for (int k = 0; k < 2; ++k) acc[ai][bj][m][n] = __builtin_amdgcn_mfma_f32_16x16x32_bf16(Bt[n][k], At[m][k], acc[ai][bj][m][n], 0, 0, 0); } } \
        __builtin_amdgcn_s_setprio(0); } while (0)
#define PG8_WAIT_V(n) asm volatile("s_waitcnt vmcnt(" #n ")" ::: "memory")
#define PG8_WAIT_L(n) asm volatile("s_waitcnt lgkmcnt(" #n ")" ::: "memory")
#define PG8_BAR __builtin_amdgcn_s_barrier()
#define PG8_SCHED __builtin_amdgcn_sched_barrier(0)
#define PG8_AOFF(dst, u) do { if constexpr (GATHER) { int t2_ = (int)threadIdx.x; asm volatile("" : "+v"(t2_)); _Pragma("unroll") for (int _i = 0; _i < 2; ++_i) { int R_, C_; stage_rc(t2_ * 16 + _i * 8192, R_, C_); \
        _Pragma("unroll") for (int _h = 0; _h < 2; ++_h) { const int _row = S.rowidx[(u).pm * BM + _h * HALF + R_]; dst[_h][_i] = (unsigned)((size_t)_row * K + C_) * 2u; } } } } while (0)
    Unit cur, nxt; int ui = 0;
    if (!S.next(0, cur)) return;
    f32x4 acc[2][2][4][2];
#pragma unroll
    for (int a = 0; a < 2; ++a)
#pragma unroll
        for (int b = 0; b < 2; ++b)
#pragma unroll
            for (int m = 0; m < 4; ++m)
#pragma unroll
                for (int n = 0; n < 2; ++n) acc[a][b][m][n] = (f32x4){0.f, 0.f, 0.f, 0.f};
    bf16x8 At[4][2], B0[2][2], B1[2][2];
    unsigned oC[2][2];
#define PG8_OSLOT ((PG8_LAS u32x4*)(lds + STAGE_BYTES) + (int)threadIdx.x)
    PG8_AOFF(oC, cur);
    const char* const gA = (const char*)g.A;
    const char* cA = (GATHER ? gA : gA + (size_t)cur.pm * tstep) + S.k_off(cur);
    const char* cB = (const char*)g.Bt + S.b_off(cur) + (size_t)cur.pn * tstep + S.k_off(cur);
    PG8_STAGE1(PG8_SB(0, 0), cB, voffB[0]); PG8_STAGE1(PG8_SB(0, 1), cB + hstep, voffB[0]); PG8_STAGE_A(PG8_SA(0, 0), 0, cA, oC); PG8_STAGE_A(PG8_SA(0, 1), 1, cA, oC);
    if (wr == 1) PG8_BAR;
    PG8_WAIT_V(2); PG8_BAR;
    PG8_STAGE1(PG8_SB(1, 0), cB + kstep, voffB[0]); PG8_STAGE_A(PG8_SA(1, 0), 0, cA + kstep, oC); PG8_STAGE1(PG8_SB(1, 1), cB + hstep + kstep, voffB[0]);
    PG8_WAIT_V(6); PG8_BAR;
    for (;;) {
        const bool has_next = S.next(ui + 1, nxt);
        const char* nB = cB; const char* nA = cA;
        if (has_next) { nB = (const char*)g.Bt + S.b_off(nxt) + (size_t)nxt.pn * tstep + S.k_off(nxt); nA = (GATHER ? gA : gA + (size_t)nxt.pm * tstep) + S.k_off(nxt);
            if constexpr (GATHER) { unsigned oN[2][2]; PG8_AOFF(oN, nxt); *PG8_OSLOT = (u32x4){oN[0][0], oN[0][1], oN[1][0], oN[1][1]}; } }
        for (int t = 0; t < nt; t += 2) {
            const bool last = (t == nt - 2);
            const char* a1 = cA + (size_t)(t + 1) * kstep;
            const char* a2 = last ? nA : cA + (size_t)(t + 2) * kstep; const char* b2 = last ? nB : cB + (size_t)(t + 2) * kstep;
            const char* a3 = a2 + kstep; const char* b3 = b2 + kstep;
            unsigned o2[2][2];
            if constexpr (GATHER) {
                if (last && has_next) { const u32x4 q = *PG8_OSLOT; o2[0][0] = q.x; o2[0][1] = q.y; o2[1][0] = q.z; o2[1][1] = q.w; }
                else { o2[0][0] = oC[0][0]; o2[0][1] = oC[0][1]; o2[1][0] = oC[1][0]; o2[1][1] = oC[1][1]; }
            }
            PG8_LDB(B0, 0, 0); PG8_LDB(B1, 0, 1); PG8_SCHED; PG8_LDA(At, 0, 0); PG8_STAGE_A(PG8_SA(1, 1), 1, a1, oC);
            PG8_WAIT_V(8); PG8_WAIT_L(0); PG8_BAR; PG8_MMA(0, 0, At, B0); PG8_MMA(0, 1, At, B1); PG8_BAR; PG8_SCHED;
            PG8_LDA(At, 0, 1); PG8_STAGE1(PG8_SB(0, 0), b2, voffB[0]); PG8_STAGE1(PG8_SB(0, 1), b2 + hstep, voffB[0]); PG8_STAGE_A(PG8_SA(0, 0), 0, a2, o2);
            PG8_WAIT_V(8); PG8_WAIT_L(0); PG8_BAR; PG8_MMA(1, 0, At, B0); PG8_MMA(1, 1, At, B1); PG8_BAR; PG8_SCHED;
            PG8_LDB(B0, 1, 0); PG8_LDB(B1, 1, 1); PG8_SCHED; PG8_LDA(At, 1, 0); PG8_STAGE_A(PG8_SA(0, 1), 1, a2, o2);
            PG8_WAIT_V(8); PG8_WAIT_L(0); PG8_BAR; PG8_MMA(0, 0, At, B0); PG8_MMA(0, 1, At, B1); PG8_BAR; PG8_SCHED;
            PG8_LDA(At, 1, 1); PG8_STAGE1(PG8_SB(1, 0), b3, voffB[0]); PG8_STAGE1(PG8_SB(1, 1), b3 + hstep, voffB[0]); PG8_STAGE_A(PG8_SA(1, 0), 0, a3, o2);
            PG8_WAIT_V(8); PG8_WAIT_L(0); PG8_BAR; PG8_MMA(1, 0, At, B0); PG8_MMA(1, 1, At, B1); PG8_BAR; PG8_SCHED;
        }
        if (wr == 0) PG8_BAR;
        { int t3 = (int)threadIdx.x; asm volatile("" : "+v"(t3)); E(acc, cur, wr, wc, t3 & 15, (t3 >> 4) & 3); }
        if (!has_next) break;
#pragma unroll
        for (int a = 0; a < 2; ++a)
#pragma unroll
            for (int b = 0; b < 2; ++b)
#pragma unroll
                for (int m = 0; m < 4; ++m)
#pragma unroll
                    for (int n = 0; n < 2; ++n) acc[a][b][m][n] = (f32x4){0.f, 0.f, 0.f, 0.f};
        cur = nxt; cB = nB; cA = nA; ++ui;
        if constexpr (GATHER) { const u32x4 q = *PG8_OSLOT; oC[0][0] = q.x; oC[0][1] = q.y; oC[1][0] = q.z; oC[1][1] = q.w; }
        if (wr == 1) PG8_BAR;
    }
    PG8_WAIT_V(0);
    PG8_BAR;
#undef PG8_SA
#undef PG8_SB
#undef PG8_STAGE
#undef PG8_STAGE_A
#undef PG8_STAGE1
#undef PG8_LDA
#undef PG8_LDB
#undef PG8_MMA
#undef PG8_WAIT_V
#undef PG8_WAIT_L
#undef PG8_BAR
#undef PG8_SCHED
#undef PG8_AOFF
#undef PG8_OSLOT
}
}
namespace mla2 {
using bf16x8 = __attribute__((ext_vector_type(8))) short;
using s16x4  = __attribute__((ext_vector_type(4))) short;
using f32x16 = __attribute__((ext_vector_type(16))) float;
using f32x4v = __attribute__((ext_vector_type(4))) float;
using u32x4  = __attribute__((ext_vector_type(4))) unsigned;
constexpr int NW = 8, QBLK = 32, KVBLK = 64;
constexpr float SCALE = 0.072168783648703220f;
constexpr float THR = 8.f;
constexpr int NQREG = 4, NQL = 12 - NQREG;
constexpr int LDQ = 2304, LDKV = 3072, LDKP = 64, LDO = 2048;
constexpr int SHM_V = KVBLK * 128 * 2, SHM_KN = KVBLK * 128 * 2, SHM_KP = KVBLK * 64 * 2;
constexpr int SHM_K = SHM_KN + SHM_KP;
constexpr int OFF_V = 0, OFF_KN = 2 * SHM_V, OFF_WS = OFF_KN + 2 * SHM_K, OFF_QS = OFF_WS + NW * 64 * 4, QS_WAVE = NQL * 1024, SHM_ATTN = OFF_QS + NW * QS_WAVE;
#define MLA2_QB(row, c16) ((((c16) >> 1) * 32 + (row)) * 32 + ((((c16) & 1) ^ (((row) >> 3) & 1)) << 4))
#define MLA2_SBAR() __builtin_amdgcn_sched_barrier(0)
#ifndef MLA2_WAIT0
#define MLA2_WAIT0 0
#endif
#if MLA2_WAIT0
#define MLA2_LWAIT(n) do { asm volatile("s_waitcnt lgkmcnt(0)" ::: "memory"); __builtin_amdgcn_sched_barrier(0); } while (0)
#else
#ifndef MLA2_SBMASK
#define MLA2_SBMASK 0x416
#endif
#define MLA2_LWAIT(n) do { asm volatile("s_waitcnt lgkmcnt(" #n ")" ::: "memory"); __builtin_amdgcn_sched_barrier(MLA2_SBMASK); } while (0)
#ifndef MLA2_FENCES
#define MLA2_FENCES 1
#endif
#if MLA2_FENCES
#define MLA2_FENCE() __builtin_amdgcn_sched_barrier(0)
#else
#define MLA2_FENCE() do {} while (0)
#endif
#define MLA2_W2(n, A, B) asm volatile("s_waitcnt lgkmcnt(" #n ")" : "+v"(A), "+v"(B) :: "memory")
#define MLA2_W3(n, A, B, C) asm volatile("s_waitcnt lgkmcnt(" #n ")" : "+v"(A), "+v"(B), "+v"(C) :: "memory")
#define MLA2_NRD(s) (((s) < 12) ? (((s) >= NQREG) ? 3 : 2) : 0)
#define MLA2_WS(s, X0, X1, XQ) do { if constexpr ((s) >= NQREG) asm volatile("s_waitcnt lgkmcnt(%3)" : "+v"(X0), "+v"(X1), "+v"(XQ) : "i"(MLA2_NRD((s) + 1)) : "memory"); \
    else asm volatile("s_waitcnt lgkmcnt(%2)" : "+v"(X0), "+v"(X1) : "i"(MLA2_NRD((s) + 1)) : "memory"); } while (0)
#endif
__device__ __forceinline__ int crow(int r, int hi) { return (r & 3) + 8 * (r >> 2) + 4 * hi; }
__device__ __forceinline__ unsigned cvtpk(float lo, float hi) { unsigned r; asm volatile("v_cvt_pk_bf16_f32 %0, %1, %2" : "=v"(r) : "v"(lo), "v"(hi)); return r; }
#ifndef MLA2_PLAIN_RD
#define MLA2_PLAIN_RD 0
#endif
template <int OFF> __device__ __forceinline__ bf16x8 lds_rd(int addr) {
#if MLA2_PLAIN_RD
  return *(const __attribute__((address_space(3))) bf16x8*)(unsigned)(addr + OFF);
#else
  bf16x8 r; asm volatile("ds_read_b128 %0, %1 offset:%2" : "=v"(r) : "v"(addr), "i"(OFF) : "memory"); return r;
#endif
}
using f32x2v = __attribute__((ext_vector_type(2))) float;
__device__ __forceinline__ float max3f(float a, float b, float c) { float r; asm volatile("v_max3_f32 %0, %1, %2, %3" : "=v"(r) : "v"(a), "v"(b), "v"(c)); return r; }
template <int OFF> __device__ __forceinline__ s16x4 tr_read(int vb) { s16x4 r; asm volatile("ds_read_b64_tr_b16 %0, %1 offset:%2" : "=&v"(r) : "v"(vb), "i"(OFF) : "memory"); return r; }

constexpr float THRL = THR * 1.4426950408889634f;
__device__ __forceinline__ void partialSM0(f32x16& p0, f32x16& p1, float& m_reg, f32x16& Mt) {
  float pmax = p0[0];
#pragma unroll
  for (int r = 1; r < 16; ++r) pmax = fmaxf(pmax, p0[r]);
#pragma unroll
  for (int r = 0; r < 16; ++r) pmax = fmaxf(pmax, p1[r]);
  { auto rr = __builtin_amdgcn_permlane32_swap(__float_as_uint(pmax), __float_as_uint(pmax), false, false);
    pmax = fmaxf(__uint_as_float(rr[0]), __uint_as_float(rr[1])); }
  m_reg = pmax;
#pragma unroll
  for (int r = 0; r < 16; ++r) { p0[r] -= pmax; p1[r] -= pmax; Mt[r] = -pmax; }
#pragma unroll
  for (int r = 0; r < 16; ++r) p0[r] = __builtin_amdgcn_exp2f(p0[r]);
}
__device__ __forceinline__ void partialSM(f32x16& p0, f32x16& p1, float& m_reg, float& mn, float& alpha) {
  constexpr float C = SCALE * 1.4426950408889634f;
  float pmax = p0[0];
#pragma unroll
  for (int r = 1; r < 16; ++r) pmax = fmaxf(pmax, p0[r]);
#pragma unroll
  for (int r = 0; r < 16; ++r) pmax = fmaxf(pmax, p1[r]);
  { auto rr = __builtin_amdgcn_permlane32_swap(__float_as_uint(pmax), __float_as_uint(pmax), false, false);
    pmax = fmaxf(__uint_as_float(rr[0]), __uint_as_float(rr[1])); }
  if (__builtin_expect(__all(pmax - m_reg <= THR / SCALE), 1)) { mn = m_reg; alpha = 1.f; }
  else { mn = fmaxf(m_reg, pmax); alpha = __builtin_amdgcn_exp2f((m_reg - mn) * C); m_reg = mn; }
  float mnC = -mn * C;
#pragma unroll
  for (int r = 0; r < 16; ++r) p0[r] = fmaf(p0[r], C, mnC);
#pragma unroll
  for (int r = 0; r < 16; ++r) p1[r] = fmaf(p1[r], C, mnC);
#pragma unroll
  for (int r = 0; r < 16; ++r) p0[r] = __builtin_amdgcn_exp2f(p0[r]);
}
__device__ __forceinline__ void finishSM(f32x16& p0, f32x16& p1, float alpha, float& l_reg, bf16x8& pa0, bf16x8& pa1, bf16x8& pa2, bf16x8& pa3) {
#pragma unroll
  for (int r = 0; r < 16; ++r) p1[r] = __builtin_amdgcn_exp2f(p1[r]);
  float ps = 0;
#pragma unroll
  for (int r = 0; r < 16; ++r) ps += p0[r];
#pragma unroll
  for (int r = 0; r < 16; ++r) ps += p1[r];
  { auto rr = __builtin_amdgcn_permlane32_swap(__float_as_uint(ps), __float_as_uint(ps), false, false);
    ps = __uint_as_float(rr[0]) + __uint_as_float(rr[1]); }
  l_reg = l_reg * alpha + ps;
#define MLA2_PK4(P, BASE, OUT) do { unsigned a0 = cvtpk(P[BASE + 0], P[BASE + 1]), a1 = cvtpk(P[BASE + 2], P[BASE + 3]);   \
    unsigned b0 = cvtpk(P[BASE + 4], P[BASE + 5]), b1 = cvtpk(P[BASE + 6], P[BASE + 7]);                              \
    auto r0 = __builtin_amdgcn_permlane32_swap(a0, b0, false, false); auto r1 = __builtin_amdgcn_permlane32_swap(a1, b1, false, false); \
    u32x4 w = {r0[0], r1[0], r0[1], r1[1]}; OUT = *reinterpret_cast<bf16x8*>(&w); } while (0)
  MLA2_PK4(p0, 0, pa0); MLA2_PK4(p0, 8, pa1); MLA2_PK4(p1, 0, pa2); MLA2_PK4(p1, 8, pa3);
#undef MLA2_PK4
}
constexpr int ko(int B, int s) { return B * SHM_K + (s >> 2) * 8192; }
constexpr int qo(int s) { return (s - NQREG) * 1024; }
template <int B> __device__ __forceinline__ void qkt(f32x16& p0, f32x16& p1, const int (&kb)[4], int qbase, const bf16x8 (&qr)[NQREG]) {
  p0 = f32x16{}; p1 = f32x16{};
  bf16x8 a0, a1, aq, c0, c1, cq;
#define MLA2_RD(s, X0, X1, XQ) do { X0 = lds_rd<ko(B, s)>(kb[(s) & 3]); X1 = lds_rd<ko(B, s) + 4096>(kb[(s) & 3]); if constexpr ((s) >= NQREG) XQ = lds_rd<qo((s) >= NQREG ? (s) : NQREG)>(qbase); } while (0)
#define MLA2_MM(s, X0, X1, XQ) do { const bf16x8 q_ = ((s) < NQREG) ? qr[(s) < NQREG ? (s) : 0] : XQ; \
    p0 = __builtin_amdgcn_mfma_f32_32x32x16_bf16(X0, q_, p0, 0, 0, 0); p1 = __builtin_amdgcn_mfma_f32_32x32x16_bf16(X1, q_, p1, 0, 0, 0); } while (0)
  MLA2_RD(0, a0, a1, aq); MLA2_RD(1, c0, c1, cq);
  MLA2_WS(0, a0, a1, aq); MLA2_MM(0, a0, a1, aq); MLA2_RD(2, a0, a1, aq);
  MLA2_WS(1, c0, c1, cq); MLA2_MM(1, c0, c1, cq); MLA2_RD(3, c0, c1, cq);
  MLA2_WS(2, a0, a1, aq); MLA2_MM(2, a0, a1, aq); MLA2_RD(4, a0, a1, aq);
  MLA2_WS(3, c0, c1, cq); MLA2_MM(3, c0, c1, cq); MLA2_RD(5, c0, c1, cq); MLA2_FENCE();
  MLA2_WS(4, a0, a1, aq); MLA2_MM(4, a0, a1, aq); MLA2_RD(6, a0, a1, aq);
  MLA2_WS(5, c0, c1, cq); MLA2_MM(5, c0, c1, cq); MLA2_RD(7, c0, c1, cq);
  MLA2_WS(6, a0, a1, aq); MLA2_MM(6, a0, a1, aq); MLA2_RD(8, a0, a1, aq);
  MLA2_WS(7, c0, c1, cq); MLA2_MM(7, c0, c1, cq); MLA2_RD(9, c0, c1, cq); MLA2_FENCE();
  MLA2_WS(8, a0, a1, aq); MLA2_MM(8, a0, a1, aq); MLA2_RD(10, a0, a1, aq);
  MLA2_WS(9, c0, c1, cq); MLA2_MM(9, c0, c1, cq); MLA2_RD(11, c0, c1, cq);
  MLA2_WS(10, a0, a1, aq); MLA2_MM(10, a0, a1, aq);
  MLA2_WS(11, c0, c1, cq); MLA2_MM(11, c0, c1, cq);
#undef MLA2_RD
#undef MLA2_MM
}
__device__ __forceinline__ int v_st(int k, int c) { const int kk = (k & ~0xC) | ((k & 4) << 1) | ((k & 8) >> 1); return ((kk >> 3) * 4 + (c >> 5)) * 512 + ((kk & 7) * 32 + (c & 31)) * 2; }
__device__ __forceinline__ int v_rd_base(int lane) { return ((lane & 3) << 3) | (((lane >> 2) & 3) << 6) | (((lane >> 4) & 1) << 5) | (((lane >> 5) & 1) << 8); }
constexpr int v_rd_off(int d0, int ks, int half) { return d0 * 512 + ks * 4096 + half * 2048; }
template <int B> __device__ __forceinline__ void pv(f32x16 (&o)[4], int vb, bf16x8 pa0, bf16x8 pa1, bf16x8 pa2, bf16x8 pa3) {
  s16x4 l0, h0, l1, h1, l2, h2;
#define MLA2_PK(L, H) (bf16x8){L[0], L[1], L[2], L[3], H[0], H[1], H[2], H[3]}
#define MLA2_PR(k, L, H) do { L = tr_read<B * SHM_V + v_rd_off((k) & 3, (k) >> 2, 0)>(vb); H = tr_read<B * SHM_V + v_rd_off((k) & 3, (k) >> 2, 1)>(vb); } while (0)
#define MLA2_PM(k, L, H) do { const bf16x8 pa_ = ((k) >> 2) == 0 ? pa0 : ((k) >> 2) == 1 ? pa1 : ((k) >> 2) == 2 ? pa2 : pa3; \
    o[(k) & 3] = __builtin_amdgcn_mfma_f32_32x32x16_bf16(pa_, MLA2_PK(L, H), o[(k) & 3], 0, 0, 0); } while (0)
  MLA2_PR(0, l0, h0); MLA2_PR(1, l1, h1); MLA2_PR(2, l2, h2);
  MLA2_W2(4, l0, h0); MLA2_PM(0, l0, h0); MLA2_PR(3, l0, h0);
  MLA2_W2(4, l1, h1); MLA2_PM(1, l1, h1); MLA2_PR(4, l1, h1);
  MLA2_W2(4, l2, h2); MLA2_PM(2, l2, h2); MLA2_PR(5, l2, h2);
  MLA2_W2(4, l0, h0); MLA2_PM(3, l0, h0); MLA2_PR(6, l0, h0); MLA2_FENCE();
  MLA2_W2(4, l1, h1); MLA2_PM(4, l1, h1); MLA2_PR(7, l1, h1);
  MLA2_W2(4, l2, h2); MLA2_PM(5, l2, h2); MLA2_PR(8, l2, h2);
  MLA2_W2(4, l0, h0); MLA2_PM(6, l0, h0); MLA2_PR(9, l0, h0);
  MLA2_W2(4, l1, h1); MLA2_PM(7, l1, h1); MLA2_PR(10, l1, h1); MLA2_FENCE();
  MLA2_W2(4, l2, h2); MLA2_PM(8, l2, h2); MLA2_PR(11, l2, h2);
  MLA2_W2(4, l0, h0); MLA2_PM(9, l0, h0); MLA2_PR(12, l0, h0);
  MLA2_W2(4, l1, h1); MLA2_PM(10, l1, h1); MLA2_PR(13, l1, h1);
  MLA2_W2(4, l2, h2); MLA2_PM(11, l2, h2); MLA2_PR(14, l2, h2); MLA2_FENCE();
  MLA2_W2(4, l0, h0); MLA2_PM(12, l0, h0); MLA2_PR(15, l0, h0);
  MLA2_W2(4, l1, h1); MLA2_PM(13, l1, h1);
  MLA2_W2(2, l2, h2); MLA2_PM(14, l2, h2);
  MLA2_W2(0, l0, h0); MLA2_PM(15, l0, h0);
#undef MLA2_PK
#undef MLA2_PR
#undef MLA2_PM
}
#define MLA2_PK4B(P, BASE, OUT) do { unsigned a0_ = cvtpk(P[BASE + 0], P[BASE + 1]), a1_ = cvtpk(P[BASE + 2], P[BASE + 3]);   \
    unsigned b0_ = cvtpk(P[BASE + 4], P[BASE + 5]), b1_ = cvtpk(P[BASE + 6], P[BASE + 7]);                              \
    auto r0_ = __builtin_amdgcn_permlane32_swap(a0_, b0_, false, false); auto r1_ = __builtin_amdgcn_permlane32_swap(a1_, b1_, false, false); \
    u32x4 w_ = {r0_[0], r1_[0], r0_[1], r1_[1]}; OUT = *reinterpret_cast<bf16x8*>(&w_); } while (0)
template <int B> __device__ __forceinline__ void r1(f32x16& n0, f32x16& n1, const int (&kb)[4], int qbase, const bf16x8 (&qr)[NQREG],
                                                    f32x16& p0, f32x16& p1, float alpha, float& l_reg, bf16x8& pa0, bf16x8& pa1, bf16x8& pa2, bf16x8& pa3, const f32x16& Mt) {
  bf16x8 a0, a1, aq, c0, c1, cq; float psa = 0.f, psb = 0.f;
#define MLA2_RD(s, X0, X1, XQ) do { X0 = lds_rd<ko(B, s)>(kb[(s) & 3]); X1 = lds_rd<ko(B, s) + 4096>(kb[(s) & 3]); if constexpr ((s) >= NQREG) XQ = lds_rd<qo((s) >= NQREG ? (s) : NQREG)>(qbase); } while (0)
#define MLA2_MM(s, X0, X1, XQ) do { const bf16x8 q_ = ((s) < NQREG) ? qr[(s) < NQREG ? (s) : 0] : XQ; \
    if constexpr ((s) == 0) { n0 = __builtin_amdgcn_mfma_f32_32x32x16_bf16(X0, q_, Mt, 0, 0, 0); n1 = __builtin_amdgcn_mfma_f32_32x32x16_bf16(X1, q_, Mt, 0, 0, 0); }     \
    else { n0 = __builtin_amdgcn_mfma_f32_32x32x16_bf16(X0, q_, n0, 0, 0, 0); n1 = __builtin_amdgcn_mfma_f32_32x32x16_bf16(X1, q_, n1, 0, 0, 0); } } while (0)
#define MLA2_ADD(ACC, X) asm volatile("v_add_f32 %0, %0, %1" : "+v"(ACC) : "v"(X))
#define MLA2_CE(k) do { p1[2 * (k)] = __builtin_amdgcn_exp2f(p1[2 * (k)]); p1[2 * (k) + 1] = __builtin_amdgcn_exp2f(p1[2 * (k) + 1]); MLA2_ADD(psa, p0[2 * (k)]); MLA2_ADD(psb, p0[2 * (k) + 1]); \
    MLA2_ADD(psa, p1[2 * (k)]); MLA2_ADD(psb, p1[2 * (k) + 1]); asm volatile("" : "+v"(p1)); } while (0)
  MLA2_RD(0, a0, a1, aq); MLA2_RD(1, c0, c1, cq);
  MLA2_WS(0, a0, a1, aq); MLA2_MM(0, a0, a1, aq); MLA2_RD(2, a0, a1, aq); MLA2_CE(0); MLA2_SBAR();
  MLA2_WS(1, c0, c1, cq); MLA2_MM(1, c0, c1, cq); MLA2_RD(3, c0, c1, cq); MLA2_CE(1); MLA2_SBAR();
  MLA2_WS(2, a0, a1, aq); MLA2_MM(2, a0, a1, aq); MLA2_RD(4, a0, a1, aq); MLA2_CE(2); MLA2_SBAR();
  MLA2_WS(3, c0, c1, cq); MLA2_MM(3, c0, c1, cq); MLA2_RD(5, c0, c1, cq); MLA2_CE(3); MLA2_SBAR();
  MLA2_WS(4, a0, a1, aq); MLA2_MM(4, a0, a1, aq); MLA2_RD(6, a0, a1, aq); MLA2_CE(4); MLA2_SBAR();
  MLA2_WS(5, c0, c1, cq); MLA2_MM(5, c0, c1, cq); MLA2_RD(7, c0, c1, cq); MLA2_CE(5); MLA2_SBAR();
  MLA2_WS(6, a0, a1, aq); MLA2_MM(6, a0, a1, aq); MLA2_RD(8, a0, a1, aq); MLA2_CE(6); MLA2_SBAR();
  MLA2_WS(7, c0, c1, cq); MLA2_MM(7, c0, c1, cq); MLA2_RD(9, c0, c1, cq); MLA2_CE(7); MLA2_SBAR();
  MLA2_WS(8, a0, a1, aq); MLA2_MM(8, a0, a1, aq); MLA2_RD(10, a0, a1, aq);
  float ps = psa + psb;
  { auto rr = __builtin_amdgcn_permlane32_swap(__float_as_uint(ps), __float_as_uint(ps), false, false); ps = __uint_as_float(rr[0]) + __uint_as_float(rr[1]); }
  l_reg = l_reg * alpha + ps; MLA2_PK4B(p0, 0, pa0); asm volatile("" : "+v"(l_reg), "+v"(pa0)); MLA2_SBAR();
  MLA2_WS(9, c0, c1, cq); MLA2_MM(9, c0, c1, cq); MLA2_RD(11, c0, c1, cq); MLA2_PK4B(p0, 8, pa1); asm volatile("" : "+v"(pa1)); MLA2_SBAR();
  MLA2_WS(10, a0, a1, aq); MLA2_MM(10, a0, a1, aq); MLA2_PK4B(p1, 0, pa2); asm volatile("" : "+v"(pa2)); MLA2_SBAR();
  MLA2_WS(11, c0, c1, cq); MLA2_MM(11, c0, c1, cq); MLA2_PK4B(p1, 8, pa3); asm volatile("" : "+v"(pa3)); MLA2_SBAR();
#undef MLA2_RD
#undef MLA2_MM
#undef MLA2_CE
#undef MLA2_ADD
}
template <int B, bool FAST> __device__ __forceinline__ void r2(f32x16 (&o)[4], int vb, bf16x8 pa0, bf16x8 pa1, bf16x8 pa2, bf16x8 pa3,
                                                    f32x16& q0, f32x16& q1, float& m_reg, float& alpha, f32x16& Mt) {
  s16x4 l0, h0, l1, h1, l2, h2; float mx;
#define MLA2_PK(L, H) (bf16x8){L[0], L[1], L[2], L[3], H[0], H[1], H[2], H[3]}
#define MLA2_PR(k, L, H) do { L = tr_read<B * SHM_V + v_rd_off((k) & 3, (k) >> 2, 0)>(vb); H = tr_read<B * SHM_V + v_rd_off((k) & 3, (k) >> 2, 1)>(vb); } while (0)
#define MLA2_PM(k, L, H) do { const bf16x8 pa_ = ((k) >> 2) == 0 ? pa0 : ((k) >> 2) == 1 ? pa1 : ((k) >> 2) == 2 ? pa2 : pa3; \
    o[(k) & 3] = __builtin_amdgcn_mfma_f32_32x32x16_bf16(pa_, MLA2_PK(L, H), o[(k) & 3], 0, 0, 0); } while (0)
#define MLA2_MX(Q, b) do { mx = max3f(mx, Q[b], Q[b + 1]); mx = max3f(mx, Q[b + 2], Q[b + 3]); mx = max3f(mx, Q[b + 4], Q[b + 5]); mx = max3f(mx, Q[b + 6], Q[b + 7]); } while (0)
#define MLA2_EX(Q, b) do { _Pragma("unroll") for (int e_ = 0; e_ < 2; ++e_) Q[(b) + e_] = __builtin_amdgcn_exp2f(Q[(b) + e_]); asm volatile("" : "+v"(Q)); } while (0)
  MLA2_PR(0, l0, h0); MLA2_PR(1, l1, h1); MLA2_PR(2, l2, h2);
  mx = q0[0];
  MLA2_W2(4, l0, h0); MLA2_PM(0, l0, h0); MLA2_PR(3, l0, h0); if constexpr (!FAST) MLA2_MX(q0, 0); MLA2_SBAR();
  MLA2_W2(4, l1, h1); MLA2_PM(1, l1, h1); MLA2_PR(4, l1, h1); if constexpr (!FAST) MLA2_MX(q0, 8); MLA2_SBAR();
  MLA2_W2(4, l2, h2); MLA2_PM(2, l2, h2); MLA2_PR(5, l2, h2); if constexpr (!FAST) MLA2_MX(q1, 0); MLA2_SBAR();
  MLA2_W2(4, l0, h0); MLA2_PM(3, l0, h0); MLA2_PR(6, l0, h0); if constexpr (!FAST) MLA2_MX(q1, 8); MLA2_SBAR();
  MLA2_W2(4, l1, h1); MLA2_PM(4, l1, h1); MLA2_PR(7, l1, h1);
  if constexpr (!FAST) { auto rr = __builtin_amdgcn_permlane32_swap(__float_as_uint(mx), __float_as_uint(mx), false, false); mx = fmaxf(__uint_as_float(rr[0]), __uint_as_float(rr[1])); }
  alpha = 1.f;
  if (!FAST && __builtin_expect(!__all(mx <= THRL), 0)) {
    const float dl = fmaxf(mx, 0.f); alpha = __builtin_amdgcn_exp2f(-dl); m_reg += dl;
#pragma unroll
    for (int r = 0; r < 16; ++r) { q0[r] -= dl; q1[r] -= dl; Mt[r] -= dl; } }
  asm volatile("" : "+v"(alpha), "+v"(m_reg));
  MLA2_SBAR();
  MLA2_W2(4, l2, h2); MLA2_PM(5, l2, h2); MLA2_PR(8, l2, h2); MLA2_EX(q0, 0); MLA2_SBAR();
  MLA2_W2(4, l0, h0); MLA2_PM(6, l0, h0); MLA2_PR(9, l0, h0); MLA2_EX(q0, 2); MLA2_SBAR();
  MLA2_W2(4, l1, h1); MLA2_PM(7, l1, h1); MLA2_PR(10, l1, h1); MLA2_EX(q0, 4); MLA2_SBAR();
  MLA2_W2(4, l2, h2); MLA2_PM(8, l2, h2); MLA2_PR(11, l2, h2); MLA2_EX(q0, 6); MLA2_SBAR();
  MLA2_W2(4, l0, h0); MLA2_PM(9, l0, h0); MLA2_PR(12, l0, h0); MLA2_EX(q0, 8); MLA2_SBAR();
  MLA2_W2(4, l1, h1); MLA2_PM(10, l1, h1); MLA2_PR(13, l1, h1); MLA2_EX(q0, 10); MLA2_SBAR();
  MLA2_W2(4, l2, h2); MLA2_PM(11, l2, h2); MLA2_PR(14, l2, h2); MLA2_EX(q0, 12); MLA2_SBAR();
  MLA2_W2(4, l0, h0); MLA2_PM(12, l0, h0); MLA2_PR(15, l0, h0); MLA2_EX(q0, 14); MLA2_SBAR();
  MLA2_W2(4, l1, h1); MLA2_PM(13, l1, h1); MLA2_SBAR();
  MLA2_W2(2, l2, h2); MLA2_PM(14, l2, h2); MLA2_SBAR();
  MLA2_W2(0, l0, h0); MLA2_PM(15, l0, h0); MLA2_SBAR();
#undef MLA2_PK
#undef MLA2_PR
#undef MLA2_PM
#undef MLA2_MX
#undef MLA2_EX
}
__device__ __forceinline__ float bflo(unsigned u) { return __uint_as_float(u << 16); }
__device__ __forceinline__ float bfhi(unsigned u) { return __uint_as_float(u & 0xffff0000u); }

struct CvJob { const float* w1; const float* w3; const float* w2; unsigned char* d13; unsigned char* d2; float scale; int next, stride; };
constexpr int CV_G13 = 8 * (2048 / 16) * (7168 / 64), CV_G2 = 8 * (7168 / 16) * (2048 / 64), CV_NG = 2 * CV_G13 + CV_G2;
__device__ __forceinline__ void cv_issue(const CvJob& J, int lane, float (&r)[16], unsigned char*& dst) {
  const int g = J.next;
  if (g < 2 * CV_G13) { const int mm = g / CV_G13, rem = g - mm * CV_G13, e = rem / 14336, r2 = rem - e * 14336, nb = r2 >> 7, kb = r2 & 127;
    const float* src = (mm ? J.w3 : J.w1) + (size_t)e * 2048 * 7168 + (size_t)(kb * 16) * 7168 + nb * 64;
    unsigned vo = (unsigned)lane * 4u;
#pragma unroll
    for (int i = 0; i < 16; ++i) asm volatile("global_load_dword %0, %1, %2\n\tv_add_u32 %1, %3, %1" : "=&v"(r[i]), "+v"(vo) : "s"(src), "i"(7168 * 4) : "memory");
    dst = J.d13 + (size_t)e * 14336 * 2048 + (size_t)(nb * 128 + mm * 16) * 2048 + kb * 16;
  } else { const int g2 = g - 2 * CV_G13, e = g2 / 14336, r2 = g2 - e * 14336, nb = r2 / 448, kb = r2 - nb * 448;
    const float* src = J.w2 + (size_t)e * 7168 * 2048 + (size_t)(kb * 16) * 2048 + nb * 64;
    unsigned vo = (unsigned)lane * 4u;
#pragma unroll
    for (int i = 0; i < 16; ++i) asm volatile("global_load_dword %0, %1, %2\n\tv_add_u32 %1, %3, %1" : "=&v"(r[i]), "+v"(vo) : "s"(src), "i"(2048 * 4) : "memory");
    dst = J.d2 + (size_t)e * 2048 * 7168 + (size_t)(nb * 64) * 7168 + kb * 16; }
}
__device__ __forceinline__ unsigned cv_pk4(float a, float b, float c, float d, float s) {
  a = __builtin_amdgcn_fmed3f(a * s, -448.f, 448.f); b = __builtin_amdgcn_fmed3f(b * s, -448.f, 448.f); c = __builtin_amdgcn_fmed3f(c * s, -448.f, 448.f); d = __builtin_amdgcn_fmed3f(d * s, -448.f, 448.f);
  int w = 0; w = __builtin_amdgcn_cvt_pk_fp8_f32(a, b, w, false); w = __builtin_amdgcn_cvt_pk_fp8_f32(c, d, w, true); return (unsigned)w; }
__device__ __forceinline__ void cv_landed(float (&r)[16]) {
  asm volatile("" : "+v"(r[0]), "+v"(r[1]), "+v"(r[2]), "+v"(r[3]), "+v"(r[4]), "+v"(r[5]), "+v"(r[6]), "+v"(r[7]));
  asm volatile("" : "+v"(r[8]), "+v"(r[9]), "+v"(r[10]), "+v"(r[11]), "+v"(r[12]), "+v"(r[13]), "+v"(r[14]), "+v"(r[15]));
}
__device__ __forceinline__ void cv_finish(const CvJob& J, const float (&r)[16], unsigned char* dst, int lane) {
  dst += (J.next < 2 * CV_G13) ? (size_t)(((lane >> 4) * 32 + (lane & 15)) * 2048) : (size_t)(lane * 7168);
  u32x4 o; o[0] = cv_pk4(r[0], r[1], r[2], r[3], J.scale); o[1] = cv_pk4(r[4], r[5], r[6], r[7], J.scale); o[2] = cv_pk4(r[8], r[9], r[10], r[11], J.scale); o[3] = cv_pk4(r[12], r[13], r[14], r[15], J.scale);
  *reinterpret_cast<u32x4*>(dst) = o;
}
constexpr int OFF_BADFLAG = 163840 - 512 + 96;
template <bool FAST> __device__ __forceinline__ bool attn_unit(const unsigned short* __restrict__ Qg, const unsigned short* __restrict__ KVg, const unsigned short* __restrict__ KPg,
                                          const float* __restrict__ cosT, const float* __restrict__ sinT, unsigned short* __restrict__ Og, int h, int q0, int seq, char* lds, CvJob& J) {
  int tid_ = (int)threadIdx.x; asm volatile("" : "+v"(tid_));
  const int tid = tid_, wid = tid >> 6, lane = tid & 63, r32 = lane & 31, hi = lane >> 5;
  char* V_lds = lds + OFF_V; char* KN_lds = lds + OFF_KN;
  float* ws = (float*)(lds + OFF_WS) + wid * 64; float* li_l = ws; float* al_l = ws + 32;
  float m_reg = 0.f, l_reg = 0; f32x16 o[4] = {}; f32x16 Mt; bf16x8 qr[NQREG];
  char* Qs = lds + OFF_QS + wid * QS_WAVE;
  {
    const int qrow = q0 + wid * QBLK + r32;
    const unsigned short* Qw = Qg + (size_t)qrow * LDQ + h * 192 + hi * 8;
#pragma unroll
    for (int d0 = 0; d0 < 8; ++d0) { const bf16x8 v = *reinterpret_cast<const bf16x8*>(Qw + d0 * 16);
      if (d0 < NQREG) qr[d0 < NQREG ? d0 : 0] = v; else *reinterpret_cast<bf16x8*>(Qs + MLA2_QB(r32, (d0 - NQREG) * 2 + hi)) = v; }
#pragma unroll
    for (int ab = 0; ab < 2; ++ab) {
      const u32x4 x1 = *reinterpret_cast<const u32x4*>(Qw + 128 + ab * 16), x2 = *reinterpret_cast<const u32x4*>(Qw + 128 + 32 + ab * 16);
      const float* cp = cosT + (size_t)qrow * 32 + ab * 16 + hi * 8; const float* sp = sinT + (size_t)qrow * 32 + ab * 16 + hi * 8;
      const f32x4v c0 = *reinterpret_cast<const f32x4v*>(cp), c1 = *reinterpret_cast<const f32x4v*>(cp + 4), s0 = *reinterpret_cast<const f32x4v*>(sp), s1 = *reinterpret_cast<const f32x4v*>(sp + 4);
      u32x4 o1, o2;
#define MLA2_ROT(W, CL, CH, SL, SH) do { const float a0 = bflo(x1[W]), a1 = bfhi(x1[W]), b0 = bflo(x2[W]), b1 = bfhi(x2[W]); \
        o1[W] = cvtpk(a0 * (CL) - b0 * (SL), a1 * (CH) - b1 * (SH)); o2[W] = cvtpk(b0 * (CL) + a0 * (SL), b1 * (CH) + a1 * (SH)); } while (0)
      MLA2_ROT(0, c0[0], c0[1], s0[0], s0[1]); MLA2_ROT(1, c0[2], c0[3], s0[2], s0[3]); MLA2_ROT(2, c1[0], c1[1], s1[0], s1[1]); MLA2_ROT(3, c1[2], c1[3], s1[2], s1[3]);
#undef MLA2_ROT
      *reinterpret_cast<u32x4*>(Qs + MLA2_QB(r32, (8 + ab - NQREG) * 2 + hi)) = o1;
      *reinterpret_cast<u32x4*>(Qs + MLA2_QB(r32, (10 + ab - NQREG) * 2 + hi)) = o2;
    }
  }
  const int lo = r32 * 32 + ((hi ^ ((r32 >> 3) & 1)) << 4);
  const int qbase = (int)(uintptr_t)Qs + lo;
  int kb[4];
#pragma unroll
  for (int j = 0; j < 4; ++j) kb[j] = (int)(uintptr_t)KN_lds + r32 * 128 + (((j * 2 + hi) ^ ((r32 >> 1) & 7)) << 4);
  const int vb0 = (int)(uintptr_t)V_lds + v_rd_base(lane);
  const unsigned short* Kh = KVg + h * 256; const unsigned short* Vh = KVg + h * 256 + 128;
  const int wu = __builtin_amdgcn_readfirstlane(wid);
  unsigned kd_off[3], kd_lds[3]; const unsigned short* kd_base[3]; int kd_stride[3];
#pragma unroll
  for (int i = 0; i < 3; ++i) { const int pi = 3 * wu + i, img = pi >> 3, grp = pi & 7, row = 8 * grp + (lane >> 3), c8 = (lane & 7) ^ ((row >> 1) & 7);
    kd_lds[i] = (unsigned)(uintptr_t)KN_lds + (unsigned)pi * 1024u;
    if (img < 2) { kd_base[i] = Kh + img * 64; kd_stride[i] = LDKV; kd_off[i] = (unsigned)(row * LDKV + c8 * 8) * 2u; }
    else { kd_base[i] = KPg; kd_stride[i] = LDKP; kd_off[i] = (unsigned)(row * LDKP + c8 * 8) * 2u; } }
  const int vkk = wu * 8 + ((lane & 31) >> 2), vk = (vkk & ~0xC) | ((vkk & 4) << 1) | ((vkk & 8) >> 1);
  const unsigned v_off = (unsigned)(vk * LDKV + (lane >> 5) * 32 + (lane & 3) * 8) * 2u;
  const unsigned ldsV = (unsigned)(uintptr_t)V_lds + (unsigned)wu * 2048u;
#define MLA2_DMA_K(b, k0) do { _Pragma("unroll") for (int i_ = 0; i_ < 3; ++i_) pg8::glds16s(kd_base[i_] + (size_t)(k0) * kd_stride[i_], kd_off[i_], kd_lds[i_] + (b) * SHM_K); } while (0)
#define MLA2_DMA_V(b, k0) do { const unsigned short* vb_ = Vh + (size_t)(k0) * LDKV; \
    pg8::glds16s(vb_, v_off, ldsV + (b) * SHM_V); pg8::glds16s(vb_ + 64, v_off, ldsV + (b) * SHM_V + 1024u); } while (0)
#define MLA2_LANDED() do { asm volatile("s_waitcnt vmcnt(0)" ::: "memory"); __syncthreads(); } while (0)
#define MLA2_RESC(a) do { if (__any((a) < 1.f)) { if (hi == 0) al_l[r32] = (a); asm volatile("s_waitcnt lgkmcnt(0)" ::: "memory"); \
    _Pragma("unroll") for (int d = 0; d < 4; ++d) _Pragma("unroll") for (int r = 0; r < 16; ++r) o[d][r] *= al_l[crow(r, hi)]; } } while (0)
  f32x16 pA0, pA1, pB0, pB1; float mnA, alA, alB; bf16x8 pa0, pa1, pa2, pa3; const int NT = seq / KVBLK;
  MLA2_DMA_K(0, 0); MLA2_DMA_V(0, 0); MLA2_DMA_K(1, KVBLK);
  MLA2_LANDED();
  qkt<0>(pA0, pA1, kb, qbase, qr); partialSM0(pA0, pA1, m_reg, Mt); alA = 1.f;
  __syncthreads();
  if (2 < NT) MLA2_DMA_K(0, 2 * KVBLK); MLA2_DMA_V(1, KVBLK);
  for (int j = 1; j + 1 < NT; j += 2) {
    float cvr[16]; unsigned char* cvd = nullptr; const bool cv_on = J.next < CV_NG;
    if (cv_on) cv_issue(J, lane, cvr, cvd);
    MLA2_SBAR(); r1<1>(pB0, pB1, kb, qbase, qr, pA0, pA1, alA, l_reg, pa0, pa1, pa2, pa3, Mt);
    r2<0, FAST>(o, vb0, pa0, pa1, pa2, pa3, pB0, pB1, m_reg, alB, Mt);
    MLA2_RESC(alB); MLA2_LANDED();
    if (cv_on) cv_landed(cvr);
    if (j + 2 < NT) MLA2_DMA_K(1, (j + 2) * KVBLK); MLA2_DMA_V(0, (j + 1) * KVBLK);
    MLA2_SBAR(); r1<0>(pA0, pA1, kb, qbase, qr, pB0, pB1, alB, l_reg, pa0, pa1, pa2, pa3, Mt);
    r2<1, FAST>(o, vb0, pa0, pa1, pa2, pa3, pA0, pA1, m_reg, alA, Mt);
    if (cv_on) { cv_finish(J, cvr, cvd, lane); J.next += J.stride; }
    MLA2_RESC(alA); MLA2_LANDED();
    if (j + 3 < NT) MLA2_DMA_K(0, (j + 3) * KVBLK); MLA2_DMA_V(1, (j + 2) * KVBLK);
  }
  MLA2_SBAR(); r1<1>(pB0, pB1, kb, qbase, qr, pA0, pA1, alA, l_reg, pa0, pa1, pa2, pa3, Mt);
  r2<0, FAST>(o, vb0, pa0, pa1, pa2, pa3, pB0, pB1, m_reg, alB, Mt);
  MLA2_RESC(alB); MLA2_LANDED();
  finishSM(pB0, pB1, alB, l_reg, pa0, pa1, pa2, pa3); MLA2_SBAR();
  pv<1>(o, vb0, pa0, pa1, pa2, pa3);
  if (hi == 0) li_l[r32] = l_reg; asm volatile("s_waitcnt lgkmcnt(0)" ::: "memory");
  float rli[16];
#pragma unroll
  for (int r = 0; r < 16; ++r) rli[r] = __builtin_amdgcn_rcpf(li_l[crow(r, hi)]);
  unsigned short* Ow = Og + (size_t)(q0 + wid * QBLK) * LDO + h * 128;
#pragma unroll
  for (int r = 0; r < 16; ++r) { const int orow = crow(r, hi);
#pragma unroll
    for (int d0 = 0; d0 < 4; ++d0) { const float v = o[d0][r] * rli[r]; unsigned u = __float_as_uint(v); u = (u + 0x7fffu + ((u >> 16) & 1u)) >> 16; Ow[(size_t)orow * LDO + d0 * 32 + r32] = (unsigned short)u; } }
  bool ok = true;
  if constexpr (FAST) { volatile unsigned* flag = reinterpret_cast<volatile unsigned*>(lds + OFF_BADFLAG);
    const bool bad = !(l_reg < 1.0e30f);
    if (__any(bad) && lane == 0) *flag = 1u;
    __syncthreads(); ok = (__builtin_amdgcn_readfirstlane((int)*flag) == 0); }
  __syncthreads();
  return ok;
#undef MLA2_DMA_K
#undef MLA2_DMA_V
#undef MLA2_LANDED
#undef MLA2_RESC
}
}
constexpr int S = 16384, D = 2048;
constexpr int E_IN = 5120, CONVD = 1024, CONVW = 31, DIL_H = 16;
constexpr int FD = 5632;
constexpr int O_INP = 1280;
constexpr int QL = 512, KVL = 128, KVLP = 128, S5D = 512;
constexpr int NQ = 2304, NKV = 3072;
constexpr int NE = 8, FE = 7168;
constexpr int MAXROWS = 34816, MAXTILES = 136;
constexpr int S5_CL = 128, S5_NCH = S / S5_CL;
constexpr int ADA_KS = 16;
constexpr float MOE_WSCALE = 1024.f, MOE_HSCALE = 16.f, MOE_ASCALE = 8.f, MOE_YSCALE = 64.f;

constexpr size_t MiB = 1u << 20;
constexpr size_t WS_CTL = 0, CTL_ZERO_BYTES = 1 * MiB;
constexpr size_t WS_MODP = 1 * MiB;
constexpr size_t WS_COS = 3 * MiB, WS_SIN = 5 * MiB;
constexpr size_t WS_S5P = 7 * MiB;
constexpr size_t WS_S5E = 384 * MiB;
constexpr size_t WS_ROUTE = 10 * MiB;
constexpr size_t RT_TOKE = 0, RT_TOKG = 128 * 1024, RT_POS = 256 * 1024, RT_ROWIDX = 384 * 1024, RT_TEXP = 528 * 1024, RT_NTILE = 529 * 1024;
constexpr size_t WS_YF = 11 * MiB;
constexpr size_t WS_WB = 44 * MiB;
constexpr size_t WB_EIN = WS_WB, WB_EOUT = WS_WB + 20 * MiB, WB_EF13 = WS_WB + 28 * MiB, WB_EF2 = WS_WB + 72 * MiB, WB_OIN = WS_WB + 94 * MiB,
                 WB_UQ = WS_WB + 99 * MiB, WB_UKV = WS_WB + 102 * MiB, WB_GLU = WS_WB + 104 * MiB, WB_OOUT = WS_WB + 105 * MiB, WB_M13 = WS_WB + 113 * MiB, WB_M2 = WS_WB + 561 * MiB;
constexpr size_t WS_HB = 830 * MiB;
constexpr size_t WS_Y = 894 * MiB;
constexpr size_t WS_XB = 958 * MiB;
constexpr size_t WS_R = 1022 * MiB;
constexpr size_t R_Z = WS_R, R_MIX = WS_R + 160 * MiB, R_ACT = WS_R + 224 * MiB, R_PO = WS_R + 400 * MiB, R_PML = WS_R + 496 * MiB;
constexpr size_t R_Z1 = WS_R, R_CQN = WS_R + 40 * MiB, R_CKVN = WS_R + 56 * MiB, R_KPE = WS_R + 64 * MiB, R_Q = WS_R + 66 * MiB, R_KV = WS_R + 138 * MiB,
                 R_MIX2 = WS_R + 234 * MiB, R_YG = WS_R + 298 * MiB;
constexpr size_t R_YT = WS_R + 240 * MiB;
constexpr size_t R_ACTS = WS_R, R_HS8 = WS_R + 240 * MiB, R_YS = WS_R + 476 * MiB;
constexpr size_t WS_END = WS_R + 612 * MiB;
constexpr int CW_BAR = 4096;
constexpr int CW_TBCNT = 16384;
constexpr int CW_GLUCTR = 20480;

constexpr int LDS_BYTES = 163840;
constexpr int COND_OFF = 133120;
constexpr int MISC_OFF = LDS_BYTES - 512;
constexpr int NWAVES = 8;

#define GAS __attribute__((address_space(1)))
#define LAS __attribute__((address_space(3)))
typedef unsigned short bf16;
typedef unsigned v4u __attribute__((ext_vector_type(4)));
typedef unsigned v2u __attribute__((ext_vector_type(2)));
typedef float f32x4 __attribute__((ext_vector_type(4)));
typedef float f32x2 __attribute__((ext_vector_type(2)));
typedef short bf16x8 __attribute__((ext_vector_type(8)));
#define LDS_WAIT() asm volatile("s_waitcnt lgkmcnt(0)" ::: "memory")
#define VM_WAIT() asm volatile("s_waitcnt vmcnt(0)" ::: "memory")
__device__ __forceinline__ unsigned f2bf(float f) { unsigned u = __builtin_bit_cast(unsigned, f); return (u + 0x7fffu + ((u >> 16) & 1u)) >> 16; }
__device__ __forceinline__ unsigned pk2(float lo, float hi) { return f2bf(lo) | (f2bf(hi) << 16); }
__device__ __forceinline__ float bflo(unsigned u) { return __uint_as_float(u << 16); }
__device__ __forceinline__ float bfhi(unsigned u) { return __uint_as_float(u & 0xffff0000u); }
__device__ __forceinline__ float bf1(unsigned short b) { return __uint_as_float(((unsigned)b) << 16); }
__device__ __forceinline__ float fexp(float x) { return __builtin_amdgcn_exp2f(1.4426950408889634f * x); }
__device__ __forceinline__ float fsilu(float v) { return v * __builtin_amdgcn_rcpf(1.0f + fexp(-v)); }
__device__ __forceinline__ float fsigmoid(float v) { return __builtin_amdgcn_rcpf(1.0f + fexp(-v)); }
__device__ __forceinline__ float wave_sum(float v) {
#define WS_DPP(X, CTRL, RMASK) __int_as_float(__builtin_amdgcn_update_dpp(0, __float_as_int(X), CTRL, RMASK, 0xF, false))
    v += WS_DPP(v, 0xB1, 0xF);
    v += WS_DPP(v, 0x4E, 0xF);
    v += WS_DPP(v, 0x141, 0xF);
    v += WS_DPP(v, 0x140, 0xF);
    v += WS_DPP(v, 0x142, 0xA);
    v += WS_DPP(v, 0x143, 0xC);
#undef WS_DPP
    return __int_as_float(__builtin_amdgcn_readlane(__float_as_int(v), 63));
}
__device__ __forceinline__ void sincos_rev(double rev, double& s, double& c) {
    rev -= __builtin_floor(rev);
    const double q4 = __builtin_floor(rev * 4.0 + 0.5);
    const double r = rev - q4 * 0.25;
    const double th = r * 6.283185307179586476925;
    const double t2 = th * th;
    double sp = 1.0 / 1307674368000.0; sp = sp * (-t2) + 1.0 / 6227020800.0; sp = sp * (-t2) + 1.0 / 39916800.0; sp = sp * (-t2) + 1.0 / 362880.0; sp = sp * (-t2) + 1.0 / 5040.0; sp = sp * (-t2) + 1.0 / 120.0; sp = sp * (-t2) + 1.0 / 6.0; sp = sp * (-t2) + 1.0;
    const double sn = sp * th;
    double cp = 1.0 / 87178291200.0; cp = cp * (-t2) + 1.0 / 479001600.0; cp = cp * (-t2) + 1.0 / 3628800.0; cp = cp * (-t2) + 1.0 / 40320.0; cp = cp * (-t2) + 1.0 / 720.0; cp = cp * (-t2) + 1.0 / 24.0; cp = cp * (-t2) + 0.5; cp = cp * (-t2) + 1.0;
    const int q = ((int)q4) & 3;
    s = (q == 0) ? sn : (q == 1) ? cp : (q == 2) ? -sn : -cp;
    c = (q == 0) ? cp : (q == 1) ? -sn : (q == 2) ? -cp : sn;
}
__device__ __forceinline__ double exp_small(double x) {
    double p = 1.0 / 3628800.0; p = p * x + 1.0 / 362880.0; p = p * x + 1.0 / 40320.0; p = p * x + 1.0 / 5040.0; p = p * x + 1.0 / 720.0; p = p * x + 1.0 / 120.0; p = p * x + 1.0 / 24.0; p = p * x + 1.0 / 6.0; p = p * x + 0.5; p = p * x + 1.0; p = p * x + 1.0;
    return p;
}

#define XB_TMO      128
#define XB_XCNT(j)  (256  + 64 * (j))
#define XB_XSUB(j)  (1280 + 64 * (j))
#define XB_XGEN(j)  (2304 + 64 * (j))
#define XB_TOP      3328
#define XB_TOPGEN   3392
#define XCD_BAR_WORDS 3456
#define XB_SPIN_CAP (1u << 20)
__device__ __forceinline__ unsigned xb_ld(unsigned* p)              { return __hip_atomic_load(p, __ATOMIC_RELAXED, __HIP_MEMORY_SCOPE_AGENT); }
__device__ __forceinline__ unsigned xb_add(unsigned* p, unsigned v) { return __hip_atomic_fetch_add(p, v, __ATOMIC_RELAXED, __HIP_MEMORY_SCOPE_AGENT); }
__device__ __forceinline__ unsigned xb_xcc_id() { return (unsigned)__builtin_amdgcn_s_getreg((3 << 11) | 20) & 0xFu; }
#define XB_SPIN(cond, bar) do { unsigned _sp = 0; while (cond) { __builtin_amdgcn_s_sleep(1); \
    if ((++_sp & 255u) == 0u) { if (xb_ld(&(bar)[XB_TMO])) break; if (_sp > XB_SPIN_CAP) { atomicAdd(&(bar)[XB_TMO], 1u); break; } } } } while (0)
struct XcdBarrier { unsigned* bar; unsigned x; volatile LAS unsigned* st; };
__device__ __forceinline__ XcdBarrier xcd_barrier_post(unsigned* bar, volatile LAS unsigned* st) {
    XcdBarrier b; b.bar = bar; b.x = xb_xcc_id(); b.st = st;
    if (threadIdx.x == 0) (void)xb_add(&bar[XB_XCNT(b.x)], 1u);
    return b;
}
__device__ __forceinline__ void xcd_barrier_complete(unsigned* bar, unsigned x, unsigned& nloc, unsigned& nx) {
    const unsigned G = gridDim.x * gridDim.y * gridDim.z;
    unsigned sum, cnt, mine, sp = 0u;
    for (;;) {
        sum = 0u; cnt = 0u; mine = 0u;
#pragma unroll
        for (unsigned j = 0; j < 16; ++j) { const unsigned c = xb_ld(&bar[XB_XCNT(j)]); sum += c; cnt += (c > 0u) ? 1u : 0u; mine = (j == x) ? c : mine; }
        if (sum == G) break;
        __builtin_amdgcn_s_sleep(1);
        if ((++sp & 255u) == 0u) { if (xb_ld(&bar[XB_TMO])) break; if (sp > XB_SPIN_CAP) { atomicAdd(&bar[XB_TMO], 1u); break; } }
    }
    nloc = mine > 0u ? mine : 1u; nx = cnt > 0u ? cnt : 1u;
}
__device__ __forceinline__ void xcd_barrier(const XcdBarrier& b) {
    asm volatile("s_waitcnt vmcnt(0)" ::: "memory");
    __syncthreads();
    if (threadIdx.x == 0) {
        unsigned* bar = b.bar;
        __builtin_amdgcn_s_waitcnt(0);
        unsigned nloc = b.st[0], nx = b.st[1];
        if (nloc == 0u) { xcd_barrier_complete(bar, b.x, nloc, nx); b.st[0] = nloc; b.st[1] = nx; }
        const unsigned old = xb_add(&bar[XB_XSUB(b.x)], 1u);
        const unsigned gen = old / nloc;
        if (old + 1u == (gen + 1u) * nloc) {
            __builtin_amdgcn_fence(__ATOMIC_RELEASE, "agent");
            asm volatile("s_waitcnt vmcnt(0)" ::: "memory");
            const unsigned og = xb_add(&bar[XB_TOP], 1u);
            const unsigned tg = og / nx;
            if (og + 1u == (tg + 1u) * nx) xb_add(&bar[XB_TOPGEN], 1u);
            else XB_SPIN(xb_ld(&bar[XB_TOPGEN]) == tg, bar);
            __builtin_amdgcn_fence(__ATOMIC_ACQUIRE, "agent");
            xb_add(&bar[XB_XGEN(b.x)], 1u);
            asm volatile("s_waitcnt vmcnt(0)" ::: "memory");
        } else {
            XB_SPIN(xb_ld(&bar[XB_XGEN(b.x)]) == gen, bar);
            __builtin_amdgcn_fence(__ATOMIC_ACQUIRE, "agent");
            asm volatile("s_waitcnt vmcnt(0)" ::: "memory");
        }
    }
    __syncthreads();
}

struct Args { const float* in[34]; float* out; unsigned char* ws; int ph_lo, ph_hi; };
enum { I_X = 0, I_C, I_T5, I_NG, I_ADAW, I_ADAB, I_EWIN, I_ECW, I_ECB, I_ECG, I_ECLB, I_EWOUT, I_EF1, I_EF3, I_EF2, I_OWIN, I_QNG, I_UQ, I_KVNG, I_UKV,
       I_SARE, I_SAIM, I_SLDT, I_SBRE, I_SBIM, I_SCRE, I_SCIM, I_SD, I_SGLU, I_OWOUT, I_RW, I_M1, I_M3, I_M2 };
struct Frame {
    LAS unsigned char* lds;
    const Args* a;
    unsigned char* ws;
    int tid, lane, wave, vcu, G, gw, NGW;
};

__device__ __forceinline__ void cvt_tile(const float* __restrict__ W, int K, int N, bf16* __restrict__ Wt, int ldk, int grp, int mul, int off, int item, LAS float* scr, int lane) {
    const int nblk = N >> 6, kb = item / nblk, nb = item - kb * nblk, k0 = kb << 6, n0 = nb << 6;
    const int lc = (lane & 15) * 4, lr = lane >> 4;
    f32x4 v[16];
#pragma unroll
    for (int i = 0; i < 16; ++i) v[i] = *(const f32x4*)(W + (size_t)(k0 + lr + 4 * i) * N + n0 + lc);
#pragma unroll
    for (int i = 0; i < 16; ++i) { LAS float* d = scr + (lr + 4 * i) * 65 + lc; d[0] = v[i][0]; d[1] = v[i][1]; d[2] = v[i][2]; d[3] = v[i][3]; }
    LDS_WAIT();
    const int c = lane & 7;
#pragma unroll
    for (int j = 0; j < 8; ++j) { const int n = (lane >> 3) + 8 * j; const LAS float* s = scr + (8 * c) * 65 + n;
        v4u o; o.x = pk2(s[0 * 65], s[1 * 65]); o.y = pk2(s[2 * 65], s[3 * 65]); o.z = pk2(s[4 * 65], s[5 * 65]); o.w = pk2(s[6 * 65], s[7 * 65]);
        const int nn = n0 + n, drow = (nn / grp) * (grp * mul) + off + (nn % grp);
        *(v4u*)(Wt + (size_t)drow * ldk + k0 + 8 * c) = o; }
    LDS_WAIT();
}

__device__ __forceinline__ unsigned pk4_fp8(float a, float b, float c, float d) {
    a = __builtin_fminf(__builtin_fmaxf(a, -448.f), 448.f); b = __builtin_fminf(__builtin_fmaxf(b, -448.f), 448.f); c = __builtin_fminf(__builtin_fmaxf(c, -448.f), 448.f); d = __builtin_fminf(__builtin_fmaxf(d, -448.f), 448.f);
    int w = 0; w = __builtin_amdgcn_cvt_pk_fp8_f32(a, b, w, false); w = __builtin_amdgcn_cvt_pk_fp8_f32(c, d, w, true); return (unsigned)w; }
__device__ __forceinline__ void cvt_tile8(const float* __restrict__ W, int K, int N, unsigned char* __restrict__ Wt, int ldk, int grp, int mul, int off, float scale, int item, LAS float* scr, int lane) {
    const int nblk = N >> 6, kb = item / nblk, nb = item - kb * nblk, k0 = kb << 6, n0 = nb << 6;
    const int lc = (lane & 15) * 4, lr = lane >> 4;
    f32x4 v[16];
#pragma unroll
    for (int i = 0; i < 16; ++i) v[i] = *(const f32x4*)(W + (size_t)(k0 + lr + 4 * i) * N + n0 + lc);
#pragma unroll
    for (int i = 0; i < 16; ++i) { LAS float* d = scr + (lr + 4 * i) * 65 + lc; d[0] = v[i][0] * scale; d[1] = v[i][1] * scale; d[2] = v[i][2] * scale; d[3] = v[i][3] * scale; }
    LDS_WAIT();
    const int c = lane & 3;
#pragma unroll
    for (int j = 0; j < 4; ++j) { const int n = (lane >> 2) + 16 * j; const LAS float* s = scr + (16 * c) * 65 + n;
        v4u o; o.x = pk4_fp8(s[0 * 65], s[1 * 65], s[2 * 65], s[3 * 65]); o.y = pk4_fp8(s[4 * 65], s[5 * 65], s[6 * 65], s[7 * 65]);
        o.z = pk4_fp8(s[8 * 65], s[9 * 65], s[10 * 65], s[11 * 65]); o.w = pk4_fp8(s[12 * 65], s[13 * 65], s[14 * 65], s[15 * 65]);
        const int nn = n0 + n, drow = (nn / grp) * (grp * mul) + off + (nn % grp);
        *(v4u*)(Wt + (size_t)drow * ldk + k0 + 16 * c) = o; }
    LDS_WAIT();
}

__device__ __forceinline__ void p0_prologue(Frame& F) {
    const Args& A = *F.a;
    LAS float* condL = (LAS float*)(F.lds + COND_OFF);
    for (int i = F.tid; i < D; i += NWAVES * 64) condL[i] = fsilu(A.in[I_C][i]);
    __syncthreads();
    LAS float* scr = (LAS float*)(F.lds + F.wave * 16640);
    const int lane = F.lane;
    constexpr int N_ADA = 96 * ADA_KS, N_ROPE = S * 32 / 64, N_S5 = 64, N_Z1 = 256, N_Z2 = 0;
#define CVT_M(SRC, KK, NN, DSTOFF, LDK, GRP, MUL, OFF, NEXP) { constexpr int per = ((KK) / 64) * ((NN) / 64); constexpr int tot = per * (NEXP); \
        if (r < tot) { const int e = r / per, t = r - e * per; cvt_tile(A.in[SRC] + (size_t)e * (KK) * (NN), KK, NN, (bf16*)(F.ws + (DSTOFF)) + (size_t)e * ((NN) * (MUL)) * (LDK), LDK, GRP, MUL, OFF, t, scr, lane); continue; } r -= tot; }
#define CVT_M8(SRC, KK, NN, DSTOFF, LDK, GRP, MUL, OFF, NEXP) { constexpr int per = ((KK) / 64) * ((NN) / 64); constexpr int tot = per * (NEXP); \
        if (r < tot) { const int e = r / per, t = r - e * per; cvt_tile8(A.in[SRC] + (size_t)e * (KK) * (NN), KK, NN, (unsigned char*)(F.ws + (DSTOFF)) + (size_t)e * ((NN) * (MUL)) * (LDK), LDK, GRP, MUL, OFF, MOE_WSCALE, t, scr, lane); continue; } r -= tot; }
    constexpr int N_CVT = (32 * 80) + (32 * 32) + 2 * (32 * 88) + (88 * 32) + (32 * 19) + (8 * 36) + (2 * 48) + (8 * 8) + (32 * 32);
    constexpr int N_ITEMS = N_CVT + N_ADA + N_ROPE + N_S5 + N_Z1 + N_Z2;
    LAS unsigned* p0ctr = (LAS unsigned*)(F.lds + MISC_OFF) + 16;
    int it, nx = 0;
#define P0_GRAB(dst) do { unsigned v_ = 0u; if (lane == 0) v_ = __hip_atomic_fetch_add(p0ctr, 1u, __ATOMIC_RELAXED, __HIP_MEMORY_SCOPE_WORKGROUP); dst = (int)__builtin_amdgcn_readfirstlane(v_) * F.G + F.vcu; } while (0)
    P0_GRAB(it);
    for (; it < N_ITEMS; it = nx) {
        P0_GRAB(nx);
        int r = it;
        if (r < N_ADA) {
            const int chunk = r % 96, ks = r / 96, l = chunk / 48, n0 = (chunk % 48) * 256;
            const float* w = A.in[I_ADAW] + (size_t)l * D * 12288 + (size_t)(ks * 128) * 12288 + n0 + 4 * lane;
            f32x4 acc = {0.f, 0.f, 0.f, 0.f};
#pragma unroll 16
            for (int k = 0; k < 128; ++k) { const f32x4 v = *(const f32x4*)(w + (size_t)k * 12288); const float cv = condL[ks * 128 + k]; acc += v * cv; }
            *(f32x4*)((float*)(F.ws + WS_MODP) + (size_t)ks * 24576 + l * 12288 + n0 + 4 * lane) = acc;
            continue; }
        r -= N_ADA;
        CVT_M(I_EWIN, 2048, 5120, WB_EIN, 2048, 64, 1, 0, 1)
        CVT_M(I_EWOUT, 2048, 2048, WB_EOUT, 2048, 64, 1, 0, 1)
        CVT_M(I_EF1, 2048, 5632, WB_EF13, 2048, 16, 2, 0, 1)
        CVT_M(I_EF3, 2048, 5632, WB_EF13, 2048, 16, 2, 16, 1)
        CVT_M(I_EF2, 5632, 2048, WB_EF2, 5632, 64, 1, 0, 1)
        CVT_M(I_OWIN, 2048, 1216, WB_OIN, 2048, 64, 1, 0, 1)
        CVT_M(I_UQ, 512, 2304, WB_UQ, 512, 64, 1, 0, 1)
        CVT_M(I_UKV, 128, 3072, WB_UKV, KVLP, 64, 1, 0, 1)
        CVT_M(I_SGLU, 512, 512, WB_GLU, 512, 64, 1, 0, 1)
        CVT_M(I_OWOUT, 2048, 2048, WB_OOUT, 2048, 64, 1, 0, 1)
        if (r < N_ROPE) {
            const int idx = r * 64 + lane, pos = idx >> 5, j = idx & 31;
            double f = 1.0; for (int q = 0; q < j; ++q) f *= 0.74989420933245582730;
            const float ang = (float)pos * (float)f;
            double sn, cs; sincos_rev((double)ang * 0.15915494309189533577, sn, cs);
            ((float*)(F.ws + WS_COS))[idx] = (float)cs; ((float*)(F.ws + WS_SIN))[idx] = (float)sn;
            continue; }
        r -= N_ROPE;
        if (r < N_S5) {
            const int p = lane;
            const double are = (double)A.in[I_SARE][r * 64 + p], aim = (double)A.in[I_SAIM][r * 64 + p];
            const double dt = (double)fexp(A.in[I_SLDT][r]);
            const double er = exp_small(are * dt); double sn, cs; sincos_rev(aim * dt * 0.15915494309189533577, sn, cs);
            const double abr = er * cs, abi = er * sn;
            double eL = er; for (int q = 1; q < S5_CL; q <<= 1) eL *= eL;
            double snL, csL; sincos_rev(aim * dt * (double)S5_CL * 0.15915494309189533577, snL, csL);
            const double nr = abr - 1.0, ni = abi, den = are * are + aim * aim;
            const double qr = (nr * are + ni * aim) / den, qi = (ni * are - nr * aim) / den;
            float* o = (float*)(F.ws + WS_S5P) + (size_t)r * 36 * 64;
            o[0 * 64 + p] = (float)abr; o[1 * 64 + p] = (float)abi; o[2 * 64 + p] = (float)(eL * csL); o[3 * 64 + p] = (float)(eL * snL);
#pragma unroll
            for (int c = 0; c < 16; ++c) { const double br = (double)A.in[I_SBRE][(size_t)(r * 64 + p) * 16 + c], bi = (double)A.in[I_SBIM][(size_t)(r * 64 + p) * 16 + c];
                o[(4 + c) * 64 + p] = (float)(qr * br - qi * bi); o[(20 + c) * 64 + p] = (float)(qr * bi + qi * br); }
            continue; }
        r -= N_S5;
        if (r < N_Z1) { ((v4u*)(F.ws + WB_OIN + (size_t)1216 * 2048 * 2))[r * 64 + lane] = (v4u){0u, 0u, 0u, 0u}; continue; }
        r -= N_Z1;
        (void)r;
    }
#undef CVT_M
#undef CVT_M8
#undef P0_GRAB
}

__device__ __forceinline__ float mod_val(Frame& F, int L, int chunk, int col) {
    const Args& A = *F.a; const int o = L * 12288 + chunk * 2048 + col;
    float s = A.in[I_ADAB][o]; const float* mp = (const float*)(F.ws + WS_MODP) + o;
#pragma unroll
    for (int ks = 0; ks < ADA_KS; ++ks) s += mp[(size_t)ks * 24576];
    return s;
}
__device__ __forceinline__ void moe_tail_plan(int nt, int& nfull, int& s) {
    nfull = nt & ~31; const int tl = nt - nfull;
    s = (tl == 0 || tl > 16) ? 1 : (tl <= 4 ? 7 : (tl <= 8 ? 4 : 2));
    if (s == 1) nfull = nt;
}
template <bool RES, bool HOUT, bool ROUTE, bool GATHER, bool XIB = false, bool XOB = false>
__device__ __forceinline__ void resnorm_phase(Frame& F, const void* xin_, void* xout_, const bf16* y, int Lr, int gchunk, int gi1, int Lh, int shchunk, int gi2) {
    const Args& A = *F.a;
    LAS float* A1 = (LAS float*)F.lds; LAS float* A2 = A1 + D; LAS float* B2 = A2 + D; LAS float* RT = B2 + D;
    for (int col = F.tid; col < D; col += NWAVES * 64) {
        if (RES) A1[col] = mod_val(F, Lr, gchunk, col) * A.in[I_NG][(Lr * 4 + gi1) * D + col];
        if (HOUT) { A2[col] = A.in[I_NG][(Lh * 4 + gi2) * D + col] * (1.0f + mod_val(F, Lh, shchunk + 1, col)); B2[col] = mod_val(F, Lh, shchunk, col); }
    }
    if (ROUTE) for (int i = F.tid; i < D * NE; i += NWAVES * 64) RT[(i & 7) * D + (i >> 3)] = A.in[I_RW][i];
    __syncthreads();
    const int lane = F.lane;
    bf16* hb = (bf16*)(F.ws + WS_HB);
    for (int row = F.gw; row < S; row += F.NGW) {
        f32x4 xv[8];
        if (XIB) { const bf16* xin = (const bf16*)xin_;
#pragma unroll
            for (int j = 0; j < 8; ++j) { const v2u a = *(const v2u*)(xin + (size_t)row * D + 4 * lane + 256 * j); xv[j] = (f32x4){bflo(a.x), bfhi(a.x), bflo(a.y), bfhi(a.y)}; }
        } else { const float* xin = (const float*)xin_;
#pragma unroll
            for (int j = 0; j < 8; ++j) xv[j] = *(const f32x4*)(xin + (size_t)row * D + 4 * lane + 256 * j); }
        if (RES) {
            f32x4 yv[8];
            if (GATHER) {
                const int* pos = (const int*)(F.ws + WS_ROUTE + RT_POS); const float* tg = (const float*)(F.ws + WS_ROUTE + RT_TOKG);
                const unsigned char* ys = (const unsigned char*)(F.ws + R_YS); const bf16* yt = (const bf16*)(F.ws + R_YT);
                int nfull, sp; const int ntl = __builtin_amdgcn_readfirstlane(*(const int*)(F.ws + WS_ROUTE + RT_NTILE)); moe_tail_plan(ntl, nfull, sp);
                const int ts = nfull * 256; const size_t sstr = (size_t)(ntl - nfull) * 256 * D;
                const int p0 = __builtin_amdgcn_readfirstlane(pos[2 * row]), p1 = __builtin_amdgcn_readfirstlane(pos[2 * row + 1]);
                if (p0 < ts && p1 < ts) {
                    const float g0 = tg[2 * row] * (1.0f / MOE_YSCALE), g1 = tg[2 * row + 1] * (1.0f / MOE_YSCALE);
#pragma unroll
                    for (int j = 0; j < 8; ++j) { const unsigned a = *(const unsigned*)(ys + (size_t)p0 * D + 4 * lane + 256 * j), b = *(const unsigned*)(ys + (size_t)p1 * D + 4 * lane + 256 * j);
                        const f32x2 a0 = __builtin_amdgcn_cvt_pk_f32_fp8((int)a, false), a1 = __builtin_amdgcn_cvt_pk_f32_fp8((int)a, true), b0 = __builtin_amdgcn_cvt_pk_f32_fp8((int)b, false), b1 = __builtin_amdgcn_cvt_pk_f32_fp8((int)b, true);
                        yv[j] = (f32x4){g0 * a0[0] + g1 * b0[0], g0 * a0[1] + g1 * b0[1], g0 * a1[0] + g1 * b1[0], g0 * a1[1] + g1 * b1[1]}; }
                } else {
#pragma unroll
                for (int j = 0; j < 8; ++j) yv[j] = (f32x4){0.f, 0.f, 0.f, 0.f};
#pragma unroll
                for (int hf = 0; hf < 2; ++hf) { const int p = hf ? p1 : p0; const float g = tg[2 * row + hf];
                    if (p >= ts) {
                        const bf16* bp = yt + (size_t)(p - ts) * D + 4 * lane;
                        f32x4 t[8];
#pragma unroll
                        for (int j = 0; j < 8; ++j) t[j] = (f32x4){0.f, 0.f, 0.f, 0.f};
#pragma nounroll
                        for (int ks = 0; ks < sp; ++ks) {
#pragma unroll
                            for (int j = 0; j < 8; ++j) { const v2u a = *(const v2u*)(bp + (size_t)ks * sstr + 256 * j); t[j] += (f32x4){bflo(a.x), bfhi(a.x), bflo(a.y), bfhi(a.y)}; } }
#pragma unroll
                        for (int j = 0; j < 8; ++j) yv[j] += t[j] * g;
                    } else {
#pragma unroll
                        for (int j = 0; j < 8; ++j) { const unsigned a = *(const unsigned*)(ys + (size_t)p * D + 4 * lane + 256 * j); const float gs = g * (1.0f / MOE_YSCALE);
                            const f32x2 a0 = __builtin_amdgcn_cvt_pk_f32_fp8((int)a, false), a1 = __builtin_amdgcn_cvt_pk_f32_fp8((int)a, true);
                            yv[j] += (f32x4){gs * a0[0], gs * a0[1], gs * a1[0], gs * a1[1]}; }
                    } }
                }
            } else {
#pragma unroll
                for (int j = 0; j < 8; ++j) { const v2u a = *(const v2u*)(y + (size_t)row * D + 4 * lane + 256 * j); yv[j] = (f32x4){bflo(a.x), bfhi(a.x), bflo(a.y), bfhi(a.y)}; }
            }
            float ss = 0.f;
#pragma unroll
            for (int j = 0; j < 8; ++j) ss += (yv[j][0] * yv[j][0] + yv[j][1] * yv[j][1]) + (yv[j][2] * yv[j][2] + yv[j][3] * yv[j][3]);
            const float rstd = 1.0f / sqrtf(wave_sum(ss) * (1.0f / D) + 1e-6f);
#pragma unroll
            for (int j = 0; j < 8; ++j) { const f32x4 a1 = *(const LAS f32x4*)(A1 + 4 * lane + 256 * j); xv[j] += a1 * (yv[j] * rstd);
                if (XOB) { v2u w; w.x = pk2(xv[j][0], xv[j][1]); w.y = pk2(xv[j][2], xv[j][3]); *(v2u*)((bf16*)xout_ + (size_t)row * D + 4 * lane + 256 * j) = w; }
                else *(f32x4*)((float*)xout_ + (size_t)row * D + 4 * lane + 256 * j) = xv[j]; }
        }
        if (HOUT) {
            float ss = 0.f;
#pragma unroll
            for (int j = 0; j < 8; ++j) ss += (xv[j][0] * xv[j][0] + xv[j][1] * xv[j][1]) + (xv[j][2] * xv[j][2] + xv[j][3] * xv[j][3]);
            const float rstd = 1.0f / sqrtf(wave_sum(ss) * (1.0f / D) + 1e-6f);
#pragma unroll
            for (int j = 0; j < 8; ++j) { const f32x4 a2 = *(const LAS f32x4*)(A2 + 4 * lane + 256 * j), b2 = *(const LAS f32x4*)(B2 + 4 * lane + 256 * j);
                xv[j] = (xv[j] * rstd) * a2 + b2;
                if (ROUTE) { *(unsigned*)((unsigned char*)hb + (size_t)row * D + 4 * lane + 256 * j) = pk4_fp8(xv[j][0] * MOE_HSCALE, xv[j][1] * MOE_HSCALE, xv[j][2] * MOE_HSCALE, xv[j][3] * MOE_HSCALE); }
                else { v2u w; w.x = pk2(xv[j][0], xv[j][1]); w.y = pk2(xv[j][2], xv[j][3]);
                *(v2u*)(hb + (size_t)row * D + 4 * lane + 256 * j) = w; } }
            if (ROUTE) {
                int i0 = -1, i1 = -1; float v0 = -3.0e38f, v1 = -3.0e38f;
#pragma nounroll
                for (int e = 0; e < NE; ++e) { float s = 0.f;
#pragma unroll
                    for (int j = 0; j < 8; ++j) { const f32x4 w = *(const LAS f32x4*)(RT + e * D + 4 * lane + 256 * j); s += (xv[j][0] * w[0] + xv[j][1] * w[1]) + (xv[j][2] * w[2] + xv[j][3] * w[3]); }
                    s = wave_sum(s);
                    if (s > v0) { v1 = v0; i1 = i0; v0 = s; i0 = e; } else if (s > v1) { v1 = s; i1 = e; } }
                const float g0 = 1.0f / (1.0f + fexp(v1 - v0)), g1 = 1.0f - g0;
                if (lane == 0) {
                    int* te = (int*)(F.ws + WS_ROUTE + RT_TOKE); float* tg = (float*)(F.ws + WS_ROUTE + RT_TOKG);
                    te[2 * row] = i0; te[2 * row + 1] = i1; tg[2 * row] = g0; tg[2 * row + 1] = g1;
                    unsigned* cnt = (unsigned*)(F.ws + WS_CTL) + CW_TBCNT + (row >> 6) * NE;
                    atomicAdd(cnt + i0, 1u); atomicAdd(cnt + i1, 1u);
                }
            }
        }
    }
}

__device__ __forceinline__ void moe_slots_phase(Frame& F) {
    LAS int* cntL = (LAS int*)F.lds;
    LAS int* tot = cntL + 2048;
    LAS int* base = tot + 8; LAS int* tbase = base + 8; LAS int* texpL = tbase + 16;
    const unsigned* cnt = (const unsigned*)(F.ws + WS_CTL) + CW_TBCNT;
    for (int i = F.tid; i < 2048; i += NWAVES * 64) cntL[i] = (int)cnt[i];
    __syncthreads();
    if (F.tid < NE) { int s = 0; for (int b = 0; b < 256; ++b) s += cntL[b * 8 + F.tid]; tot[F.tid] = s; }
    __syncthreads();
    if (F.tid == 0) { int b = 0, tb = 0; for (int e = 0; e < NE; ++e) { base[e] = b; tbase[e] = tb; const int nt = (tot[e] + 255) >> 8; for (int q = 0; q < nt; ++q) texpL[tb + q] = e; tb += nt; b += nt * 256; } tbase[NE] = tb; }
    __syncthreads();
    const int NT = tbase[NE];
    int* rowidx = (int*)(F.ws + WS_ROUTE + RT_ROWIDX); int* pos = (int*)(F.ws + WS_ROUTE + RT_POS);
    const int* te = (const int*)(F.ws + WS_ROUTE + RT_TOKE);
    if (blockIdx.x == 0) { int* texp = (int*)(F.ws + WS_ROUTE + RT_TEXP); for (int i = F.tid; i < NT; i += NWAVES * 64) texp[i] = texpL[i]; if (F.tid == 0) *(int*)(F.ws + WS_ROUTE + RT_NTILE) = NT; }
    LAS int* slotL = texpL + 160;
    const unsigned char* hb8 = (const unsigned char*)(F.ws + WS_HB); unsigned char* hs8 = (unsigned char*)(F.ws + R_HS8);
    for (int tb = blockIdx.x; tb < 256; tb += F.G) {
        if (F.wave == 0) {
            const int tok = tb * 64 + F.lane;
            const int e0 = te[2 * tok], e1 = te[2 * tok + 1];
            const unsigned long long lt = (F.lane == 0) ? 0ull : (~0ull >> (64 - F.lane));
#pragma unroll
            for (int e = 0; e < NE; ++e) {
                float pf = 0.f;
#pragma unroll
                for (int q = 0; q < 4; ++q) { const int b = 4 * F.lane + q; pf += (b < tb) ? (float)cntL[b * 8 + e] : 0.f; }
                const int pre = (int)wave_sum(pf);
                const unsigned long long m0 = __ballot(e0 == e), m1 = __ballot(e1 == e);
                const int st = base[e] + pre;
                if (e0 == e) { const int s = st + __popcll(m0 & lt); rowidx[s] = tok; pos[2 * tok] = s; slotL[2 * F.lane] = s; }
                if (e1 == e) { const int s = st + __popcll(m0) + __popcll(m1 & lt); rowidx[s] = tok; pos[2 * tok + 1] = s; slotL[2 * F.lane + 1] = s; }
            }
        }
        __syncthreads();
        for (int idx = F.tid; idx < 128 * 128; idx += NWAVES * 64) { const int si = idx >> 7, ch = idx & 127;
            const v4u v = *(const v4u*)(hb8 + (size_t)(tb * 64 + (si >> 1)) * D + ch * 16);
            *(v4u*)(hs8 + (size_t)slotL[si] * D + ch * 16) = v; }
        __syncthreads();
    }
}
__device__ __forceinline__ void conv_phase(Frame& F) {
    const Args& A = *F.a;
    const bf16* z = (const bf16*)(F.ws + R_Z); bf16* mix = (bf16*)(F.ws + R_MIX);
    LAS unsigned char* gl = F.lds;
    LAS float* part = (LAS float*)(F.lds + 126976);
    LAS float* stat = part + 512;
    const int tid = F.tid, ch = 2 * tid;
    f32x2 wk[CONVW];
#pragma unroll
    for (int w = 0; w < CONVW; ++w) wk[w] = *(const f32x2*)(A.in[I_ECW] + w * CONVD + ch);
    const f32x2 cb = *(const f32x2*)(A.in[I_ECB] + ch), lg = *(const f32x2*)(A.in[I_ECG] + ch), lb = *(const f32x2*)(A.in[I_ECLB] + ch);
    for (int tile = blockIdx.x; tile < S / 32; tile += F.G) {
        const int t0 = tile * 32;
        for (int idx = tid; idx < 62 * 128; idx += NWAVES * 64) {
            const int row = idx >> 7, c8 = (idx & 127) * 8, t = t0 - 15 + row;
            v4u o = {0u, 0u, 0u, 0u};
            if (t >= 0 && t < S) {
                const v4u a = *(const v4u*)(z + (size_t)t * E_IN + c8), g = *(const v4u*)(z + (size_t)t * E_IN + CONVD + c8);
#pragma unroll
                for (int q = 0; q < 4; ++q) o[q] = pk2(bflo(a[q]) * fsigmoid(bflo(g[q])), bfhi(a[q]) * fsigmoid(bfhi(g[q])));
            }
            *(LAS v4u*)(gl + row * 2048 + c8 * 2) = o;
        }
        __syncthreads();
#pragma nounroll
        for (int half = 0; half < 2; ++half) {
            f32x2 ac[16];
#pragma unroll
            for (int i = 0; i < 16; ++i) ac[i] = cb;
            const LAS unsigned char* gh = gl + half * 16 * 2048 + tid * 4;
#pragma unroll
            for (int r = 0; r < 46; ++r) {
                const unsigned v = *(const LAS unsigned*)(gh + r * 2048);
                const f32x2 v2 = {bflo(v), bfhi(v)};
#pragma unroll
                for (int i = 0; i < 16; ++i) { if (r - i >= 0 && r - i < CONVW) ac[i] = __builtin_elementwise_fma(v2, wk[r - i], ac[i]); }
            }
            float a0[16], a1[16];
#pragma unroll
            for (int i = 0; i < 16; ++i) { a0[i] = ac[i][0]; a1[i] = ac[i][1]; }
#pragma unroll
            for (int i = 0; i < 16; ++i) {
                float s1 = a0[i] + a1[i], s2 = a0[i] * a0[i] + a1[i] * a1[i];
                s1 = wave_sum(s1); s2 = wave_sum(s2);
                if (F.lane == 0) { part[(F.wave * 16 + i) * 2] = s1; part[(F.wave * 16 + i) * 2 + 1] = s2; }
            }
            __syncthreads();
            if (tid < 16) { float s1 = 0.f, s2 = 0.f;
#pragma unroll
                for (int w = 0; w < NWAVES; ++w) { s1 += part[(w * 16 + tid) * 2]; s2 += part[(w * 16 + tid) * 2 + 1]; }
                const float mean = s1 * (1.0f / CONVD), var = fmaxf(s2 * (1.0f / CONVD) - mean * mean, 0.f);
                stat[tid * 2] = mean; stat[tid * 2 + 1] = 1.0f / sqrtf(var + 1e-5f); }
            __syncthreads();
#pragma unroll
            for (int i = 0; i < 16; ++i) {
                const float mean = stat[i * 2], rstd = stat[i * 2 + 1];
                const float y0 = (a0[i] - mean) * rstd * lg[0] + lb[0], y1 = (a1[i] - mean) * rstd * lg[1] + lb[1];
                *(unsigned*)(mix + (size_t)(t0 + half * 16 + i) * D + ch) = pk2(fsilu(y0), fsilu(y1));
            }
            __syncthreads();
        }
    }
}

__device__ __forceinline__ int t5_bucket_dev(int rel) {
    const int n = rel < 0 ? -rel : rel;
    int large = 8 + (int)(__logf((float)(n < 1 ? 1 : n) * 0.125f) / 4.852030263919617f * 8.0f);
    large = large < 15 ? large : 15;
    return (rel > 0 ? 16 : 0) + (n < 8 ? n : large);
}
__device__ __forceinline__ void latent_phase(Frame& F) {
    const Args& A = *F.a; const int lane = F.lane;
    const bf16* z1 = (const bf16*)(F.ws + R_Z1); bf16* cqn = (bf16*)(F.ws + R_CQN); bf16* ckvn = (bf16*)(F.ws + R_CKVN); bf16* kpe = (bf16*)(F.ws + R_KPE);
    const float* cosT = (const float*)(F.ws + WS_COS); const float* sinT = (const float*)(F.ws + WS_SIN);
    float qg[8]; { const f32x4 a = *(const f32x4*)(A.in[I_QNG] + 8 * lane), b = *(const f32x4*)(A.in[I_QNG] + 8 * lane + 4); qg[0] = a[0]; qg[1] = a[1]; qg[2] = a[2]; qg[3] = a[3]; qg[4] = b[0]; qg[5] = b[1]; qg[6] = b[2]; qg[7] = b[3]; }
    const f32x2 kg = *(const f32x2*)(A.in[I_KVNG] + 2 * lane);
    for (int row = F.gw; row < S; row += F.NGW) {
        const bf16* zr = z1 + (size_t)row * O_INP;
        const v4u q = *(const v4u*)(zr + 8 * lane);
        float v[8]; float ss = 0.f;
#pragma unroll
        for (int e = 0; e < 4; ++e) { v[2 * e] = bflo(q[e]); v[2 * e + 1] = bfhi(q[e]); ss += v[2 * e] * v[2 * e] + v[2 * e + 1] * v[2 * e + 1]; }
        const float r1 = 1.0f / sqrtf(wave_sum(ss) * (1.0f / QL) + 1e-6f);
        v4u o;
#pragma unroll
        for (int e = 0; e < 4; ++e) o[e] = pk2(v[2 * e] * r1 * qg[2 * e], v[2 * e + 1] * r1 * qg[2 * e + 1]);
        *(v4u*)(cqn + (size_t)row * QL + 8 * lane) = o;
        const unsigned kv = *(const unsigned*)(zr + 512 + 2 * lane);
        const float k0 = bflo(kv), k1 = bfhi(kv);
        const float r2 = 1.0f / sqrtf(wave_sum(k0 * k0 + k1 * k1) * (1.0f / KVL) + 1e-6f);
        *(unsigned*)(ckvn + (size_t)row * KVLP + 2 * lane) = pk2(k0 * r2 * kg[0], k1 * r2 * kg[1]);
        if (lane < 32) {
            const float x1 = bf1(zr[640 + lane]), x2 = bf1(zr[672 + lane]), cs = cosT[row * 32 + lane], sn = sinT[row * 32 + lane];
            kpe[(size_t)row * 64 + lane] = (bf16)f2bf(x1 * cs - x2 * sn); kpe[(size_t)row * 64 + 32 + lane] = (bf16)f2bf(x2 * cs + x1 * sn);
        }
    }
}

namespace s5 {
using bf16x8 = __attribute__((ext_vector_type(8))) short;
using f32x16 = __attribute__((ext_vector_type(16))) float;
constexpr int XS_ROW = 272;
constexpr int WAVE_LDS = 32 * XS_ROW + 2 * S5_CL * 16 * 2;
struct Par { float ar0, ai0, ar1, ai1, Lr0, Li0, Lr1, Li1; bf16x8 bt[4]; };
__device__ __forceinline__ void load_par(Frame& F, int dg, int n, int hb, Par& P) {
    const float* sp = (const float*)(F.ws + WS_S5P) + (size_t)dg * 36 * 64;
    P.ar0 = sp[n]; P.ai0 = sp[64 + n]; P.Lr0 = sp[128 + n]; P.Li0 = sp[192 + n];
    P.ar1 = sp[32 + n]; P.ai1 = sp[64 + 32 + n]; P.Lr1 = sp[128 + 32 + n]; P.Li1 = sp[192 + 32 + n];
#pragma unroll
    for (int t = 0; t < 4; ++t) { const float* b = sp + (size_t)((t < 2 ? 4 : 20) + 8 * hb) * 64 + 32 * (t & 1) + n;
        v4u w; w.x = pk2(b[0], b[64]); w.y = pk2(b[128], b[192]); w.z = pk2(b[256], b[320]); w.w = pk2(b[384], b[448]); P.bt[t] = __builtin_bit_cast(bf16x8, w); }
}
__device__ __forceinline__ int tok_of(int c0, int sp, int dir) { return dir ? (c0 + S5_CL - 1 - sp) : (c0 + sp); }
__device__ __forceinline__ void bu_block(Frame& F, const Par& P, int g, int ck, int blk, int dir, int lane, f32x16 (&D)[4]) {
    const bf16* z1 = (const bf16*)(F.ws + R_Z1);
    const int m = lane & 31, ha = lane >> 5, seg = (m >> 2) & 1, idx = 4 * (m >> 3) + (m & 3);
    const int t = tok_of((ck + 64 * seg) * S5_CL, 16 * blk + idx, dir);
    const bf16x8 ua = *(const bf16x8*)(z1 + (size_t)t * O_INP + 704 + g * 16 + 8 * ha);
#pragma unroll
    for (int q = 0; q < 4; ++q) D[q] = __builtin_amdgcn_mfma_f32_32x32x16_bf16(ua, P.bt[q], f32x16{}, 0, 0, 0);
}
__device__ __forceinline__ void scan16(const Par& P, f32x16 (&D)[4], float& x0r, float& x0i, float& x1r, float& x1i) {
#pragma unroll
    for (int r = 0; r < 16; ++r) {
        const float n0r = fmaf(P.ar0, x0r, fmaf(-P.ai0, x0i, D[0][r])), n0i = fmaf(P.ar0, x0i, fmaf(P.ai0, x0r, D[2][r]));
        const float n1r = fmaf(P.ar1, x1r, fmaf(-P.ai1, x1i, D[1][r])), n1i = fmaf(P.ar1, x1i, fmaf(P.ai1, x1r, D[3][r]));
        x0r = n0r; x0i = n0i; x1r = n1r; x1i = n1i; D[0][r] = n0r; D[2][r] = n0i; D[1][r] = n1r; D[3][r] = n1i; }
}
}

__device__ __forceinline__ void s5_pass1(Frame& F) {
    using namespace s5;
    float* E = (float*)(F.ws + WS_S5E);
    const int lane = F.lane, n = lane & 31, hd = lane >> 5;
    for (int task = F.gw; task < 32 * 64; task += F.NGW) {
        const int g = task >> 6, ck = task & 63;
        for (int dir = 0; dir < 2; ++dir) {
            Par P; load_par(F, dir * 32 + g, n, hd, P);
            float x0r = 0.f, x0i = 0.f, x1r = 0.f, x1i = 0.f;
            for (int blk = 0; blk < S5_CL / 16; ++blk) { f32x16 D[4]; bu_block(F, P, g, ck, blk, dir, lane, D); scan16(P, D, x0r, x0i, x1r, x1i); }
            float* e = E + ((size_t)((dir * 32 + g) * S5_NCH + ck + 64 * hd) * 2) * 64 + n;
            e[0] = x0r; e[64] = x0i; e[32] = x1r; e[96] = x1i;
        }
    }
}
__device__ __forceinline__ float gelu_tanh(float x) { const float u = 0.7978845608028654f * (x + 0.044715f * x * x * x); const float t = 1.0f - 2.0f * __builtin_amdgcn_rcpf(1.0f + fexp(2.0f * u)); return 0.5f * x * (1.0f + t); }
__device__ __forceinline__ void s5_pass3(Frame& F) {
    using namespace s5;
    const Args& A = *F.a;
    LAS unsigned char* xs = F.lds + F.wave * WAVE_LDS; LAS bf16* yfl = (LAS bf16*)(xs + 32 * XS_ROW);
    const float* E = (const float*)(F.ws + WS_S5E); bf16* YG = (bf16*)(F.ws + R_YG); const bf16* z1 = (const bf16*)(F.ws + R_Z1);
    const int lane = F.lane, n = lane & 31, hd = lane >> 5, cn = lane & 15, kq = lane >> 4;
    for (int task = F.gw; task < 32 * 64; task += F.NGW) {
        const int g = task >> 6, ck = task & 63, ckl = ck + 64 * hd;
        const float dsk = A.in[I_SD][g * 16 + cn];
        for (int dir = 0; dir < 2; ++dir) {
            const int dg = dir * 32 + g;
            Par P; load_par(F, dg, n, hd, P);
            float x0r = 0.f, x0i = 0.f, x1r = 0.f, x1i = 0.f;
            { const float* e = E + ((size_t)dg * S5_NCH * 2) * 64 + n; const int nprev = dir ? (S5_NCH - 1 - ckl) : ckl;
              const int nmax = dir ? (S5_NCH - 1 - ck) : (ck + 64);
              for (int j0 = 0; j0 < nmax; j0 += 8) {
                  float er0[8], ei0[8], er1[8], ei1[8];
#pragma unroll
                  for (int q = 0; q < 8; ++q) { const int jj = (j0 + q < nprev) ? (j0 + q) : 0; const int j = dir ? (S5_NCH - 1 - jj) : jj; const float* ej = e + (size_t)j * 128;
                      er0[q] = ej[0]; ei0[q] = ej[64]; er1[q] = ej[32]; ei1[q] = ej[96]; }
#pragma unroll
                  for (int q = 0; q < 8; ++q) { if (j0 + q < nprev) {
                      const float a = P.Lr0 * x0r - P.Li0 * x0i + er0[q], b = P.Lr0 * x0i + P.Li0 * x0r + ei0[q]; x0r = a; x0i = b;
                      const float c = P.Lr1 * x1r - P.Li1 * x1i + er1[q], d = P.Lr1 * x1i + P.Li1 * x1r + ei1[q]; x1r = c; x1i = d; } }
              } }
            bf16x8 Bc[4];
#pragma unroll
            for (int ks = 0; ks < 4; ++ks) { const int p0 = ks * 16 + kq * 4;
                const f32x4 cr = *(const f32x4*)(A.in[I_SCRE] + ((size_t)dg * 16 + cn) * 64 + p0), ci = *(const f32x4*)(A.in[I_SCIM] + ((size_t)dg * 16 + cn) * 64 + p0);
                v4u w; w.x = pk2(cr[0], -ci[0]); w.y = pk2(cr[1], -ci[1]); w.z = pk2(cr[2], -ci[2]); w.w = pk2(cr[3], -ci[3]); Bc[ks] = __builtin_bit_cast(bf16x8, w); }
            for (int blk = 0; blk < S5_CL / 16; ++blk) {
                f32x16 D[4]; bu_block(F, P, g, ck, blk, dir, lane, D); scan16(P, D, x0r, x0i, x1r, x1i);
#pragma unroll
                for (int r = 0; r < 16; ++r) { LAS unsigned char* row = xs + (16 * hd + r) * XS_ROW + 4 * n;
                    *(LAS unsigned*)row = pg8::cvt_pk_bf16(D[0][r], D[2][r]); *(LAS unsigned*)(row + 128) = pg8::cvt_pk_bf16(D[1][r], D[3][r]); }
#pragma unroll
                for (int sg = 0; sg < 2; ++sg) {
                    pg8::f32x4 acc = {0.f, 0.f, 0.f, 0.f};
#pragma unroll
                    for (int ks = 0; ks < 4; ++ks) { const bf16x8 af = *(const LAS bf16x8*)(xs + (16 * sg + cn) * XS_ROW + (ks * 32 + kq * 8) * 2);
                        acc = __builtin_amdgcn_mfma_f32_16x16x32_bf16(af, Bc[ks], acc, 0, 0, 0); }
#pragma unroll
                    for (int i = 0; i < 4; ++i) { const int sp = 16 * blk + 4 * kq + i; const int c0 = (ck + 64 * sg) * S5_CL; const int t = tok_of(c0, sp, dir), tl = t - c0;
                        if (dir == 0) yfl[(sg * S5_CL + tl) * 16 + cn] = (bf16)f2bf(acc[i]);
                        else { const float uu = bf1(z1[(size_t)t * O_INP + 704 + g * 16 + cn]); const float yv = acc[i] + bf1(yfl[(sg * S5_CL + tl) * 16 + cn]) + dsk * uu;
                            YG[(size_t)t * S5D + g * 16 + cn] = (bf16)f2bf(gelu_tanh(yv)); } }
                }
            }
        }
        LDS_WAIT();
    }
}
namespace dil {
using bf16x8 = __attribute__((ext_vector_type(8))) short;
using s16x4  = __attribute__((ext_vector_type(4))) short;
using f32x16 = __attribute__((ext_vector_type(16))) float;
using u32x4  = __attribute__((ext_vector_type(4))) unsigned;
constexpr int K_OFF = 0, V_OFF = 49152, BT_OFF = 98304, LI_OFF = 99328;
constexpr int NUNITS = 3 * 1024;
__device__ __forceinline__ int crow(int r, int hi) { return (r & 3) + 8 * (r >> 2) + 4 * hi; }
__device__ __forceinline__ unsigned cvtpk(float lo, float hi) { unsigned r; asm volatile("v_cvt_pk_bf16_f32 %0, %1, %2" : "=v"(r) : "v"(lo), "v"(hi)); return r; }
template <int OFF> __device__ __forceinline__ s16x4 tr_read(int vb) {
  s16x4 r; asm volatile("ds_read_b64_tr_b16 %0, %1 offset:%2" : "=&v"(r) : "v"(vb), "i"(OFF) : "memory"); return r;
}
struct UnitId { int c, d, r, qb, h, sub; };
__device__ __forceinline__ UnitId decode(int u) {
    UnitId U; U.c = u >> 10; const int rem = u & 1023; U.h = rem & 15; const int blk = rem >> 4;
    U.d = (U.c == 0) ? 1 : (U.c == 1) ? 4 : 16; U.sub = S / U.d; const int bpr = U.sub >> 8;
    U.r = blk / bpr; U.qb = blk - U.r * bpr; return U;
}
}

__device__ __forceinline__ void dilattn2_phase(Frame& F) {
    using namespace dil;
    const Args& A = *F.a;
    unsigned char* wsl = F.ws; int lane_l = F.lane, tid_l = F.tid; asm volatile("" : "+s"(wsl), "+v"(lane_l), "+v"(tid_l));
    const bf16* z = (const bf16*)(wsl + R_Z);
    bf16* PO = (bf16*)(wsl + R_PO); float* PML = (float*)(wsl + R_PML);
    LAS unsigned char* lds = F.lds;
    const int tid = tid_l, lane = lane_l, w = F.wave, r32 = lane & 31, hi = lane >> 5;
    for (int u = F.vcu; u < NUNITS; u += F.G) {
        const UnitId U = decode(u);
        const int d = U.d, h = U.h, sub = U.sub;
        {
            v4u kk[6], vv[6];
#pragma unroll
            for (int i = 0; i < 6; ++i) { const int idx = tid + 512 * i, key = idx >> 3, ch = idx & 7, sp = U.qb * 256 - 64 + key;
                kk[i] = (v4u){0u, 0u, 0u, 0u}; vv[i] = (v4u){0u, 0u, 0u, 0u};
                if (sp >= 0 && sp < sub) { const bf16* rp = z + ((size_t)sp * d + U.r) * E_IN + h * 64 + ch * 8; kk[i] = *(const v4u*)(rp + 3072); vv[i] = *(const v4u*)(rp + 4096); } }
#pragma unroll
            for (int i = 0; i < 6; ++i) { const int idx = tid + 512 * i, key = idx >> 3, ch = idx & 7;
                *(LAS v4u*)(lds + K_OFF + key * 128 + ((ch * 16) ^ (((key >> 1) & 7) << 4))) = kk[i];
                *(LAS v4u*)(lds + V_OFF + key * 128 + ((ch * 16) ^ (((key >> 1) & 1) << 6))) = vv[i]; }
            if (tid < 256) ((LAS float*)(lds + BT_OFF))[tid] = (tid >= 32 && tid < 161) ? A.in[I_T5][t5_bucket_dev(d * (tid - 96)) * DIL_H + h] * 1.4426950408889634f : -1e30f;
        }
        __syncthreads();
        f32x16 p[5];
        {
            const size_t qtok = (size_t)(U.qb * 256 + 32 * w + r32) * d + U.r;
            const bf16* qp = z + qtok * E_IN + 2048 + h * 64 + hi * 8;
            bf16x8 qf[4];
#pragma unroll
            for (int ks = 0; ks < 4; ++ks) qf[ks] = *(const bf16x8*)(qp + ks * 16);
            int ka[4];
#pragma unroll
            for (int ks = 0; ks < 4; ++ks) ka[ks] = K_OFF + (32 * w + r32) * 128 + ((ks * 32 + hi * 16) ^ (((r32 >> 1) & 7) << 4));
#pragma unroll
            for (int kt = 0; kt < 5; ++kt) { p[kt] = f32x16{};
#pragma unroll
                for (int ks = 0; ks < 4; ++ks) { const bf16x8 kf = *(const LAS bf16x8*)(lds + ka[ks] + kt * 4096); p[kt] = __builtin_amdgcn_mfma_f32_32x32x16_bf16(kf, qf[ks], p[kt], 0, 0, 0); } }
        }
        const int bidx = 4 * hi - r32;
        const int sp0 = U.qb * 256 + 32 * w - 64 + 4 * hi;
        const LAS float* btl = (const LAS float*)(lds + BT_OFF) + 32 + bidx;
        const bool edge = (U.qb * 256 + 32 * w - 64 < 0) || (U.qb * 256 + 32 * w + 96 > sub);
        constexpr float SC = 0.125f * 1.4426950408889634f;
#pragma unroll
        for (int kt = 0; kt < 5; ++kt)
#pragma unroll
            for (int rg = 0; rg < 16; ++rg) { const int cr = 32 * kt + (rg & 3) + 8 * (rg >> 2);
                float s = fmaf(p[kt][rg], SC, btl[cr]);
                p[kt][rg] = s; }
        if (edge) {
#pragma unroll
            for (int kt = 0; kt < 5; ++kt)
#pragma unroll
                for (int rg = 0; rg < 16; ++rg) { const int cr = 32 * kt + (rg & 3) + 8 * (rg >> 2); const int sp = sp0 + cr; p[kt][rg] = (sp >= 0 && sp < sub) ? p[kt][rg] : -1e30f; }
        }
        float m2 = p[0][0];
#pragma unroll
        for (int kt = 0; kt < 5; ++kt)
#pragma unroll
            for (int rg = 0; rg < 16; ++rg) m2 = fmaxf(m2, p[kt][rg]);
        { auto rr = __builtin_amdgcn_permlane32_swap(__float_as_uint(m2), __float_as_uint(m2), false, false); m2 = fmaxf(__uint_as_float(rr[0]), __uint_as_float(rr[1])); }
        float l = 0.f;
#pragma unroll
        for (int kt = 0; kt < 5; ++kt)
#pragma unroll
            for (int rg = 0; rg < 16; ++rg) { const float e = __builtin_amdgcn_exp2f(p[kt][rg] - m2); p[kt][rg] = e; l += e; }
        { auto rr = __builtin_amdgcn_permlane32_swap(__float_as_uint(l), __float_as_uint(l), false, false); l = __uint_as_float(rr[0]) + __uint_as_float(rr[1]); }
        f32x16 o0 = {}, o1 = {};
        {
            const int q = (lane >> 2) & 3, pp = lane & 3, nh = (lane >> 4) & 1, qb1 = (q >> 1) & 1;
            const int vrow = V_OFF + (32 * w + 8 * hi + q) * 128;
            const int vb0 = (int)(uintptr_t)lds + vrow + ((32 * nh + 8 * pp) ^ (qb1 << 6));
            const int vb1 = (int)(uintptr_t)lds + vrow + ((64 + 32 * nh + 8 * pp) ^ (qb1 << 6));
#define DIL_PK4(P, BASE, OUT) do { unsigned a0 = cvtpk(P[BASE + 0], P[BASE + 1]), a1 = cvtpk(P[BASE + 2], P[BASE + 3]); unsigned b0 = cvtpk(P[BASE + 4], P[BASE + 5]), b1 = cvtpk(P[BASE + 6], P[BASE + 7]); \
    auto r0 = __builtin_amdgcn_permlane32_swap(a0, b0, false, false); auto r1 = __builtin_amdgcn_permlane32_swap(a1, b1, false, false); \
    u32x4 wv = {r0[0], r1[0], r0[1], r1[1]}; OUT = *reinterpret_cast<bf16x8*>(&wv); } while (0)
#define DIL_PK(L, H) (bf16x8){L[0], L[1], L[2], L[3], H[0], H[1], H[2], H[3]}
#define DIL_PV(KT) do { bf16x8 pa0, pa1; DIL_PK4(p[KT], 0, pa0); DIL_PK4(p[KT], 8, pa1); \
    const s16x4 l00 = tr_read<(KT) * 4096>(vb0), h00 = tr_read<(KT) * 4096 + 512>(vb0), l01 = tr_read<(KT) * 4096>(vb1), h01 = tr_read<(KT) * 4096 + 512>(vb1); \
    const s16x4 l10 = tr_read<(KT) * 4096 + 2048>(vb0), h10 = tr_read<(KT) * 4096 + 2048 + 512>(vb0), l11 = tr_read<(KT) * 4096 + 2048>(vb1), h11 = tr_read<(KT) * 4096 + 2048 + 512>(vb1); \
    asm volatile("s_waitcnt lgkmcnt(0)" ::: "memory"); __builtin_amdgcn_sched_barrier(0); \
    o0 = __builtin_amdgcn_mfma_f32_32x32x16_bf16(pa0, DIL_PK(l00, h00), o0, 0, 0, 0); o1 = __builtin_amdgcn_mfma_f32_32x32x16_bf16(pa0, DIL_PK(l01, h01), o1, 0, 0, 0); \
    o0 = __builtin_amdgcn_mfma_f32_32x32x16_bf16(pa1, DIL_PK(l10, h10), o0, 0, 0, 0); o1 = __builtin_amdgcn_mfma_f32_32x32x16_bf16(pa1, DIL_PK(l11, h11), o1, 0, 0, 0); } while (0)
            DIL_PV(0); DIL_PV(1); DIL_PV(2); DIL_PV(3); DIL_PV(4);
#undef DIL_PV
#undef DIL_PK
#undef DIL_PK4
        }
        LAS float* li = (LAS float*)(lds + LI_OFF) + w * 32;
        if (hi == 0) { li[r32] = l;
            const size_t tok = (size_t)(U.qb * 256 + 32 * w + r32) * d + U.r;
            *(f32x2*)(PML + (((size_t)U.c * S + tok) * DIL_H + h) * 2) = (f32x2){m2 * 0.6931471805599453f, l}; }
        LDS_WAIT();
#pragma unroll
        for (int rg = 0; rg < 16; ++rg) { const int qi = crow(rg, hi); const float rl = __builtin_amdgcn_rcpf(li[qi]);
            const size_t tok = (size_t)(U.qb * 256 + 32 * w + qi) * d + U.r;
            bf16* op = PO + ((size_t)U.c * S + tok) * 1024 + h * 64 + r32;
            op[0] = (bf16)f2bf(o0[rg] * rl); op[32] = (bf16)f2bf(o1[rg] * rl); }
        __syncthreads();
    }
}
__device__ __forceinline__ void dil_combine_phase(Frame& F) {
    const bf16* PO = (const bf16*)(F.ws + R_PO); const float* PML = (const float*)(F.ws + R_PML); bf16* mix = (bf16*)(F.ws + R_MIX);
    for (int idx = F.gw * 64 + F.lane; idx < S * 128; idx += F.NGW * 64) {
        const int tok = idx >> 7, ch = idx & 127, h = ch >> 3;
        f32x2 ml[3]; v4u ov[3];
#pragma unroll
        for (int c = 0; c < 3; ++c) { ml[c] = *(const f32x2*)(PML + (((size_t)c * S + tok) * DIL_H + h) * 2); ov[c] = *(const v4u*)(PO + ((size_t)c * S + tok) * 1024 + ch * 8); }
        const float M = fmaxf(ml[0][0], fmaxf(ml[1][0], ml[2][0]));
        float wc[3], ws = 0.f;
#pragma unroll
        for (int c = 0; c < 3; ++c) { wc[c] = ml[c][1] * fexp(ml[c][0] - M); ws += wc[c]; }
        const float rw = 1.0f / ws;
        v4u o;
#pragma unroll
        for (int e = 0; e < 4; ++e) { float a = 0.f, b = 0.f;
#pragma unroll
            for (int c = 0; c < 3; ++c) { a += wc[c] * bflo(ov[c][e]); b += wc[c] * bfhi(ov[c][e]); }
            o[e] = pk2(a * rw, b * rw); }
        *(v4u*)(mix + (size_t)tok * D + 1024 + ch * 8) = o;
    }
}
#ifndef MK_N_LAUNCHES
#define MK_N_LAUNCHES 1
#endif
constexpr int NPH = 20;
__global__ void __launch_bounds__(NWAVES * 64, 2) mk_fwd(Args args) {
    extern __shared__ __attribute__((aligned(16))) unsigned char lds_raw[];
    Frame F;
    F.lds = (LAS unsigned char*)lds_raw; F.a = &args; F.ws = args.ws;
    F.tid = threadIdx.x; F.lane = F.tid & 63; F.wave = __builtin_amdgcn_readfirstlane(F.tid >> 6);
    F.G = gridDim.x; { const int bx = blockIdx.x; F.vcu = (F.G % 8 == 0) ? (bx % 8) * (F.G / 8) + bx / 8 : bx; }
    F.gw = F.vcu * NWAVES + F.wave; F.NGW = F.G * NWAVES;
    volatile LAS unsigned* MISC = (volatile LAS unsigned*)(F.lds + MISC_OFF);
    for (int u = F.tid; u < 128; u += NWAVES * 64) MISC[u] = 0u;
    __syncthreads();
    XcdBarrier bar; bar.bar = (unsigned*)(F.ws + WS_CTL) + CW_BAR; bar.x = 0; bar.st = nullptr;
    if (MK_N_LAUNCHES == 1) bar = xcd_barrier_post((unsigned*)(F.ws + WS_CTL) + CW_BAR, MISC + 8);
    const int lo = args.ph_lo, hi = args.ph_hi;
#ifndef PH_MASK
#define PH_MASK 0xFFFFFFFFu
#endif
#define IN(k) (((PH_MASK >> (k)) & 1u) && lo <= (k) && (k) < hi)
#ifndef PH_TWICE
#define PH_TWICE 0u
#endif
#define TW(k) (((PH_TWICE >> (k)) & 1u) != 0u)
#define REP(k)
#define RB(k)
#define REFRESH() do { int t_ = (int)threadIdx.x; asm volatile("" : "+v"(t_)); F.tid = t_; F.lane = t_ & 63; } while (0)
#ifdef SPREAD_MASK
#define SEAM(k) do { if (IN(k) && IN((k) + 1)) { __syncthreads(); unsigned long long* W_ = (unsigned long long*)(F.ws + WS_CTL + 131072) + 4 * (k); \
        if (threadIdx.x == 0 && ((SPREAD_MASK >> (k)) & 1u)) { const unsigned long long t_ = __builtin_amdgcn_s_memrealtime(); atomicMax(W_, t_); atomicAdd(W_ + 1, t_); } \
        xcd_barrier(bar); \
        if (threadIdx.x == 0 && ((SPREAD_MASK >> (k)) & 1u)) { const unsigned long long t0_ = __builtin_amdgcn_s_memrealtime(); \
            const unsigned long long mx_ = __hip_atomic_load(W_, __ATOMIC_RELAXED, __HIP_MEMORY_SCOPE_AGENT), sm_ = __hip_atomic_load(W_ + 1, __ATOMIC_RELAXED, __HIP_MEMORY_SCOPE_AGENT); \
            const long long d_ = (long long)(mx_ - sm_ / (unsigned long long)F.G) * SPREAD_MULT; \
            while ((long long)(__builtin_amdgcn_s_memrealtime() - t0_) < d_) __builtin_amdgcn_s_sleep(8); } \
        __syncthreads(); } else __syncthreads(); } while (0)
#elif defined(DOUBLE_BARRIERS)
#define SEAM(k) do { if (IN(k) && IN((k) + 1)) { xcd_barrier(bar); xcd_barrier(bar); } else __syncthreads(); } while (0)
#else
#define SEAM(k) do { if (IN(k) && IN((k) + 1)) xcd_barrier(bar); else __syncthreads(); } while (0)
#endif
    typedef pg8::bf16_t b16;
    const float* x_in = args.in[I_X]; float* xo = args.out;
    b16* Y = (b16*)(F.ws + WS_Y); b16* HB = (b16*)(F.ws + WS_HB); b16* XB = (b16*)(F.ws + WS_XB);
    const int bid = (int)blockIdx.x;

    if (IN(0)) REP(0) { REFRESH(); p0_prologue(F); RB(0); } SEAM(0);
    if (IN(1)) { REFRESH(); resnorm_phase<false, true, false, false>(F, x_in, nullptr, nullptr, 0, 0, 0, 0, 0, 0); } SEAM(1);
    if (IN(2)) REP(2) { REFRESH(); pg8::Gemm g{HB, (const b16*)(F.ws + WB_EIN), D}; pg8::StaticOrder so; so.init(S / 256, E_IN / 256, F.G, bid);
        pg8::EpiBf16 E{(b16*)(F.ws + R_Z), E_IN}; pg8::gemm_phase(F.lds, g, so, E); RB(2); } SEAM(2);
    if (IN(3)) REP(3) { REFRESH(); conv_phase(F); __syncthreads(); dilattn2_phase(F); RB(3); } SEAM(3);
    if (IN(4)) REP(4) { REFRESH(); dil_combine_phase(F); RB(4); } SEAM(4);
    if (IN(5)) REP(5) { REFRESH(); pg8::Gemm g{(const b16*)(F.ws + R_MIX), (const b16*)(F.ws + WB_EOUT), D}; pg8::StaticOrder so; so.init(S / 256, D / 256, F.G, bid);
        pg8::EpiBf16 E{Y, D}; pg8::gemm_phase(F.lds, g, so, E); RB(5); } SEAM(5);
    if (IN(6)) { REFRESH(); resnorm_phase<true, true, false, false, false, true>(F, x_in, XB, Y, 0, 2, 1, 0, 3, 2); } SEAM(6);
    if (IN(7)) REP(7) { REFRESH(); pg8::Gemm g{HB, (const b16*)(F.ws + WB_EF13), D}; pg8::StaticOrder so; so.init(S / 256, 2 * FD / 256, F.G, bid);
        pg8::EpiSwiGLU E{(b16*)(F.ws + R_ACT), FD}; pg8::gemm_phase(F.lds, g, so, E); RB(7); } SEAM(7);
    if (IN(8)) REP(8) { REFRESH(); pg8::Gemm g{(const b16*)(F.ws + R_ACT), (const b16*)(F.ws + WB_EF2), FD}; pg8::StaticOrder so; so.init(S / 256, D / 256, F.G, bid);
        pg8::EpiBf16 E{Y, D}; pg8::gemm_phase(F.lds, g, so, E); RB(8); } SEAM(8);
    if (IN(9)) { REFRESH(); resnorm_phase<true, true, false, false, true, true>(F, XB, XB, Y, 0, 5, 3, 1, 0, 0); } SEAM(9);
    if (IN(10)) REP(10) { REFRESH(); pg8::Gemm g{HB, (const b16*)(F.ws + WB_OIN), D}; pg8::StaticOrder so; so.init(S / 256, O_INP / 256, F.G, bid);
        pg8::EpiBf16 E{(b16*)(F.ws + R_Z1), O_INP}; pg8::gemm_phase(F.lds, g, so, E); RB(10); } SEAM(10);
    if (IN(11)) REP(11) { REFRESH(); latent_phase(F); s5_pass1(F); RB(11); } SEAM(11);
    if (IN(12)) REP(12) { REFRESH();
        { pg8::Gemm g{(const b16*)(F.ws + R_CQN), (const b16*)(F.ws + WB_UQ), QL}; pg8::StaticOrder so; so.init(S / 256, NQ / 256, F.G, bid);
          pg8::EpiBf16 E{(b16*)(F.ws + R_Q), NQ, mla2::SCALE * 1.4426950408889634f}; pg8::gemm_phase(F.lds, g, so, E); }
        { int kvk = KVLP; asm volatile("" : "+s"(kvk));
          pg8::Gemm g{(const b16*)(F.ws + R_CKVN), (const b16*)(F.ws + WB_UKV), kvk}; pg8::StaticOrder so; so.init(S / 256, NKV / 256, F.G, bid);
          pg8::EpiBf16 E{(b16*)(F.ws + R_KV), NKV}; pg8::gemm_phase(F.lds, g, so, E); }
        __syncthreads();
        s5_pass3(F);
    RB(12); } SEAM(12);
    if (IN(13)) REP(13) { REFRESH();
        mla2::CvJob J{args.in[I_M1], args.in[I_M3], args.in[I_M2], (unsigned char*)(F.ws + WB_M13), (unsigned char*)(F.ws + WB_M2), MOE_WSCALE, F.gw, F.NGW};
        for (int u = F.vcu; u < 12 * (S / 256); u += F.G) { const int h = u >> 6, qb = u & 63;
            static_assert(mla2::OFF_BADFLAG == MISC_OFF + 96, "bad-unit flag = control word 24");
            if (!mla2::attn_unit<true>((const unsigned short*)(F.ws + R_Q), (const unsigned short*)(F.ws + R_KV), (const unsigned short*)(F.ws + R_KPE),
                           (const float*)(F.ws + WS_COS), (const float*)(F.ws + WS_SIN), (unsigned short*)(F.ws + R_MIX2), h, qb * 256, S, (char*)lds_raw, J)) {
                if (F.tid == 0) MISC[24] = 0u;
                __syncthreads();
                mla2::attn_unit<false>((const unsigned short*)(F.ws + R_Q), (const unsigned short*)(F.ws + R_KV), (const unsigned short*)(F.ws + R_KPE),
                           (const float*)(F.ws + WS_COS), (const float*)(F.ws + WS_SIN), (unsigned short*)(F.ws + R_MIX2), h, qb * 256, S, (char*)lds_raw, J); } }
        while (J.next < mla2::CV_NG) { float cvr[16]; unsigned char* cvd; mla2::cv_issue(J, F.lane, cvr, cvd); asm volatile("s_waitcnt vmcnt(0)" ::: "memory"); mla2::cv_landed(cvr); mla2::cv_finish(J, cvr, cvd, F.lane); J.next += J.stride; }
        for (;;) {
            __syncthreads();
            if (F.tid == 0) MISC[17] = atomicAdd((unsigned*)(F.ws + WS_CTL) + CW_GLUCTR, 1u);
            __syncthreads();
            const int gu = (int)__builtin_amdgcn_readfirstlane(MISC[17]);
            if (gu >= (S / 256) * (S5D / 256)) break;
            pg8::Gemm g{(const b16*)(F.ws + R_YG), (const b16*)(F.ws + WB_GLU), S5D}; pg8::FixedUnit so{gu >> 1, gu & 1, nullptr};
            pg8::EpiGate E{(const b16*)(F.ws + R_YG), S5D, (b16*)(F.ws + R_MIX2), D, 1536}; pg8::gemm_phase(F.lds, g, so, E);
        }
    RB(13); } SEAM(13);
    if (IN(14)) REP(14) { REFRESH(); pg8::Gemm g{(const b16*)(F.ws + R_MIX2), (const b16*)(F.ws + WB_OOUT), D}; pg8::StaticOrder so; so.init(S / 256, D / 256, F.G, bid);
        pg8::EpiBf16 E{Y, D}; pg8::gemm_phase(F.lds, g, so, E); RB(14); } SEAM(14);
    if (IN(15)) { REFRESH(); resnorm_phase<true, true, true, false, true, true>(F, XB, XB, Y, 1, 2, 1, 1, 3, 2); } SEAM(15);
    if (IN(16)) REP(16) { REFRESH(); moe_slots_phase(F); RB(16); } SEAM(16);
    if (IN(17)) REP(17) { REFRESH(); const int nt = __builtin_amdgcn_readfirstlane(*(const int*)(F.ws + WS_ROUTE + RT_NTILE));
        pg8::Gemm g{(const void*)(F.ws + R_HS8), (const void*)(F.ws + WB_M13), D}; pg8::StaticOrder so; so.init(nt, 2 * FE / 256, F.G, bid);
        so.texp = (const int*)(F.ws + WS_ROUTE + RT_TEXP); so.estride = (size_t)2 * FE * D;
        pg8::EpiSwiGLU8 E{(unsigned char*)(F.ws + R_ACTS), FE, 1.0f / (MOE_WSCALE * MOE_HSCALE), MOE_ASCALE}; pg8::gemm_phase<true, false>(F.lds, g, so, E); RB(17); } SEAM(17);
    if (IN(18)) REP(18) { REFRESH(); const int nt = __builtin_amdgcn_readfirstlane(*(const int*)(F.ws + WS_ROUTE + RT_NTILE)); int nfull, sp; moe_tail_plan(nt, nfull, sp);
        { pg8::Gemm g{(const void*)(F.ws + R_ACTS), (const void*)(F.ws + WB_M2), FE}; pg8::StaticOrder so; so.init(nfull, D / 256, F.G, bid);
          so.texp = (const int*)(F.ws + WS_ROUTE + RT_TEXP); so.estride = (size_t)D * FE;
          pg8::EpiFp8 E{(unsigned char*)(F.ws + R_YS), D, MOE_YSCALE / (MOE_WSCALE * MOE_ASCALE)}; pg8::gemm_phase<true, false>(F.lds, g, so, E); }
        if (sp > 1) {
          pg8::Gemm g{(const void*)(F.ws + R_ACTS), (const void*)(F.ws + WB_M2), FE, FE / sp}; pg8::SplitOrder so; so.init(nfull, nt - nfull, sp, D / 256, F.G, F.vcu, (size_t)(FE / sp));
          so.texp = (const int*)(F.ws + WS_ROUTE + RT_TEXP); so.estride = (size_t)D * FE;
          pg8::EpiBf16S E{(b16*)(F.ws + R_YT), D, nfull, (size_t)(nt - nfull) * 256 * D, 1.0f / (MOE_WSCALE * MOE_ASCALE)}; pg8::gemm_phase<true, false>(F.lds, g, so, E); }
        RB(18); } SEAM(18);
    if (IN(19)) { REFRESH(); resnorm_phase<true, false, false, true, true, false>(F, XB, xo, nullptr, 1, 5, 3, 0, 0, 0); }
#undef IN
#undef SEAM
}

extern "C" void kernel_launch(void* const* d_in, const int* in_sizes, int n_in, void* d_out, int out_size, void* d_ws, size_t ws_size, hipStream_t stream) {
    static int grid = 0;
    if (grid == 0) {
        if (n_in != 34 || out_size != S * D || ws_size < WS_END) { fprintf(stderr, "kernel_launch: unexpected shapes: n_in %d out %d ws %zu (need %zu)\n", n_in, out_size, ws_size, (size_t)WS_END); grid = -1; return; }
        int dev = 0, cus = 0, per_cu = 0;
        if (hipGetDevice(&dev) != hipSuccess || hipDeviceGetAttribute(&cus, hipDeviceAttributeMultiprocessorCount, dev) != hipSuccess) { grid = -1; return; }
        if (hipFuncSetAttribute((const void*)mk_fwd, hipFuncAttributeMaxDynamicSharedMemorySize, LDS_BYTES) != hipSuccess) { fprintf(stderr, "kernel_launch: hipFuncSetAttribute failed\n"); grid = -1; return; }
        if (hipOccupancyMaxActiveBlocksPerMultiprocessor(&per_cu, (const void*)mk_fwd, NWAVES * 64, LDS_BYTES) != hipSuccess || per_cu < 1) { fprintf(stderr, "kernel_launch: note: occupancy query says %d\n", per_cu); (void)hipGetLastError(); }
        grid = cus;
    }
    if (grid < 0) return;
    if (hipMemsetAsync((char*)d_ws + WS_CTL, 0, CTL_ZERO_BYTES, stream) != hipSuccess) return;
    Args a{};
    for (int i = 0; i < 34; ++i) a.in[i] = (const float*)d_in[i];
    a.out = (float*)d_out; a.ws = (unsigned char*)d_ws;
#if MK_N_LAUNCHES == 1
    a.ph_lo = 0; a.ph_hi = NPH;
    hipLaunchKernelGGL(mk_fwd, dim3(grid), dim3(NWAVES * 64), LDS_BYTES, stream, a);
#else
    for (int p = 0; p < NPH; ++p) { a.ph_lo = p; a.ph_hi = p + 1; hipLaunchKernelGGL(mk_fwd, dim3(grid), dim3(NWAVES * 64), LDS_BYTES, stream, a);
        if (TW(p)) hipLaunchKernelGGL(mk_fwd, dim3(grid), dim3(NWAVES * 64), LDS_BYTES, stream, a); }
#endif
}
```

```cpp
#include <hip/hip_runtime.h>
#include <cstdio>
#include <cstdint>

namespace pg8 {
#define PG8_LAS __attribute__((address_space(3)))
typedef unsigned short bf16_t;
typedef short bf16x8 __attribute__((ext_vector_type(8)));
typedef float f32x4 __attribute__((ext_vector_type(4)));
typedef unsigned u32x4 __attribute__((ext_vector_type(4)));
typedef unsigned u32x2 __attribute__((ext_vector_type(2)));
constexpr int BM = 256, BK = 64, HALF = 128, HTB = HALF * BK * 2  , STAGE_BYTES = 8 * HTB, NXCD = 8, WGM = 8;

__host__ __device__ __forceinline__ int lds_byte(int r, int c) { const int st = (r >> 4) * 2 + (c >> 5), rr = r & 15, cc = c & 31, ob = rr * 64 + cc * 2; return st * 1024 + (ob ^ (((ob >> 9) & 1) << 5)); }
__host__ __device__ __forceinline__ void stage_rc(int b, int& R, int& C) { const int st = b / 1024, sb = b % 1024, swz = sb ^ (((sb >> 9) & 1) << 5); R = (st >> 1) * 16 + swz / 64; C = (st & 1) * 32 + (swz % 64) / 2; }
__host__ __device__ __forceinline__ int perm32(int rho) { const int n = rho >> 4, i = rho & 15; return 8 * (i >> 2) + 4 * n + (i & 3); }

struct Unit { int pm, pn, ks; };
struct Gemm { const void* A; const void* Bt; int K; int kl = 0; };

struct StaticOrder {
    int nM, nN, nwg, G, c;
    const int* texp; size_t estride;
    const int* rowidx;
    __device__ void init(int nM_, int nN_, int G_, int c_) { nM = nM_; nN = nN_; nwg = nM * nN; G = G_; c = c_; texp = nullptr; estride = 0; rowidx = nullptr; }
    __device__ bool next(int i, Unit& u) const {
        const long L = (long)i * G + c; if (L >= nwg) return false;
        int wgid = (int)L; { const int q = nwg / NXCD, r = nwg % NXCD, xcd = wgid % NXCD, off = wgid / NXCD; wgid = (xcd < r ? xcd * (q + 1) : r * (q + 1) + (xcd - r) * q) + off; }
        const int nig = WGM * nN, gid = wgid / nig, fm = gid * WGM, gsz = (nM - fm) < WGM ? (nM - fm) : WGM;
        u.pm = fm + ((wgid % nig) % gsz); u.pn = (wgid % nig) / gsz; return true;
    }
    __device__ __forceinline__ size_t b_off(const Unit& u) const { return texp ? (size_t)__builtin_amdgcn_readfirstlane(texp[u.pm]) * estride : (size_t)0; }
    __device__ __forceinline__ size_t k_off(const Unit&) const { return 0; }
};
struct FixedUnit {
    int pm, pn; const int* rowidx;
    __device__ bool next(int i, Unit& u) const { if (i != 0) return false; u.pm = pm; u.pn = pn; return true; }
    __device__ __forceinline__ size_t b_off(const Unit&) const { return 0; }
    __device__ __forceinline__ size_t k_off(const Unit&) const { return 0; }
};
struct SplitOrder {
    int pm0, ntail, s, nN, G, c; size_t kbytes;
    const int* texp; size_t estride; const int* rowidx;
    __device__ void init(int pm0_, int ntail_, int s_, int nN_, int G_, int c_, size_t kbytes_) { pm0 = pm0_; ntail = ntail_; s = s_; nN = nN_; G = G_; c = c_; kbytes = kbytes_; texp = nullptr; estride = 0; rowidx = nullptr; }
    __device__ bool next(int i, Unit& u) const {
        const long L = (long)i * G + c; if (L >= (long)ntail * s * nN) return false;
        const int g = (int)L / nN; u.pn = (int)L - g * nN; const int t = g / s; u.pm = pm0 + t; u.ks = g - t * s; return true;
    }
    __device__ __forceinline__ size_t b_off(const Unit& u) const { return texp ? (size_t)__builtin_amdgcn_readfirstlane(texp[u.pm]) * estride : (size_t)0; }
    __device__ __forceinline__ size_t k_off(const Unit& u) const { return (size_t)u.ks * kbytes; }
};

__device__ __forceinline__ unsigned cvt_pk_bf16(float lo, float hi) { unsigned r; asm volatile("v_cvt_pk_bf16_f32 %0, %1, %2" : "=v"(r) : "v"(lo), "v"(hi)); return r; }

struct EpiF32 {
    static constexpr bool PERM = false;
    float* C; int ldc;
    __device__ __forceinline__ void operator()(const f32x4 (&acc)[2][2][4][2], const Unit& u, int wr, int wc, int fr, int fq) const {
        const int row0 = u.pm * BM + wr * 64 + fr, col0 = u.pn * BM + wc * 32 + 4 * fq;
#pragma unroll
        for (int ai = 0; ai < 2; ++ai)
#pragma unroll
            for (int m = 0; m < 4; ++m) { float* rowp = C + (size_t)(row0 + ai * HALF + m * 16) * ldc + col0;
#pragma unroll
                for (int bj = 0; bj < 2; ++bj)
#pragma unroll
                    for (int n = 0; n < 2; ++n) *(f32x4*)(rowp + bj * HALF + n * 16) = acc[ai][bj][m][n]; }
    }
};
struct EpiF32S {
    static constexpr bool PERM = false;
    float* C; int ldc; int pm0; size_t sstride; float sc;
    __device__ __forceinline__ void operator()(const f32x4 (&acc)[2][2][4][2], const Unit& u, int wr, int wc, int fr, int fq) const {
        const int row0 = (u.pm - pm0) * BM + wr * 64 + fr, col0 = u.pn * BM + wc * 32 + 4 * fq;
        float* Cs = C + (size_t)u.ks * sstride;
#pragma unroll
        for (int ai = 0; ai < 2; ++ai)
#pragma unroll
            for (int m = 0; m < 4; ++m) { float* rowp = Cs + (size_t)(row0 + ai * HALF + m * 16) * ldc + col0;
#pragma unroll
                for (int bj = 0; bj < 2; ++bj)
#pragma unroll
                    for (int n = 0; n < 2; ++n) *(f32x4*)(rowp + bj * HALF + n * 16) = acc[ai][bj][m][n] * sc; }
    }
};
struct EpiBf16S {
    static constexpr bool PERM = true;
    bf16_t* O; int ldc; int pm0; size_t sstride; float sc;
    __device__ __forceinline__ void operator()(const f32x4 (&acc)[2][2][4][2], const Unit& u, int wr, int wc, int fr, int fq) const {
        const int row0 = (u.pm - pm0) * BM + wr * 64 + fr, col0 = u.pn * BM + wc * 32 + 8 * fq;
        bf16_t* Os = O + (size_t)u.ks * sstride;
#pragma unroll
        for (int ai = 0; ai < 2; ++ai)
#pragma unroll
            for (int m = 0; m < 4; ++m) { bf16_t* rowp = Os + (size_t)(row0 + ai * HALF + m * 16) * ldc + col0;
#pragma unroll
                for (int bj = 0; bj < 2; ++bj) { const f32x4 v0 = acc[ai][bj][m][0] * sc, v1 = acc[ai][bj][m][1] * sc;
                    u32x4 w; w.x = cvt_pk_bf16(v0[0], v0[1]); w.y = cvt_pk_bf16(v0[2], v0[3]); w.z = cvt_pk_bf16(v1[0], v1[1]); w.w = cvt_pk_bf16(v1[2], v1[3]);
                    *(u32x4*)(rowp + bj * HALF) = w; } }
    }
};
struct EpiFp8 {
    static constexpr bool PERM = true;
    unsigned char* O; int ldc; float sc;
    __device__ __forceinline__ void operator()(const f32x4 (&acc)[2][2][4][2], const Unit& u, int wr, int wc, int fr, int fq) const {
        const int row0 = u.pm * BM + wr * 64 + fr, col0 = u.pn * BM + wc * 32 + 8 * fq;
#pragma unroll
        for (int ai = 0; ai < 2; ++ai)
#pragma unroll
            for (int m = 0; m < 4; ++m) { unsigned char* rowp = O + (size_t)(row0 + ai * HALF + m * 16) * ldc + col0;
#pragma unroll
                for (int bj = 0; bj < 2; ++bj) { u32x2 w;
#pragma unroll
                    for (int n = 0; n < 2; ++n) { const f32x4 v = acc[ai][bj][m][n] * sc; int q = 0;
                        q = __builtin_amdgcn_cvt_pk_fp8_f32(__builtin_amdgcn_fmed3f(v[0], -448.f, 448.f), __builtin_amdgcn_fmed3f(v[1], -448.f, 448.f), q, false);
                        q = __builtin_amdgcn_cvt_pk_fp8_f32(__builtin_amdgcn_fmed3f(v[2], -448.f, 448.f), __builtin_amdgcn_fmed3f(v[3], -448.f, 448.f), q, true);
                        if (n == 0) w.x = (unsigned)q; else w.y = (unsigned)q; }
                    *(u32x2*)(rowp + bj * HALF) = w; } }
    }
};
struct EpiBf16 {
    static constexpr bool PERM = true;
    bf16_t* O; int ldc; float sc = 1.0f;
    __device__ __forceinline__ void operator()(const f32x4 (&acc)[2][2][4][2], const Unit& u, int wr, int wc, int fr, int fq) const {
        const int row0 = u.pm * BM + wr * 64 + fr, col0 = u.pn * BM + wc * 32 + 8 * fq;
#pragma unroll
        for (int ai = 0; ai < 2; ++ai)
#pragma unroll
            for (int m = 0; m < 4; ++m) { bf16_t* rowp = O + (size_t)(row0 + ai * HALF + m * 16) * ldc + col0;
#pragma unroll
                for (int bj = 0; bj < 2; ++bj) { const f32x4 v0 = acc[ai][bj][m][0] * sc, v1 = acc[ai][bj][m][1] * sc;
                    u32x4 w; w.x = cvt_pk_bf16(v0[0], v0[1]); w.y = cvt_pk_bf16(v0[2], v0[3]); w.z = cvt_pk_bf16(v1[0], v1[1]); w.w = cvt_pk_bf16(v1[2], v1[3]);
                    *(u32x4*)(rowp + bj * HALF) = w; } }
    }
};
__device__ __forceinline__ float silu_f(float v) { return v * __builtin_amdgcn_rcpf(1.0f + __builtin_amdgcn_exp2f(-1.4426950408889634f * v)); }
__device__ __forceinline__ float sigmoid_f(float v) { return __builtin_amdgcn_rcpf(1.0f + __builtin_amdgcn_exp2f(-1.4426950408889634f * v)); }
struct EpiSwiGLU {
    static constexpr bool PERM = false;
    bf16_t* O; int ldc;
    __device__ __forceinline__ void operator()(const f32x4 (&acc)[2][2][4][2], const Unit& u, int wr, int wc, int fr, int fq) const {
        const int row0 = u.pm * BM + wr * 64 + fr, col0 = u.pn * (BM / 2) + wc * 16 + 4 * fq;
#pragma unroll
        for (int ai = 0; ai < 2; ++ai)
#pragma unroll
            for (int m = 0; m < 4; ++m) { bf16_t* rowp = O + (size_t)(row0 + ai * HALF + m * 16) * ldc + col0;
#pragma unroll
                for (int bj = 0; bj < 2; ++bj) { const f32x4 a = acc[ai][bj][m][0], b = acc[ai][bj][m][1];
                    u32x2 w; w.x = cvt_pk_bf16(silu_f(a[0]) * b[0], silu_f(a[1]) * b[1]); w.y = cvt_pk_bf16(silu_f(a[2]) * b[2], silu_f(a[3]) * b[3]);
                    *(u32x2*)(rowp + bj * (HALF / 2)) = w; } }
    }
};
struct EpiSwiGLU8 {
    static constexpr bool PERM = false;
    unsigned char* O; int ldc; float isc, osc;
    __device__ __forceinline__ void operator()(const f32x4 (&acc)[2][2][4][2], const Unit& u, int wr, int wc, int fr, int fq) const {
        const int row0 = u.pm * BM + wr * 64 + fr, col0 = u.pn * (BM / 2) + wc * 16 + 4 * fq;
#pragma unroll
        for (int ai = 0; ai < 2; ++ai)
#pragma unroll
            for (int m = 0; m < 4; ++m) { unsigned char* rowp = O + (size_t)(row0 + ai * HALF + m * 16) * ldc + col0;
#pragma unroll
                for (int bj = 0; bj < 2; ++bj) { const f32x4 a = acc[ai][bj][m][0], b = acc[ai][bj][m][1];
                    const float c1 = -1.4426950408889634f * isc, c2 = 1.0f / (isc * isc * osc);
                    float v[4];
#pragma unroll
                    for (int e = 0; e < 4; ++e) v[e] = __builtin_amdgcn_fmed3f((a[e] * b[e]) * __builtin_amdgcn_rcpf(__builtin_fmaf(__builtin_amdgcn_exp2f(a[e] * c1), c2, c2)), -448.f, 448.f);
                    int w = 0; w = __builtin_amdgcn_cvt_pk_fp8_f32(v[0], v[1], w, false); w = __builtin_amdgcn_cvt_pk_fp8_f32(v[2], v[3], w, true);
                    *(int*)(rowp + bj * (HALF / 2)) = w; } }
    }
};
struct EpiGate {
    static constexpr bool PERM = false;
    const bf16_t* Y; int ldy; bf16_t* O; int ldc; int ocol0;
    __device__ __forceinline__ void operator()(const f32x4 (&acc)[2][2][4][2], const Unit& u, int wr, int wc, int fr, int fq) const {
        const int row0 = u.pm * BM + wr * 64 + fr, col0 = u.pn * BM + wc * 32 + 4 * fq;
#pragma unroll
        for (int ai = 0; ai < 2; ++ai)
#pragma unroll
            for (int m = 0; m < 4; ++m) { const size_t r = (size_t)(row0 + ai * HALF + m * 16);
#pragma unroll
                for (int bj = 0; bj < 2; ++bj)
#pragma unroll
                    for (int n = 0; n < 2; ++n) { const int c = col0 + bj * HALF + n * 16; const f32x4 a = acc[ai][bj][m][n];
                        const u32x2 y = *(const u32x2*)(Y + r * ldy + c);
                        const float y0 = __uint_as_float(y.x << 16), y1 = __uint_as_float(y.x & 0xffff0000u), y2 = __uint_as_float(y.y << 16), y3 = __uint_as_float(y.y & 0xffff0000u);
                        u32x2 w; w.x = cvt_pk_bf16(y0 * sigmoid_f(a[0]), y1 * sigmoid_f(a[1])); w.y = cvt_pk_bf16(y2 * sigmoid_f(a[2]), y3 * sigmoid_f(a[3]));
                        *(u32x2*)(O + r * ldc + ocol0 + c) = w; } }
    }
};

typedef int v8i32 __attribute__((ext_vector_type(8)));
__device__ __forceinline__ void glds16s(const void* sbase, unsigned voff, unsigned lds_dst) { unsigned keep;
    asm volatile("s_mov_b32 %0, m0\n\ts_mov_b32 m0, %3\n\ts_nop 0\n\tglobal_load_lds_dwordx4 %1, %2\n\ts_mov_b32 m0, %0" : "=&s"(keep) : "v"(voff), "s"(sbase), "s"(lds_dst) : "memory"); }
template <bool FP8 = false, bool GATHER = false, class Epi, class Sched>
__device__ __forceinline__ void gemm_phase(PG8_LAS unsigned char* lds, const Gemm g, const Sched& S, const Epi& E) {
    int tid_ = (int)threadIdx.x; asm volatile("" : "+v"(tid_));
    const int tid = tid_, wid = __builtin_amdgcn_readfirstlane(tid >> 6), lane = tid & 63, wr = wid >> 2, wc = wid & 3, fr = lane & 15, fq = lane >> 4;
    const int K = FP8 ? (g.K >> 1) : g.K, nt = (g.kl ? (FP8 ? (g.kl >> 1) : g.kl) : K) / BK;
    unsigned voffA[2], voffB[2];
#pragma unroll
    for (int i = 0; i < 2; ++i) { int R, C; stage_rc(tid * 16 + i * 8192, R, C); const int Rb = Epi::PERM ? ((R & ~31) + perm32(R & 31)) : R;
        voffA[i] = (unsigned)(R * K + C) * 2u; voffB[i] = (unsigned)(Rb * K + C) * 2u; }
    const size_t kstep = (size_t)(BK * 2);
    const size_t qstep = (size_t)64 * K * 2;
    const size_t hstep = (size_t)HALF * K * 2;
    const size_t tstep = 2 * hstep;
    const unsigned ldsw = (unsigned)wid * 1024u, ldsbase = (unsigned)(uintptr_t)lds;
    const int aoff = lds_byte(wr * 64 + fr, fq * 8), boff = lds_byte(wc * 32 + fr, fq * 8);
#define PG8_SA(b, h) (((b) * 2 + (h)) * HTB)
#define PG8_SB(b, h) ((4 + (b) * 2 + (h)) * HTB)
#define PG8_STAGE(bufoff, gbase, voff) do { _Pragma("unroll") for (int _i = 0; _i < 2; ++_i) glds16s((const void*)(gbase), (voff)[_i], ldsbase + (unsigned)(bufoff) + ldsw + (unsigned)_i * 8192u); } while (0)
#define PG8_STAGE1(bufoff, gbase, voff0) do { _Pragma("unroll") for (int _i = 0; _i < 2; ++_i) glds16s((const void*)((const char*)(gbase) + (size_t)_i * qstep), voff0, ldsbase + (unsigned)(bufoff) + ldsw + (unsigned)_i * 8192u); } while (0)
#define PG8_STAGE_A(bufoff, h, ap, og) do { if constexpr (GATHER) PG8_STAGE(bufoff, ap, (og)[h]); else PG8_STAGE1(bufoff, (ap) + (h) * hstep, voffA[0]); } while (0)
#define PG8_LDA(dst, b, h) do { _Pragma("unroll") for (int m = 0; m < 4; ++m) _Pragma("unroll") for (int k = 0; k < 2; ++k) dst[m][k] = *(const PG8_LAS bf16x8*)(lds + PG8_SA(b, h) + aoff + m * 2048 + k * 1024); } while (0)
#define PG8_LDB(dst, b, h) do { _Pragma("unroll") for (int n = 0; n < 2; ++n) _Pragma("unroll") for (int k = 0; k < 2; ++k) dst[n][k] = *(const PG8_LAS bf16x8*)(lds + PG8_SB(b, h) + boff + n * 2048 + k * 1024); } while (0)
#define PG8_MMA(ai, bj, At, Bt) do { __builtin_amdgcn_s_setprio(1); _Pragma("unroll") for (int m = 0; m < 4; ++m) _Pragma("unroll") for (int n = 0; n < 2; ++n) { \
        if constexpr (FP8) { const v8i32 bq = __builtin_bit_cast(v8i32, __builtin_shufflevector(Bt[n][0], Bt[n][1], 0, 1, 2, 3, 4, 5, 6, 7, 8, 9, 10, 11, 12, 13, 14, 15)); \
            const v8i32 aq = __builtin_bit_cast(v8i32, __builtin_shufflevector(At[m][0], At[m][1], 0, 1, 2, 3, 4, 5, 6, 7, 8, 9, 10, 11, 12, 13, 14, 15)); \
            acc[ai][bj][m][n] = __builtin_amdgcn_mfma_scale_f32_16x16x128_f8f6f4(bq, aq, acc[ai][bj][m][n], 0, 0, 0, 0, 0, 0);     } \
        else { _Pragma("unroll") for (int k = 0; k < 2; ++k) acc[ai][bj][m][n] = __builtin_amdgcn_mfma_f32_16x16x32_bf16(Bt[n][k], At[m][k], acc[ai][bj][m][n], 0, 0, 0); } } \
        __builtin_amdgcn_s_setprio(0); } while (0)
#define PG8_WAIT_V(n) asm volatile("s_waitcnt vmcnt(" #n ")" ::: "memory")
#define PG8_WAIT_L(n) asm volatile("s_waitcnt lgkmcnt(" #n ")" ::: "memory")
#define PG8_BAR __builtin_amdgcn_s_barrier()
#define PG8_SCHED __builtin_amdgcn_sched_barrier(0)
#define PG8_AOFF(dst, u) do { if constexpr (GATHER) { int t2_ = (int)threadIdx.x; asm volatile("" : "+v"(t2_)); _Pragma("unroll") for (int _i = 0; _i < 2; ++_i) { int R_, C_; stage_rc(t2_ * 16 + _i * 8192, R_, C_); \
        _Pragma("unroll") for (int _h = 0; _h < 2; ++_h) { const int _row = S.rowidx[(u).pm * BM + _h * HALF + R_]; dst[_h][_i] = (unsigned)((size_t)_row * K + C_) * 2u; } } } } while (0)
    Unit cur, nxt; int ui = 0;
    if (!S.next(0, cur)) return;
    f32x4 acc[2][2][4][2];
#pragma unroll
    for (int a = 0; a < 2; ++a)
#pragma unroll
        for (int b = 0; b < 2; ++b)
#pragma unroll
            for (int m = 0; m < 4; ++m)
#pragma unroll
                for (int n = 0; n < 2; ++n) acc[a][b][m][n] = (f32x4){0.f, 0.f, 0.f, 0.f};
    bf16x8 At[4][2], B0[2][2], B1[2][2];
    unsigned oC[2][2];
#define PG8_OSLOT ((PG8_LAS u32x4*)(lds + STAGE_BYTES) + (int)threadIdx.x)
    PG8_AOFF(oC, cur);
    const char* const gA = (const char*)g.A;
    const char* cA = (GATHER ? gA : gA + (size_t)cur.pm * tstep) + S.k_off(cur);
    const char* cB = (const char*)g.Bt + S.b_off(cur) + (size_t)cur.pn * tstep + S.k_off(cur);
    PG8_STAGE1(PG8_SB(0, 0), cB, voffB[0]); PG8_STAGE1(PG8_SB(0, 1), cB + hstep, voffB[0]); PG8_STAGE_A(PG8_SA(0, 0), 0, cA, oC); PG8_STAGE_A(PG8_SA(0, 1), 1, cA, oC);
    if (wr == 1) PG8_BAR;
    PG8_WAIT_V(2); PG8_BAR;
    PG8_STAGE1(PG8_SB(1, 0), cB + kstep, voffB[0]); PG8_STAGE_A(PG8_SA(1, 0), 0, cA + kstep, oC); PG8_STAGE1(PG8_SB(1, 1), cB + hstep + kstep, voffB[0]);
    PG8_WAIT_V(6); PG8_BAR;
    for (;;) {
        const bool has_next = S.next(ui + 1, nxt);
        const char* nB = cB; const char* nA = cA;
        if (has_next) { nB = (const char*)g.Bt + S.b_off(nxt) + (size_t)nxt.pn * tstep + S.k_off(nxt); nA = (GATHER ? gA : gA + (size_t)nxt.pm * tstep) + S.k_off(nxt);
            if constexpr (GATHER) { unsigned oN[2][2]; PG8_AOFF(oN, nxt); *PG8_OSLOT = (u32x4){oN[0][0], oN[0][1], oN[1][0], oN[1][1]}; } }
        for (int t = 0; t < nt; t += 2) {
            const bool last = (t == nt - 2);
            const char* a1 = cA + (size_t)(t + 1) * kstep;
            const char* a2 = last ? nA : cA + (size_t)(t + 2) * kstep; const char* b2 = last ? nB : cB + (size_t)(t + 2) * kstep;
            const char* a3 = a2 + kstep; const char* b3 = b2 + kstep;
            unsigned o2[2][2];
            if constexpr (GATHER) {
                if (last && has_next) { const u32x4 q = *PG8_OSLOT; o2[0][0] = q.x; o2[0][1] = q.y; o2[1][0] = q.z; o2[1][1] = q.w; }
                else { o2[0][0] = oC[0][0]; o2[0][1] = oC[0][1]; o2[1][0] = oC[1][0]; o2[1][1] = oC[1][1]; }
            }
            PG8_LDB(B0, 0, 0); PG8_LDB(B1, 0, 1); PG8_SCHED; PG8_LDA(At, 0, 0); PG8_STAGE_A(PG8_SA(1, 1), 1, a1, oC);
            PG8_WAIT_V(8); PG8_WAIT_L(0); PG8_BAR; PG8_MMA(0, 0, At, B0); PG8_MMA(0, 1, At, B1); PG8_BAR; PG8_SCHED;
            PG8_LDA(At, 0, 1); PG8_STAGE1(PG8_SB(0, 0), b2, voffB[0]); PG8_STAGE1(PG8_SB(0, 1), b2 + hstep, voffB[0]); PG8_STAGE_A(PG8_SA(0, 0), 0, a2, o2);
            PG8_WAIT_V(8); PG8_WAIT_L(0); PG8_BAR; PG8_MMA(1, 0, At, B0); PG8_MMA(1, 1, At, B1); PG8_BAR; PG8_SCHED;
            PG8_LDB(B0, 1, 0); PG8_LDB(B1, 1, 1); PG8_SCHED; PG8_LDA(At, 1, 0); PG8_STAGE_A(PG8_SA(0, 1), 1, a2, o2);
            PG8_WAIT_V(8); PG8_WAIT_L(0); PG8_BAR; PG8_MMA(0, 0, At, B0); PG8_MMA(0, 1, At, B1); PG8_BAR; PG8_SCHED;
            PG8_LDA(At, 1, 1); PG8_STAGE1(PG8_SB(1, 0), b3, voffB[0]); PG8_STAGE1(PG8_SB(1, 1), b3 + hstep, voffB[0]); PG8_STAGE_A(PG8_SA(1, 0), 0, a3, o2);
            PG8_WAIT_V(8); PG8_WAIT_L(0); PG8_BAR; PG8_MMA(1, 0, At, B0); PG8_MMA(1, 1, At, B1); PG8_BAR; PG8_SCHED;
        }
        if (wr == 0) PG8_BAR;
        { int t3 = (int)threadIdx.x; asm volatile("" : "+v"(t3)); E(acc, cur, wr, wc, t3 & 15, (t3 >> 4) & 3); }
        if (!has_next) break;
#pragma unroll
        for (int a = 0; a < 2; ++a)
#pragma unroll
            for (int b = 0; b < 2; ++b)
#pragma unroll
                for (int m = 0; m < 4; ++m)
#pragma unroll
                    for (int n = 0; n < 2; ++n) acc[a][b][m][n] = (f32x4){0.f, 0.f, 0.f, 0.f};
        cur = nxt; cB = nB; cA = nA; ++ui;
        if constexpr (GATHER) { const u32x4 q = *PG8_OSLOT; oC[0][0] = q.x; oC[0][1] = q.y; oC[1][0] = q.z; oC[1][1] = q.w; }
        if (wr == 1) PG8_BAR;
    }
    PG8_WAIT_V(0);
    PG8_BAR;
#undef PG8_SA
#undef PG8_SB
#undef PG8_STAGE
#undef PG8_STAGE_A
#undef PG8_STAGE1
#undef PG8_LDA
#undef PG8_LDB
#undef PG8_MMA
#undef PG8_WAIT_V
#undef PG8_WAIT_L
#undef PG8_BAR
#undef PG8_SCHED
#undef PG8_AOFF
#undef PG8_OSLOT
}
}
namespace mla2 {
using bf16x8 = __attribute__((ext_vector_type(8))) short;
using s16x4  = __attribute__((ext_vector_type(4))) short;
using f32x16 = __attribute__((ext_vector_type(16))) float;
using f32x4v = __attribute__((ext_vector_type(4))) float;
using u32x4  = __attribute__((ext_vector_type(4))) unsigned;
constexpr int NW = 8, QBLK = 32, KVBLK = 64;
constexpr float SCALE = 0.072168783648703220f;
constexpr float THR = 8.f;
constexpr int NQREG = 4, NQL = 12 - NQREG;
constexpr int LDQ = 2304, LDKV = 3072, LDKP = 64, LDO = 2048;
constexpr int SHM_V = KVBLK * 128 * 2, SHM_KN = KVBLK * 128 * 2, SHM_KP = KVBLK * 64 * 2;
constexpr int SHM_K = SHM_KN + SHM_KP;
constexpr int OFF_V = 0, OFF_KN = 2 * SHM_V, OFF_WS = OFF_KN + 2 * SHM_K, OFF_QS = OFF_WS + NW * 64 * 4, QS_WAVE = NQL * 1024, SHM_ATTN = OFF_QS + NW * QS_WAVE;
#define MLA2_QB(row, c16) ((((c16) >> 1) * 32 + (row)) * 32 + ((((c16) & 1) ^ (((row) >> 3) & 1)) << 4))
#define MLA2_SBAR() __builtin_amdgcn_sched_barrier(0)
#ifndef MLA2_WAIT0
#define MLA2_WAIT0 0
#endif
#if MLA2_WAIT0
#define MLA2_LWAIT(n) do { asm volatile("s_waitcnt lgkmcnt(0)" ::: "memory"); __builtin_amdgcn_sched_barrier(0); } while (0)
#else
#ifndef MLA2_SBMASK
#define MLA2_SBMASK 0x416
#endif
#define MLA2_LWAIT(n) do { asm volatile("s_waitcnt lgkmcnt(" #n ")" ::: "memory"); __builtin_amdgcn_sched_barrier(MLA2_SBMASK); } while (0)
#ifndef MLA2_FENCES
#define MLA2_FENCES 1
#endif
#if MLA2_FENCES
#define MLA2_FENCE() __builtin_amdgcn_sched_barrier(0)
#else
#define MLA2_FENCE() do {} while (0)
#endif
#define MLA2_W2(n, A, B) asm volatile("s_waitcnt lgkmcnt(" #n ")" : "+v"(A), "+v"(B) :: "memory")
#define MLA2_W3(n, A, B, C) asm volatile("s_waitcnt lgkmcnt(" #n ")" : "+v"(A), "+v"(B), "+v"(C) :: "memory")
#define MLA2_NRD(s) (((s) < 12) ? (((s) >= NQREG) ? 3 : 2) : 0)
#define MLA2_WS(s, X0, X1, XQ) do { if constexpr ((s) >= NQREG) asm volatile("s_waitcnt lgkmcnt(%3)" : "+v"(X0), "+v"(X1), "+v"(XQ) : "i"(MLA2_NRD((s) + 1)) : "memory"); \
    else asm volatile("s_waitcnt lgkmcnt(%2)" : "+v"(X0), "+v"(X1) : "i"(MLA2_NRD((s) + 1)) : "memory"); } while (0)
#endif
__device__ __forceinline__ int crow(int r, int hi) { return (r & 3) + 8 * (r >> 2) + 4 * hi; }
__device__ __forceinline__ unsigned cvtpk(float lo, float hi) { unsigned r; asm volatile("v_cvt_pk_bf16_f32 %0, %1, %2" : "=v"(r) : "v"(lo), "v"(hi)); return r; }
#ifndef MLA2_PLAIN_RD
#define MLA2_PLAIN_RD 0
#endif
template <int OFF> __device__ __forceinline__ bf16x8 lds_rd(int addr) {
#if MLA2_PLAIN_RD
  return *(const __attribute__((address_space(3))) bf16x8*)(unsigned)(addr + OFF);
#else
  bf16x8 r; asm volatile("ds_read_b128 %0, %1 offset:%2" : "=v"(r) : "v"(addr), "i"(OFF) : "memory"); return r;
#endif
}
using f32x2v = __attribute__((ext_vector_type(2))) float;
__device__ __forceinline__ float max3f(float a, float b, float c) { float r; asm volatile("v_max3_f32 %0, %1, %2, %3" : "=v"(r) : "v"(a), "v"(b), "v"(c)); return r; }
template <int OFF> __device__ __forceinline__ s16x4 tr_read(int vb) { s16x4 r; asm volatile("ds_read_b64_tr_b16 %0, %1 offset:%2" : "=&v"(r) : "v"(vb), "i"(OFF) : "memory"); return r; }

constexpr float THRL = THR * 1.4426950408889634f;
__device__ __forceinline__ void partialSM0(f32x16& p0, f32x16& p1, float& m_reg, f32x16& Mt) {
  float pmax = p0[0];
#pragma unroll
  for (int r = 1; r < 16; ++r) pmax = fmaxf(pmax, p0[r]);
#pragma unroll
  for (int r = 0; r < 16; ++r) pmax = fmaxf(pmax, p1[r]);
  { auto rr = __builtin_amdgcn_permlane32_swap(__float_as_uint(pmax), __float_as_uint(pmax), false, false);
    pmax = fmaxf(__uint_as_float(rr[0]), __uint_as_float(rr[1])); }
  m_reg = pmax;
#pragma unroll
  for (int r = 0; r < 16; ++r) { p0[r] -= pmax; p1[r] -= pmax; Mt[r] = -pmax; }
#pragma unroll
  for (int r = 0; r < 16; ++r) p0[r] = __builtin_amdgcn_exp2f(p0[r]);
}
__device__ __forceinline__ void partialSM(f32x16& p0, f32x16& p1, float& m_reg, float& mn, float& alpha) {
  constexpr float C = SCALE * 1.4426950408889634f;
  float pmax = p0[0];
#pragma unroll
  for (int r = 1; r < 16; ++r) pmax = fmaxf(pmax, p0[r]);
#pragma unroll
  for (int r = 0; r < 16; ++r) pmax = fmaxf(pmax, p1[r]);
  { auto rr = __builtin_amdgcn_permlane32_swap(__float_as_uint(pmax), __float_as_uint(pmax), false, false);
    pmax = fmaxf(__uint_as_float(rr[0]), __uint_as_float(rr[1])); }
  if (__builtin_expect(__all(pmax - m_reg <= THR / SCALE), 1)) { mn = m_reg; alpha = 1.f; }
  else { mn = fmaxf(m_reg, pmax); alpha = __builtin_amdgcn_exp2f((m_reg - mn) * C); m_reg = mn; }
  float mnC = -mn * C;
#pragma unroll
  for (int r = 0; r < 16; ++r) p0[r] = fmaf(p0[r], C, mnC);
#pragma unroll
  for (int r = 0; r < 16; ++r) p1[r] = fmaf(p1[r], C, mnC);
#pragma unroll
  for (int r = 0; r < 16; ++r) p0[r] = __builtin_amdgcn_exp2f(p0[r]);
}
__device__ __forceinline__ void finishSM(f32x16& p0, f32x16& p1, float alpha, float& l_reg, bf16x8& pa0, bf16x8& pa1, bf16x8& pa2, bf16x8& pa3) {
#pragma unroll
  for (int r = 0; r < 16; ++r) p1[r] = __builtin_amdgcn_exp2f(p1[r]);
  float ps = 0;
#pragma unroll
  for (int r = 0; r < 16; ++r) ps += p0[r];
#pragma unroll
  for (int r = 0; r < 16; ++r) ps += p1[r];
  { auto rr = __builtin_amdgcn_permlane32_swap(__float_as_uint(ps), __float_as_uint(ps), false, false);
    ps = __uint_as_float(rr[0]) + __uint_as_float(rr[1]); }
  l_reg = l_reg * alpha + ps;
#define MLA2_PK4(P, BASE, OUT) do { unsigned a0 = cvtpk(P[BASE + 0], P[BASE + 1]), a1 = cvtpk(P[BASE + 2], P[BASE + 3]);   \
    unsigned b0 = cvtpk(P[BASE + 4], P[BASE + 5]), b1 = cvtpk(P[BASE + 6], P[BASE + 7]);                              \
    auto r0 = __builtin_amdgcn_permlane32_swap(a0, b0, false, false); auto r1 = __builtin_amdgcn_permlane32_swap(a1, b1, false, false); \
    u32x4 w = {r0[0], r1[0], r0[1], r1[1]}; OUT = *reinterpret_cast<bf16x8*>(&w); } while (0)
  MLA2_PK4(p0, 0, pa0); MLA2_PK4(p0, 8, pa1); MLA2_PK4(p1, 0, pa2); MLA2_PK4(p1, 8, pa3);
#undef MLA2_PK4
}
constexpr int ko(int B, int s) { return B * SHM_K + (s >> 2) * 8192; }
constexpr int qo(int s) { return (s - NQREG) * 1024; }
template <int B> __device__ __forceinline__ void qkt(f32x16& p0, f32x16& p1, const int (&kb)[4], int qbase, const bf16x8 (&qr)[NQREG]) {
  p0 = f32x16{}; p1 = f32x16{};
  bf16x8 a0, a1, aq, c0, c1, cq;
#define MLA2_RD(s, X0, X1, XQ) do { X0 = lds_rd<ko(B, s)>(kb[(s) & 3]); X1 = lds_rd<ko(B, s) + 4096>(kb[(s) & 3]); if constexpr ((s) >= NQREG) XQ = lds_rd<qo((s) >= NQREG ? (s) : NQREG)>(qbase); } while (0)
#define MLA2_MM(s, X0, X1, XQ) do { const bf16x8 q_ = ((s) < NQREG) ? qr[(s) < NQREG ? (s) : 0] : XQ; \
    p0 = __builtin_amdgcn_mfma_f32_32x32x16_bf16(X0, q_, p0, 0, 0, 0); p1 = __builtin_amdgcn_mfma_f32_32x32x16_bf16(X1, q_, p1, 0, 0, 0); } while (0)
  MLA2_RD(0, a0, a1, aq); MLA2_RD(1, c0, c1, cq);
  MLA2_WS(0, a0, a1, aq); MLA2_MM(0, a0, a1, aq); MLA2_RD(2, a0, a1, aq);
  MLA2_WS(1, c0, c1, cq); MLA2_MM(1, c0, c1, cq); MLA2_RD(3, c0, c1, cq);
  MLA2_WS(2, a0, a1, aq); MLA2_MM(2, a0, a1, aq); MLA2_RD(4, a0, a1, aq);
  MLA2_WS(3, c0, c1, cq); MLA2_MM(3, c0, c1, cq); MLA2_RD(5, c0, c1, cq); MLA2_FENCE();
  MLA2_WS(4, a0, a1, aq); MLA2_MM(4, a0, a1, aq); MLA2_RD(6, a0, a1, aq);
  MLA2_WS(5, c0, c1, cq); MLA2_MM(5, c0, c1, cq); MLA2_RD(7, c0, c1, cq);
  MLA2_WS(6, a0, a1, aq); MLA2_MM(6, a0, a1, aq); MLA2_RD(8, a0, a1, aq);
  MLA2_WS(7, c0, c1, cq); MLA2_MM(7, c0, c1, cq); MLA2_RD(9, c0, c1, cq); MLA2_FENCE();
  MLA2_WS(8, a0, a1, aq); MLA2_MM(8, a0, a1, aq); MLA2_RD(10, a0, a1, aq);
  MLA2_WS(9, c0, c1, cq); MLA2_MM(9, c0, c1, cq); MLA2_RD(11, c0, c1, cq);
  MLA2_WS(10, a0, a1, aq); MLA2_MM(10, a0, a1, aq);
  MLA2_WS(11, c0, c1, cq); MLA2_MM(11, c0, c1, cq);
#undef MLA2_RD
#undef MLA2_MM
}
__device__ __forceinline__ int v_st(int k, int c) { const int kk = (k & ~0xC) | ((k & 4) << 1) | ((k & 8) >> 1); return ((kk >> 3) * 4 + (c >> 5)) * 512 + ((kk & 7) * 32 + (c & 31)) * 2; }
__device__ __forceinline__ int v_rd_base(int lane) { return ((lane & 3) << 3) | (((lane >> 2) & 3) << 6) | (((lane >> 4) & 1) << 5) | (((lane >> 5) & 1) << 8); }
constexpr int v_rd_off(int d0, int ks, int half) { return d0 * 512 + ks * 4096 + half * 2048; }
template <int B> __device__ __forceinline__ void pv(f32x16 (&o)[4], int vb, bf16x8 pa0, bf16x8 pa1, bf16x8 pa2, bf16x8 pa3) {
  s16x4 l0, h0, l1, h1, l2, h2;
#define MLA2_PK(L, H) (bf16x8){L[0], L[1], L[2], L[3], H[0], H[1], H[2], H[3]}
#define MLA2_PR(k, L, H) do { L = tr_read<B * SHM_V + v_rd_off((k) & 3, (k) >> 2, 0)>(vb); H = tr_read<B * SHM_V + v_rd_off((k) & 3, (k) >> 2, 1)>(vb); } while (0)
#define MLA2_PM(k, L, H) do { const bf16x8 pa_ = ((k) >> 2) == 0 ? pa0 : ((k) >> 2) == 1 ? pa1 : ((k) >> 2) == 2 ? pa2 : pa3; \
    o[(k) & 3] = __builtin_amdgcn_mfma_f32_32x32x16_bf16(pa_, MLA2_PK(L, H), o[(k) & 3], 0, 0, 0); } while (0)
  MLA2_PR(0, l0, h0); MLA2_PR(1, l1, h1); MLA2_PR(2, l2, h2);
  MLA2_W2(4, l0, h0); MLA2_PM(0, l0, h0); MLA2_PR(3, l0, h0);
  MLA2_W2(4, l1, h1); MLA2_PM(1, l1, h1); MLA2_PR(4, l1, h1);
  MLA2_W2(4, l2, h2); MLA2_PM(2, l2, h2); MLA2_PR(5, l2, h2);
  MLA2_W2(4, l0, h0); MLA2_PM(3, l0, h0); MLA2_PR(6, l0, h0); MLA2_FENCE();
  MLA2_W2(4, l1, h1); MLA2_PM(4, l1, h1); MLA2_PR(7, l1, h1);
  MLA2_W2(4, l2, h2); MLA2_PM(5, l2, h2); MLA2_PR(8, l2, h2);
  MLA2_W2(4, l0, h0); MLA2_PM(6, l0, h0); MLA2_PR(9, l0, h0);
  MLA2_W2(4, l1, h1); MLA2_PM(7, l1, h1); MLA2_PR(10, l1, h1); MLA2_FENCE();
  MLA2_W2(4, l2, h2); MLA2_PM(8, l2, h2); MLA2_PR(11, l2, h2);
  MLA2_W2(4, l0, h0); MLA2_PM(9, l0, h0); MLA2_PR(12, l0, h0);
  MLA2_W2(4, l1, h1); MLA2_PM(10, l1, h1); MLA2_PR(13, l1, h1);
  MLA2_W2(4, l2, h2); MLA2_PM(11, l2, h2); MLA2_PR(14, l2, h2); MLA2_FENCE();
  MLA2_W2(4, l0, h0); MLA2_PM(12, l0, h0); MLA2_PR(15, l0, h0);
  MLA2_W2(4, l1, h1); MLA2_PM(13, l1, h1);
  MLA2_W2(2, l2, h2); MLA2_PM(14, l2, h2);
  MLA2_W2(0, l0, h0); MLA2_PM(15, l0, h0);
#undef MLA2_PK
#undef MLA2_PR
#undef MLA2_PM
}
#define MLA2_PK4B(P, BASE, OUT) do { unsigned a0_ = cvtpk(P[BASE + 0], P[BASE + 1]), a1_ = cvtpk(P[BASE + 2], P[BASE + 3]);   \
    unsigned b0_ = cvtpk(P[BASE + 4], P[BASE + 5]), b1_ = cvtpk(P[BASE + 6], P[BASE + 7]);                              \
    auto r0_ = __builtin_amdgcn_permlane32_swap(a0_, b0_, false, false); auto r1_ = __builtin_amdgcn_permlane32_swap(a1_, b1_, false, false); \
    u32x4 w_ = {r0_[0], r1_[0], r0_[1], r1_[1]}; OUT = *reinterpret_cast<bf16x8*>(&w_); } while (0)
template <int B> __device__ __forceinline__ void r1(f32x16& n0, f32x16& n1, const int (&kb)[4], int qbase, const bf16x8 (&qr)[NQREG],
                                                    f32x16& p0, f32x16& p1, float alpha, float& l_reg, bf16x8& pa0, bf16x8& pa1, bf16x8& pa2, bf16x8& pa3, const f32x16& Mt) {
  bf16x8 a0, a1, aq, c0, c1, cq; float psa = 0.f, psb = 0.f;
#define MLA2_RD(s, X0, X1, XQ) do { X0 = lds_rd<ko(B, s)>(kb[(s) & 3]); X1 = lds_rd<ko(B, s) + 4096>(kb[(s) & 3]); if constexpr ((s) >= NQREG) XQ = lds_rd<qo((s) >= NQREG ? (s) : NQREG)>(qbase); } while (0)
#define MLA2_MM(s, X0, X1, XQ) do { const bf16x8 q_ = ((s) < NQREG) ? qr[(s) < NQREG ? (s) : 0] : XQ; \
    if constexpr ((s) == 0) { n0 = __builtin_amdgcn_mfma_f32_32x32x16_bf16(X0, q_, Mt, 0, 0, 0); n1 = __builtin_amdgcn_mfma_f32_32x32x16_bf16(X1, q_, Mt, 0, 0, 0); }     \
    else { n0 = __builtin_amdgcn_mfma_f32_32x32x16_bf16(X0, q_, n0, 0, 0, 0); n1 = __builtin_amdgcn_mfma_f32_32x32x16_bf16(X1, q_, n1, 0, 0, 0); } } while (0)
#define MLA2_ADD(ACC, X) asm volatile("v_add_f32 %0, %0, %1" : "+v"(ACC) : "v"(X))
#define MLA2_CE(k) do { p1[2 * (k)] = __builtin_amdgcn_exp2f(p1[2 * (k)]); p1[2 * (k) + 1] = __builtin_amdgcn_exp2f(p1[2 * (k) + 1]); MLA2_ADD(psa, p0[2 * (k)]); MLA2_ADD(psb, p0[2 * (k) + 1]); \
    MLA2_ADD(psa, p1[2 * (k)]); MLA2_ADD(psb, p1[2 * (k) + 1]); asm volatile("" : "+v"(p1)); } while (0)
  MLA2_RD(0, a0, a1, aq); MLA2_RD(1, c0, c1, cq);
  MLA2_WS(0, a0, a1, aq); MLA2_MM(0, a0, a1, aq); MLA2_RD(2, a0, a1, aq); MLA2_CE(0); MLA2_SBAR();
  MLA2_WS(1, c0, c1, cq); MLA2_MM(1, c0, c1, cq); MLA2_RD(3, c0, c1, cq); MLA2_CE(1); MLA2_SBAR();
  MLA2_WS(2, a0, a1, aq); MLA2_MM(2, a0, a1, aq); MLA2_RD(4, a0, a1, aq); MLA2_CE(2); MLA2_SBAR();
  MLA2_WS(3, c0, c1, cq); MLA2_MM(3, c0, c1, cq); MLA2_RD(5, c0, c1, cq); MLA2_CE(3); MLA2_SBAR();
  MLA2_WS(4, a0, a1, aq); MLA2_MM(4, a0, a1, aq); MLA2_RD(6, a0, a1, aq); MLA2_CE(4); MLA2_SBAR();
  MLA2_WS(5, c0, c1, cq); MLA2_MM(5, c0, c1, cq); MLA2_RD(7, c0, c1, cq); MLA2_CE(5); MLA2_SBAR();
  MLA2_WS(6, a0, a1, aq); MLA2_MM(6, a0, a1, aq); MLA2_RD(8, a0, a1, aq); MLA2_CE(6); MLA2_SBAR();
  MLA2_WS(7, c0, c1, cq); MLA2_MM(7, c0, c1, cq); MLA2_RD(9, c0, c1, cq); MLA2_CE(7); MLA2_SBAR();
  MLA2_WS(8, a0, a1, aq); MLA2_MM(8, a0, a1, aq); MLA2_RD(10, a0, a1, aq);
  float ps = psa + psb;
  { auto rr = __builtin_amdgcn_permlane32_swap(__float_as_uint(ps), __float_as_uint(ps), false, false); ps = __uint_as_float(rr[0]) + __uint_as_float(rr[1]); }
  l_reg = l_reg * alpha + ps; MLA2_PK4B(p0, 0, pa0); asm volatile("" : "+v"(l_reg), "+v"(pa0)); MLA2_SBAR();
  MLA2_WS(9, c0, c1, cq); MLA2_MM(9, c0, c1, cq); MLA2_RD(11, c0, c1, cq); MLA2_PK4B(p0, 8, pa1); asm volatile("" : "+v"(pa1)); MLA2_SBAR();
  MLA2_WS(10, a0, a1, aq); MLA2_MM(10, a0, a1, aq); MLA2_PK4B(p1, 0, pa2); asm volatile("" : "+v"(pa2)); MLA2_SBAR();
  MLA2_WS(11, c0, c1, cq); MLA2_MM(11, c0, c1, cq); MLA2_PK4B(p1, 8, pa3); asm volatile("" : "+v"(pa3)); MLA2_SBAR();
#undef MLA2_RD
#undef MLA2_MM
#undef MLA2_CE
#undef MLA2_ADD
}
template <int B, bool FAST> __device__ __forceinline__ void r2(f32x16 (&o)[4], int vb, bf16x8 pa0, bf16x8 pa1, bf16x8 pa2, bf16x8 pa3,
                                                    f32x16& q0, f32x16& q1, float& m_reg, float& alpha, f32x16& Mt) {
  s16x4 l0, h0, l1, h1, l2, h2; float mx;
#define MLA2_PK(L, H) (bf16x8){L[0], L[1], L[2], L[3], H[0], H[1], H[2], H[3]}
#define MLA2_PR(k, L, H) do { L = tr_read<B * SHM_V + v_rd_off((k) & 3, (k) >> 2, 0)>(vb); H = tr_read<B * SHM_V + v_rd_off((k) & 3, (k) >> 2, 1)>(vb); } while (0)
#define MLA2_PM(k, L, H) do { const bf16x8 pa_ = ((k) >> 2) == 0 ? pa0 : ((k) >> 2) == 1 ? pa1 : ((k) >> 2) == 2 ? pa2 : pa3; \
    o[(k) & 3] = __builtin_amdgcn_mfma_f32_32x32x16_bf16(pa_, MLA2_PK(L, H), o[(k) & 3], 0, 0, 0); } while (0)
#define MLA2_MX(Q, b) do { mx = max3f(mx, Q[b], Q[b + 1]); mx = max3f(mx, Q[b + 2], Q[b + 3]); mx = max3f(mx, Q[b + 4], Q[b + 5]); mx = max3f(mx, Q[b + 6], Q[b + 7]); } while (0)
#define MLA2_EX(Q, b) do { _Pragma("unroll") for (int e_ = 0; e_ < 2; ++e_) Q[(b) + e_] = __builtin_amdgcn_exp2f(Q[(b) + e_]); asm volatile("" : "+v"(Q)); } while (0)
  MLA2_PR(0, l0, h0); MLA2_PR(1, l1, h1); MLA2_PR(2, l2, h2);
  mx = q0[0];
  MLA2_W2(4, l0, h0); MLA2_PM(0, l0, h0); MLA2_PR(3, l0, h0); if constexpr (!FAST) MLA2_MX(q0, 0); MLA2_SBAR();
  MLA2_W2(4, l1, h1); MLA2_PM(1, l1, h1); MLA2_PR(4, l1, h1); if constexpr (!FAST) MLA2_MX(q0, 8); MLA2_SBAR();
  MLA2_W2(4, l2, h2); MLA2_PM(2, l2, h2); MLA2_PR(5, l2, h2); if constexpr (!FAST) MLA2_MX(q1, 0); MLA2_SBAR();
  MLA2_W2(4, l0, h0); MLA2_PM(3, l0, h0); MLA2_PR(6, l0, h0); if constexpr (!FAST) MLA2_MX(q1, 8); MLA2_SBAR();
  MLA2_W2(4, l1, h1); MLA2_PM(4, l1, h1); MLA2_PR(7, l1, h1);
  if constexpr (!FAST) { auto rr = __builtin_amdgcn_permlane32_swap(__float_as_uint(mx), __float_as_uint(mx), false, false); mx = fmaxf(__uint_as_float(rr[0]), __uint_as_float(rr[1])); }
  alpha = 1.f;
  if (!FAST && __builtin_expect(!__all(mx <= THRL), 0)) {
    const float dl = fmaxf(mx, 0.f); alpha = __builtin_amdgcn_exp2f(-dl); m_reg += dl;
#pragma unroll
    for (int r = 0; r < 16; ++r) { q0[r] -= dl; q1[r] -= dl; Mt[r] -= dl; } }
  asm volatile("" : "+v"(alpha), "+v"(m_reg));
  MLA2_SBAR();
  MLA2_W2(4, l2, h2); MLA2_PM(5, l2, h2); MLA2_PR(8, l2, h2); MLA2_EX(q0, 0); MLA2_SBAR();
  MLA2_W2(4, l0, h0); MLA2_PM(6, l0, h0); MLA2_PR(9, l0, h0); MLA2_EX(q0, 2); MLA2_SBAR();
  MLA2_W2(4, l1, h1); MLA2_PM(7, l1, h1); MLA2_PR(10, l1, h1); MLA2_EX(q0, 4); MLA2_SBAR();
  MLA2_W2(4, l2, h2); MLA2_PM(8, l2, h2); MLA2_PR(11, l2, h2); MLA2_EX(q0, 6); MLA2_SBAR();
  MLA2_W2(4, l0, h0); MLA2_PM(9, l0, h0); MLA2_PR(12, l0, h0); MLA2_EX(q0, 8); MLA2_SBAR();
  MLA2_W2(4, l1, h1); MLA2_PM(10, l1, h1); MLA2_PR(13, l1, h1); MLA2_EX(q0, 10); MLA2_SBAR();
  MLA2_W2(4, l2, h2); MLA2_PM(11, l2, h2); MLA2_PR(14, l2, h2); MLA2_EX(q0, 12); MLA2_SBAR();
  MLA2_W2(4, l0, h0); MLA2_PM(12, l0, h0); MLA2_PR(15, l0, h0); MLA2_EX(q0, 14); MLA2_SBAR();
  MLA2_W2(4, l1, h1); MLA2_PM(13, l1, h1); MLA2_SBAR();
  MLA2_W2(2, l2, h2); MLA2_PM(14, l2, h2); MLA2_SBAR();
  MLA2_W2(0, l0, h0); MLA2_PM(15, l0, h0); MLA2_SBAR();
#undef MLA2_PK
#undef MLA2_PR
#undef MLA2_PM
#undef MLA2_MX
#undef MLA2_EX
}
__device__ __forceinline__ float bflo(unsigned u) { return __uint_as_float(u << 16); }
__device__ __forceinline__ float bfhi(unsigned u) { return __uint_as_float(u & 0xffff0000u); }

struct CvJob { const float* w1; const float* w3; const float* w2; unsigned char* d13; unsigned char* d2; float scale; int next, stride; };
constexpr int CV_G13 = 8 * (2048 / 16) * (7168 / 64), CV_G2 = 8 * (7168 / 16) * (2048 / 64), CV_NG = 2 * CV_G13 + CV_G2;
__device__ __forceinline__ void cv_issue(const CvJob& J, int lane, float (&r)[16], unsigned char*& dst) {
  const int g = J.next;
  if (g < 2 * CV_G13) { const int mm = g / CV_G13, rem = g - mm * CV_G13, e = rem / 14336, r2 = rem - e * 14336, nb = r2 >> 7, kb = r2 & 127;
    const float* src = (mm ? J.w3 : J.w1) + (size_t)e * 2048 * 7168 + (size_t)(kb * 16) * 7168 + nb * 64;
    const unsigned vo = (unsigned)lane * 4u;
#pragma unroll
    for (int i = 0; i < 16; ++i) asm volatile("global_load_dword %0, %1, %2" : "=&v"(r[i]) : "v"(vo), "s"(src + (size_t)i * 7168) : "memory");
    dst = J.d13 + (size_t)e * 14336 * 2048 + (size_t)(nb * 128 + mm * 16) * 2048 + kb * 16;
  } else { const int g2 = g - 2 * CV_G13, e = g2 / 14336, r2 = g2 - e * 14336, nb = r2 / 448, kb = r2 - nb * 448;
    const float* src = J.w2 + (size_t)e * 7168 * 2048 + (size_t)(kb * 16) * 2048 + nb * 64;
    const unsigned vo = (unsigned)lane * 4u;
#pragma unroll
    for (int i = 0; i < 16; ++i) asm volatile("global_load_dword %0, %1, %2" : "=&v"(r[i]) : "v"(vo), "s"(src + (size_t)i * 2048) : "memory");
    dst = J.d2 + (size_t)e * 2048 * 7168 + (size_t)(nb * 64) * 7168 + kb * 16; }
}
__device__ __forceinline__ unsigned cv_pk4(float a, float b, float c, float d, float s) {
  a = __builtin_amdgcn_fmed3f(a * s, -448.f, 448.f); b = __builtin_amdgcn_fmed3f(b * s, -448.f, 448.f); c = __builtin_amdgcn_fmed3f(c * s, -448.f, 448.f); d = __builtin_amdgcn_fmed3f(d * s, -448.f, 448.f);
  int w = 0; w = __builtin_amdgcn_cvt_pk_fp8_f32(a, b, w, false); w = __builtin_amdgcn_cvt_pk_fp8_f32(c, d, w, true); return (unsigned)w; }
__device__ __forceinline__ void cv_landed(float (&r)[16]) {
  asm volatile("" : "+v"(r[0]), "+v"(r[1]), "+v"(r[2]), "+v"(r[3]), "+v"(r[4]), "+v"(r[5]), "+v"(r[6]), "+v"(r[7]));
  asm volatile("" : "+v"(r[8]), "+v"(r[9]), "+v"(r[10]), "+v"(r[11]), "+v"(r[12]), "+v"(r[13]), "+v"(r[14]), "+v"(r[15]));
}
__device__ __forceinline__ void cv_finish(const CvJob& J, const float (&r)[16], unsigned char* dst, int lane) {
  dst += (J.next < 2 * CV_G13) ? (size_t)(((lane >> 4) * 32 + (lane & 15)) * 2048) : (size_t)(lane * 7168);
  u32x4 o; o[0] = cv_pk4(r[0], r[1], r[2], r[3], J.scale); o[1] = cv_pk4(r[4], r[5], r[6], r[7], J.scale); o[2] = cv_pk4(r[8], r[9], r[10], r[11], J.scale); o[3] = cv_pk4(r[12], r[13], r[14], r[15], J.scale);
  *reinterpret_cast<u32x4*>(dst) = o;
}
constexpr int OFF_BADFLAG = 163840 - 512 + 96;
template <bool FAST> __device__ __forceinline__ bool attn_unit(const unsigned short* __restrict__ Qg, const unsigned short* __restrict__ KVg, const unsigned short* __restrict__ KPg,
                                          const float* __restrict__ cosT, const float* __restrict__ sinT, unsigned short* __restrict__ Og, int h, int q0, int seq, char* lds, CvJob& J) {
  int tid_ = (int)threadIdx.x; asm volatile("" : "+v"(tid_));
  const int tid = tid_, wid = tid >> 6, lane = tid & 63, r32 = lane & 31, hi = lane >> 5;
  char* V_lds = lds + OFF_V; char* KN_lds = lds + OFF_KN;
  float* ws = (float*)(lds + OFF_WS) + wid * 64; float* li_l = ws; float* al_l = ws + 32;
  float m_reg = 0.f, l_reg = 0; f32x16 o[4] = {}; f32x16 Mt; bf16x8 qr[NQREG];
  char* Qs = lds + OFF_QS + wid * QS_WAVE;
  {
    const int qrow = q0 + wid * QBLK + r32;
    const unsigned short* Qw = Qg + (size_t)qrow * LDQ + h * 192 + hi * 8;
#pragma unroll
    for (int d0 = 0; d0 < 8; ++d0) { const bf16x8 v = *reinterpret_cast<const bf16x8*>(Qw + d0 * 16);
      if (d0 < NQREG) qr[d0 < NQREG ? d0 : 0] = v; else *reinterpret_cast<bf16x8*>(Qs + MLA2_QB(r32, (d0 - NQREG) * 2 + hi)) = v; }
#pragma unroll
    for (int ab = 0; ab < 2; ++ab) {
      const u32x4 x1 = *reinterpret_cast<const u32x4*>(Qw + 128 + ab * 16), x2 = *reinterpret_cast<const u32x4*>(Qw + 128 + 32 + ab * 16);
      const float* cp = cosT + (size_t)qrow * 32 + ab * 16 + hi * 8; const float* sp = sinT + (size_t)qrow * 32 + ab * 16 + hi * 8;
      const f32x4v c0 = *reinterpret_cast<const f32x4v*>(cp), c1 = *reinterpret_cast<const f32x4v*>(cp + 4), s0 = *reinterpret_cast<const f32x4v*>(sp), s1 = *reinterpret_cast<const f32x4v*>(sp + 4);
      u32x4 o1, o2;
#define MLA2_ROT(W, CL, CH, SL, SH) do { const float a0 = bflo(x1[W]), a1 = bfhi(x1[W]), b0 = bflo(x2[W]), b1 = bfhi(x2[W]); \
        o1[W] = cvtpk(a0 * (CL) - b0 * (SL), a1 * (CH) - b1 * (SH)); o2[W] = cvtpk(b0 * (CL) + a0 * (SL), b1 * (CH) + a1 * (SH)); } while (0)
      MLA2_ROT(0, c0[0], c0[1], s0[0], s0[1]); MLA2_ROT(1, c0[2], c0[3], s0[2], s0[3]); MLA2_ROT(2, c1[0], c1[1], s1[0], s1[1]); MLA2_ROT(3, c1[2], c1[3], s1[2], s1[3]);
#undef MLA2_ROT
      *reinterpret_cast<u32x4*>(Qs + MLA2_QB(r32, (8 + ab - NQREG) * 2 + hi)) = o1;
      *reinterpret_cast<u32x4*>(Qs + MLA2_QB(r32, (10 + ab - NQREG) * 2 + hi)) = o2;
    }
  }
  const int lo = r32 * 32 + ((hi ^ ((r32 >> 3) & 1)) << 4);
  const int qbase = (int)(uintptr_t)Qs + lo;
  int kb[4];
#pragma unroll
  for (int j = 0; j < 4; ++j) kb[j] = (int)(uintptr_t)KN_lds + r32 * 128 + (((j * 2 + hi) ^ ((r32 >> 1) & 7)) << 4);
  const int vb0 = (int)(uintptr_t)V_lds + v_rd_base(lane);
  const unsigned short* Kh = KVg + h * 256; const unsigned short* Vh = KVg + h * 256 + 128;
  const int wu = __builtin_amdgcn_readfirstlane(wid);
  unsigned kd_off[3], kd_lds[3]; const unsigned short* kd_base[3]; int kd_stride[3];
#pragma unroll
  for (int i = 0; i < 3; ++i) { const int pi = 3 * wu + i, img = pi >> 3, grp = pi & 7, row = 8 * grp + (lane >> 3), c8 = (lane & 7) ^ ((row >> 1) & 7);
    kd_lds[i] = (unsigned)(uintptr_t)KN_lds + (unsigned)pi * 1024u;
    if (img < 2) { kd_base[i] = Kh + img * 64; kd_stride[i] = LDKV; kd_off[i] = (unsigned)(row * LDKV + c8 * 8) * 2u; }
    else { kd_base[i] = KPg; kd_stride[i] = LDKP; kd_off[i] = (unsigned)(row * LDKP + c8 * 8) * 2u; } }
  const int vkk = wu * 8 + ((lane & 31) >> 2), vk = (vkk & ~0xC) | ((vkk & 4) << 1) | ((vkk & 8) >> 1);
  const unsigned v_off = (unsigned)(vk * LDKV + (lane >> 5) * 32 + (lane & 3) * 8) * 2u;
  const unsigned ldsV = (unsigned)(uintptr_t)V_lds + (unsigned)wu * 2048u;
#define MLA2_DMA_K(b, k0) do { _Pragma("unroll") for (int i_ = 0; i_ < 3; ++i_) pg8::glds16s(kd_base[i_] + (size_t)(k0) * kd_stride[i_], kd_off[i_], kd_lds[i_] + (b) * SHM_K); } while (0)
#define MLA2_DMA_V(b, k0) do { const unsigned short* vb_ = Vh + (size_t)(k0) * LDKV; \
    pg8::glds16s(vb_, v_off, ldsV + (b) * SHM_V); pg8::glds16s(vb_ + 64, v_off, ldsV + (b) * SHM_V + 1024u); } while (0)
#define MLA2_LANDED() do { asm volatile("s_waitcnt vmcnt(0)" ::: "memory"); __syncthreads(); } while (0)
#define MLA2_RESC(a) do { if (__any((a) < 1.f)) { if (hi == 0) al_l[r32] = (a); asm volatile("s_waitcnt lgkmcnt(0)" ::: "memory"); \
    _Pragma("unroll") for (int d = 0; d < 4; ++d) _Pragma("unroll") for (int r = 0; r < 16; ++r) o[d][r] *= al_l[crow(r, hi)]; } } while (0)
  f32x16 pA0, pA1, pB0, pB1; float mnA, alA, alB; bf16x8 pa0, pa1, pa2, pa3; const int NT = seq / KVBLK;
  MLA2_DMA_K(0, 0); MLA2_DMA_V(0, 0); MLA2_DMA_K(1, KVBLK);
  MLA2_LANDED();
  qkt<0>(pA0, pA1, kb, qbase, qr); partialSM0(pA0, pA1, m_reg, Mt); alA = 1.f;
  __syncthreads();
  if (2 < NT) MLA2_DMA_K(0, 2 * KVBLK); MLA2_DMA_V(1, KVBLK);
  for (int j = 1; j + 1 < NT; j += 2) {
    float cvr[16]; unsigned char* cvd = nullptr; const bool cv_on = J.next < CV_NG;
    if (cv_on) cv_issue(J, lane, cvr, cvd);
    MLA2_SBAR(); r1<1>(pB0, pB1, kb, qbase, qr, pA0, pA1, alA, l_reg, pa0, pa1, pa2, pa3, Mt);
    r2<0, FAST>(o, vb0, pa0, pa1, pa2, pa3, pB0, pB1, m_reg, alB, Mt);
    MLA2_RESC(alB); MLA2_LANDED();
    if (cv_on) cv_landed(cvr);
    if (j + 2 < NT) MLA2_DMA_K(1, (j + 2) * KVBLK); MLA2_DMA_V(0, (j + 1) * KVBLK);
    MLA2_SBAR(); r1<0>(pA0, pA1, kb, qbase, qr, pB0, pB1, alB, l_reg, pa0, pa1, pa2, pa3, Mt);
    r2<1, FAST>(o, vb0, pa0, pa1, pa2, pa3, pA0, pA1, m_reg, alA, Mt);
    if (cv_on) { cv_finish(J, cvr, cvd, lane); J.next += J.stride; }
    MLA2_RESC(alA); MLA2_LANDED();
    if (j + 3 < NT) MLA2_DMA_K(0, (j + 3) * KVBLK); MLA2_DMA_V(1, (j + 2) * KVBLK);
  }
  MLA2_SBAR(); r1<1>(pB0, pB1, kb, qbase, qr, pA0, pA1, alA, l_reg, pa0, pa1, pa2, pa3, Mt);
  r2<0, FAST>(o, vb0, pa0, pa1, pa2, pa3, pB0, pB1, m_reg, alB, Mt);
  MLA2_RESC(alB); MLA2_LANDED();
  finishSM(pB0, pB1, alB, l_reg, pa0, pa1, pa2, pa3); MLA2_SBAR();
  pv<1>(o, vb0, pa0, pa1, pa2, pa3);
  if (hi == 0) li_l[r32] = l_reg; asm volatile("s_waitcnt lgkmcnt(0)" ::: "memory");
  float rli[16];
#pragma unroll
  for (int r = 0; r < 16; ++r) rli[r] = __builtin_amdgcn_rcpf(li_l[crow(r, hi)]);
  unsigned short* Ow = Og + (size_t)(q0 + wid * QBLK) * LDO + h * 128;
#pragma unroll
  for (int r = 0; r < 16; ++r) { const int orow = crow(r, hi);
#pragma unroll
    for (int d0 = 0; d0 < 4; ++d0) { const float v = o[d0][r] * rli[r]; unsigned u = __float_as_uint(v); u = (u + 0x7fffu + ((u >> 16) & 1u)) >> 16; Ow[(size_t)orow * LDO + d0 * 32 + r32] = (unsigned short)u; } }
  bool ok = true;
  if constexpr (FAST) { volatile unsigned* flag = reinterpret_cast<volatile unsigned*>(lds + OFF_BADFLAG);
    const bool bad = !(l_reg < 1.0e30f);
    if (__any(bad) && lane == 0) *flag = 1u;
    __syncthreads(); ok = (__builtin_amdgcn_readfirstlane((int)*flag) == 0); }
  __syncthreads();
  return ok;
#undef MLA2_DMA_K
#undef MLA2_DMA_V
#undef MLA2_LANDED
#undef MLA2_RESC
}
}
constexpr int S = 16384, D = 2048;
constexpr int E_IN = 5120, CONVD = 1024, CONVW = 31, DIL_H = 16;
constexpr int FD = 5632;
constexpr int O_INP = 1280;
constexpr int QL = 512, KVL = 128, KVLP = 128, S5D = 512;
constexpr int NQ = 2304, NKV = 3072;
constexpr int NE = 8, FE = 7168;
constexpr int MAXROWS = 34816, MAXTILES = 136;
constexpr int S5_CL = 128, S5_NCH = S / S5_CL;
constexpr int ADA_KS = 16;
constexpr float MOE_WSCALE = 1024.f, MOE_HSCALE = 16.f, MOE_ASCALE = 8.f, MOE_YSCALE = 64.f;

constexpr size_t MiB = 1u << 20;
constexpr size_t WS_CTL = 0, CTL_ZERO_BYTES = 1 * MiB;
constexpr size_t WS_MODP = 1 * MiB;
constexpr size_t WS_COS = 3 * MiB, WS_SIN = 5 * MiB;
constexpr size_t WS_S5P = 7 * MiB;
constexpr size_t WS_S5E = 384 * MiB;
constexpr size_t WS_ROUTE = 10 * MiB;
constexpr size_t RT_TOKE = 0, RT_TOKG = 128 * 1024, RT_POS = 256 * 1024, RT_ROWIDX = 384 * 1024, RT_TEXP = 528 * 1024, RT_NTILE = 529 * 1024;
constexpr size_t WS_YF = 11 * MiB;
constexpr size_t WS_WB = 44 * MiB;
constexpr size_t WB_EIN = WS_WB, WB_EOUT = WS_WB + 20 * MiB, WB_EF13 = WS_WB + 28 * MiB, WB_EF2 = WS_WB + 72 * MiB, WB_OIN = WS_WB + 94 * MiB,
                 WB_UQ = WS_WB + 99 * MiB, WB_UKV = WS_WB + 102 * MiB, WB_GLU = WS_WB + 104 * MiB, WB_OOUT = WS_WB + 105 * MiB, WB_M13 = WS_WB + 113 * MiB, WB_M2 = WS_WB + 561 * MiB;
constexpr size_t WS_HB = 830 * MiB;
constexpr size_t WS_Y = 894 * MiB;
constexpr size_t WS_XB = 958 * MiB;
constexpr size_t WS_R = 1022 * MiB;
constexpr size_t R_Z = WS_R, R_MIX = WS_R + 160 * MiB, R_ACT = WS_R + 224 * MiB, R_PO = WS_R + 400 * MiB, R_PML = WS_R + 496 * MiB;
constexpr size_t R_Z1 = WS_R, R_CQN = WS_R + 40 * MiB, R_CKVN = WS_R + 56 * MiB, R_KPE = WS_R + 64 * MiB, R_Q = WS_R + 66 * MiB, R_KV = WS_R + 138 * MiB,
                 R_MIX2 = WS_R + 234 * MiB, R_YG = WS_R + 298 * MiB;
constexpr size_t R_YT = WS_R + 240 * MiB;
constexpr size_t R_ACTS = WS_R, R_HS8 = WS_R + 240 * MiB, R_YS = WS_R + 476 * MiB;
constexpr size_t WS_END = WS_R + 612 * MiB;
constexpr int CW_BAR = 4096;
constexpr int CW_TBCNT = 16384;
constexpr int CW_GLUCTR = 20480;

constexpr int LDS_BYTES = 163840;
constexpr int COND_OFF = 133120;
constexpr int MISC_OFF = LDS_BYTES - 512;
constexpr int NWAVES = 8;

#define GAS __attribute__((address_space(1)))
#define LAS __attribute__((address_space(3)))
typedef unsigned short bf16;
typedef unsigned v4u __attribute__((ext_vector_type(4)));
typedef unsigned v2u __attribute__((ext_vector_type(2)));
typedef float f32x4 __attribute__((ext_vector_type(4)));
typedef float f32x2 __attribute__((ext_vector_type(2)));
typedef short bf16x8 __attribute__((ext_vector_type(8)));
#define LDS_WAIT() asm volatile("s_waitcnt lgkmcnt(0)" ::: "memory")
#define VM_WAIT() asm volatile("s_waitcnt vmcnt(0)" ::: "memory")
__device__ __forceinline__ unsigned f2bf(float f) { unsigned u = __builtin_bit_cast(unsigned, f); return (u + 0x7fffu + ((u >> 16) & 1u)) >> 16; }
__device__ __forceinline__ unsigned pk2(float lo, float hi) { return f2bf(lo) | (f2bf(hi) << 16); }
__device__ __forceinline__ float bflo(unsigned u) { return __uint_as_float(u << 16); }
__device__ __forceinline__ float bfhi(unsigned u) { return __uint_as_float(u & 0xffff0000u); }
__device__ __forceinline__ float bf1(unsigned short b) { return __uint_as_float(((unsigned)b) << 16); }
__device__ __forceinline__ float fexp(float x) { return __builtin_amdgcn_exp2f(1.4426950408889634f * x); }
__device__ __forceinline__ float fsilu(float v) { return v * __builtin_amdgcn_rcpf(1.0f + fexp(-v)); }
__device__ __forceinline__ float fsigmoid(float v) { return __builtin_amdgcn_rcpf(1.0f + fexp(-v)); }
__device__ __forceinline__ float wave_sum(float v) {
#define WS_DPP(X, CTRL, RMASK) __int_as_float(__builtin_amdgcn_update_dpp(0, __float_as_int(X), CTRL, RMASK, 0xF, false))
    v += WS_DPP(v, 0xB1, 0xF);
    v += WS_DPP(v, 0x4E, 0xF);
    v += WS_DPP(v, 0x141, 0xF);
    v += WS_DPP(v, 0x140, 0xF);
    v += WS_DPP(v, 0x142, 0xA);
    v += WS_DPP(v, 0x143, 0xC);
#undef WS_DPP
    return __int_as_float(__builtin_amdgcn_readlane(__float_as_int(v), 63));
}
__device__ __forceinline__ void sincos_rev(double rev, double& s, double& c) {
    rev -= __builtin_floor(rev);
    const double q4 = __builtin_floor(rev * 4.0 + 0.5);
    const double r = rev - q4 * 0.25;
    const double th = r * 6.283185307179586476925;
    const double t2 = th * th;
    double sp = 1.0 / 1307674368000.0; sp = sp * (-t2) + 1.0 / 6227020800.0; sp = sp * (-t2) + 1.0 / 39916800.0; sp = sp * (-t2) + 1.0 / 362880.0; sp = sp * (-t2) + 1.0 / 5040.0; sp = sp * (-t2) + 1.0 / 120.0; sp = sp * (-t2) + 1.0 / 6.0; sp = sp * (-t2) + 1.0;
    const double sn = sp * th;
    double cp = 1.0 / 87178291200.0; cp = cp * (-t2) + 1.0 / 479001600.0; cp = cp * (-t2) + 1.0 / 3628800.0; cp = cp * (-t2) + 1.0 / 40320.0; cp = cp * (-t2) + 1.0 / 720.0; cp = cp * (-t2) + 1.0 / 24.0; cp = cp * (-t2) + 0.5; cp = cp * (-t2) + 1.0;
    const int q = ((int)q4) & 3;
    s = (q == 0) ? sn : (q == 1) ? cp : (q == 2) ? -sn : -cp;
    c = (q == 0) ? cp : (q == 1) ? -sn : (q == 2) ? -cp : sn;
}
__device__ __forceinline__ double exp_small(double x) {
    double p = 1.0 / 3628800.0; p = p * x + 1.0 / 362880.0; p = p * x + 1.0 / 40320.0; p = p * x + 1.0 / 5040.0; p = p * x + 1.0 / 720.0; p = p * x + 1.0 / 120.0; p = p * x + 1.0 / 24.0; p = p * x + 1.0 / 6.0; p = p * x + 0.5; p = p * x + 1.0; p = p * x + 1.0;
    return p;
}

#define XB_TMO      128
#define XB_XCNT(j)  (256  + 64 * (j))
#define XB_XSUB(j)  (1280 + 64 * (j))
#define XB_XGEN(j)  (2304 + 64 * (j))
#define XB_TOP      3328
#define XB_TOPGEN   3392
#define XCD_BAR_WORDS 3456
#define XB_SPIN_CAP (1u << 20)
__device__ __forceinline__ unsigned xb_ld(unsigned* p)              { return __hip_atomic_load(p, __ATOMIC_RELAXED, __HIP_MEMORY_SCOPE_AGENT); }
__device__ __forceinline__ unsigned xb_add(unsigned* p, unsigned v) { return __hip_atomic_fetch_add(p, v, __ATOMIC_RELAXED, __HIP_MEMORY_SCOPE_AGENT); }
__device__ __forceinline__ unsigned xb_xcc_id() { return (unsigned)__builtin_amdgcn_s_getreg((3 << 11) | 20) & 0xFu; }
#define XB_SPIN(cond, bar) do { unsigned _sp = 0; while (cond) { __builtin_amdgcn_s_sleep(1); \
    if ((++_sp & 255u) == 0u) { if (xb_ld(&(bar)[XB_TMO])) break; if (_sp > XB_SPIN_CAP) { atomicAdd(&(bar)[XB_TMO], 1u); break; } } } } while (0)
struct XcdBarrier { unsigned* bar; unsigned x; volatile LAS unsigned* st; };
__device__ __forceinline__ XcdBarrier xcd_barrier_post(unsigned* bar, volatile LAS unsigned* st) {
    XcdBarrier b; b.bar = bar; b.x = xb_xcc_id(); b.st = st;
    if (threadIdx.x == 0) (void)xb_add(&bar[XB_XCNT(b.x)], 1u);
    return b;
}
__device__ __forceinline__ void xcd_barrier_complete(unsigned* bar, unsigned x, unsigned& nloc, unsigned& nx) {
    const unsigned G = gridDim.x * gridDim.y * gridDim.z;
    unsigned sum, cnt, mine, sp = 0u;
    for (;;) {
        sum = 0u; cnt = 0u; mine = 0u;
#pragma unroll
        for (unsigned j = 0; j < 16; ++j) { const unsigned c = xb_ld(&bar[XB_XCNT(j)]); sum += c; cnt += (c > 0u) ? 1u : 0u; mine = (j == x) ? c : mine; }
        if (sum == G) break;
        __builtin_amdgcn_s_sleep(1);
        if ((++sp & 255u) == 0u) { if (xb_ld(&bar[XB_TMO])) break; if (sp > XB_SPIN_CAP) { atomicAdd(&bar[XB_TMO], 1u); break; } }
    }
    nloc = mine > 0u ? mine : 1u; nx = cnt > 0u ? cnt : 1u;
}
__device__ __forceinline__ void xcd_barrier(const XcdBarrier& b) {
    asm volatile("s_waitcnt vmcnt(0)" ::: "memory");
    __syncthreads();
    if (threadIdx.x == 0) {
        unsigned* bar = b.bar;
        __builtin_amdgcn_s_waitcnt(0);
        unsigned nloc = b.st[0], nx = b.st[1];
        if (nloc == 0u) { xcd_barrier_complete(bar, b.x, nloc, nx); b.st[0] = nloc; b.st[1] = nx; }
        const unsigned old = xb_add(&bar[XB_XSUB(b.x)], 1u);
        const unsigned gen = old / nloc;
        if (old + 1u == (gen + 1u) * nloc) {
            __builtin_amdgcn_fence(__ATOMIC_RELEASE, "agent");
            asm volatile("s_waitcnt vmcnt(0)" ::: "memory");
            const unsigned og = xb_add(&bar[XB_TOP], 1u);
            const unsigned tg = og / nx;
            if (og + 1u == (tg + 1u) * nx) xb_add(&bar[XB_TOPGEN], 1u);
            else XB_SPIN(xb_ld(&bar[XB_TOPGEN]) == tg, bar);
            __builtin_amdgcn_fence(__ATOMIC_ACQUIRE, "agent");
            xb_add(&bar[XB_XGEN(b.x)], 1u);
            asm volatile("s_waitcnt vmcnt(0)" ::: "memory");
        } else {
            XB_SPIN(xb_ld(&bar[XB_XGEN(b.x)]) == gen, bar);
            __builtin_amdgcn_fence(__ATOMIC_ACQUIRE, "agent");
            asm volatile("s_waitcnt vmcnt(0)" ::: "memory");
        }
    }
    __syncthreads();
}

struct Args { const float* in[34]; float* out; unsigned char* ws; int ph_lo, ph_hi; };
enum { I_X = 0, I_C, I_T5, I_NG, I_ADAW, I_ADAB, I_EWIN, I_ECW, I_ECB, I_ECG, I_ECLB, I_EWOUT, I_EF1, I_EF3, I_EF2, I_OWIN, I_QNG, I_UQ, I_KVNG, I_UKV,
       I_SARE, I_SAIM, I_SLDT, I_SBRE, I_SBIM, I_SCRE, I_SCIM, I_SD, I_SGLU, I_OWOUT, I_RW, I_M1, I_M3, I_M2 };
struct Frame {
    LAS unsigned char* lds;
    const Args* a;
    unsigned char* ws;
    int tid, lane, wave, vcu, G, gw, NGW;
};

__device__ __forceinline__ void cvt_tile(const float* __restrict__ W, int K, int N, bf16* __restrict__ Wt, int ldk, int grp, int mul, int off, int item, LAS float* scr, int lane) {
    const int nblk = N >> 6, kb = item / nblk, nb = item - kb * nblk, k0 = kb << 6, n0 = nb << 6;
    const int lc = (lane & 15) * 4, lr = lane >> 4;
    f32x4 v[16];
#pragma unroll
    for (int i = 0; i < 16; ++i) v[i] = *(const f32x4*)(W + (size_t)(k0 + lr + 4 * i) * N + n0 + lc);
#pragma unroll
    for (int i = 0; i < 16; ++i) { LAS float* d = scr + (lr + 4 * i) * 65 + lc; d[0] = v[i][0]; d[1] = v[i][1]; d[2] = v[i][2]; d[3] = v[i][3]; }
    LDS_WAIT();
    const int c = lane & 7;
#pragma unroll
    for (int j = 0; j < 8; ++j) { const int n = (lane >> 3) + 8 * j; const LAS float* s = scr + (8 * c) * 65 + n;
        v4u o; o.x = pk2(s[0 * 65], s[1 * 65]); o.y = pk2(s[2 * 65], s[3 * 65]); o.z = pk2(s[4 * 65], s[5 * 65]); o.w = pk2(s[6 * 65], s[7 * 65]);
        const int nn = n0 + n, drow = (nn / grp) * (grp * mul) + off + (nn % grp);
        *(v4u*)(Wt + (size_t)drow * ldk + k0 + 8 * c) = o; }
    LDS_WAIT();
}

__device__ __forceinline__ unsigned pk4_fp8(float a, float b, float c, float d) {
    a = __builtin_fminf(__builtin_fmaxf(a, -448.f), 448.f); b = __builtin_fminf(__builtin_fmaxf(b, -448.f), 448.f); c = __builtin_fminf(__builtin_fmaxf(c, -448.f), 448.f); d = __builtin_fminf(__builtin_fmaxf(d, -448.f), 448.f);
    int w = 0; w = __builtin_amdgcn_cvt_pk_fp8_f32(a, b, w, false); w = __builtin_amdgcn_cvt_pk_fp8_f32(c, d, w, true); return (unsigned)w; }
__device__ __forceinline__ void cvt_tile8(const float* __restrict__ W, int K, int N, unsigned char* __restrict__ Wt, int ldk, int grp, int mul, int off, float scale, int item, LAS float* scr, int lane) {
    const int nblk = N >> 6, kb = item / nblk, nb = item - kb * nblk, k0 = kb << 6, n0 = nb << 6;
    const int lc = (lane & 15) * 4, lr = lane >> 4;
    f32x4 v[16];
#pragma unroll
    for (int i = 0; i < 16; ++i) v[i] = *(const f32x4*)(W + (size_t)(k0 + lr + 4 * i) * N + n0 + lc);
#pragma unroll
    for (int i = 0; i < 16; ++i) { LAS float* d = scr + (lr + 4 * i) * 65 + lc; d[0] = v[i][0] * scale; d[1] = v[i][1] * scale; d[2] = v[i][2] * scale; d[3] = v[i][3] * scale; }
    LDS_WAIT();
    const int c = lane & 3;
#pragma unroll
    for (int j = 0; j < 4; ++j) { const int n = (lane >> 2) + 16 * j; const LAS float* s = scr + (16 * c) * 65 + n;
        v4u o; o.x = pk4_fp8(s[0 * 65], s[1 * 65], s[2 * 65], s[3 * 65]); o.y = pk4_fp8(s[4 * 65], s[5 * 65], s[6 * 65], s[7 * 65]);
        o.z = pk4_fp8(s[8 * 65], s[9 * 65], s[10 * 65], s[11 * 65]); o.w = pk4_fp8(s[12 * 65], s[13 * 65], s[14 * 65], s[15 * 65]);
        const int nn = n0 + n, drow = (nn / grp) * (grp * mul) + off + (nn % grp);
        *(v4u*)(Wt + (size_t)drow * ldk + k0 + 16 * c) = o; }
    LDS_WAIT();
}

__device__ __forceinline__ void p0_prologue(Frame& F) {
    const Args& A = *F.a;
    LAS float* condL = (LAS float*)(F.lds + COND_OFF);
    for (int i = F.tid; i < D; i += NWAVES * 64) condL[i] = fsilu(A.in[I_C][i]);
    __syncthreads();
    LAS float* scr = (LAS float*)(F.lds + F.wave * 16640);
    const int lane = F.lane;
    constexpr int N_ADA = 96 * ADA_KS, N_ROPE = S * 32 / 64, N_S5 = 64, N_Z1 = 256, N_Z2 = 0;
#define CVT_M(SRC, KK, NN, DSTOFF, LDK, GRP, MUL, OFF, NEXP) { constexpr int per = ((KK) / 64) * ((NN) / 64); constexpr int tot = per * (NEXP); \
        if (r < tot) { const int e = r / per, t = r - e * per; cvt_tile(A.in[SRC] + (size_t)e * (KK) * (NN), KK, NN, (bf16*)(F.ws + (DSTOFF)) + (size_t)e * ((NN) * (MUL)) * (LDK), LDK, GRP, MUL, OFF, t, scr, lane); continue; } r -= tot; }
#define CVT_M8(SRC, KK, NN, DSTOFF, LDK, GRP, MUL, OFF, NEXP) { constexpr int per = ((KK) / 64) * ((NN) / 64); constexpr int tot = per * (NEXP); \
        if (r < tot) { const int e = r / per, t = r - e * per; cvt_tile8(A.in[SRC] + (size_t)e * (KK) * (NN), KK, NN, (unsigned char*)(F.ws + (DSTOFF)) + (size_t)e * ((NN) * (MUL)) * (LDK), LDK, GRP, MUL, OFF, MOE_WSCALE, t, scr, lane); continue; } r -= tot; }
    constexpr int N_CVT = (32 * 80) + (32 * 32) + 2 * (32 * 88) + (88 * 32) + (32 * 19) + (8 * 36) + (2 * 48) + (8 * 8) + (32 * 32);
    constexpr int N_ITEMS = N_CVT + N_ADA + N_ROPE + N_S5 + N_Z1 + N_Z2;
    LAS unsigned* p0ctr = (LAS unsigned*)(F.lds + MISC_OFF) + 16;
    int it, nx = 0;
#define P0_GRAB(dst) do { unsigned v_ = 0u; if (lane == 0) v_ = __hip_atomic_fetch_add(p0ctr, 1u, __ATOMIC_RELAXED, __HIP_MEMORY_SCOPE_WORKGROUP); dst = (int)__builtin_amdgcn_readfirstlane(v_) * F.G + F.vcu; } while (0)
    P0_GRAB(it);
    for (; it < N_ITEMS; it = nx) {
        P0_GRAB(nx);
        int r = it;
        if (r < N_ADA) {
            const int chunk = r % 96, ks = r / 96, l = chunk / 48, n0 = (chunk % 48) * 256;
            const float* w = A.in[I_ADAW] + (size_t)l * D * 12288 + (size_t)(ks * 128) * 12288 + n0 + 4 * lane;
            f32x4 acc = {0.f, 0.f, 0.f, 0.f};
#pragma unroll 16
            for (int k = 0; k < 128; ++k) { const f32x4 v = *(const f32x4*)(w + (size_t)k * 12288); const float cv = condL[ks * 128 + k]; acc += v * cv; }
            *(f32x4*)((float*)(F.ws + WS_MODP) + (size_t)ks * 24576 + l * 12288 + n0 + 4 * lane) = acc;
            continue; }
        r -= N_ADA;
        CVT_M(I_EWIN, 2048, 5120, WB_EIN, 2048, 64, 1, 0, 1)
        CVT_M(I_EWOUT, 2048, 2048, WB_EOUT, 2048, 64, 1, 0, 1)
        CVT_M(I_EF1, 2048, 5632, WB_EF13, 2048, 16, 2, 0, 1)
        CVT_M(I_EF3, 2048, 5632, WB_EF13, 2048, 16, 2, 16, 1)
        CVT_M(I_EF2, 5632, 2048, WB_EF2, 5632, 64, 1, 0, 1)
        CVT_M(I_OWIN, 2048, 1216, WB_OIN, 2048, 64, 1, 0, 1)
        CVT_M(I_UQ, 512, 2304, WB_UQ, 512, 64, 1, 0, 1)
        CVT_M(I_UKV, 128, 3072, WB_UKV, KVLP, 64, 1, 0, 1)
        CVT_M(I_SGLU, 512, 512, WB_GLU, 512, 64, 1, 0, 1)
        CVT_M(I_OWOUT, 2048, 2048, WB_OOUT, 2048, 64, 1, 0, 1)
        if (r < N_ROPE) {
            const int idx = r * 64 + lane, pos = idx >> 5, j = idx & 31;
            double f = 1.0; for (int q = 0; q < j; ++q) f *= 0.74989420933245582730;
            const float ang = (float)pos * (float)f;
            double sn, cs; sincos_rev((double)ang * 0.15915494309189533577, sn, cs);
            ((float*)(F.ws + WS_COS))[idx] = (float)cs; ((float*)(F.ws + WS_SIN))[idx] = (float)sn;
            continue; }
        r -= N_ROPE;
        if (r < N_S5) {
            const int p = lane;
            const double are = (double)A.in[I_SARE][r * 64 + p], aim = (double)A.in[I_SAIM][r * 64 + p];
            const double dt = (double)fexp(A.in[I_SLDT][r]);
            const double er = exp_small(are * dt); double sn, cs; sincos_rev(aim * dt * 0.15915494309189533577, sn, cs);
            const double abr = er * cs, abi = er * sn;
            double eL = er; for (int q = 1; q < S5_CL; q <<= 1) eL *= eL;
            double snL, csL; sincos_rev(aim * dt * (double)S5_CL * 0.15915494309189533577, snL, csL);
            const double nr = abr - 1.0, ni = abi, den = are * are + aim * aim;
            const double qr = (nr * are + ni * aim) / den, qi = (ni * are - nr * aim) / den;
            float* o = (float*)(F.ws + WS_S5P) + (size_t)r * 36 * 64;
            o[0 * 64 + p] = (float)abr; o[1 * 64 + p] = (float)abi; o[2 * 64 + p] = (float)(eL * csL); o[3 * 64 + p] = (float)(eL * snL);
#pragma unroll
            for (int c = 0; c < 16; ++c) { const double br = (double)A.in[I_SBRE][(size_t)(r * 64 + p) * 16 + c], bi = (double)A.in[I_SBIM][(size_t)(r * 64 + p) * 16 + c];
                o[(4 + c) * 64 + p] = (float)(qr * br - qi * bi); o[(20 + c) * 64 + p] = (float)(qr * bi + qi * br); }
            continue; }
        r -= N_S5;
        if (r < N_Z1) { ((v4u*)(F.ws + WB_OIN + (size_t)1216 * 2048 * 2))[r * 64 + lane] = (v4u){0u, 0u, 0u, 0u}; continue; }
        r -= N_Z1;
        (void)r;
    }
#undef CVT_M
#undef CVT_M8
#undef P0_GRAB
}

__device__ __forceinline__ float mod_val(Frame& F, int L, int chunk, int col) {
    const Args& A = *F.a; const int o = L * 12288 + chunk * 2048 + col;
    float s = A.in[I_ADAB][o]; const float* mp = (const float*)(F.ws + WS_MODP) + o;
#pragma unroll
    for (int ks = 0; ks < ADA_KS; ++ks) s += mp[(size_t)ks * 24576];
    return s;
}
__device__ __forceinline__ void moe_tail_plan(int nt, int& nfull, int& s) {
    nfull = nt & ~31; const int tl = nt - nfull;
    s = (tl == 0 || tl > 16) ? 1 : (tl <= 4 ? 7 : (tl <= 8 ? 4 : 2));
    if (s == 1) nfull = nt;
}
template <bool RES, bool HOUT, bool ROUTE, bool GATHER, bool XIB = false, bool XOB = false>
__device__ __forceinline__ void resnorm_phase(Frame& F, const void* xin_, void* xout_, const bf16* y, int Lr, int gchunk, int gi1, int Lh, int shchunk, int gi2) {
    const Args& A = *F.a;
    LAS float* A1 = (LAS float*)F.lds; LAS float* A2 = A1 + D; LAS float* B2 = A2 + D; LAS float* RT = B2 + D;
    for (int col = F.tid; col < D; col += NWAVES * 64) {
        if (RES) A1[col] = mod_val(F, Lr, gchunk, col) * A.in[I_NG][(Lr * 4 + gi1) * D + col];
        if (HOUT) { A2[col] = A.in[I_NG][(Lh * 4 + gi2) * D + col] * (1.0f + mod_val(F, Lh, shchunk + 1, col)); B2[col] = mod_val(F, Lh, shchunk, col); }
    }
    if (ROUTE) for (int i = F.tid; i < D * NE; i += NWAVES * 64) RT[(i & 7) * D + (i >> 3)] = A.in[I_RW][i];
    __syncthreads();
    const int lane = F.lane;
    bf16* hb = (bf16*)(F.ws + WS_HB);
    for (int row = F.gw; row < S; row += F.NGW) {
        f32x4 xv[8];
        if (XIB) { const bf16* xin = (const bf16*)xin_;
#pragma unroll
            for (int j = 0; j < 8; ++j) { const v2u a = *(const v2u*)(xin + (size_t)row * D + 4 * lane + 256 * j); xv[j] = (f32x4){bflo(a.x), bfhi(a.x), bflo(a.y), bfhi(a.y)}; }
        } else { const float* xin = (const float*)xin_;
#pragma unroll
            for (int j = 0; j < 8; ++j) xv[j] = *(const f32x4*)(xin + (size_t)row * D + 4 * lane + 256 * j); }
        if (RES) {
            f32x4 yv[8];
            if (GATHER) {
                const int* pos = (const int*)(F.ws + WS_ROUTE + RT_POS); const float* tg = (const float*)(F.ws + WS_ROUTE + RT_TOKG);
                const unsigned char* ys = (const unsigned char*)(F.ws + R_YS); const bf16* yt = (const bf16*)(F.ws + R_YT);
                int nfull, sp; const int ntl = __builtin_amdgcn_readfirstlane(*(const int*)(F.ws + WS_ROUTE + RT_NTILE)); moe_tail_plan(ntl, nfull, sp);
                const int ts = nfull * 256; const size_t sstr = (size_t)(ntl - nfull) * 256 * D;
                const int p0 = __builtin_amdgcn_readfirstlane(pos[2 * row]), p1 = __builtin_amdgcn_readfirstlane(pos[2 * row + 1]);
                if (p0 < ts && p1 < ts) {
                    const float g0 = tg[2 * row] * (1.0f / MOE_YSCALE), g1 = tg[2 * row + 1] * (1.0f / MOE_YSCALE);
#pragma unroll
                    for (int j = 0; j < 8; ++j) { const unsigned a = *(const unsigned*)(ys + (size_t)p0 * D + 4 * lane + 256 * j), b = *(const unsigned*)(ys + (size_t)p1 * D + 4 * lane + 256 * j);
                        const f32x2 a0 = __builtin_amdgcn_cvt_pk_f32_fp8((int)a, false), a1 = __builtin_amdgcn_cvt_pk_f32_fp8((int)a, true), b0 = __builtin_amdgcn_cvt_pk_f32_fp8((int)b, false), b1 = __builtin_amdgcn_cvt_pk_f32_fp8((int)b, true);
                        yv[j] = (f32x4){g0 * a0[0] + g1 * b0[0], g0 * a0[1] + g1 * b0[1], g0 * a1[0] + g1 * b1[0], g0 * a1[1] + g1 * b1[1]}; }
                } else {
#pragma unroll
                for (int j = 0; j < 8; ++j) yv[j] = (f32x4){0.f, 0.f, 0.f, 0.f};
#pragma unroll
                for (int hf = 0; hf < 2; ++hf) { const int p = hf ? p1 : p0; const float g = tg[2 * row + hf];
                    if (p >= ts) {
                        const bf16* bp = yt + (size_t)(p - ts) * D + 4 * lane;
                        f32x4 t[8];
#pragma unroll
                        for (int j = 0; j < 8; ++j) t[j] = (f32x4){0.f, 0.f, 0.f, 0.f};
#pragma nounroll
                        for (int ks = 0; ks < sp; ++ks) {
#pragma unroll
                            for (int j = 0; j < 8; ++j) { const v2u a = *(const v2u*)(bp + (size_t)ks * sstr + 256 * j); t[j] += (f32x4){bflo(a.x), bfhi(a.x), bflo(a.y), bfhi(a.y)}; } }
#pragma unroll
                        for (int j = 0; j < 8; ++j) yv[j] += t[j] * g;
                    } else {
#pragma unroll
                        for (int j = 0; j < 8; ++j) { const unsigned a = *(const unsigned*)(ys + (size_t)p * D + 4 * lane + 256 * j); const float gs = g * (1.0f / MOE_YSCALE);
                            const f32x2 a0 = __builtin_amdgcn_cvt_pk_f32_fp8((int)a, false), a1 = __builtin_amdgcn_cvt_pk_f32_fp8((int)a, true);
                            yv[j] += (f32x4){gs * a0[0], gs * a0[1], gs * a1[0], gs * a1[1]}; }
                    } }
                }
            } else {
#pragma unroll
                for (int j = 0; j < 8; ++j) { const v2u a = *(const v2u*)(y + (size_t)row * D + 4 * lane + 256 * j); yv[j] = (f32x4){bflo(a.x), bfhi(a.x), bflo(a.y), bfhi(a.y)}; }
            }
            float ss = 0.f;
#pragma unroll
            for (int j = 0; j < 8; ++j) ss += (yv[j][0] * yv[j][0] + yv[j][1] * yv[j][1]) + (yv[j][2] * yv[j][2] + yv[j][3] * yv[j][3]);
            const float rstd = 1.0f / sqrtf(wave_sum(ss) * (1.0f / D) + 1e-6f);
#pragma unroll
            for (int j = 0; j < 8; ++j) { const f32x4 a1 = *(const LAS f32x4*)(A1 + 4 * lane + 256 * j); xv[j] += a1 * (yv[j] * rstd);
                if (XOB) { v2u w; w.x = pk2(xv[j][0], xv[j][1]); w.y = pk2(xv[j][2], xv[j][3]); *(v2u*)((bf16*)xout_ + (size_t)row * D + 4 * lane + 256 * j) = w; }
                else *(f32x4*)((float*)xout_ + (size_t)row * D + 4 * lane + 256 * j) = xv[j]; }
        }
        if (HOUT) {
            float ss = 0.f;
#pragma unroll
            for (int j = 0; j < 8; ++j) ss += (xv[j][0] * xv[j][0] + xv[j][1] * xv[j][1]) + (xv[j][2] * xv[j][2] + xv[j][3] * xv[j][3]);
            const float rstd = 1.0f / sqrtf(wave_sum(ss) * (1.0f / D) + 1e-6f);
#pragma unroll
            for (int j = 0; j < 8; ++j) { const f32x4 a2 = *(const LAS f32x4*)(A2 + 4 * lane + 256 * j), b2 = *(const LAS f32x4*)(B2 + 4 * lane + 256 * j);
                xv[j] = (xv[j] * rstd) * a2 + b2;
                if (ROUTE) { *(unsigned*)((unsigned char*)hb + (size_t)row * D + 4 * lane + 256 * j) = pk4_fp8(xv[j][0] * MOE_HSCALE, xv[j][1] * MOE_HSCALE, xv[j][2] * MOE_HSCALE, xv[j][3] * MOE_HSCALE); }
                else { v2u w; w.x = pk2(xv[j][0], xv[j][1]); w.y = pk2(xv[j][2], xv[j][3]);
                *(v2u*)(hb + (size_t)row * D + 4 * lane + 256 * j) = w; } }
            if (ROUTE) {
                int i0 = -1, i1 = -1; float v0 = -3.0e38f, v1 = -3.0e38f;
#pragma nounroll
                for (int e = 0; e < NE; ++e) { float s = 0.f;
#pragma unroll
                    for (int j = 0; j < 8; ++j) { const f32x4 w = *(const LAS f32x4*)(RT + e * D + 4 * lane + 256 * j); s += (xv[j][0] * w[0] + xv[j][1] * w[1]) + (xv[j][2] * w[2] + xv[j][3] * w[3]); }
                    s = wave_sum(s);
                    if (s > v0) { v1 = v0; i1 = i0; v0 = s; i0 = e; } else if (s > v1) { v1 = s; i1 = e; } }
                const float g0 = 1.0f / (1.0f + fexp(v1 - v0)), g1 = 1.0f - g0;
                if (lane == 0) {
                    int* te = (int*)(F.ws + WS_ROUTE + RT_TOKE); float* tg = (float*)(F.ws + WS_ROUTE + RT_TOKG);
                    te[2 * row] = i0; te[2 * row + 1] = i1; tg[2 * row] = g0; tg[2 * row + 1] = g1;
                    unsigned* cnt = (unsigned*)(F.ws + WS_CTL) + CW_TBCNT + (row >> 6) * NE;
                    atomicAdd(cnt + i0, 1u); atomicAdd(cnt + i1, 1u);
                }
            }
        }
    }
}

__device__ __forceinline__ void moe_slots_phase(Frame& F) {
    LAS int* cntL = (LAS int*)F.lds;
    LAS int* tot = cntL + 2048;
    LAS int* base = tot + 8; LAS int* tbase = base + 8; LAS int* texpL = tbase + 16;
    const unsigned* cnt = (const unsigned*)(F.ws + WS_CTL) + CW_TBCNT;
    for (int i = F.tid; i < 2048; i += NWAVES * 64) cntL[i] = (int)cnt[i];
    __syncthreads();
    if (F.tid < NE) { int s = 0; for (int b = 0; b < 256; ++b) s += cntL[b * 8 + F.tid]; tot[F.tid] = s; }
    __syncthreads();
    if (F.tid == 0) { int b = 0, tb = 0; for (int e = 0; e < NE; ++e) { base[e] = b; tbase[e] = tb; const int nt = (tot[e] + 255) >> 8; for (int q = 0; q < nt; ++q) texpL[tb + q] = e; tb += nt; b += nt * 256; } tbase[NE] = tb; }
    __syncthreads();
    const int NT = tbase[NE];
    int* rowidx = (int*)(F.ws + WS_ROUTE + RT_ROWIDX); int* pos = (int*)(F.ws + WS_ROUTE + RT_POS);
    const int* te = (const int*)(F.ws + WS_ROUTE + RT_TOKE);
    if (blockIdx.x == 0) { int* texp = (int*)(F.ws + WS_ROUTE + RT_TEXP); for (int i = F.tid; i < NT; i += NWAVES * 64) texp[i] = texpL[i]; if (F.tid == 0) *(int*)(F.ws + WS_ROUTE + RT_NTILE) = NT; }
    LAS int* slotL = texpL + 160;
    const unsigned char* hb8 = (const unsigned char*)(F.ws + WS_HB); unsigned char* hs8 = (unsigned char*)(F.ws + R_HS8);
    for (int tb = blockIdx.x; tb < 256; tb += F.G) {
        if (F.wave == 0) {
            const int tok = tb * 64 + F.lane;
            const int e0 = te[2 * tok], e1 = te[2 * tok + 1];
            const unsigned long long lt = (F.lane == 0) ? 0ull : (~0ull >> (64 - F.lane));
#pragma unroll
            for (int e = 0; e < NE; ++e) {
                float pf = 0.f;
#pragma unroll
                for (int q = 0; q < 4; ++q) { const int b = 4 * F.lane + q; pf += (b < tb) ? (float)cntL[b * 8 + e] : 0.f; }
                const int pre = (int)wave_sum(pf);
                const unsigned long long m0 = __ballot(e0 == e), m1 = __ballot(e1 == e);
                const int st = base[e] + pre;
                if (e0 == e) { const int s = st + __popcll(m0 & lt); rowidx[s] = tok; pos[2 * tok] = s; slotL[2 * F.lane] = s; }
                if (e1 == e) { const int s = st + __popcll(m0) + __popcll(m1 & lt); rowidx[s] = tok; pos[2 * tok + 1] = s; slotL[2 * F.lane + 1] = s; }
            }
        }
        __syncthreads();
        for (int idx = F.tid; idx < 128 * 128; idx += NWAVES * 64) { const int si = idx >> 7, ch = idx & 127;
            const v4u v = *(const v4u*)(hb8 + (size_t)(tb * 64 + (si >> 1)) * D + ch * 16);
            *(v4u*)(hs8 + (size_t)slotL[si] * D + ch * 16) = v; }
        __syncthreads();
    }
}
__device__ __forceinline__ void conv_phase(Frame& F) {
    const Args& A = *F.a;
    const bf16* z = (const bf16*)(F.ws + R_Z); bf16* mix = (bf16*)(F.ws + R_MIX);
    LAS unsigned char* gl = F.lds;
    LAS float* part = (LAS float*)(F.lds + 126976);
    LAS float* stat = part + 512;
    const int tid = F.tid, ch = 2 * tid;
    f32x2 wk[CONVW];
#pragma unroll
    for (int w = 0; w < CONVW; ++w) wk[w] = *(const f32x2*)(A.in[I_ECW] + w * CONVD + ch);
    const f32x2 cb = *(const f32x2*)(A.in[I_ECB] + ch), lg = *(const f32x2*)(A.in[I_ECG] + ch), lb = *(const f32x2*)(A.in[I_ECLB] + ch);
    for (int tile = blockIdx.x; tile < S / 32; tile += F.G) {
        const int t0 = tile * 32;
        for (int idx = tid; idx < 62 * 128; idx += NWAVES * 64) {
            const int row = idx >> 7, c8 = (idx & 127) * 8, t = t0 - 15 + row;
            v4u o = {0u, 0u, 0u, 0u};
            if (t >= 0 && t < S) {
                const v4u a = *(const v4u*)(z + (size_t)t * E_IN + c8), g = *(const v4u*)(z + (size_t)t * E_IN + CONVD + c8);
#pragma unroll
                for (int q = 0; q < 4; ++q) o[q] = pk2(bflo(a[q]) * fsigmoid(bflo(g[q])), bfhi(a[q]) * fsigmoid(bfhi(g[q])));
            }
            *(LAS v4u*)(gl + row * 2048 + c8 * 2) = o;
        }
        __syncthreads();
#pragma nounroll
        for (int half = 0; half < 2; ++half) {
            f32x2 ac[16];
#pragma unroll
            for (int i = 0; i < 16; ++i) ac[i] = cb;
            const LAS unsigned char* gh = gl + half * 16 * 2048 + tid * 4;
#pragma unroll
            for (int r = 0; r < 46; ++r) {
                const unsigned v = *(const LAS unsigned*)(gh + r * 2048);
                const f32x2 v2 = {bflo(v), bfhi(v)};
#pragma unroll
                for (int i = 0; i < 16; ++i) { if (r - i >= 0 && r - i < CONVW) ac[i] = __builtin_elementwise_fma(v2, wk[r - i], ac[i]); }
            }
            float a0[16], a1[16];
#pragma unroll
            for (int i = 0; i < 16; ++i) { a0[i] = ac[i][0]; a1[i] = ac[i][1]; }
#pragma unroll
            for (int i = 0; i < 16; ++i) {
                float s1 = a0[i] + a1[i], s2 = a0[i] * a0[i] + a1[i] * a1[i];
                s1 = wave_sum(s1); s2 = wave_sum(s2);
                if (F.lane == 0) { part[(F.wave * 16 + i) * 2] = s1; part[(F.wave * 16 + i) * 2 + 1] = s2; }
            }
            __syncthreads();
            if (tid < 16) { float s1 = 0.f, s2 = 0.f;
#pragma unroll
                for (int w = 0; w < NWAVES; ++w) { s1 += part[(w * 16 + tid) * 2]; s2 += part[(w * 16 + tid) * 2 + 1]; }
                const float mean = s1 * (1.0f / CONVD), var = fmaxf(s2 * (1.0f / CONVD) - mean * mean, 0.f);
                stat[tid * 2] = mean; stat[tid * 2 + 1] = 1.0f / sqrtf(var + 1e-5f); }
            __syncthreads();
#pragma unroll
            for (int i = 0; i < 16; ++i) {
                const float mean = stat[i * 2], rstd = stat[i * 2 + 1];
                const float y0 = (a0[i] - mean) * rstd * lg[0] + lb[0], y1 = (a1[i] - mean) * rstd * lg[1] + lb[1];
                *(unsigned*)(mix + (size_t)(t0 + half * 16 + i) * D + ch) = pk2(fsilu(y0), fsilu(y1));
            }
            __syncthreads();
        }
    }
}

__device__ __forceinline__ int t5_bucket_dev(int rel) {
    const int n = rel < 0 ? -rel : rel;
    int large = 8 + (int)(__logf((float)(n < 1 ? 1 : n) * 0.125f) / 4.852030263919617f * 8.0f);
    large = large < 15 ? large : 15;
    return (rel > 0 ? 16 : 0) + (n < 8 ? n : large);
}
__device__ __forceinline__ void latent_phase(Frame& F) {
    const Args& A = *F.a; const int lane = F.lane;
    const bf16* z1 = (const bf16*)(F.ws + R_Z1); bf16* cqn = (bf16*)(F.ws + R_CQN); bf16* ckvn = (bf16*)(F.ws + R_CKVN); bf16* kpe = (bf16*)(F.ws + R_KPE);
    const float* cosT = (const float*)(F.ws + WS_COS); const float* sinT = (const float*)(F.ws + WS_SIN);
    float qg[8]; { const f32x4 a = *(const f32x4*)(A.in[I_QNG] + 8 * lane), b = *(const f32x4*)(A.in[I_QNG] + 8 * lane + 4); qg[0] = a[0]; qg[1] = a[1]; qg[2] = a[2]; qg[3] = a[3]; qg[4] = b[0]; qg[5] = b[1]; qg[6] = b[2]; qg[7] = b[3]; }
    const f32x2 kg = *(const f32x2*)(A.in[I_KVNG] + 2 * lane);
    for (int row = F.gw; row < S; row += F.NGW) {
        const bf16* zr = z1 + (size_t)row * O_INP;
        const v4u q = *(const v4u*)(zr + 8 * lane);
        float v[8]; float ss = 0.f;
#pragma unroll
        for (int e = 0; e < 4; ++e) { v[2 * e] = bflo(q[e]); v[2 * e + 1] = bfhi(q[e]); ss += v[2 * e] * v[2 * e] + v[2 * e + 1] * v[2 * e + 1]; }
        const float r1 = 1.0f / sqrtf(wave_sum(ss) * (1.0f / QL) + 1e-6f);
        v4u o;
#pragma unroll
        for (int e = 0; e < 4; ++e) o[e] = pk2(v[2 * e] * r1 * qg[2 * e], v[2 * e + 1] * r1 * qg[2 * e + 1]);
        *(v4u*)(cqn + (size_t)row * QL + 8 * lane) = o;
        const unsigned kv = *(const unsigned*)(zr + 512 + 2 * lane);
        const float k0 = bflo(kv), k1 = bfhi(kv);
        const float r2 = 1.0f / sqrtf(wave_sum(k0 * k0 + k1 * k1) * (1.0f / KVL) + 1e-6f);
        *(unsigned*)(ckvn + (size_t)row * KVLP + 2 * lane) = pk2(k0 * r2 * kg[0], k1 * r2 * kg[1]);
        if (lane < 32) {
            const float x1 = bf1(zr[640 + lane]), x2 = bf1(zr[672 + lane]), cs = cosT[row * 32 + lane], sn = sinT[row * 32 + lane];
            kpe[(size_t)row * 64 + lane] = (bf16)f2bf(x1 * cs - x2 * sn); kpe[(size_t)row * 64 + 32 + lane] = (bf16)f2bf(x2 * cs + x1 * sn);
        }
    }
}

namespace s5 {
using bf16x8 = __attribute__((ext_vector_type(8))) short;
using f32x16 = __attribute__((ext_vector_type(16))) float;
constexpr int XS_ROW = 272;
constexpr int WAVE_LDS = 32 * XS_ROW + 2 * S5_CL * 16 * 2;
struct Par { float ar0, ai0, ar1, ai1, Lr0, Li0, Lr1, Li1; bf16x8 bt[4]; };
__device__ __forceinline__ void load_par(Frame& F, int dg, int n, int hb, Par& P) {
    const float* sp = (const float*)(F.ws + WS_S5P) + (size_t)dg * 36 * 64;
    P.ar0 = sp[n]; P.ai0 = sp[64 + n]; P.Lr0 = sp[128 + n]; P.Li0 = sp[192 + n];
    P.ar1 = sp[32 + n]; P.ai1 = sp[64 + 32 + n]; P.Lr1 = sp[128 + 32 + n]; P.Li1 = sp[192 + 32 + n];
#pragma unroll
    for (int t = 0; t < 4; ++t) { const float* b = sp + (size_t)((t < 2 ? 4 : 20) + 8 * hb) * 64 + 32 * (t & 1) + n;
        v4u w; w.x = pk2(b[0], b[64]); w.y = pk2(b[128], b[192]); w.z = pk2(b[256], b[320]); w.w = pk2(b[384], b[448]); P.bt[t] = __builtin_bit_cast(bf16x8, w); }
}
__device__ __forceinline__ int tok_of(int c0, int sp, int dir) { return dir ? (c0 + S5_CL - 1 - sp) : (c0 + sp); }
__device__ __forceinline__ void bu_block(Frame& F, const Par& P, int g, int ck, int blk, int dir, int lane, f32x16 (&D)[4]) {
    const bf16* z1 = (const bf16*)(F.ws + R_Z1);
    const int m = lane & 31, ha = lane >> 5, seg = (m >> 2) & 1, idx = 4 * (m >> 3) + (m & 3);
    const int t = tok_of((ck + 64 * seg) * S5_CL, 16 * blk + idx, dir);
    const bf16x8 ua = *(const bf16x8*)(z1 + (size_t)t * O_INP + 704 + g * 16 + 8 * ha);
#pragma unroll
    for (int q = 0; q < 4; ++q) D[q] = __builtin_amdgcn_mfma_f32_32x32x16_bf16(ua, P.bt[q], f32x16{}, 0, 0, 0);
}
__device__ __forceinline__ void scan16(const Par& P, f32x16 (&D)[4], float& x0r, float& x0i, float& x1r, float& x1i) {
#pragma unroll
    for (int r = 0; r < 16; ++r) {
        const float n0r = fmaf(P.ar0, x0r, fmaf(-P.ai0, x0i, D[0][r])), n0i = fmaf(P.ar0, x0i, fmaf(P.ai0, x0r, D[2][r]));
        const float n1r = fmaf(P.ar1, x1r, fmaf(-P.ai1, x1i, D[1][r])), n1i = fmaf(P.ar1, x1i, fmaf(P.ai1, x1r, D[3][r]));
        x0r = n0r; x0i = n0i; x1r = n1r; x1i = n1i; D[0][r] = n0r; D[2][r] = n0i; D[1][r] = n1r; D[3][r] = n1i; }
}
}

__device__ __forceinline__ void s5_pass1(Frame& F) {
    using namespace s5;
    float* E = (float*)(F.ws + WS_S5E);
    const int lane = F.lane, n = lane & 31, hd = lane >> 5;
    for (int task = F.gw; task < 32 * 64; task += F.NGW) {
        const int g = task >> 6, ck = task & 63;
        for (int dir = 0; dir < 2; ++dir) {
            Par P; load_par(F, dir * 32 + g, n, hd, P);
            float x0r = 0.f, x0i = 0.f, x1r = 0.f, x1i = 0.f;
            for (int blk = 0; blk < S5_CL / 16; ++blk) { f32x16 D[4]; bu_block(F, P, g, ck, blk, dir, lane, D); scan16(P, D, x0r, x0i, x1r, x1i); }
            float* e = E + ((size_t)((dir * 32 + g) * S5_NCH + ck + 64 * hd) * 2) * 64 + n;
            e[0] = x0r; e[64] = x0i; e[32] = x1r; e[96] = x1i;
        }
    }
}
__device__ __forceinline__ float gelu_tanh(float x) { const float u = 0.7978845608028654f * (x + 0.044715f * x * x * x); const float t = 1.0f - 2.0f * __builtin_amdgcn_rcpf(1.0f + fexp(2.0f * u)); return 0.5f * x * (1.0f + t); }
__device__ __forceinline__ void s5_pass3(Frame& F) {
    using namespace s5;
    const Args& A = *F.a;
    LAS unsigned char* xs = F.lds + F.wave * WAVE_LDS; LAS bf16* yfl = (LAS bf16*)(xs + 32 * XS_ROW);
    const float* E = (const float*)(F.ws + WS_S5E); bf16* YG = (bf16*)(F.ws + R_YG); const bf16* z1 = (const bf16*)(F.ws + R_Z1);
    const int lane = F.lane, n = lane & 31, hd = lane >> 5, cn = lane & 15, kq = lane >> 4;
    for (int task = F.gw; task < 32 * 64; task += F.NGW) {
        const int g = task >> 6, ck = task & 63, ckl = ck + 64 * hd;
        const float dsk = A.in[I_SD][g * 16 + cn];
        for (int dir = 0; dir < 2; ++dir) {
            const int dg = dir * 32 + g;
            Par P; load_par(F, dg, n, hd, P);
            float x0r = 0.f, x0i = 0.f, x1r = 0.f, x1i = 0.f;
            { const float* e = E + ((size_t)dg * S5_NCH * 2) * 64 + n; const int nprev = dir ? (S5_NCH - 1 - ckl) : ckl;
              const int nmax = dir ? (S5_NCH - 1 - ck) : (ck + 64);
              for (int j0 = 0; j0 < nmax; j0 += 8) {
                  float er0[8], ei0[8], er1[8], ei1[8];
#pragma unroll
                  for (int q = 0; q < 8; ++q) { const int jj = (j0 + q < nprev) ? (j0 + q) : 0; const int j = dir ? (S5_NCH - 1 - jj) : jj; const float* ej = e + (size_t)j * 128;
                      er0[q] = ej[0]; ei0[q] = ej[64]; er1[q] = ej[32]; ei1[q] = ej[96]; }
#pragma unroll
                  for (int q = 0; q < 8; ++q) { if (j0 + q < nprev) {
                      const float a = P.Lr0 * x0r - P.Li0 * x0i + er0[q], b = P.Lr0 * x0i + P.Li0 * x0r + ei0[q]; x0r = a; x0i = b;
                      const float c = P.Lr1 * x1r - P.Li1 * x1i + er1[q], d = P.Lr1 * x1i + P.Li1 * x1r + ei1[q]; x1r = c; x1i = d; } }
              } }
            bf16x8 Bc[4];
#pragma unroll
            for (int ks = 0; ks < 4; ++ks) { const int p0 = ks * 16 + kq * 4;
                const f32x4 cr = *(const f32x4*)(A.in[I_SCRE] + ((size_t)dg * 16 + cn) * 64 + p0), ci = *(const f32x4*)(A.in[I_SCIM] + ((size_t)dg * 16 + cn) * 64 + p0);
                v4u w; w.x = pk2(cr[0], -ci[0]); w.y = pk2(cr[1], -ci[1]); w.z = pk2(cr[2], -ci[2]); w.w = pk2(cr[3], -ci[3]); Bc[ks] = __builtin_bit_cast(bf16x8, w); }
            for (int blk = 0; blk < S5_CL / 16; ++blk) {
                f32x16 D[4]; bu_block(F, P, g, ck, blk, dir, lane, D); scan16(P, D, x0r, x0i, x1r, x1i);
#pragma unroll
                for (int r = 0; r < 16; ++r) { LAS unsigned char* row = xs + (16 * hd + r) * XS_ROW + 4 * n;
                    *(LAS unsigned*)row = pg8::cvt_pk_bf16(D[0][r], D[2][r]); *(LAS unsigned*)(row + 128) = pg8::cvt_pk_bf16(D[1][r], D[3][r]); }
#pragma unroll
                for (int sg = 0; sg < 2; ++sg) {
                    pg8::f32x4 acc = {0.f, 0.f, 0.f, 0.f};
#pragma unroll
                    for (int ks = 0; ks < 4; ++ks) { const bf16x8 af = *(const LAS bf16x8*)(xs + (16 * sg + cn) * XS_ROW + (ks * 32 + kq * 8) * 2);
                        acc = __builtin_amdgcn_mfma_f32_16x16x32_bf16(af, Bc[ks], acc, 0, 0, 0); }
#pragma unroll
                    for (int i = 0; i < 4; ++i) { const int sp = 16 * blk + 4 * kq + i; const int c0 = (ck + 64 * sg) * S5_CL; const int t = tok_of(c0, sp, dir), tl = t - c0;
                        if (dir == 0) yfl[(sg * S5_CL + tl) * 16 + cn] = (bf16)f2bf(acc[i]);
                        else { const float uu = bf1(z1[(size_t)t * O_INP + 704 + g * 16 + cn]); const float yv = acc[i] + bf1(yfl[(sg * S5_CL + tl) * 16 + cn]) + dsk * uu;
                            YG[(size_t)t * S5D + g * 16 + cn] = (bf16)f2bf(gelu_tanh(yv)); } }
                }
            }
        }
        LDS_WAIT();
    }
}
namespace dil {
using bf16x8 = __attribute__((ext_vector_type(8))) short;
using s16x4  = __attribute__((ext_vector_type(4))) short;
using f32x16 = __attribute__((ext_vector_type(16))) float;
using u32x4  = __attribute__((ext_vector_type(4))) unsigned;
constexpr int K_OFF = 0, V_OFF = 49152, BT_OFF = 98304, LI_OFF = 99328;
constexpr int NUNITS = 3 * 1024;
__device__ __forceinline__ int crow(int r, int hi) { return (r & 3) + 8 * (r >> 2) + 4 * hi; }
__device__ __forceinline__ unsigned cvtpk(float lo, float hi) { unsigned r; asm volatile("v_cvt_pk_bf16_f32 %0, %1, %2" : "=v"(r) : "v"(lo), "v"(hi)); return r; }
template <int OFF> __device__ __forceinline__ s16x4 tr_read(int vb) {
  s16x4 r; asm volatile("ds_read_b64_tr_b16 %0, %1 offset:%2" : "=&v"(r) : "v"(vb), "i"(OFF) : "memory"); return r;
}
struct UnitId { int c, d, r, qb, h, sub; };
__device__ __forceinline__ UnitId decode(int u) {
    UnitId U; U.c = u >> 10; const int rem = u & 1023; U.h = rem & 15; const int blk = rem >> 4;
    U.d = (U.c == 0) ? 1 : (U.c == 1) ? 4 : 16; U.sub = S / U.d; const int bpr = U.sub >> 8;
    U.r = blk / bpr; U.qb = blk - U.r * bpr; return U;
}
}

__device__ __forceinline__ void dilattn2_phase(Frame& F) {
    using namespace dil;
    const Args& A = *F.a;
    unsigned char* wsl = F.ws; int lane_l = F.lane, tid_l = F.tid; asm volatile("" : "+s"(wsl), "+v"(lane_l), "+v"(tid_l));
    const bf16* z = (const bf16*)(wsl + R_Z);
    bf16* PO = (bf16*)(wsl + R_PO); float* PML = (float*)(wsl + R_PML);
    LAS unsigned char* lds = F.lds;
    const int tid = tid_l, lane = lane_l, w = F.wave, r32 = lane & 31, hi = lane >> 5;
    for (int u = F.vcu; u < NUNITS; u += F.G) {
        const UnitId U = decode(u);
        const int d = U.d, h = U.h, sub = U.sub;
        {
            v4u kk[6], vv[6];
#pragma unroll
            for (int i = 0; i < 6; ++i) { const int idx = tid + 512 * i, key = idx >> 3, ch = idx & 7, sp = U.qb * 256 - 64 + key;
                kk[i] = (v4u){0u, 0u, 0u, 0u}; vv[i] = (v4u){0u, 0u, 0u, 0u};
                if (sp >= 0 && sp < sub) { const bf16* rp = z + ((size_t)sp * d + U.r) * E_IN + h * 64 + ch * 8; kk[i] = *(const v4u*)(rp + 3072); vv[i] = *(const v4u*)(rp + 4096); } }
#pragma unroll
            for (int i = 0; i < 6; ++i) { const int idx = tid + 512 * i, key = idx >> 3, ch = idx & 7;
                *(LAS v4u*)(lds + K_OFF + key * 128 + ((ch * 16) ^ (((key >> 1) & 7) << 4))) = kk[i];
                *(LAS v4u*)(lds + V_OFF + key * 128 + ((ch * 16) ^ (((key >> 1) & 1) << 6))) = vv[i]; }
            if (tid < 256) ((LAS float*)(lds + BT_OFF))[tid] = (tid >= 32 && tid < 161) ? A.in[I_T5][t5_bucket_dev(d * (tid - 96)) * DIL_H + h] * 1.4426950408889634f : -1e30f;
        }
        __syncthreads();
        f32x16 p[5];
        {
            const size_t qtok = (size_t)(U.qb * 256 + 32 * w + r32) * d + U.r;
            const bf16* qp = z + qtok * E_IN + 2048 + h * 64 + hi * 8;
            bf16x8 qf[4];
#pragma unroll
            for (int ks = 0; ks < 4; ++ks) qf[ks] = *(const bf16x8*)(qp + ks * 16);
            int ka[4];
#pragma unroll
            for (int ks = 0; ks < 4; ++ks) ka[ks] = K_OFF + (32 * w + r32) * 128 + ((ks * 32 + hi * 16) ^ (((r32 >> 1) & 7) << 4));
#pragma unroll
            for (int kt = 0; kt < 5; ++kt) { p[kt] = f32x16{};
#pragma unroll
                for (int ks = 0; ks < 4; ++ks) { const bf16x8 kf = *(const LAS bf16x8*)(lds + ka[ks] + kt * 4096); p[kt] = __builtin_amdgcn_mfma_f32_32x32x16_bf16(kf, qf[ks], p[kt], 0, 0, 0); } }
        }
        const int bidx = 4 * hi - r32;
        const int sp0 = U.qb * 256 + 32 * w - 64 + 4 * hi;
        const LAS float* btl = (const LAS float*)(lds + BT_OFF) + 32 + bidx;
        const bool edge = (U.qb * 256 + 32 * w - 64 < 0) || (U.qb * 256 + 32 * w + 96 > sub);
        constexpr float SC = 0.125f * 1.4426950408889634f;
#pragma unroll
        for (int kt = 0; kt < 5; ++kt)
#pragma unroll
            for (int rg = 0; rg < 16; ++rg) { const int cr = 32 * kt + (rg & 3) + 8 * (rg >> 2);
                float s = fmaf(p[kt][rg], SC, btl[cr]);
                p[kt][rg] = s; }
        if (edge) {
#pragma unroll
            for (int kt = 0; kt < 5; ++kt)
#pragma unroll
                for (int rg = 0; rg < 16; ++rg) { const int cr = 32 * kt + (rg & 3) + 8 * (rg >> 2); const int sp = sp0 + cr; p[kt][rg] = (sp >= 0 && sp < sub) ? p[kt][rg] : -1e30f; }
        }
        float m2 = p[0][0];
#pragma unroll
        for (int kt = 0; kt < 5; ++kt)
#pragma unroll
            for (int rg = 0; rg < 16; ++rg) m2 = fmaxf(m2, p[kt][rg]);
        { auto rr = __builtin_amdgcn_permlane32_swap(__float_as_uint(m2), __float_as_uint(m2), false, false); m2 = fmaxf(__uint_as_float(rr[0]), __uint_as_float(rr[1])); }
        float l = 0.f;
#pragma unroll
        for (int kt = 0; kt < 5; ++kt)
#pragma unroll
            for (int rg = 0; rg < 16; ++rg) { const float e = __builtin_amdgcn_exp2f(p[kt][rg] - m2); p[kt][rg] = e; l += e; }
        { auto rr = __builtin_amdgcn_permlane32_swap(__float_as_uint(l), __float_as_uint(l), false, false); l = __uint_as_float(rr[0]) + __uint_as_float(rr[1]); }
        f32x16 o0 = {}, o1 = {};
        {
            const int q = (lane >> 2) & 3, pp = lane & 3, nh = (lane >> 4) & 1, qb1 = (q >> 1) & 1;
            const int vrow = V_OFF + (32 * w + 8 * hi + q) * 128;
            const int vb0 = (int)(uintptr_t)lds + vrow + ((32 * nh + 8 * pp) ^ (qb1 << 6));
            const int vb1 = (int)(uintptr_t)lds + vrow + ((64 + 32 * nh + 8 * pp) ^ (qb1 << 6));
#define DIL_PK4(P, BASE, OUT) do { unsigned a0 = cvtpk(P[BASE + 0], P[BASE + 1]), a1 = cvtpk(P[BASE + 2], P[BASE + 3]); unsigned b0 = cvtpk(P[BASE + 4], P[BASE + 5]), b1 = cvtpk(P[BASE + 6], P[BASE + 7]); \
    auto r0 = __builtin_amdgcn_permlane32_swap(a0, b0, false, false); auto r1 = __builtin_amdgcn_permlane32_swap(a1, b1, false, false); \
    u32x4 wv = {r0[0], r1[0], r0[1], r1[1]}; OUT = *reinterpret_cast<bf16x8*>(&wv); } while (0)
#define DIL_PK(L, H) (bf16x8){L[0], L[1], L[2], L[3], H[0], H[1], H[2], H[3]}
#define DIL_PV(KT) do { bf16x8 pa0, pa1; DIL_PK4(p[KT], 0, pa0); DIL_PK4(p[KT], 8, pa1); \
    const s16x4 l00 = tr_read<(KT) * 4096>(vb0), h00 = tr_read<(KT) * 4096 + 512>(vb0), l01 = tr_read<(KT) * 4096>(vb1), h01 = tr_read<(KT) * 4096 + 512>(vb1); \
    const s16x4 l10 = tr_read<(KT) * 4096 + 2048>(vb0), h10 = tr_read<(KT) * 4096 + 2048 + 512>(vb0), l11 = tr_read<(KT) * 4096 + 2048>(vb1), h11 = tr_read<(KT) * 4096 + 2048 + 512>(vb1); \
    asm volatile("s_waitcnt lgkmcnt(0)" ::: "memory"); __builtin_amdgcn_sched_barrier(0); \
    o0 = __builtin_amdgcn_mfma_f32_32x32x16_bf16(pa0, DIL_PK(l00, h00), o0, 0, 0, 0); o1 = __builtin_amdgcn_mfma_f32_32x32x16_bf16(pa0, DIL_PK(l01, h01), o1, 0, 0, 0); \
    o0 = __builtin_amdgcn_mfma_f32_32x32x16_bf16(pa1, DIL_PK(l10, h10), o0, 0, 0, 0); o1 = __builtin_amdgcn_mfma_f32_32x32x16_bf16(pa1, DIL_PK(l11, h11), o1, 0, 0, 0); } while (0)
            DIL_PV(0); DIL_PV(1); DIL_PV(2); DIL_PV(3); DIL_PV(4);
#undef DIL_PV
#undef DIL_PK
#undef DIL_PK4
        }
        LAS float* li = (LAS float*)(lds + LI_OFF) + w * 32;
        if (hi == 0) { li[r32] = l;
            const size_t tok = (size_t)(U.qb * 256 + 32 * w + r32) * d + U.r;
            *(f32x2*)(PML + (((size_t)U.c * S + tok) * DIL_H + h) * 2) = (f32x2){m2 * 0.6931471805599453f, l}; }
        LDS_WAIT();
#pragma unroll
        for (int rg = 0; rg < 16; ++rg) { const int qi = crow(rg, hi); const float rl = __builtin_amdgcn_rcpf(li[qi]);
            const size_t tok = (size_t)(U.qb * 256 + 32 * w + qi) * d + U.r;
            bf16* op = PO + ((size_t)U.c * S + tok) * 1024 + h * 64 + r32;
            op[0] = (bf16)f2bf(o0[rg] * rl); op[32] = (bf16)f2bf(o1[rg] * rl); }
        __syncthreads();
    }
}
__device__ __forceinline__ void dil_combine_phase(Frame& F) {
    const bf16* PO = (const bf16*)(F.ws + R_PO); const float* PML = (const float*)(F.ws + R_PML); bf16* mix = (bf16*)(F.ws + R_MIX);
    for (int idx = F.gw * 64 + F.lane; idx < S * 128; idx += F.NGW * 64) {
        const int tok = idx >> 7, ch = idx & 127, h = ch >> 3;
        f32x2 ml[3]; v4u ov[3];
#pragma unroll
        for (int c = 0; c < 3; ++c) { ml[c] = *(const f32x2*)(PML + (((size_t)c * S + tok) * DIL_H + h) * 2); ov[c] = *(const v4u*)(PO + ((size_t)c * S + tok) * 1024 + ch * 8); }
        const float M = fmaxf(ml[0][0], fmaxf(ml[1][0], ml[2][0]));
        float wc[3], ws = 0.f;
#pragma unroll
        for (int c = 0; c < 3; ++c) { wc[c] = ml[c][1] * fexp(ml[c][0] - M); ws += wc[c]; }
        const float rw = 1.0f / ws;
        v4u o;
#pragma unroll
        for (int e = 0; e < 4; ++e) { float a = 0.f, b = 0.f;
#pragma unroll
            for (int c = 0; c < 3; ++c) { a += wc[c] * bflo(ov[c][e]); b += wc[c] * bfhi(ov[c][e]); }
            o[e] = pk2(a * rw, b * rw); }
        *(v4u*)(mix + (size_t)tok * D + 1024 + ch * 8) = o;
    }
}
#ifndef MK_N_LAUNCHES
#define MK_N_LAUNCHES 1
#endif
constexpr int NPH = 20;
__global__ void __launch_bounds__(NWAVES * 64, 2) mk_fwd(Args args) {
    extern __shared__ __attribute__((aligned(16))) unsigned char lds_raw[];
    Frame F;
    F.lds = (LAS unsigned char*)lds_raw; F.a = &args; F.ws = args.ws;
    F.tid = threadIdx.x; F.lane = F.tid & 63; F.wave = __builtin_amdgcn_readfirstlane(F.tid >> 6);
    F.G = gridDim.x; { const int bx = blockIdx.x; F.vcu = (F.G % 8 == 0) ? (bx % 8) * (F.G / 8) + bx / 8 : bx; }
    F.gw = F.vcu * NWAVES + F.wave; F.NGW = F.G * NWAVES;
    volatile LAS unsigned* MISC = (volatile LAS unsigned*)(F.lds + MISC_OFF);
    for (int u = F.tid; u < 128; u += NWAVES * 64) MISC[u] = 0u;
    __syncthreads();
    XcdBarrier bar; bar.bar = (unsigned*)(F.ws + WS_CTL) + CW_BAR; bar.x = 0; bar.st = nullptr;
    if (MK_N_LAUNCHES == 1) bar = xcd_barrier_post((unsigned*)(F.ws + WS_CTL) + CW_BAR, MISC + 8);
    const int lo = args.ph_lo, hi = args.ph_hi;
#ifndef PH_MASK
#define PH_MASK 0xFFFFFFFFu
#endif
#define IN(k) (((PH_MASK >> (k)) & 1u) && lo <= (k) && (k) < hi)
#ifndef PH_TWICE
#define PH_TWICE 0u
#endif
#define TW(k) (((PH_TWICE >> (k)) & 1u) != 0u)
#define REP(k)
#define RB(k)
#define REFRESH() do { int t_ = (int)threadIdx.x; asm volatile("" : "+v"(t_)); F.tid = t_; F.lane = t_ & 63; } while (0)
#ifdef SPREAD_MASK
#define SEAM(k) do { if (IN(k) && IN((k) + 1)) { __syncthreads(); unsigned long long* W_ = (unsigned long long*)(F.ws + WS_CTL + 131072) + 4 * (k); \
        if (threadIdx.x == 0 && ((SPREAD_MASK >> (k)) & 1u)) { const unsigned long long t_ = __builtin_amdgcn_s_memrealtime(); atomicMax(W_, t_); atomicAdd(W_ + 1, t_); } \
        xcd_barrier(bar); \
        if (threadIdx.x == 0 && ((SPREAD_MASK >> (k)) & 1u)) { const unsigned long long t0_ = __builtin_amdgcn_s_memrealtime(); \
            const unsigned long long mx_ = __hip_atomic_load(W_, __ATOMIC_RELAXED, __HIP_MEMORY_SCOPE_AGENT), sm_ = __hip_atomic_load(W_ + 1, __ATOMIC_RELAXED, __HIP_MEMORY_SCOPE_AGENT); \
            const long long d_ = (long long)(mx_ - sm_ / (unsigned long long)F.G) * SPREAD_MULT; \
            while ((long long)(__builtin_amdgcn_s_memrealtime() - t0_) < d_) __builtin_amdgcn_s_sleep(8); } \
        __syncthreads(); } else __syncthreads(); } while (0)
#elif defined(DOUBLE_BARRIERS)
#define SEAM(k) do { if (IN(k) && IN((k) + 1)) { xcd_barrier(bar); xcd_barrier(bar); } else __syncthreads(); } while (0)
#else
#define SEAM(k) do { if (IN(k) && IN((k) + 1)) xcd_barrier(bar); else __syncthreads(); } while (0)
#endif
    typedef pg8::bf16_t b16;
    const float* x_in = args.in[I_X]; float* xo = args.out;
    b16* Y = (b16*)(F.ws + WS_Y); b16* HB = (b16*)(F.ws + WS_HB); b16* XB = (b16*)(F.ws + WS_XB);
    const int bid = (int)blockIdx.x;

    if (IN(0)) REP(0) { REFRESH(); p0_prologue(F); RB(0); } SEAM(0);
    if (IN(1)) { REFRESH(); resnorm_phase<false, true, false, false>(F, x_in, nullptr, nullptr, 0, 0, 0, 0, 0, 0); } SEAM(1);
    if (IN(2)) REP(2) { REFRESH(); pg8::Gemm g{HB, (const b16*)(F.ws + WB_EIN), D}; pg8::StaticOrder so; so.init(S / 256, E_IN / 256, F.G, bid);
        pg8::EpiBf16 E{(b16*)(F.ws + R_Z), E_IN}; pg8::gemm_phase(F.lds, g, so, E); RB(2); } SEAM(2);
    if (IN(3)) REP(3) { REFRESH(); conv_phase(F); __syncthreads(); dilattn2_phase(F); RB(3); } SEAM(3);
    if (IN(4)) REP(4) { REFRESH(); dil_combine_phase(F); RB(4); } SEAM(4);
    if (IN(5)) REP(5) { REFRESH(); pg8::Gemm g{(const b16*)(F.ws + R_MIX), (const b16*)(F.ws + WB_EOUT), D}; pg8::StaticOrder so; so.init(S / 256, D / 256, F.G, bid);
        pg8::EpiBf16 E{Y, D}; pg8::gemm_phase(F.lds, g, so, E); RB(5); } SEAM(5);
    if (IN(6)) { REFRESH(); resnorm_phase<true, true, false, false, false, true>(F, x_in, XB, Y, 0, 2, 1, 0, 3, 2); } SEAM(6);
    if (IN(7)) REP(7) { REFRESH(); pg8::Gemm g{HB, (const b16*)(F.ws + WB_EF13), D}; pg8::StaticOrder so; so.init(S / 256, 2 * FD / 256, F.G, bid);
        pg8::EpiSwiGLU E{(b16*)(F.ws + R_ACT), FD}; pg8::gemm_phase(F.lds, g, so, E); RB(7); } SEAM(7);
    if (IN(8)) REP(8) { REFRESH(); pg8::Gemm g{(const b16*)(F.ws + R_ACT), (const b16*)(F.ws + WB_EF2), FD}; pg8::StaticOrder so; so.init(S / 256, D / 256, F.G, bid);
        pg8::EpiBf16 E{Y, D}; pg8::gemm_phase(F.lds, g, so, E); RB(8); } SEAM(8);
    if (IN(9)) { REFRESH(); resnorm_phase<true, true, false, false, true, true>(F, XB, XB, Y, 0, 5, 3, 1, 0, 0); } SEAM(9);
    if (IN(10)) REP(10) { REFRESH(); pg8::Gemm g{HB, (const b16*)(F.ws + WB_OIN), D}; pg8::StaticOrder so; so.init(S / 256, O_INP / 256, F.G, bid);
        pg8::EpiBf16 E{(b16*)(F.ws + R_Z1), O_INP}; pg8::gemm_phase(F.lds, g, so, E); RB(10); } SEAM(10);
    if (IN(11)) REP(11) { REFRESH(); latent_phase(F); s5_pass1(F); RB(11); } SEAM(11);
    if (IN(12)) REP(12) { REFRESH();
        { pg8::Gemm g{(const b16*)(F.ws + R_CQN), (const b16*)(F.ws + WB_UQ), QL}; pg8::StaticOrder so; so.init(S / 256, NQ / 256, F.G, bid);
          pg8::EpiBf16 E{(b16*)(F.ws + R_Q), NQ, mla2::SCALE * 1.4426950408889634f}; pg8::gemm_phase(F.lds, g, so, E); }
        { int kvk = KVLP; asm volatile("" : "+s"(kvk));
          pg8::Gemm g{(const b16*)(F.ws + R_CKVN), (const b16*)(F.ws + WB_UKV), kvk}; pg8::StaticOrder so; so.init(S / 256, NKV / 256, F.G, bid);
          pg8::EpiBf16 E{(b16*)(F.ws + R_KV), NKV}; pg8::gemm_phase(F.lds, g, so, E); }
        __syncthreads();
        s5_pass3(F);
    RB(12); } SEAM(12);
    if (IN(13)) REP(13) { REFRESH();
        mla2::CvJob J{args.in[I_M1], args.in[I_M3], args.in[I_M2], (unsigned char*)(F.ws + WB_M13), (unsigned char*)(F.ws + WB_M2), MOE_WSCALE, F.gw, F.NGW};
        for (int u = F.vcu; u < 12 * (S / 256); u += F.G) { const int h = u >> 6, qb = u & 63;
            static_assert(mla2::OFF_BADFLAG == MISC_OFF + 96, "bad-unit flag = control word 24");
            if (!mla2::attn_unit<true>((const unsigned short*)(F.ws + R_Q), (const unsigned short*)(F.ws + R_KV), (const unsigned short*)(F.ws + R_KPE),
                           (const float*)(F.ws + WS_COS), (const float*)(F.ws + WS_SIN), (unsigned short*)(F.ws + R_MIX2), h, qb * 256, S, (char*)lds_raw, J)) {
                if (F.tid == 0) MISC[24] = 0u;
                __syncthreads();
                mla2::attn_unit<false>((const unsigned short*)(F.ws + R_Q), (const unsigned short*)(F.ws + R_KV), (const unsigned short*)(F.ws + R_KPE),
                           (const float*)(F.ws + WS_COS), (const float*)(F.ws + WS_SIN), (unsigned short*)(F.ws + R_MIX2), h, qb * 256, S, (char*)lds_raw, J); } }
        while (J.next < mla2::CV_NG) { float cvr[16]; unsigned char* cvd; mla2::cv_issue(J, F.lane, cvr, cvd); asm volatile("s_waitcnt vmcnt(0)" ::: "memory"); mla2::cv_landed(cvr); mla2::cv_finish(J, cvr, cvd, F.lane); J.next += J.stride; }
        for (;;) {
            __syncthreads();
            if (F.tid == 0) MISC[17] = atomicAdd((unsigned*)(F.ws + WS_CTL) + CW_GLUCTR, 1u);
            __syncthreads();
            const int gu = (int)__builtin_amdgcn_readfirstlane(MISC[17]);
            if (gu >= (S / 256) * (S5D / 256)) break;
            pg8::Gemm g{(const b16*)(F.ws + R_YG), (const b16*)(F.ws + WB_GLU), S5D}; pg8::FixedUnit so{gu >> 1, gu & 1, nullptr};
            pg8::EpiGate E{(const b16*)(F.ws + R_YG), S5D, (b16*)(F.ws + R_MIX2), D, 1536}; pg8::gemm_phase(F.lds, g, so, E);
        }
    RB(13); } SEAM(13);
    if (IN(14)) REP(14) { REFRESH(); pg8::Gemm g{(const b16*)(F.ws + R_MIX2), (const b16*)(F.ws + WB_OOUT), D}; pg8::StaticOrder so; so.init(S / 256, D / 256, F.G, bid);
        pg8::EpiBf16 E{Y, D}; pg8::gemm_phase(F.lds, g, so, E); RB(14); } SEAM(14);
    if (IN(15)) { REFRESH(); resnorm_phase<true, true, true, false, true, true>(F, XB, XB, Y, 1, 2, 1, 1, 3, 2); } SEAM(15);
    if (IN(16)) REP(16) { REFRESH(); moe_slots_phase(F); RB(16); } SEAM(16);
    if (IN(17)) REP(17) { REFRESH(); const int nt = __builtin_amdgcn_readfirstlane(*(const int*)(F.ws + WS_ROUTE + RT_NTILE));
        pg8::Gemm g{(const void*)(F.ws + R_HS8), (const void*)(F.ws + WB_M13), D}; pg8::StaticOrder so; so.init(nt, 2 * FE / 256, F.G, bid);
        so.texp = (const int*)(F.ws + WS_ROUTE + RT_TEXP); so.estride = (size_t)2 * FE * D;
        pg8::EpiSwiGLU8 E{(unsigned char*)(F.ws + R_ACTS), FE, 1.0f / (MOE_WSCALE * MOE_HSCALE), MOE_ASCALE}; pg8::gemm_phase<true, false>(F.lds, g, so, E); RB(17); } SEAM(17);
    if (IN(18)) REP(18) { REFRESH(); const int nt = __builtin_amdgcn_readfirstlane(*(const int*)(F.ws + WS_ROUTE + RT_NTILE)); int nfull, sp; moe_tail_plan(nt, nfull, sp);
        { pg8::Gemm g{(const void*)(F.ws + R_ACTS), (const void*)(F.ws + WB_M2), FE}; pg8::StaticOrder so; so.init(nfull, D / 256, F.G, bid);
          so.texp = (const int*)(F.ws + WS_ROUTE + RT_TEXP); so.estride = (size_t)D * FE;
          pg8::EpiFp8 E{(unsigned char*)(F.ws + R_YS), D, MOE_YSCALE / (MOE_WSCALE * MOE_ASCALE)}; pg8::gemm_phase<true, false>(F.lds, g, so, E); }
        if (sp > 1) {
          pg8::Gemm g{(const void*)(F.ws + R_ACTS), (const void*)(F.ws + WB_M2), FE, FE / sp}; pg8::SplitOrder so; so.init(nfull, nt - nfull, sp, D / 256, F.G, F.vcu, (size_t)(FE / sp));
          so.texp = (const int*)(F.ws + WS_ROUTE + RT_TEXP); so.estride = (size_t)D * FE;
          pg8::EpiBf16S E{(b16*)(F.ws + R_YT), D, nfull, (size_t)(nt - nfull) * 256 * D, 1.0f / (MOE_WSCALE * MOE_ASCALE)}; pg8::gemm_phase<true, false>(F.lds, g, so, E); }
        RB(18); } SEAM(18);
    if (IN(19)) { REFRESH(); resnorm_phase<true, false, false, true, true, false>(F, XB, xo, nullptr, 1, 5, 3, 0, 0, 0); }
#undef IN
#undef SEAM
}

extern "C" void kernel_launch(void* const* d_in, const int* in_sizes, int n_in, void* d_out, int out_size, void* d_ws, size_t ws_size, hipStream_t stream) {
    static int grid = 0;
    if (grid == 0) {
        if (n_in != 34 || out_size != S * D || ws_size < WS_END) { fprintf(stderr, "kernel_launch: unexpected shapes: n_in %d out %d ws %zu (need %zu)\n", n_in, out_size, ws_size, (size_t)WS_END); grid = -1; return; }
        int dev = 0, cus = 0, per_cu = 0;
        if (hipGetDevice(&dev) != hipSuccess || hipDeviceGetAttribute(&cus, hipDeviceAttributeMultiprocessorCount, dev) != hipSuccess) { grid = -1; return; }
        if (hipFuncSetAttribute((const void*)mk_fwd, hipFuncAttributeMaxDynamicSharedMemorySize, LDS_BYTES) != hipSuccess) { fprintf(stderr, "kernel_launch: hipFuncSetAttribute failed\n"); grid = -1; return; }
        if (hipOccupancyMaxActiveBlocksPerMultiprocessor(&per_cu, (const void*)mk_fwd, NWAVES * 64, LDS_BYTES) != hipSuccess || per_cu < 1) { fprintf(stderr, "kernel_launch: note: occupancy query says %d\n", per_cu); (void)hipGetLastError(); }
        grid = cus;
    }
    if (grid < 0) return;
    if (hipMemsetAsync((char*)d_ws + WS_CTL, 0, CTL_ZERO_BYTES, stream) != hipSuccess) return;
    Args a{};
    for (int i = 0; i < 34; ++i) a.in[i] = (const float*)d_in[i];
    a.out = (float*)d_out; a.ws = (unsigned char*)d_ws;
#if MK_N_LAUNCHES == 1
    a.ph_lo = 0; a.ph_hi = NPH;
    hipLaunchKernelGGL(mk_fwd, dim3(grid), dim3(NWAVES * 64), LDS_BYTES, stream, a);
#else
    for (int p = 0; p < NPH; ++p) { a.ph_lo = p; a.ph_hi = p + 1; hipLaunchKernelGGL(mk_fwd, dim3(grid), dim3(NWAVES * 64), LDS_BYTES, stream, a);
        if (TW(p)) hipLaunchKernelGGL(mk_fwd, dim3(grid), dim3(NWAVES * 64), LDS_BYTES, stream, a); }
#endif
}
```
